# Optimizing an MI355X kernel written in HIP

```python
import jax
import jax.numpy as jnp
from jax import lax
import numpy as np

D_MODEL = 1024
BATCH = 16
SEQ = 256
DEPTH = 4
DEC_BATCH = 2
DEC_SEQ = 1024
PAST_LEN = 256

GRID_W = 64
EPS = 1e-6
QBLOCK = 128
ROPE_BASE = 10000.0
H_A = 8
NOPE_DIM = 64
ROPE_DIM = 32
V_DIM = 64
QK_DIM = NOPE_DIM + ROPE_DIM
Q_RANK = 256
KV_RANK = 128
W_A = H_A * V_DIM
H_B = 4
DH_B = 128
W_B = H_B * DH_B
CHUNK = 64
W_C = 512
CONV_W = 3
H_D = 8
DH_D = 64
W_D = H_D * DH_D
WIN_R = 8
WIN_C = 16
EVEN_SPLITS = (Q_RANK, KV_RANK, ROPE_DIM, W_A, W_B, W_B, W_B, 2 * H_B, 2 * H_B, W_B, W_B)
EVEN_IN = Q_RANK + KV_RANK + ROPE_DIM + W_A + 5 * W_B + 4 * H_B
ODD_SPLITS = (W_C, W_C, W_C, W_C, W_D, W_D, W_D, W_D)
ODD_IN = 4 * W_C + 4 * W_D

kernel_name = 'hybrid_mla_mlstm_conv_natten_diffusion_step'


def rms_norm(x, g):
    xf = x.astype(jnp.float32)
    y = xf * lax.rsqrt(jnp.mean(xf * xf, axis=-1, keepdims=True) + EPS)
    return (y * g.astype(jnp.float32)).astype(x.dtype)


def split_cols(u, sizes):
    out, start = [], 0
    for sz in sizes:
        out.append(u[..., start:start + sz])
        start += sz
    return out


def modulation(cond, w, b):
    mod = jax.nn.silu(cond) @ w + b
    shift, scale, gate = jnp.split(mod[:, None, :], 3, axis=-1)
    return shift, scale, gate


def _rotate_half(x, ang):
    cos = jnp.cos(ang)[None, :, None, :].astype(x.dtype)
    sin = jnp.sin(ang)[None, :, None, :].astype(x.dtype)
    x1, x2 = jnp.split(x, 2, axis=-1)
    return jnp.concatenate([x1 * cos - x2 * sin, x1 * sin + x2 * cos], axis=-1)


def axial_rope(x):
    n_tok = x.shape[1]
    t = jnp.arange(n_tok)
    row = (t // GRID_W).astype(jnp.float32)
    col = (t % GRID_W).astype(jnp.float32)
    nf = ROPE_DIM // 4
    inv = ROPE_BASE ** (-jnp.arange(nf, dtype=jnp.float32) / nf)
    xr, xc = jnp.split(x, 2, axis=-1)
    return jnp.concatenate([_rotate_half(xr, row[:, None] * inv), _rotate_half(xc, col[:, None] * inv)], axis=-1)


def rope_tail(x):
    return jnp.concatenate([x[..., :NOPE_DIM], axial_rope(x[..., NOPE_DIM:])], axis=-1)


def block_attention(q, k, v):
    b, sq, h, d = q.shape
    nb = sq // QBLOCK
    scale = d ** -0.5
    qb = jnp.moveaxis(q.reshape(b, nb, QBLOCK, h, d), 1, 0)

    def one_block(qblk):
        s = jnp.einsum('bqhd,bkhd->bhqk', qblk, k, preferred_element_type=jnp.float32) * scale
        p = jax.nn.softmax(s, axis=-1).astype(v.dtype)
        return jnp.einsum('bhqk,bkhd->bqhd', p, v)

    out = lax.map(one_block, qb)
    return jnp.moveaxis(out, 0, 1).reshape(b, sq, h, v.shape[-1])


def mla_keys_values(ckv, kpe, w_kv_b, k_norm):
    b, s, _ = ckv.shape
    kv = (ckv @ w_kv_b).reshape(b, s, H_A, NOPE_DIM + V_DIM)
    k_nope, v = kv[..., :NOPE_DIM], kv[..., NOPE_DIM:]
    k_pe = jnp.broadcast_to(kpe[:, :, None, :], (b, s, H_A, ROPE_DIM))
    k = rms_norm(jnp.concatenate([k_nope, k_pe], axis=-1), k_norm)
    return k, v


def mlstm_chunkwise(q, k, v, i_pre, f_pre, C0, n0, m0):
    b, s, h, d = q.shape
    nc = s // CHUNK

    def chunks(a):
        return jnp.moveaxis(a.reshape((b, nc, CHUNK) + a.shape[2:]), (1, 3), (0, 2))

    xs = (chunks(q), chunks(k * (d ** -0.5)), chunks(v), chunks(i_pre), chunks(jax.nn.log_sigmoid(f_pre)))
    tri = jnp.tril(jnp.ones((CHUNK, CHUNK), dtype=bool))

    def step(carry, inp):
        C, n, m = carry
        qc, kc, vc, ic, lf = inp
        cum = jnp.cumsum(lf, axis=-1)
        inter = cum + m[..., None]
        dmat = jnp.where(tri, cum[..., :, None] - cum[..., None, :] + ic[..., None, :], -jnp.inf)
        m_t = jnp.maximum(inter, jnp.max(dmat, axis=-1))
        w_inter = jnp.exp(inter - m_t)
        sc = jnp.einsum('bhtd,bhsd->bhts', qc, kc) * jnp.exp(dmat - m_t[..., None])
        num = w_inter[..., None] * jnp.einsum('bhtd,bhde->bhte', qc, C) + jnp.einsum('bhts,bhse->bhte', sc, vc)
        qn = w_inter * jnp.einsum('bhtd,bhd->bht', qc, n) + jnp.sum(sc, axis=-1)
        h_out = num / jnp.maximum(jnp.abs(qn), jnp.exp(-m_t))[..., None]
        cum_last = cum[..., -1]
        dec = cum_last[..., None] - cum + ic
        m_new = jnp.maximum(cum_last + m, jnp.max(dec, axis=-1))
        w_state = jnp.exp(cum_last + m - m_new)
        wk = jnp.exp(dec - m_new[..., None])
        C_new = w_state[..., None, None] * C + jnp.einsum('bhs,bhsd,bhse->bhde', wk, kc, vc)
        n_new = w_state[..., None] * n + jnp.einsum('bhs,bhsd->bhd', wk, kc)
        return (C_new, n_new, m_new), h_out

    final, hs = lax.scan(step, (C0, n0, m0), xs)
    h_seq = jnp.moveaxis(hs, (0, 2), (1, 3)).reshape(b, s, h, d)
    return final, h_seq


def mlstm_bidirectional(q, k, v, i_pre, f_pre, C0, n0, m0):
    dt = q.dtype
    q, k, v, i_pre, f_pre = (a.astype(jnp.float32) for a in (q, k, v, i_pre, f_pre))
    C0, n0, m0 = (a.astype(jnp.float32) for a in (C0, n0, m0))
    (Cf, nf, mf), h_f = mlstm_chunkwise(q, k, v, i_pre[:, :, 0], f_pre[:, :, 0], C0[:, 0], n0[:, 0], m0[:, 0])

    def flip(a):
        return jnp.flip(a, axis=1)

    (Cb, nb, mb), h_b = mlstm_chunkwise(flip(q), flip(k), flip(v), flip(i_pre[:, :, 1]), flip(f_pre[:, :, 1]),
                                        C0[:, 1], n0[:, 1], m0[:, 1])
    h = (h_f + flip(h_b)).astype(dt)
    return h, jnp.stack([Cf, Cb], axis=1), jnp.stack([nf, nb], axis=1), jnp.stack([mf, mb], axis=1)


def short_conv(u, w, bias):
    up = jnp.pad(u, ((0, 0), (1, 1), (0, 0)))
    return up[:, :-2] * w[0] + up[:, 1:-1] * w[1] + up[:, 2:] * w[2] + bias


def neighbourhood_attention(q, k, v, k_ctx, v_ctx, rpb):
    b, n, h, d = q.shape
    rows = n // GRID_W
    kr = min(WIN_R, rows)
    scale = d ** -0.5
    r = jnp.arange(rows)
    band = jnp.clip(r - kr // 2, 0, rows - kr)[:, None] + jnp.arange(kr)[None, :]
    col = jnp.arange(GRID_W)
    c0 = jnp.clip(col - WIN_C // 2, 0, GRID_W - WIN_C)
    col_ok = (col[None, :] >= c0[:, None]) & (col[None, :] < c0[:, None] + WIN_C)
    dr = band - r[:, None] + (WIN_R - 1)
    dc = jnp.clip(col[None, :] - col[:, None], -(WIN_C - 1), WIN_C - 1) + (WIN_C - 1)
    bias = rpb[:, dr[:, None, :, None], dc[None, :, None, :]].astype(jnp.float32)
    qg = q.reshape(b, rows, GRID_W, h, d)
    kg = k.reshape(b, rows, GRID_W, h, d)[:, band]
    vg = v.reshape(b, rows, GRID_W, h, d)[:, band].reshape(b, rows, kr * GRID_W, h, d)
    s_win = jnp.einsum('brqhd,brkwhd->bhrqkw', qg, kg, preferred_element_type=jnp.float32) * scale + bias[None]
    s_win = jnp.where(col_ok[None, None, None, :, None, :], s_win, -jnp.inf).reshape(b, h, rows, GRID_W, kr * GRID_W)
    s_ctx = jnp.einsum('brqhd,bkhd->bhrqk', qg, k_ctx, preferred_element_type=jnp.float32) * scale
    p = jax.nn.softmax(jnp.concatenate([s_win, s_ctx], axis=-1), axis=-1).astype(v.dtype)
    p_win, p_ctx = p[..., :kr * GRID_W], p[..., kr * GRID_W:]
    out = jnp.einsum('bhrqk,brkhd->brqhd', p_win, vg) + jnp.einsum('bhrqk,bkhd->brqhd', p_ctx, v_ctx)
    return out.reshape(b, n, h, d)


def even_mixer(h, lp, ctx=None):
    b, s, _ = h.shape
    qa, kva, kpe, g_a, q_m, k_m, v_m, i_m, f_m, o_m, g_m = split_cols(h @ lp['w_in'], EVEN_SPLITS)
    q = rms_norm((rms_norm(qa, lp['q_a_norm']) @ lp['w_q_b']).reshape(b, s, H_A, QK_DIM), lp['q_norm'])
    ckv = rms_norm(kva, lp['kv_a_norm'])
    k, v = mla_keys_values(ckv, kpe, lp['w_kv_b'], lp['k_norm'])
    i_pre = i_m.reshape(b, s, 2, H_B) + lp['b_i']
    f_pre = f_m.reshape(b, s, 2, H_B) + lp['b_f']
    if ctx is None:
        C0 = jnp.zeros((b, 2, H_B, DH_B, DH_B), jnp.float32)
        n0 = jnp.zeros((b, 2, H_B, DH_B), jnp.float32)
        m0 = jnp.zeros((b, 2, H_B), jnp.float32)
    else:
        ckv_c, kpe_c, C0, n0, m0 = ctx
        q, k = rope_tail(q), rope_tail(k)
        k_c, v_c = mla_keys_values(ckv_c, kpe_c, lp['w_kv_b'], lp['k_norm'])
        k = jnp.concatenate([k_c, k], axis=1)
        v = jnp.concatenate([v_c, v], axis=1)
    att = block_attention(q, k, v).reshape(b, s, W_A) * jax.nn.silu(g_a)
    hm, C_fin, n_fin, m_fin = mlstm_bidirectional(
        q_m.reshape(b, s, H_B, DH_B), k_m.reshape(b, s, H_B, DH_B), v_m.reshape(b, s, H_B, DH_B),
        i_pre, f_pre, C0, n0, m0)
    hm = rms_norm(hm, lp['h_norm'].reshape(H_B, DH_B)).reshape(b, s, W_B)
    hm = hm * jax.nn.sigmoid(o_m) * jax.nn.silu(g_m)
    out = jnp.concatenate([att, hm], axis=-1) @ lp['w_out']
    return out, (ckv, kpe, C_fin.astype(h.dtype), n_fin.astype(h.dtype), m_fin.astype(h.dtype))


def odd_mixer(h, lp, ctx=None):
    b, s, _ = h.shape
    xc, bc, cc, g_c, q_d, k_d, v_d, g_d = split_cols(h @ lp['w_in'], ODD_SPLITS)
    conv_out = bc * short_conv(cc * xc, lp['conv_w'], lp['conv_b']) * jax.nn.silu(g_c)
    q = rms_norm(q_d.reshape(b, s, H_D, DH_D), lp['q_norm'])
    k = rms_norm(k_d.reshape(b, s, H_D, DH_D), lp['k_norm'])
    v = v_d.reshape(b, s, H_D, DH_D)
    if ctx is None:
        na = block_attention(q, k, v)
    else:
        k_c, v_c = ctx
        na = neighbourhood_attention(q, k, v, k_c, v_c, lp['rpb'])
    na = na.reshape(b, s, W_D) * jax.nn.silu(g_d)
    out = jnp.concatenate([conv_out, na], axis=-1) @ lp['w_out']
    return out, (k, v)


def setup_inputs(seed: int = 0) -> dict:
    key = jax.random.key(seed)
    keys = jax.random.split(key, 48)
    ks = iter([keys[i] for i in range(48)])

    def nrm(shape, scale=1.0):
        return scale * jax.random.normal(next(ks), shape, jnp.float32)

    def gain(shape):
        return 1.0 + nrm(shape, 0.05)

    ne = (DEPTH + 1) // 2
    no = DEPTH // 2
    D = D_MODEL
    return {
        'x_prompt': nrm((BATCH, SEQ, D)),
        'x_sample': nrm((DEC_BATCH, DEC_SEQ, D)),
        'c': nrm((DEC_BATCH, D)),
        'cache_mla_ckv': nrm((DEC_BATCH, ne, PAST_LEN, KV_RANK)),
        'cache_mla_kpe': nrm((DEC_BATCH, ne, PAST_LEN, ROPE_DIM)),
        'state_mlstm_C': nrm((DEC_BATCH, ne, 2, H_B, DH_B, DH_B), 0.05),
        'state_mlstm_n': nrm((DEC_BATCH, ne, 2, H_B, DH_B), 0.05),
        'state_mlstm_m': 2.0 + nrm((DEC_BATCH, ne, 2, H_B), 0.5),
        'cache_na_k': nrm((DEC_BATCH, no, PAST_LEN, H_D, DH_D)),
        'cache_na_v': nrm((DEC_BATCH, no, PAST_LEN, H_D, DH_D)),
        'c_ctx': nrm((D,)),
        'norm_w': gain((DEPTH, D)),
        'ada_w': nrm((DEPTH, D, 3 * D), 0.5 * D ** -0.5),
        'ada_b': nrm((DEPTH, 3 * D), 0.02),
        'ev_w_in': nrm((ne, D, EVEN_IN), D ** -0.5),
        'ev_q_a_norm': gain((ne, Q_RANK)),
        'ev_kv_a_norm': gain((ne, KV_RANK)),
        'ev_w_q_b': nrm((ne, Q_RANK, H_A * QK_DIM), Q_RANK ** -0.5),
        'ev_w_kv_b': nrm((ne, KV_RANK, H_A * (NOPE_DIM + V_DIM)), KV_RANK ** -0.5),
        'ev_q_norm': gain((ne, QK_DIM)),
        'ev_k_norm': gain((ne, QK_DIM)),
        'ev_b_i': -1.0 + nrm((ne, 2, H_B), 0.3),
        'ev_b_f': 3.0 + nrm((ne, 2, H_B), 0.5),
        'ev_h_norm': gain((ne, W_B)),
        'ev_w_out': nrm((ne, W_A + W_B, D), (W_A + W_B) ** -0.5),
        'od_w_in': nrm((no, D, ODD_IN), D ** -0.5),
        'od_conv_w': nrm((no, CONV_W, W_C), CONV_W ** -0.5),
        'od_conv_b': nrm((no, W_C), 0.02),
        'od_q_norm': gain((no, DH_D)),
        'od_k_norm': gain((no, DH_D)),
        'od_rpb': nrm((no, H_D, 2 * WIN_R - 1, 2 * WIN_C - 1), 0.5),
        'od_w_out': nrm((no, W_C + W_D, D), (W_C + W_D) ** -0.5),
    }


def reference(x_prompt, x_sample, c, cache_mla_ckv, cache_mla_kpe, state_mlstm_C, state_mlstm_n, state_mlstm_m,
              cache_na_k, cache_na_v, c_ctx, norm_w, ada_w, ada_b,
              ev_w_in, ev_q_a_norm, ev_kv_a_norm, ev_w_q_b, ev_w_kv_b, ev_q_norm, ev_k_norm, ev_b_i, ev_b_f,
              ev_h_norm, ev_w_out,
              od_w_in, od_conv_w, od_conv_b, od_q_norm, od_k_norm, od_rpb, od_w_out):
    yp, ys = x_prompt, x_sample
    l_ckv, l_kpe, l_C, l_n, l_m, l_k, l_v = [], [], [], [], [], [], []
    for l in range(DEPTH):
        j = l // 2
        sh_p, sc_p, g_p = modulation(c_ctx[None, :], ada_w[l], ada_b[l])
        sh_s, sc_s, g_s = modulation(c, ada_w[l], ada_b[l])
        hp = rms_norm(yp, norm_w[l]) * (1 + sc_p) + sh_p
        hs = rms_norm(ys, norm_w[l]) * (1 + sc_s) + sh_s
        if l % 2 == 0:
            lp = {'w_in': ev_w_in[j], 'q_a_norm': ev_q_a_norm[j], 'kv_a_norm': ev_kv_a_norm[j],
                  'w_q_b': ev_w_q_b[j], 'w_kv_b': ev_w_kv_b[j], 'q_norm': ev_q_norm[j], 'k_norm': ev_k_norm[j],
                  'b_i': ev_b_i[j], 'b_f': ev_b_f[j], 'h_norm': ev_h_norm[j], 'w_out': ev_w_out[j]}
            out_p, (ckv, kpe, C_s, n_s, m_s) = even_mixer(hp, lp)
            out_s, _ = even_mixer(hs, lp, ctx=(cache_mla_ckv[:, j], cache_mla_kpe[:, j], state_mlstm_C[:, j],
                                              state_mlstm_n[:, j], state_mlstm_m[:, j]))
            l_ckv.append(ckv)
            l_kpe.append(kpe)
            l_C.append(C_s)
            l_n.append(n_s)
            l_m.append(m_s)
        else:
            lp = {'w_in': od_w_in[j], 'conv_w': od_conv_w[j], 'conv_b': od_conv_b[j], 'q_norm': od_q_norm[j],
                  'k_norm': od_k_norm[j], 'rpb': od_rpb[j], 'w_out': od_w_out[j]}
            out_p, (k_p, v_p) = odd_mixer(hp, lp)
            out_s, _ = odd_mixer(hs, lp, ctx=(cache_na_k[:, j], cache_na_v[:, j]))
            l_k.append(k_p)
            l_v.append(v_p)
        yp = yp + g_p * out_p
        ys = ys + g_s * out_s
    new_mla_ckv = jnp.stack(l_ckv, axis=1)
    new_mla_kpe = jnp.stack(l_kpe, axis=1)
    new_mlstm_C = jnp.stack(l_C, axis=1)
    new_mlstm_n = jnp.stack(l_n, axis=1)
    new_mlstm_m = jnp.stack(l_m, axis=1)
    new_na_k = jnp.stack(l_k, axis=1)
    new_na_v = jnp.stack(l_v, axis=1)
    return (yp, ys, new_mla_ckv, new_mla_kpe, new_mlstm_C, new_mlstm_n, new_mlstm_m, new_na_k, new_na_v)
```

```cpp
#include <hip/hip_runtime.h>
#include <cstdio>
#include <cstdint>
#include <math.h>

#define GAS __attribute__((address_space(1)))
#define LAS __attribute__((address_space(3)))
typedef unsigned short bf16;
typedef unsigned v4u __attribute__((ext_vector_type(4)));
typedef unsigned v2u __attribute__((ext_vector_type(2)));
typedef float f32x4 __attribute__((ext_vector_type(4)));
typedef float f32x2 __attribute__((ext_vector_type(2)));
typedef float f32x16 __attribute__((ext_vector_type(16)));
typedef short bf16x8 __attribute__((ext_vector_type(8)));
typedef __bf16 bh8 __attribute__((ext_vector_type(8)));
typedef __bf16 bh2 __attribute__((ext_vector_type(2)));
typedef GAS unsigned gu32;
#define RLX_AGENT __ATOMIC_RELAXED, __HIP_MEMORY_SCOPE_AGENT
#define LDS_WAIT() asm volatile("s_waitcnt lgkmcnt(0)" ::: "memory")
#define VM_WAIT() asm volatile("s_waitcnt vmcnt(0)" ::: "memory")

constexpr int DM = 1024, NP = 4096, NS = 2048, NT = 6144;
constexpr int UE = 3584, UO = 4096;
constexpr float EPS = 1e-6f;
constexpr int CE_QA = 0, CE_KVA = 256, CE_GA = 384, CE_QM = 896, CE_KM = 1408, CE_VM = 1920, CE_OM = 2432, CE_GM = 2944, CE_KPE = 3456;
constexpr int CO_XC = 0, CO_BC = 512, CO_CC = 1024, CO_GC = 1536, CO_QD = 2048, CO_KD = 2560, CO_VD = 3072, CO_GD = 3584;
constexpr size_t O_Y = 0, O_CKV = 6291456, O_KPE = 7340032, O_C = 7602176, O_N = 11796480, O_M = 11829248, O_NK = 11829504, O_NV = 16023808;
constexpr size_t MiB = 1u << 20;
constexpr size_t WS_CTL = 0, CTL_ZERO_BYTES = 65536;
constexpr size_t WS_ROPE = 65536;
constexpr size_t WS_MOD = 131072;
constexpr size_t WS_AG = 327680;
constexpr size_t WS_WTEV = 1 * MiB;
constexpr size_t WS_WTOD = 17 * MiB;
constexpr size_t WS_WTOUT = 33 * MiB;
constexpr size_t WS_WTQB = 41 * MiB;
constexpr size_t WS_WTKVB = 42 * MiB;
constexpr size_t WS_NAKC = 43 * MiB;
constexpr size_t WS_NAVC = 44 * MiB;
constexpr size_t WS_C0T = 45 * MiB;
constexpr size_t WS_H = 47 * MiB;
constexpr size_t WS_U = 59 * MiB;
constexpr size_t WS_Z = 107 * MiB;
constexpr size_t WS_GATES = 119 * MiB;
constexpr size_t WS_Q = 120 * MiB;
constexpr size_t WS_KM = 129 * MiB;
constexpr size_t WS_VTM = 139 * MiB;
constexpr size_t WS_VTO = 146 * MiB;
constexpr size_t WS_LT = 152 * MiB;
constexpr size_t WS_NL = 200 * MiB;
constexpr size_t WS_CTB = 201 * MiB;
constexpr size_t WS_NPV = 225 * MiB;
constexpr size_t WS_MPV = 226 * MiB;
constexpr size_t WS_KFO = 227 * MiB;
constexpr size_t WS_VFM = 234 * MiB;
constexpr size_t WS_GQ = 241 * MiB;
constexpr int KROWS = 6656;

__device__ __forceinline__ unsigned pk2(float lo, float hi) { f32x2 v = {lo, hi}; bh2 b = __builtin_convertvector(v, bh2); return __builtin_bit_cast(unsigned, b); }
__device__ __forceinline__ float bf2f(unsigned u16) { return __builtin_bit_cast(float, u16 << 16); }
__device__ __forceinline__ float bflo(unsigned u) { return __builtin_bit_cast(float, u << 16); }
__device__ __forceinline__ float bfhi(unsigned u) { return __builtin_bit_cast(float, u & 0xffff0000u); }
__device__ __forceinline__ float silu_f(float x) { return x / (1.f + __expf(-x)); }
__device__ __forceinline__ float sigmoid_f(float x) { return 1.f / (1.f + __expf(-x)); }
__device__ __forceinline__ float logsigmoid_f(float x) { return fminf(x, 0.f) - log1pf(expf(-fabsf(x))); }
__device__ __forceinline__ int cond_of_row(int r) { return r < NP ? 0 : 1 + ((r - NP) >> 10); }
__device__ __forceinline__ float wave_sum(float v) {
#pragma unroll
    for (int o = 1; o < 64; o <<= 1) v += __shfl_xor(v, o);
    return v;
}
__device__ __forceinline__ float wave_max(float v) {
#pragma unroll
    for (int o = 1; o < 64; o <<= 1) v = fmaxf(v, __shfl_xor(v, o));
    return v;
}
__device__ __forceinline__ f32x16 mfma32(bh8 a, bh8 b, f32x16 c) { return __builtin_amdgcn_mfma_f32_32x32x16_bf16(a, b, c, 0, 0, 0); }
__device__ __forceinline__ bh8 ld16(const bf16* p) { return *(const bh8*)p; }
__device__ __forceinline__ bh8 ld2x8(const bf16* p0, const bf16* p1) { v2u a = *(const v2u*)p0, b = *(const v2u*)p1; v4u v = {a.x, a.y, b.x, b.y}; return __builtin_bit_cast(bh8, v); }
__device__ __forceinline__ bh8 pfrag(const f32x16& p, int s) {
    v4u v; v.x = pk2(p[8 * s + 0], p[8 * s + 1]); v.y = pk2(p[8 * s + 2], p[8 * s + 3]); v.z = pk2(p[8 * s + 4], p[8 * s + 5]); v.w = pk2(p[8 * s + 6], p[8 * s + 7]);
    return __builtin_bit_cast(bh8, v);
}
__device__ __forceinline__ int crow(int i, int hh) { return (i & 3) + 8 * (i >> 2) + 4 * hh; }
__device__ __forceinline__ void st4bf(bf16* p, float a, float b, float c, float d) { v2u v; v.x = pk2(a, b); v.y = pk2(c, d); *(v2u*)p = v; }

namespace pg8 {
#define PG8_LAS __attribute__((address_space(3)))
typedef unsigned short bf16_t;
typedef short bf16x8 __attribute__((ext_vector_type(8)));
typedef float f32x4 __attribute__((ext_vector_type(4)));
typedef unsigned u32x4 __attribute__((ext_vector_type(4)));
#ifndef PG8_BMA_ROWS
#define PG8_BMA_ROWS 192
#endif
constexpr int BMA = PG8_BMA_ROWS, HA = BMA / 2, MA = HA / 32, WRA = HA / 2;
constexpr int BM = 256, BK = 64, HALF = 128, HTB = HALF * BK * 2  , STAGE_BYTES = 8 * HTB, NXCD = 8, WGM = 8;

__host__ __device__ __forceinline__ int lds_byte(int r, int c) { const int st = (r >> 4) * 2 + (c >> 5), rr = r & 15, cc = c & 31, ob = rr * 64 + cc * 2; return st * 1024 + (ob ^ (((ob >> 9) & 1) << 5)); }
__host__ __device__ __forceinline__ void stage_rc(int b, int& R, int& C) { const int st = b / 1024, sb = b % 1024, swz = sb ^ (((sb >> 9) & 1) << 5); R = (st >> 1) * 16 + swz / 64; C = (st & 1) * 32 + (swz % 64) / 2; }
__host__ __device__ __forceinline__ int perm32(int rho) { const int n = rho >> 4, i = rho & 15; return 8 * (i >> 2) + 4 * n + (i & 3); }

struct Unit { int pm, pn; };
struct Gemm { const bf16_t* A; const bf16_t* Bt; int M, N, K; };

struct StaticOrder {
    int nM, nN, nwg, G, c;
    __host__ __device__ void init(int M, int N, int G_, int c_) { nM = M / BMA; nN = N / BM; nwg = nM * nN; G = G_; c = c_; }
    __host__ __device__ bool next(int i, Unit& u) const {
        const long L = (long)i * G + c; if (L >= nwg) return false;
        int wgid = (int)L; { const int q = nwg / NXCD, r = nwg % NXCD, xcd = wgid % NXCD, off = wgid / NXCD; wgid = (xcd < r ? xcd * (q + 1) : r * (q + 1) + (xcd - r) * q) + off; }
        const int nig = WGM * nN, gid = wgid / nig, fm = gid * WGM, gsz = (nM - fm) < WGM ? (nM - fm) : WGM;
        u.pm = fm + ((wgid % nig) % gsz); u.pn = (wgid % nig) / gsz; return true;
    }
    __device__ __forceinline__ void a_ready(const Unit&) const {}
    __device__ __forceinline__ void done(const Unit&) const {}
};

__device__ __forceinline__ int pg8_opaque(int x) { asm volatile("" : "+v"(x)); return x; }
__device__ __forceinline__ unsigned cvt_pk_bf16(float lo, float hi) { unsigned r; asm volatile("v_cvt_pk_bf16_f32 %0, %1, %2" : "=v"(r) : "v"(lo), "v"(hi)); return r; }

struct EpiU {
    static constexpr bool PERM = true, AFTER_DRAIN = false;
    bf16_t* U; int ldu; float* gates; bf16_t* vto; bf16_t* kfo; bf16_t* vfm;
    __device__ __forceinline__ void operator()(const f32x4 (&acc)[2][2][4][2], const Unit& u, int wr, int wc, int fr, int fq) const {
        const int row0 = u.pm * BMA + wr * WRA + fr, col0 = u.pn * BM + wc * 32 + 8 * fq;
        const bool dog = gates != nullptr && u.pn == 13 && wc == 1 && fq < 2;
        const bool dov = vto != nullptr && (u.pn == 12 || u.pn == 13);
        const bool dok = kfo != nullptr && (u.pn == 10 || u.pn == 11);
        const bool dom = vfm != nullptr && u.pn >= 7 && u.pn <= 9;
#pragma unroll
        for (int ai = 0; ai < 2; ++ai)
#pragma unroll
            for (int m = 0; m < MA; ++m) {
                const int row = row0 + ai * HA + m * 16;
#pragma unroll
                for (int bj = 0; bj < 2; ++bj) {
                    const f32x4 v0 = acc[ai][bj][m][0], v1 = acc[ai][bj][m][1];
                    const int col = col0 + bj * HALF;
                    u32x4 w; w.x = cvt_pk_bf16(v0[0], v0[1]); w.y = cvt_pk_bf16(v0[2], v0[3]); w.z = cvt_pk_bf16(v1[0], v1[1]); w.w = cvt_pk_bf16(v1[2], v1[3]);
                    *(u32x4*)(U + (size_t)row * ldu + col) = w;
                    if (bj == 1 && dog) { float* g = gates + (size_t)row * 16 + 8 * fq; *(f32x4*)g = v0; *(f32x4*)(g + 4) = v1; }
                    if (dom && col >= 1920 && col < 2432) { const int cc = col - 1920, hd = cc >> 7, ev = cc & 127, t16 = row & 15;
                        bf16_t* vp = vfm + ((size_t)((row >> 5) * 4 + hd) * 8 + (ev >> 5) * 2 + ((row >> 4) & 1)) * 512 + (((t16 >> 2) & 1) * 32 + (ev & 31)) * 8 + 4 * (t16 >> 3) + (t16 & 3);
                        vp[0] = (bf16_t)(w.x & 0xffffu); vp[8] = (bf16_t)(w.x >> 16); vp[16] = (bf16_t)(w.y & 0xffffu); vp[24] = (bf16_t)(w.y >> 16);
                        vp[32] = (bf16_t)(w.z & 0xffffu); vp[40] = (bf16_t)(w.z >> 16); vp[48] = (bf16_t)(w.w & 0xffffu); vp[56] = (bf16_t)(w.w >> 16);
                    }
                    if (dok) { const int cc = col - 2560, hd = cc >> 6, d = cc & 63;
                        *(u32x4*)(kfo + ((size_t)((row >> 5) * 8 + hd) * 4 + (d >> 4)) * 512 + (((d >> 3) & 1) * 32 + (row & 31)) * 8) = w; }
                    if (dov) { const int cc = col - 3072, hd = cc >> 6, dv = cc & 63, t16 = row & 15;
                        bf16_t* vp = vto + ((size_t)((row >> 5) * 8 + hd) * 4 + (dv >> 5) * 2 + ((row >> 4) & 1)) * 512 + (((t16 >> 2) & 1) * 32 + (dv & 31)) * 8 + 4 * (t16 >> 3) + (t16 & 3);
                        vp[0] = (bf16_t)(w.x & 0xffffu); vp[8] = (bf16_t)(w.x >> 16); vp[16] = (bf16_t)(w.y & 0xffffu); vp[24] = (bf16_t)(w.y >> 16);
                        vp[32] = (bf16_t)(w.z & 0xffffu); vp[40] = (bf16_t)(w.z >> 16); vp[48] = (bf16_t)(w.w & 0xffffu); vp[56] = (bf16_t)(w.w >> 16);
                    }
                }
            }
    }
};

struct EpiY {
    static constexpr bool PERM = true, AFTER_DRAIN = false;
    float* Y; const float* ysp; const float* yss; const float* mod_l;
    __device__ __forceinline__ void operator()(const f32x4 (&acc)[2][2][4][2], const Unit& u, int wr, int wc, int fr, int fq) const {
        const int row0 = u.pm * BMA + wr * WRA + fr, col0 = u.pn * BM + wc * 32 + 8 * fq;
#pragma unroll
        for (int bj = 0; bj < 2; ++bj) {
            const int col = col0 + bj * HALF;
#pragma unroll
            for (int ai = 0; ai < 2; ++ai)
#pragma unroll
                for (int m = 0; m < MA; ++m) {
                    const int row = row0 + ai * HA + m * 16;
                    const float* gp = mod_l + (row < 4096 ? 0 : (row < 5120 ? 1 : 2)) * 3072 + 2048 + col;
                    const f32x4 g0 = *(const f32x4*)gp, g1 = *(const f32x4*)(gp + 4);
                    const float* src = (row < 4096 ? ysp + (size_t)row * 1024 : yss + (size_t)(row - 4096) * 1024) + col;
                    const f32x4 y0 = *(const f32x4*)src, y1 = *(const f32x4*)(src + 4);
                    float* dst = Y + (size_t)row * 1024 + col;
                    *(f32x4*)dst = y0 + g0 * acc[ai][bj][m][0];
                    *(f32x4*)(dst + 4) = y1 + g1 * acc[ai][bj][m][1];
                }
        }
    }
};

template <class Epi, class Sched, bool ALIGN_EPI = false, bool SP2 = false>
__device__ __forceinline__ void gemm_phase(PG8_LAS unsigned char* lds, const Gemm g, const Sched& S, const Epi& E) {
    const int tid = pg8_opaque((int)threadIdx.x), wid = __builtin_amdgcn_readfirstlane(tid >> 6), lane = tid & 63, wr = wid >> 2, wc = wid & 3, fr = lane & 15, fq = lane >> 4;
    const int K = g.K, nt = K / BK;
    unsigned voffA[2], voffB[2];
#pragma unroll
    for (int i = 0; i < 2; ++i) { int R, C; stage_rc(tid * 16 + i * 8192, R, C); const int Rb = Epi::PERM ? ((R & ~31) + perm32(R & 31)) : R;
        voffA[i] = (unsigned)(R * K + C) * 2u; voffB[i] = (unsigned)(Rb * K + C) * 2u; }
    const size_t kstep = (size_t)(BK * 2);
    const size_t hstep = (size_t)HALF * K * 2;
    const size_t tstep = 2 * hstep;
    const size_t hstepA = (size_t)HA * K * 2, tstepA = 2 * hstepA;
    const unsigned ldsw = (unsigned)wid * 1024u;
    const int aoff = lds_byte(wr * WRA + fr, fq * 8), boff = lds_byte(wc * 32 + fr, fq * 8);
#define PG8_SA(b, h) (((b) * 2 + (h)) * HTB)
#define PG8_SB(b, h) ((4 + (b) * 2 + (h)) * HTB)
#define PG8_STAGE(bufoff, gbase, voff) do { _Pragma("unroll") for (int _i = 0; _i < 2; ++_i) \
        __builtin_amdgcn_global_load_lds((const unsigned*)((const char*)(gbase) + (voff)[_i]), (PG8_LAS unsigned*)(lds + (bufoff) + ldsw + _i * 8192), 16, 0, 0); } while (0)
#define PG8_LDA(dst, b, h) do { _Pragma("unroll") for (int m = 0; m < MA; ++m) _Pragma("unroll") for (int k = 0; k < 2; ++k) dst[m][k] = *(const PG8_LAS bf16x8*)(lds + PG8_SA(b, h) + aoff + m * 2048 + k * 1024); } while (0)
#define PG8_LDB(dst, b, h) do { _Pragma("unroll") for (int n = 0; n < 2; ++n) _Pragma("unroll") for (int k = 0; k < 2; ++k) dst[n][k] = *(const PG8_LAS bf16x8*)(lds + PG8_SB(b, h) + boff + n * 2048 + k * 1024); } while (0)
#define PG8_MMA(ai, bj, At, Bt) do { __builtin_amdgcn_s_setprio(1); _Pragma("unroll") for (int m = 0; m < MA; ++m) _Pragma("unroll") for (int n = 0; n < 2; ++n) _Pragma("unroll") for (int k = 0; k < 2; ++k) \
        acc[ai][bj][m][n] = __builtin_amdgcn_mfma_f32_16x16x32_bf16(Bt[n][k], At[m][k], acc[ai][bj][m][n], 0, 0, 0); __builtin_amdgcn_s_setprio(0); } while (0)
#define PG8_WAIT_V(n) asm volatile("s_waitcnt vmcnt(" #n ")" ::: "memory")
#define PG8_WAIT_L(n) asm volatile("s_waitcnt lgkmcnt(" #n ")" ::: "memory")
#define PG8_BAR __builtin_amdgcn_s_barrier()
#define PG8_SCHED __builtin_amdgcn_sched_barrier(0)
    Unit cur, nxt; int ui = 0;
    if (!S.next(0, cur)) return;
    f32x4 acc[2][2][4][2];
#pragma unroll
    for (int a = 0; a < 2; ++a)
#pragma unroll
        for (int b = 0; b < 2; ++b)
#pragma unroll
            for (int m = 0; m < MA; ++m)
#pragma unroll
                for (int n = 0; n < 2; ++n) acc[a][b][m][n] = (f32x4){0.f, 0.f, 0.f, 0.f};
    bf16x8 At[4][2], B0[2][2], B1[2][2];
    const char* cA = (const char*)g.A + (size_t)cur.pm * tstepA; const char* cB = (const char*)g.Bt + (size_t)cur.pn * tstep;
    S.a_ready(cur);
    if constexpr (SP2) {
        PG8_STAGE(PG8_SB(0, 0), cB, voffB); PG8_STAGE(PG8_SB(0, 1), cB + hstep, voffB); PG8_STAGE(PG8_SA(0, 0), cA, voffA); PG8_STAGE(PG8_SA(0, 1), cA + hstepA, voffA);
        if (wr == 1) PG8_BAR;
        PG8_WAIT_V(2); PG8_BAR;
        PG8_STAGE(PG8_SB(1, 0), cB + kstep, voffB); PG8_STAGE(PG8_SA(1, 0), cA + kstep, voffA); PG8_STAGE(PG8_SB(1, 1), cB + hstep + kstep, voffB);
        PG8_WAIT_V(6); PG8_BAR;
    } else {
        PG8_STAGE(PG8_SB(0, 0), cB, voffB); PG8_STAGE(PG8_SA(0, 0), cA, voffA); PG8_STAGE(PG8_SB(0, 1), cB + hstep, voffB); PG8_STAGE(PG8_SA(0, 1), cA + hstepA, voffA);
        if (wr == 1) PG8_BAR;
        PG8_WAIT_V(4); PG8_BAR;
        PG8_STAGE(PG8_SB(1, 0), cB + kstep, voffB); PG8_STAGE(PG8_SA(1, 0), cA + kstep, voffA); PG8_STAGE(PG8_SB(1, 1), cB + hstep + kstep, voffB);
        PG8_WAIT_V(6); PG8_BAR;
    }
    for (;;) {
        const bool has_next = S.next(ui + 1, nxt);
        const char* nA = has_next ? (const char*)g.A + (size_t)nxt.pm * tstepA : cA; const char* nB = has_next ? (const char*)g.Bt + (size_t)nxt.pn * tstep : cB;
        for (int t = 0; t < nt; t += 2) {
            const bool last = (t == nt - 2);
            const char* a1 = cA + (size_t)(t + 1) * kstep;
            const char* a2 = last ? nA : cA + (size_t)(t + 2) * kstep; const char* b2 = last ? nB : cB + (size_t)(t + 2) * kstep;
            const char* a3 = a2 + kstep; const char* b3 = b2 + kstep;
            if (last && has_next) S.a_ready(nxt);
            if constexpr (SP2) {
            PG8_LDB(B0, 0, 0); PG8_LDB(B1, 0, 1); PG8_SCHED; PG8_LDA(At, 0, 0); PG8_STAGE(PG8_SA(1, 1), a1 + hstepA, voffA);
            PG8_WAIT_V(8); PG8_WAIT_L(0); PG8_BAR; PG8_MMA(0, 0, At, B0); PG8_MMA(0, 1, At, B1); PG8_BAR; PG8_SCHED;
            PG8_LDA(At, 0, 1); PG8_STAGE(PG8_SB(0, 0), b2, voffB); PG8_STAGE(PG8_SB(0, 1), b2 + hstep, voffB); PG8_STAGE(PG8_SA(0, 0), a2, voffA);
            PG8_WAIT_V(8); PG8_WAIT_L(0); PG8_BAR; PG8_MMA(1, 0, At, B0); PG8_MMA(1, 1, At, B1); PG8_BAR; PG8_SCHED;
            PG8_LDB(B0, 1, 0); PG8_LDB(B1, 1, 1); PG8_SCHED; PG8_LDA(At, 1, 0); PG8_STAGE(PG8_SA(0, 1), a2 + hstepA, voffA);
            PG8_WAIT_V(8); PG8_WAIT_L(0); PG8_BAR; PG8_MMA(0, 0, At, B0); PG8_MMA(0, 1, At, B1); PG8_BAR; PG8_SCHED;
            PG8_LDA(At, 1, 1); PG8_STAGE(PG8_SB(1, 0), b3, voffB); PG8_STAGE(PG8_SB(1, 1), b3 + hstep, voffB); PG8_STAGE(PG8_SA(1, 0), a3, voffA);
            PG8_WAIT_V(8); PG8_WAIT_L(0); PG8_BAR; PG8_MMA(1, 0, At, B0); PG8_MMA(1, 1, At, B1); PG8_BAR; PG8_SCHED;
            } else {
            PG8_LDB(B0, 0, 0); PG8_SCHED; PG8_LDA(At, 0, 0); PG8_STAGE(PG8_SA(1, 1), a1 + hstepA, voffA);
            PG8_WAIT_L(8); PG8_BAR; PG8_WAIT_L(0); PG8_MMA(0, 0, At, B0); PG8_BAR; PG8_SCHED;
            PG8_LDB(B1, 0, 1); PG8_STAGE(PG8_SB(0, 0), b2, voffB);
            PG8_BAR; PG8_WAIT_L(0); PG8_MMA(0, 1, At, B1); PG8_BAR;
            PG8_LDA(At, 0, 1); PG8_STAGE(PG8_SA(0, 0), a2, voffA);
            PG8_BAR; PG8_WAIT_L(0); PG8_MMA(1, 0, At, B0); PG8_BAR; PG8_SCHED;
            PG8_STAGE(PG8_SB(0, 1), b2 + hstep, voffB);
            PG8_WAIT_V(6); PG8_BAR; PG8_MMA(1, 1, At, B1); PG8_BAR;
            PG8_LDB(B0, 1, 0); PG8_SCHED; PG8_LDA(At, 1, 0); PG8_STAGE(PG8_SA(0, 1), a2 + hstepA, voffA);
            PG8_WAIT_L(8); PG8_BAR; PG8_WAIT_L(0); PG8_MMA(0, 0, At, B0); PG8_BAR; PG8_SCHED;
            PG8_LDB(B1, 1, 1); PG8_STAGE(PG8_SB(1, 0), b3, voffB);
            PG8_BAR; PG8_WAIT_L(0); PG8_MMA(0, 1, At, B1); PG8_BAR;
            PG8_LDA(At, 1, 1); PG8_STAGE(PG8_SA(1, 0), a3, voffA);
            PG8_BAR; PG8_WAIT_L(0); PG8_MMA(1, 0, At, B0); PG8_BAR; PG8_SCHED;
            PG8_STAGE(PG8_SB(1, 1), b3 + hstep, voffB);
            PG8_WAIT_V(6); PG8_BAR; PG8_MMA(1, 1, At, B1); PG8_BAR;
            }
        }
        if constexpr (ALIGN_EPI) { if (wr == 0) PG8_BAR; }
        if constexpr (!Epi::AFTER_DRAIN) { E(acc, cur, wr, wc, fr, fq); S.done(cur); }
        if (!has_next) break;
#pragma unroll
        for (int a = 0; a < 2; ++a)
#pragma unroll
            for (int b = 0; b < 2; ++b)
#pragma unroll
                for (int m = 0; m < MA; ++m)
#pragma unroll
                    for (int n = 0; n < 2; ++n) acc[a][b][m][n] = (f32x4){0.f, 0.f, 0.f, 0.f};
        cur = nxt; cA = nA; cB = nB; ++ui;
        if constexpr (ALIGN_EPI) { if (wr == 1) PG8_BAR; }
    }
    PG8_WAIT_V(0);
    if constexpr (!ALIGN_EPI) { if (wr == 0) PG8_BAR; }
    PG8_BAR;
    if constexpr (Epi::AFTER_DRAIN) { E.fused(acc, cur, wr, wc, fr, fq, lds, wid, lane); S.done(cur); }
#undef PG8_SA
#undef PG8_SB
#undef PG8_STAGE
#undef PG8_LDA
#undef PG8_LDB
#undef PG8_MMA
#undef PG8_WAIT_V
#undef PG8_WAIT_L
#undef PG8_BAR
#undef PG8_SCHED
}
}
#define XB_TMO      128
#define XB_XCNT(j)  (256  + 64 * (j))
#define XB_XSUB(j)  (1280 + 64 * (j))
#define XB_XGEN(j)  (2304 + 64 * (j))
#define XB_TOP      3328
#define XB_TOPGEN   3392
#define XCD_BAR_WORDS 3456
#define XB_SPIN_CAP (1u << 18)

__device__ __forceinline__ unsigned xb_ld(unsigned* p)              { return __hip_atomic_load(p, __ATOMIC_RELAXED, __HIP_MEMORY_SCOPE_AGENT); }
__device__ __forceinline__ unsigned xb_add(unsigned* p, unsigned v) { return __hip_atomic_fetch_add(p, v, __ATOMIC_RELAXED, __HIP_MEMORY_SCOPE_AGENT); }
__device__ __forceinline__ unsigned xb_xcc_id() { return (unsigned)__builtin_amdgcn_s_getreg((3 << 11) | 20) & 0xFu; }
#define XB_SPIN(cond, bar) do { unsigned _sp = 0; while (cond) { __builtin_amdgcn_s_sleep(1); \
    if ((++_sp & 255u) == 0u) { if (xb_ld(&(bar)[XB_TMO])) break; if (_sp > XB_SPIN_CAP) { atomicAdd(&(bar)[XB_TMO], 1u); break; } } } } while (0)

struct XcdBarrier {
    unsigned* bar; unsigned x;
    volatile LAS unsigned* st;
};

__device__ __forceinline__ XcdBarrier xcd_barrier_post(unsigned* bar, volatile LAS unsigned* st) {
    XcdBarrier b; b.bar = bar; b.x = xb_xcc_id(); b.st = st;
    if (threadIdx.x == 0) (void)xb_add(&bar[XB_XCNT(b.x)], 1u);
    return b;
}
__device__ __forceinline__ void xcd_barrier_complete(unsigned* bar, unsigned x, unsigned& nloc, unsigned& nx) {
    const unsigned G = gridDim.x * gridDim.y * gridDim.z;
    unsigned sum, cnt, mine, sp = 0u;
    for (;;) {
        sum = 0u; cnt = 0u; mine = 0u;
#pragma unroll
        for (unsigned j = 0; j < 16; ++j) { const unsigned c = xb_ld(&bar[XB_XCNT(j)]); sum += c; cnt += (c > 0u) ? 1u : 0u; mine = (j == x) ? c : mine; }
        if (sum == G) break;
        __builtin_amdgcn_s_sleep(1);
        if ((++sp & 255u) == 0u) { if (xb_ld(&bar[XB_TMO])) break; if (sp > XB_SPIN_CAP) { atomicAdd(&bar[XB_TMO], 1u); break; } }
    }
    nloc = mine > 0u ? mine : 1u; nx = cnt > 0u ? cnt : 1u;
}

__device__ __forceinline__ void xcd_barrier(const XcdBarrier& b) {
    asm volatile("s_waitcnt vmcnt(0)" ::: "memory");
    __syncthreads();
    if (threadIdx.x == 0) {
        unsigned* bar = b.bar;
        __builtin_amdgcn_s_waitcnt(0);
        unsigned nloc = b.st[0], nx = b.st[1];
        if (nloc == 0u) { xcd_barrier_complete(bar, b.x, nloc, nx); b.st[0] = nloc; b.st[1] = nx; }
        const unsigned old = xb_add(&bar[XB_XSUB(b.x)], 1u);
        const unsigned gen = old / nloc;
        if (old + 1u == (gen + 1u) * nloc) {
            __builtin_amdgcn_fence(__ATOMIC_RELEASE, "agent");
            asm volatile("s_waitcnt vmcnt(0)" ::: "memory");
            const unsigned og = xb_add(&bar[XB_TOP], 1u);
            const unsigned tg = og / nx;
            if (og + 1u == (tg + 1u) * nx) xb_add(&bar[XB_TOPGEN], 1u);
            else XB_SPIN(xb_ld(&bar[XB_TOPGEN]) == tg, bar);
            __builtin_amdgcn_fence(__ATOMIC_ACQUIRE, "agent");
            xb_add(&bar[XB_XGEN(b.x)], 1u);
            asm volatile("s_waitcnt vmcnt(0)" ::: "memory");
        } else {
            XB_SPIN(xb_ld(&bar[XB_XGEN(b.x)]) == gen, bar);
            __builtin_amdgcn_fence(__ATOMIC_ACQUIRE, "agent");
            asm volatile("s_waitcnt vmcnt(0)" ::: "memory");
        }
    }
    __syncthreads();
}

constexpr int NWAVES = 8, NTHR = 512;
constexpr int LDS_BYTES = 147456;
constexpr int MISC_OFF = 147456 - 256;
constexpr int CW_BAR = 4096;

struct Args {
    const float* in[32];
    float* out;
    unsigned char* ws;
    int ph_lo, ph_hi;
};

struct Ctx {
    LAS unsigned char* lds;
    unsigned char* ldsg;
    int tid, lane, wave, G, bid;
};


__device__ __forceinline__ int opaque_v(int x) { asm volatile("" : "+v"(x)); return x; }
__device__ __forceinline__ int opaque_s(int x) { asm volatile("" : "+s"(x)); return x; }
__device__ __forceinline__ int map_even(int dg) {
    if (dg < 24) return dg;
    if (dg < 152) return dg + 2;
    if (dg < 216) return dg + 3;
    if (dg < 218) return dg - 192;
    if (dg == 218) return 154;
    return -1;
}
__device__ __forceinline__ void transpose_item(const float* W, int ldn, int K, bf16* WT, int k0, int n0, int ca, int cb, LAS float* scr, int lane, bool frag = false) {
    const int n = lane & 31; const int sc = (n < 16) ? ca : cb;
    float tv[32];
#pragma unroll
    for (int i = 0; i < 32; ++i) { const int kk = 2 * i + (lane >> 5); tv[i] = sc >= 0 ? W[(size_t)(k0 + kk) * ldn + sc + (n & 15)] : 0.f; }
#pragma unroll
    for (int i = 0; i < 32; ++i) { const int kk = 2 * i + (lane >> 5); scr[kk * 33 + n] = tv[i]; }
    LDS_WAIT(); asm volatile("" ::: "memory");
    const int c = lane & 7;
#pragma unroll
    for (int j = 0; j < 4; ++j) { const int nn = (lane >> 3) + 8 * j; const LAS float* s = scr + (8 * c) * 33 + nn;
        v4u o; o.x = pk2(s[0 * 33], s[1 * 33]); o.y = pk2(s[2 * 33], s[3 * 33]); o.z = pk2(s[4 * 33], s[5 * 33]); o.w = pk2(s[6 * 33], s[7 * 33]);
        bf16* dst = frag ? WT + ((size_t)((n0 + nn) >> 5) * (K >> 4) + ((k0 + 8 * c) >> 4)) * 512 + ((((k0 + 8 * c) >> 3) & 1) * 32 + ((n0 + nn) & 31)) * 8 : WT + (size_t)(n0 + nn) * K + k0 + 8 * c;
        *(v4u*)dst = o; }
    LDS_WAIT(); asm volatile("" ::: "memory");
}

__device__ __forceinline__ void mod_unit(const Args& a, const Ctx& X, int l, int chunk, int tid, int lane, int wave) {
    LAS float* scs = (LAS float*)X.lds;
    LAS float* part = scs + 3072;
    const float* c_ctx = a.in[10]; const float* c = a.in[2];
    for (int i = tid; i < 3072; i += NTHR) { const int r = i >> 10, k = i & 1023; const float v = r == 0 ? c_ctx[k] : c[(r - 1) * 1024 + k]; scs[i] = v / (1.f + expf(-v)); }
    __syncthreads();
    const int j0 = chunk * 64;
    const float* w = a.in[12] + (size_t)l * 1024 * 3072 + j0 + lane;
    float a0 = 0.f, a1 = 0.f, a2 = 0.f;
#pragma unroll 32
    for (int kk = 0; kk < 128; ++kk) { const int k = wave * 128 + kk; const float wv = w[(size_t)k * 3072]; a0 += scs[k] * wv; a1 += scs[1024 + k] * wv; a2 += scs[2048 + k] * wv; }
    part[(wave * 3 + 0) * 64 + lane] = a0; part[(wave * 3 + 1) * 64 + lane] = a1; part[(wave * 3 + 2) * 64 + lane] = a2;
    __syncthreads();
    if (tid < 192) { const int r = tid >> 6, cc = tid & 63; float s = 0.f;
#pragma unroll
        for (int w8 = 0; w8 < 8; ++w8) s += part[(w8 * 3 + r) * 64 + cc];
        ((float*)(a.ws + WS_MOD))[(l * 3 + r) * 3072 + j0 + cc] = s + a.in[13][l * 3072 + j0 + cc]; }
    __syncthreads();
}
__device__ __forceinline__ void prep_weights(const Args& a, const Ctx& X, int l, int gw, int NGW, int lane, int wave) {
    unsigned char* ws = a.ws;
    LAS float* scr = (LAS float*)(X.lds + 32768 + wave * 8448);
    const int j = l >> 1;
    if ((l & 1) == 0) {
        for (int it = gw; it < 2464; it += NGW) {
            if (it < 1792) { const int nb = it % 112, kb = it / 112;
                transpose_item(a.in[14] + (size_t)j * 1024 * 3504, 3504, 1024, (bf16*)(ws + WS_WTEV) + (size_t)j * 3584 * 1024, kb * 64, nb * 32,
                               map_even(2 * nb) < 0 ? -1 : map_even(2 * nb) * 16, map_even(2 * nb + 1) < 0 ? -1 : map_even(2 * nb + 1) * 16, scr, lane);
            } else if (it < 2304) { const int r = it - 1792, nb = r % 32, kb = r / 32;
                transpose_item(a.in[24] + (size_t)j * 1024 * 1024, 1024, 1024, (bf16*)(ws + WS_WTOUT) + (size_t)l * 1024 * 1024, kb * 64, nb * 32, nb * 32, nb * 32 + 16, scr, lane);
            } else if (it < 2400) { const int r = it - 2304, nb = r % 24, kb = r / 24;
                transpose_item(a.in[17] + (size_t)j * 256 * 768, 768, 256, (bf16*)(ws + WS_WTQB) + (size_t)j * 768 * 256, kb * 64, nb * 32, nb * 32, nb * 32 + 16, scr, lane, true);
            } else { const int r = it - 2400, nb = r % 32, kb = r / 32;
                transpose_item(a.in[18] + (size_t)j * 128 * 1024, 1024, 128, (bf16*)(ws + WS_WTKVB) + (size_t)j * 1024 * 128, kb * 64, nb * 32, nb * 32, nb * 32 + 16, scr, lane, true);
            }
        }
    } else {
        for (int it = gw; it < 2560; it += NGW) {
            if (it < 2048) { const int nb = it % 128, kb = it / 128;
                transpose_item(a.in[25] + (size_t)j * 1024 * 4096, 4096, 1024, (bf16*)(ws + WS_WTOD) + (size_t)j * 4096 * 1024, kb * 64, nb * 32, nb * 32, nb * 32 + 16, scr, lane);
            } else { const int r = it - 2048, nb = r % 32, kb = r / 32;
                transpose_item(a.in[31] + (size_t)j * 1024 * 1024, 1024, 1024, (bf16*)(ws + WS_WTOUT) + (size_t)l * 1024 * 1024, kb * 64, nb * 32, nb * 32, nb * 32 + 16, scr, lane);
            }
        }
    }
}
__device__ __forceinline__ void phase_p0a(const Args& a, const Ctx& X) {
    unsigned char* ws = a.ws;
    const int tid = opaque_v(X.tid), lane = tid & 63, wave = opaque_s(X.wave);
    if (X.bid < 192) mod_unit(a, X, X.bid / 48, X.bid % 48, tid, lane, wave);
    else if (X.bid == 192) {
        const int pos = tid >> 3, f = tid & 7;
        const float ang = (float)pos * powf(10000.f, -(float)f / 8.f);
        float* rt = (float*)(ws + WS_ROPE);
        rt[pos * 16 + f] = cosf(ang); rt[pos * 16 + 8 + f] = sinf(ang);
    } else {
        const int nb = X.G - 193, b0 = X.bid - 193;
        const float* ck = a.in[8]; const float* cv = a.in[9]; const float* c0 = a.in[5];
        bf16* nakc = (bf16*)(ws + WS_NAKC); bf16* navc = (bf16*)(ws + WS_NAVC); float* c0t = (float*)(ws + WS_C0T);
#pragma unroll 4
        for (int idx = b0 * NTHR + tid; idx < 524288; idx += nb * NTHR) {
            const int d = idx & 63, h = (idx >> 6) & 7, key = (idx >> 9) & 255, bj = idx >> 17;
            { const size_t blk = ((size_t)(bj * 8 + h) * 8 + (key >> 5)) * 4; const int kr = key & 31, t16 = key & 15;
              nakc[(blk + (d >> 4)) * 512 + (((d >> 3) & 1) * 32 + kr) * 8 + (d & 7)] = (bf16)(pk2(ck[idx] / a.in[29][(bj & 1) * 64 + d], 0.f) & 0xffffu);
              navc[(blk + (d >> 5) * 2 + (kr >> 4)) * 512 + (((t16 >> 2) & 1) * 32 + (d & 31)) * 8 + 4 * (t16 >> 3) + (t16 & 3)] = (bf16)(pk2(cv[idx], 0.f) & 0xffffu); }
            const int e = idx & 127, dd = (idx >> 7) & 127, mat = idx >> 14;
            c0t[(size_t)mat * 16384 + e * 128 + dd] = c0[idx];
        }
    }
    for (int l = 0; l < 4; ++l) prep_weights(a, X, l, X.bid * NWAVES + wave, X.G * NWAVES, lane, wave);
}
__device__ __forceinline__ void gemm2_side(const Args& a, const Ctx& X, int l) {
    const int tid = opaque_v(X.tid), lane = tid & 63, wave = opaque_s(X.wave), idx = X.bid - 96;
    if (idx < 48) mod_unit(a, X, l + 1, idx, tid, lane, wave);
    prep_weights(a, X, l + 1, idx * NWAVES + wave, (X.G - 96) * NWAVES, lane, wave);
}

__device__ __forceinline__ void phase_norm(const Args& a, const Ctx& X, int l) {
    const float* ysp = l == 0 ? a.in[0] : a.out; const float* yss = l == 0 ? a.in[1] : a.out + (size_t)NP * DM;
    const float* nw = a.in[11] + l * DM;
    const float* modl = (const float*)(a.ws + WS_MOD) + l * 3 * 3072;
    bf16* H = (bf16*)(a.ws + WS_H);
    const int lane = opaque_v(X.tid) & 63; const int gw = X.bid * NWAVES + opaque_s(X.wave), NGW = X.G * NWAVES;
    f32x4 v[3][4];
#pragma unroll
    for (int q = 0; q < 3; ++q) { const int r = gw + q * NGW; const float* y = r < NP ? ysp + (size_t)r * DM : yss + (size_t)(r - NP) * DM;
#pragma unroll
        for (int j = 0; j < 4; ++j) v[q][j] = r < NT ? *(const f32x4*)(y + 4 * lane + 256 * j) : (f32x4){0.f, 0.f, 0.f, 0.f}; }
#pragma unroll
    for (int q = 0; q < 3; ++q) { const int r = gw + q * NGW; if (r < NT) {
        const float* md = modl + cond_of_row(r) * 3072;
        float ss = 0.f;
#pragma unroll
        for (int j = 0; j < 4; ++j) ss += (v[q][j].x * v[q][j].x + v[q][j].y * v[q][j].y) + (v[q][j].z * v[q][j].z + v[q][j].w * v[q][j].w);
        const float rstd = rsqrtf(wave_sum(ss) * (1.f / DM) + EPS);
#pragma unroll
        for (int j = 0; j < 4; ++j) { const int k = 4 * lane + 256 * j;
            const f32x4 g = *(const f32x4*)(nw + k), sh = *(const f32x4*)(md + k), sc = *(const f32x4*)(md + 1024 + k);
            const f32x4 o = v[q][j] * rstd * g * (sc + 1.f) + sh;
            st4bf(H + (size_t)r * DM + k, o.x, o.y, o.z, o.w); }
    } }
}

__device__ __forceinline__ void unit_mla_q(const Args& a, const Ctx& X, int j, int t) {
    const bf16* U = (const bf16*)(a.ws + WS_U); bf16* Q = (bf16*)(a.ws + WS_Q);
    const bf16* Wq = (const bf16*)(a.ws + WS_WTQB) + (size_t)j * 768 * 256;
    const float* rope = (const float*)(a.ws + WS_ROPE);
    const float* qan = a.in[15] + j * 256; const float* qn = a.in[19] + j * 96;
    bf16* Xn = (bf16*)X.ldsg;
    const int tid = opaque_v(X.tid), lane = tid & 63, w = opaque_s(X.wave), r = lane & 31, hh = lane >> 5, R0 = t * 64; (void)tid;
    { v2u raw8[8]; const f32x4 g = *(const f32x4*)(qan + 4 * lane);
#pragma unroll
      for (int i = 0; i < 8; ++i) raw8[i] = *(const v2u*)(U + (size_t)(R0 + 8 * w + i) * UE + CE_QA + 4 * lane);
#pragma unroll
      for (int i = 0; i < 8; ++i) { const int row = 8 * w + i; const v2u raw = raw8[i];
        const float x0 = bflo(raw.x), x1 = bfhi(raw.x), x2 = bflo(raw.y), x3 = bfhi(raw.y);
        const float rstd = rsqrtf(wave_sum(x0 * x0 + x1 * x1 + x2 * x2 + x3 * x3) * (1.f / 256.f) + EPS);
        st4bf(Xn + row * 264 + 4 * lane, x0 * rstd * g.x, x1 * rstd * g.y, x2 * rstd * g.z, x3 * rstd * g.w); } }
    __syncthreads();
    f32x16 acc[3][2];
#pragma unroll
    for (int fb = 0; fb < 3; ++fb)
#pragma unroll
        for (int tb = 0; tb < 2; ++tb)
#pragma unroll
            for (int i = 0; i < 16; ++i) acc[fb][tb][i] = 0.f;
    const bf16* wp = Wq + (size_t)(w * 3) * 16 * 512 + lane * 8;
    const bf16* xp = Xn + r * 264 + 8 * hh;
#pragma unroll 4
    for (int ks = 0; ks < 16; ++ks) {
        bh8 af[3], bfr[2];
#pragma unroll
        for (int fb = 0; fb < 3; ++fb) af[fb] = ld16(wp + (size_t)(fb * 16 + ks) * 512);
#pragma unroll
        for (int tb = 0; tb < 2; ++tb) bfr[tb] = ld16(xp + tb * 32 * 264 + 16 * ks);
#pragma unroll
        for (int fb = 0; fb < 3; ++fb)
#pragma unroll
            for (int tb = 0; tb < 2; ++tb) acc[fb][tb] = mfma32(af[fb], bfr[tb], acc[fb][tb]);
    }
#pragma unroll
    for (int tb = 0; tb < 2; ++tb) {
        float ss = 0.f;
#pragma unroll
        for (int fb = 0; fb < 3; ++fb)
#pragma unroll
            for (int i = 0; i < 16; ++i) ss += acc[fb][tb][i] * acc[fb][tb][i];
        ss += __shfl_xor(ss, 32);
        const float rstd = rsqrtf(ss * (1.f / 96.f) + EPS) * 0.10206207261596577f;
        const int row = R0 + 32 * tb + r;
        const bool sample = row >= NP; const int tp = (row - NP) & 1023;
#pragma unroll
        for (int fb = 0; fb < 3; ++fb) {
            float v[16];
#pragma unroll
            for (int g = 0; g < 4; ++g) { const f32x4 gn = *(const f32x4*)(qn + 32 * fb + 8 * g + 4 * hh);
                v[4 * g + 0] = acc[fb][tb][4 * g + 0] * rstd * gn.x; v[4 * g + 1] = acc[fb][tb][4 * g + 1] * rstd * gn.y;
                v[4 * g + 2] = acc[fb][tb][4 * g + 2] * rstd * gn.z; v[4 * g + 3] = acc[fb][tb][4 * g + 3] * rstd * gn.w; }
            if (fb == 2 && sample) {
                const float* rr_ = rope + (tp >> 6) * 16 + 4 * hh; const float* rc_ = rope + (tp & 63) * 16 + 4 * hh;
#pragma unroll
                for (int e = 0; e < 4; ++e) {
                    float cs = rr_[e], sn = rr_[8 + e], x1 = v[e], x2 = v[4 + e];
                    v[e] = x1 * cs - x2 * sn; v[4 + e] = x1 * sn + x2 * cs;
                    cs = rc_[e]; sn = rc_[8 + e]; x1 = v[8 + e]; x2 = v[12 + e];
                    v[8 + e] = x1 * cs - x2 * sn; v[12 + e] = x1 * sn + x2 * cs;
                }
            }
#pragma unroll
            for (int g = 0; g < 4; ++g) st4bf(Q + (size_t)row * 768 + w * 96 + 32 * fb + 8 * g + 4 * hh, v[4 * g], v[4 * g + 1], v[4 * g + 2], v[4 * g + 3]);
        }
    }
    __syncthreads();
}

__device__ __forceinline__ void unit_mla_kv(const Args& a, const Ctx& X, int j, int t) {
    const bf16* U = (const bf16*)(a.ws + WS_U); bf16* KM = (bf16*)(a.ws + WS_KM); bf16* VTM = (bf16*)(a.ws + WS_VTM);
    const bf16* Wkv = (const bf16*)(a.ws + WS_WTKVB) + (size_t)j * 1024 * 128;
    const float* rope = (const float*)(a.ws + WS_ROPE);
    const float* kvan = a.in[16] + j * 128; const float* kn = a.in[20] + j * 96;
    bf16* Xc = (bf16*)X.ldsg;
    float* kpes = (float*)(X.ldsg + 17408);
    const int tid = opaque_v(X.tid), lane = tid & 63, w = opaque_s(X.wave), r = lane & 31, hh = lane >> 5; (void)tid;
    const bool own = t >= 0;
    int R0 = 0, krow0, bs = 0;
    if (own) { R0 = t * 64; if (R0 < NP) krow0 = R0; else { bs = (R0 - NP) >> 10; krow0 = NP + bs * 1280 + 256 + ((R0 - NP) & 1023); } }
    else { const int ct = -1 - t; bs = ct >> 2; krow0 = NP + bs * 1280 + (ct & 3) * 64; }
    { unsigned raw8[8]; float kp8[8]; f32x2 c8[8];
      if (own) {
#pragma unroll
          for (int i = 0; i < 8; ++i) { raw8[i] = *(const unsigned*)(U + (size_t)(R0 + 8 * w + i) * UE + CE_KVA + 2 * lane);
              kp8[i] = lane < 32 ? bf2f(U[(size_t)(R0 + 8 * w + i) * UE + CE_KPE + lane]) : 0.f; }
      } else {
#pragma unroll
          for (int i = 0; i < 8; ++i) { const int s = ((-1 - t) & 3) * 64 + 8 * w + i; const size_t o = (size_t)(bs * 2 + j) * 256 + s;
              c8[i] = *(const f32x2*)(a.in[3] + o * 128 + 2 * lane); kp8[i] = lane < 32 ? a.in[4][o * 32 + lane] : 0.f; }
      }
      const f32x2 g = *(const f32x2*)(kvan + 2 * lane);
#pragma unroll
      for (int i = 0; i < 8; ++i) { const int row = 8 * w + i;
        if (own) {
            const float x0 = bflo(raw8[i]), x1 = bfhi(raw8[i]);
            const float rstd = rsqrtf(wave_sum(x0 * x0 + x1 * x1) * (1.f / 128.f) + EPS);
            const float c0 = x0 * rstd * g.x, c1 = x1 * rstd * g.y;
            *(unsigned*)(Xc + row * 136 + 2 * lane) = pk2(c0, c1);
            if (lane < 32) kpes[row * 32 + lane] = kp8[i];
            if (R0 < NP) { const int b = (R0 + row) >> 8, s = (R0 + row) & 255; const size_t o = (size_t)(b * 2 + j) * 256 + s;
                *(f32x2*)(a.out + O_CKV + o * 128 + 2 * lane) = (f32x2){c0, c1};
                if (lane < 32) a.out[O_KPE + o * 32 + lane] = kp8[i]; }
        } else {
            *(unsigned*)(Xc + row * 136 + 2 * lane) = pk2(c8[i].x, c8[i].y);
            if (lane < 32) kpes[row * 32 + lane] = kp8[i];
        } } }
    __syncthreads();
    f32x16 ak[2][2], av[2][2];
#pragma unroll
    for (int x = 0; x < 2; ++x)
#pragma unroll
        for (int y = 0; y < 2; ++y)
#pragma unroll
            for (int i = 0; i < 16; ++i) { ak[x][y][i] = 0.f; av[x][y][i] = 0.f; }
    const bf16* wp = Wkv + (size_t)(w * 4) * 8 * 512 + lane * 8;
    const bf16* xp = Xc + r * 136 + 8 * hh;
#pragma unroll
    for (int ks = 0; ks < 8; ++ks) {
        bh8 wk[2], wv[2], xf[2];
#pragma unroll
        for (int fb = 0; fb < 2; ++fb) { wk[fb] = ld16(wp + (size_t)(fb * 8 + ks) * 512); wv[fb] = ld16(wp + (size_t)((2 + fb) * 8 + ks) * 512); }
#pragma unroll
        for (int tb = 0; tb < 2; ++tb) xf[tb] = ld16(xp + tb * 32 * 136 + 16 * ks);
#pragma unroll
        for (int fb = 0; fb < 2; ++fb)
#pragma unroll
            for (int tb = 0; tb < 2; ++tb) { ak[fb][tb] = mfma32(wk[fb], xf[tb], ak[fb][tb]); av[tb][fb] = mfma32(xf[tb], wv[fb], av[tb][fb]); }
    }
    const bool sample_own = own && R0 >= NP;
#pragma unroll
    for (int tb = 0; tb < 2; ++tb) {
        const int tok = 32 * tb + r;
        float kp[16]; float ss = 0.f;
#pragma unroll
        for (int g = 0; g < 4; ++g) { const f32x4 q4 = *(const f32x4*)(kpes + tok * 32 + 16 * hh + 4 * g); kp[4 * g] = q4.x; kp[4 * g + 1] = q4.y; kp[4 * g + 2] = q4.z; kp[4 * g + 3] = q4.w; }
#pragma unroll
        for (int i = 0; i < 16; ++i) ss += kp[i] * kp[i] + ak[0][tb][i] * ak[0][tb][i] + ak[1][tb][i] * ak[1][tb][i];
        ss += __shfl_xor(ss, 32);
        const float rstd = rsqrtf(ss * (1.f / 96.f) + EPS);
        bf16* kdst = KM + ((size_t)(((krow0 >> 5) + tb) * 8 + w) * 6) * 512 + r * 8;
#pragma unroll
        for (int fb = 0; fb < 2; ++fb)
#pragma unroll
            for (int g = 0; g < 4; ++g) { const int f0 = 32 * fb + 8 * g + 4 * hh; const f32x4 gn = *(const f32x4*)(kn + f0);
                st4bf(kdst + (2 * fb + (g >> 1)) * 512 + (g & 1) * 256 + 4 * hh, ak[fb][tb][4 * g] * rstd * gn.x, ak[fb][tb][4 * g + 1] * rstd * gn.y, ak[fb][tb][4 * g + 2] * rstd * gn.z, ak[fb][tb][4 * g + 3] * rstd * gn.w); }
#pragma unroll
        for (int g = 0; g < 4; ++g) { const f32x4 gn = *(const f32x4*)(kn + 64 + 16 * hh + 4 * g);
            kp[4 * g] *= rstd * gn.x; kp[4 * g + 1] *= rstd * gn.y; kp[4 * g + 2] *= rstd * gn.z; kp[4 * g + 3] *= rstd * gn.w; }
        if (sample_own) {
            const int tp = (R0 - NP + tok) & 1023; const int pos = hh == 0 ? (tp >> 6) : (tp & 63);
            const float* rp = rope + pos * 16;
#pragma unroll
            for (int i = 0; i < 8; ++i) { const float cs = rp[i], sn = rp[8 + i], x1 = kp[i], x2 = kp[8 + i]; kp[i] = x1 * cs - x2 * sn; kp[8 + i] = x1 * sn + x2 * cs; }
        }
#pragma unroll
        for (int g = 0; g < 4; ++g) st4bf(kdst + (4 + hh) * 512 + (g >> 1) * 256 + 4 * (g & 1), kp[4 * g], kp[4 * g + 1], kp[4 * g + 2], kp[4 * g + 3]);
#pragma unroll
        for (int fb = 0; fb < 2; ++fb) { bf16* vdst = VTM + ((size_t)(((krow0 >> 5) + tb) * 8 + w) * 4 + 2 * fb) * 512 + (hh * 32 + r) * 8;
#pragma unroll
            for (int g = 0; g < 4; ++g) st4bf(vdst + (g >> 1) * 512 + 4 * (g & 1), av[tb][fb][4 * g], av[tb][fb][4 * g + 1], av[tb][fb][4 * g + 2], av[tb][fb][4 * g + 3]); }
    }
    __syncthreads();
}

struct AttnState { f32x16 o0, o1; float m, l; };
__device__ __forceinline__ void attn_init(AttnState& st) {
#pragma unroll
    for (int i = 0; i < 16; ++i) { st.o0[i] = 0.f; st.o1[i] = 0.f; }
    st.m = -1e30f; st.l = 0.f;
}
template <int NKS> struct KVf { bh8 k[NKS]; bh8 v[4]; };
template <int NKS> __device__ __forceinline__ void load_kv(KVf<NKS>& f, const bf16* kp, const bf16* vp) {
#pragma unroll
    for (int ks = 0; ks < NKS; ++ks) f.k[ks] = ld16(kp + ks * 512);
#pragma unroll
    for (int q = 0; q < 4; ++q) f.v[q] = ld16(vp + q * 512);
}
template <int NKS>
__device__ __forceinline__ void attn_compute(AttnState& st, const bh8* qf, const KVf<NKS>& f, const float* rk, int hh, bool na, int kc0, int dr, int cq, int c0, const float* rpbs) {
    f32x16 s;
#pragma unroll
    for (int i = 0; i < 16; ++i) s[i] = 0.f;
#pragma unroll
    for (int ks = 0; ks < NKS; ++ks) s = mfma32(f.k[ks], qf[ks], s);
    if (rk) {
#pragma unroll
        for (int g = 0; g < 4; ++g) { const f32x4 rv = *(const f32x4*)(rk + 8 * g + 4 * hh); s[4 * g] *= rv.x; s[4 * g + 1] *= rv.y; s[4 * g + 2] *= rv.z; s[4 * g + 3] *= rv.w; }
    }
    if (na) {
#pragma unroll
        for (int i = 0; i < 16; ++i) { const int kc = kc0 + crow(i, hh); const bool ok = kc >= c0 && kc < c0 + 16;
            int dc = kc - cq; dc = dc < -15 ? -15 : (dc > 15 ? 15 : dc);
            s[i] = ok ? s[i] + rpbs[dr * 31 + dc + 15] : -1e30f; }
    }
    float mx = s[0];
#pragma unroll
    for (int i = 1; i < 16; ++i) mx = fmaxf(mx, s[i]);
    mx = fmaxf(mx, __shfl_xor(mx, 32));
    const float mn = fmaxf(st.m, mx);
    const float alpha = __expf(st.m - mn);
    float ps = 0.f;
#pragma unroll
    for (int i = 0; i < 16; ++i) { float p = __expf(s[i] - mn); p = s[i] > -1e29f ? p : 0.f; s[i] = p; ps += p; }
    st.l = st.l * alpha + ps; st.m = mn;
#pragma unroll
    for (int i = 0; i < 16; ++i) { st.o0[i] *= alpha; st.o1[i] *= alpha; }
    const bh8 p0 = pfrag(s, 0), p1 = pfrag(s, 1);
    st.o0 = mfma32(f.v[0], p0, st.o0); st.o0 = mfma32(f.v[1], p1, st.o0);
    st.o1 = mfma32(f.v[2], p0, st.o1); st.o1 = mfma32(f.v[3], p1, st.o1);
}
template <int KS>
__device__ __forceinline__ void attn_merge_store(AttnState& st, float* part, int w, int lane, const bf16* gp, bf16* zp) {
    const int r = lane & 31, hh = lane >> 5;
    float* mine = part + w * 2048; float* ml = part + 8 * 2048;
#pragma unroll
    for (int i = 0; i < 16; ++i) { mine[crow(i, hh) * 32 + r] = st.o0[i]; mine[(32 + crow(i, hh)) * 32 + r] = st.o1[i]; }
    const float lt = st.l + __shfl_xor(st.l, 32);
    if (hh == 0) { ml[(w * 2) * 32 + r] = st.m; ml[(w * 2 + 1) * 32 + r] = lt; }
    __syncthreads();
    const int qb = w / KS, kp = w % KS;
    float f[KS]; float ms = -1e30f, L = 0.f;
#pragma unroll
    for (int k = 0; k < KS; ++k) ms = fmaxf(ms, ml[((qb * KS + k) * 2) * 32 + r]);
#pragma unroll
    for (int k = 0; k < KS; ++k) { f[k] = __expf(ml[((qb * KS + k) * 2) * 32 + r] - ms); L += f[k] * ml[((qb * KS + k) * 2 + 1) * 32 + r]; }
    const float inv = 1.f / L;
    constexpr int ND = 32 / KS;
    const int dv0 = (64 / KS) * kp + ND * hh;
#pragma unroll
    for (int c = 0; c < ND / 8; ++c) {
        float o[8];
#pragma unroll
        for (int e = 0; e < 8; ++e) { float v = 0.f;
#pragma unroll
            for (int k = 0; k < KS; ++k) v += f[k] * part[(qb * KS + k) * 2048 + (dv0 + 8 * c + e) * 32 + r];
            o[e] = v * inv; }
        const v4u gr = *(const v4u*)(gp + dv0 + 8 * c);
        v4u z; z.x = pk2(o[0] * silu_f(bflo(gr.x)), o[1] * silu_f(bfhi(gr.x))); z.y = pk2(o[2] * silu_f(bflo(gr.y)), o[3] * silu_f(bfhi(gr.y)));
        z.z = pk2(o[4] * silu_f(bflo(gr.z)), o[5] * silu_f(bfhi(gr.z))); z.w = pk2(o[6] * silu_f(bflo(gr.w)), o[7] * silu_f(bfhi(gr.w)));
        *(v4u*)(zp + dv0 + 8 * c) = z;
    }
    __syncthreads();
}

__device__ __forceinline__ void unit_mla_attn(const Args& a, const Ctx& X, int u) {
    const bf16* U = (const bf16*)(a.ws + WS_U); const bf16* Q = (const bf16*)(a.ws + WS_Q); const bf16* KM = (const bf16*)(a.ws + WS_KM); const bf16* VTM = (const bf16*)(a.ws + WS_VTM);
    bf16* Z = (bf16*)(a.ws + WS_Z);
    const int tid = opaque_v(X.tid), lane = tid & 63, w = opaque_s(X.wave), r = lane & 31, hh = lane >> 5;
    int h, q0, kb0, nkb; const bool samp = u < 256;
    if (samp) { const int bs = u >> 7, qg = u & 15; h = (u >> 4) & 7; q0 = NP + bs * 1024 + 64 * qg + 32 * (w >> 2); kb0 = NP + bs * 1280 + 320 * (w & 3); nkb = 10; }
    else { const int v = u - 256, b = v >> 4, qh = v & 1; h = (v >> 1) & 7; q0 = b * 256 + 128 * qh + 32 * (w >> 1); kb0 = b * 256 + 128 * (w & 1); nkb = 4; }
    bh8 qf[6];
#pragma unroll
    for (int ks = 0; ks < 6; ++ks) qf[ks] = ld16(Q + (size_t)(q0 + r) * 768 + h * 96 + 16 * ks + 8 * hh);
    AttnState st; attn_init(st);
    const bf16* kp = KM + ((size_t)((kb0 >> 5) * 8 + h) * 6) * 512 + lane * 8;
    const bf16* vp = VTM + ((size_t)((kb0 >> 5) * 8 + h) * 4) * 512 + lane * 8;
    KVf<6> fa, fb;
    load_kv<6>(fa, kp, vp);
    for (int kb = 0; kb < nkb; kb += 2) {
        load_kv<6>(fb, kp + (size_t)(kb + 1) * 8 * 6 * 512, vp + (size_t)(kb + 1) * 8 * 4 * 512);
        attn_compute<6>(st, qf, fa, nullptr, hh, false, 0, 0, 0, 0, nullptr);
        if (kb + 2 < nkb) load_kv<6>(fa, kp + (size_t)(kb + 2) * 8 * 6 * 512, vp + (size_t)(kb + 2) * 8 * 4 * 512);
        attn_compute<6>(st, qf, fb, nullptr, hh, false, 0, 0, 0, 0, nullptr);
    }
    const int row = q0 + r;
    if (samp) attn_merge_store<4>(st, (float*)X.ldsg, w, lane, U + (size_t)row * UE + CE_GA + h * 64, Z + (size_t)row * DM + h * 64);
    else attn_merge_store<2>(st, (float*)X.ldsg, w, lane, U + (size_t)row * UE + CE_GA + h * 64, Z + (size_t)row * DM + h * 64);
}

__device__ __forceinline__ void load_q64(const bf16* qrow  , const float* qnorm, const float* knorm, int hh, bh8* qa) {
    float x[4][8]; float ss = 0.f;
#pragma unroll
    for (int ks = 0; ks < 4; ++ks) { const v4u raw = *(const v4u*)(qrow + 16 * ks + 8 * hh);
        x[ks][0] = bflo(raw.x); x[ks][1] = bfhi(raw.x); x[ks][2] = bflo(raw.y); x[ks][3] = bfhi(raw.y); x[ks][4] = bflo(raw.z); x[ks][5] = bfhi(raw.z); x[ks][6] = bflo(raw.w); x[ks][7] = bfhi(raw.w);
#pragma unroll
        for (int e = 0; e < 8; ++e) ss += x[ks][e] * x[ks][e]; }
    ss += __shfl_xor(ss, 32);
    const float rstd = rsqrtf(ss * (1.f / 64.f) + EPS) * 0.125f;
#pragma unroll
    for (int ks = 0; ks < 4; ++ks) { float ya[8];
#pragma unroll
        for (int e = 0; e < 8; ++e) { const int d = 16 * ks + 8 * hh + e; ya[e] = x[ks][e] * rstd * qnorm[d] * knorm[d]; }
        v4u va; va.x = pk2(ya[0], ya[1]); va.y = pk2(ya[2], ya[3]); va.z = pk2(ya[4], ya[5]); va.w = pk2(ya[6], ya[7]);
        qa[ks] = __builtin_bit_cast(bh8, va); }
}

__device__ __forceinline__ void unit_odd_attn(const Args& a, const Ctx& X, int j, int u) {
    const bf16* U = (const bf16*)(a.ws + WS_U); const bf16* VTO = (const bf16*)(a.ws + WS_VTO); bf16* Z = (bf16*)(a.ws + WS_Z);
    const float* qnorm = a.in[28] + j * 64; const float* knorm = a.in[29] + j * 64;
    float* part = (float*)X.ldsg; float* rk = part + 8 * 2048 + 512;
    const int b = u >> 4, h = (u >> 1) & 7, qh = u & 1, tid = opaque_v(X.tid), lane = tid & 63, w = opaque_s(X.wave), r = lane & 31, hh = lane >> 5, R0 = b * 256;
    { const int key = tid >> 1, half = tid & 1;
      const bf16* kp = U + (size_t)(R0 + key) * UO + CO_KD + h * 64 + 32 * half;
      float kx[32]; float ss = 0.f;
#pragma unroll
      for (int q = 0; q < 4; ++q) { const v4u kr = *(const v4u*)(kp + 8 * q);
          kx[8 * q] = bflo(kr.x); kx[8 * q + 1] = bfhi(kr.x); kx[8 * q + 2] = bflo(kr.y); kx[8 * q + 3] = bfhi(kr.y); kx[8 * q + 4] = bflo(kr.z); kx[8 * q + 5] = bfhi(kr.z); kx[8 * q + 6] = bflo(kr.w); kx[8 * q + 7] = bfhi(kr.w); }
#pragma unroll
      for (int e = 0; e < 32; ++e) ss += kx[e] * kx[e];
      ss += __shfl_xor(ss, 1);
      const float rstd = rsqrtf(ss * (1.f / 64.f) + EPS);
      if (half == 0) rk[key] = rstd;
      if (qh == 0) {
          const bf16* vp = U + (size_t)(R0 + key) * UO + CO_VD + h * 64 + 32 * half;
          float* ok = a.out + O_NK + ((size_t)(b * 2 + j) * 256 + key) * 512 + h * 64 + 32 * half; float* ov = a.out + O_NV + ((size_t)(b * 2 + j) * 256 + key) * 512 + h * 64 + 32 * half;
#pragma unroll
          for (int q = 0; q < 8; ++q) { const f32x4 g = *(const f32x4*)(knorm + 32 * half + 4 * q);
              *(f32x4*)(ok + 4 * q) = (f32x4){kx[4 * q] * rstd * g.x, kx[4 * q + 1] * rstd * g.y, kx[4 * q + 2] * rstd * g.z, kx[4 * q + 3] * rstd * g.w}; }
#pragma unroll
          for (int q = 0; q < 4; ++q) { const v4u vr = *(const v4u*)(vp + 8 * q);
              *(f32x4*)(ov + 8 * q) = (f32x4){bflo(vr.x), bfhi(vr.x), bflo(vr.y), bfhi(vr.y)}; *(f32x4*)(ov + 8 * q + 4) = (f32x4){bflo(vr.z), bfhi(vr.z), bflo(vr.w), bfhi(vr.w)}; }
      } }
    __syncthreads();
    const int row = R0 + 128 * qh + 32 * (w >> 1) + r, kb0 = R0 + 128 * (w & 1);
    bh8 qa[4];
    load_q64(U + (size_t)row * UO + CO_QD + h * 64, qnorm, knorm, hh, qa);
    AttnState st; attn_init(st);
    const bf16* kp = (const bf16*)(a.ws + WS_KFO) + ((size_t)((kb0 >> 5) * 8 + h) * 4) * 512 + lane * 8;
    const bf16* vp = VTO + ((size_t)((kb0 >> 5) * 8 + h) * 4) * 512 + lane * 8;
    const float* rkp = rk + 128 * (w & 1);
    KVf<4> fa, fb;
    load_kv<4>(fa, kp, vp);
#pragma unroll
    for (int kb = 0; kb < 4; kb += 2) {
        load_kv<4>(fb, kp + (size_t)(kb + 1) * 8 * 4 * 512, vp + (size_t)(kb + 1) * 8 * 4 * 512);
        attn_compute<4>(st, qa, fa, rkp + 32 * kb, hh, false, 0, 0, 0, 0, nullptr);
        if (kb + 2 < 4) load_kv<4>(fa, kp + (size_t)(kb + 2) * 8 * 4 * 512, vp + (size_t)(kb + 2) * 8 * 4 * 512);
        attn_compute<4>(st, qa, fb, rkp + 32 * (kb + 1), hh, false, 0, 0, 0, 0, nullptr);
    }
    attn_merge_store<2>(st, part, w, lane, U + (size_t)row * UO + CO_GD + h * 64, Z + (size_t)row * DM + 512 + h * 64);
}

__device__ __forceinline__ void na_block_ptrs(int g, int rb, int R0s, int h, int lane, const bf16* KFO, const bf16* VFO, const bf16* kc, const bf16* vc,
                                              const bf16*& kp, const bf16*& vp, int& rki, bool& win, int& kc0, int& bi) {
    if (g < 8) { kp = kc + (size_t)g * 4 * 512 + lane * 8; vp = vc + (size_t)g * 4 * 512 + lane * 8; rki = 512 + 32 * g; win = false; kc0 = 0; bi = 0; }
    else { const int i = (g - 8) >> 1, xk = g & 1; const int tok0 = (rb + i) * 64 + 32 * xk; const size_t blk = ((size_t)(((R0s + tok0) >> 5) * 8 + h) * 4) * 512 + lane * 8;
        kp = KFO + blk; vp = VFO + blk; rki = i * 64 + 32 * xk; win = true; kc0 = 32 * xk; bi = i; }
}
__device__ __forceinline__ void unit_na(const Args& a, const Ctx& X, int j, int u) {
    const bf16* U = (const bf16*)(a.ws + WS_U); const bf16* VTO = (const bf16*)(a.ws + WS_VTO); bf16* Z = (bf16*)(a.ws + WS_Z);
    const float* qnorm = a.in[28] + j * 64; const float* knorm = a.in[29] + j * 64;
    float* part = (float*)X.ldsg; float* rk = part + 8 * 2048 + 512;
    float* rpbs = rk + 768;
    const int bs = u >> 7, h = (u >> 4) & 7, rr = u & 15, tid = opaque_v(X.tid), lane = tid & 63, w = opaque_s(X.wave), r = lane & 31, hh = lane >> 5, R0s = NP + bs * 1024;
    const int rb = rr - 4 < 0 ? 0 : (rr - 4 > 8 ? 8 : rr - 4);
    { const bf16* kp = U + (size_t)(R0s + rb * 64 + tid) * UO + CO_KD + h * 64; float ss = 0.f;
#pragma unroll
      for (int q = 0; q < 8; ++q) { const v4u kr = *(const v4u*)(kp + 8 * q);
          const float k0 = bflo(kr.x), k1 = bfhi(kr.x), k2 = bflo(kr.y), k3 = bfhi(kr.y), k4 = bflo(kr.z), k5 = bfhi(kr.z), k6 = bflo(kr.w), k7 = bfhi(kr.w);
          ss += (k0 * k0 + k1 * k1) + (k2 * k2 + k3 * k3) + (k4 * k4 + k5 * k5) + (k6 * k6 + k7 * k7); }
      rk[tid] = rsqrtf(ss * (1.f / 64.f) + EPS);
      if (tid < 256) rk[512 + tid] = 1.f;
      if (tid < 465) rpbs[tid] = a.in[30][(size_t)(j * 8 + h) * 465 + tid]; }
    __syncthreads();
    const int xq = w >> 2, kpart = w & 3, tok = rr * 64 + 32 * xq + r, cq = 32 * xq + r;
    const int c0 = cq - 8 < 0 ? 0 : (cq - 8 > 48 ? 48 : cq - 8);
    const int row = R0s + tok;
    bh8 qa[4];
    load_q64(U + (size_t)row * UO + CO_QD + h * 64, qnorm, knorm, hh, qa);
    AttnState st; attn_init(st);
    const bf16* kc = (const bf16*)(a.ws + WS_NAKC) + (size_t)((bs * 2 + j) * 8 + h) * 8 * 4 * 512;
    const bf16* vc = (const bf16*)(a.ws + WS_NAVC) + (size_t)((bs * 2 + j) * 8 + h) * 8 * 4 * 512;
    const bf16* KFO = (const bf16*)(a.ws + WS_KFO);
    const int g0 = 6 * kpart;
    KVf<4> fa, fb;
    const bf16 *kpa, *vpa, *kpb, *vpb; int rka, rkb, kca, kcb, bia, bib; bool wa, wb;
    na_block_ptrs(g0, rb, R0s, h, lane, KFO, VTO, kc, vc, kpa, vpa, rka, wa, kca, bia);
    load_kv<4>(fa, kpa, vpa);
#pragma unroll 1
    for (int g = 0; g < 6; g += 2) {
        na_block_ptrs(g0 + g + 1, rb, R0s, h, lane, KFO, VTO, kc, vc, kpb, vpb, rkb, wb, kcb, bib);
        load_kv<4>(fb, kpb, vpb);
        attn_compute<4>(st, qa, fa, rk + rka, hh, wa, kca, rb + bia - rr + 7, cq, c0, rpbs);
        if (g + 2 < 6) { na_block_ptrs(g0 + g + 2, rb, R0s, h, lane, KFO, VTO, kc, vc, kpa, vpa, rka, wa, kca, bia); load_kv<4>(fa, kpa, vpa); }
        attn_compute<4>(st, qa, fb, rk + rkb, hh, wb, kcb, rb + bib - rr + 7, cq, c0, rpbs);
    }
    attn_merge_store<4>(st, part, w, lane, U + (size_t)row * UO + CO_GD + h * 64, Z + (size_t)row * DM + 512 + h * 64);
}
#ifndef RU_OUT_A
#define RU_OUT_A 1
#endif
#ifndef RU_OUT_B
#define RU_OUT_B 1
#endif
#ifndef RU_OUT_C
#define RU_OUT_C 1
#endif
__device__ __forceinline__ float scan_incl_sum(float v, int lane) {
#pragma unroll
    for (int o = 1; o < 64; o <<= 1) { const float t = __shfl_up(v, o); if (lane >= o) v += t; }
    return v;
}
__device__ __forceinline__ float scan_incl_max(float v, int lane) {
#pragma unroll
    for (int o = 1; o < 64; o <<= 1) { const float t = __shfl_up(v, o); if (lane >= o) v = fmaxf(v, t); }
    return v;
}
__device__ __forceinline__ float scan_incl_max_rev(float v, int lane) {
#pragma unroll
    for (int o = 1; o < 64; o <<= 1) { const float t = __shfl_down(v, o); if (lane + o < 64) v = fmaxf(v, t); }
    return v;
}
constexpr float KSC = 0.08838834764831845f;

__device__ __forceinline__ void stage_T(const bf16* src  , int pitch, bf16* d0, const float* w0, bf16* d1, const float* w1, int wave, int lane) {
#pragma unroll
    for (int i = 0; i < 2; ++i) { const int c = wave * 2 + i;
        const v4u raw = *(const v4u*)(src + (size_t)lane * pitch + 8 * c);
        float x[8] = {bflo(raw.x), bfhi(raw.x), bflo(raw.y), bfhi(raw.y), bflo(raw.z), bfhi(raw.z), bflo(raw.w), bfhi(raw.w)};
        if (w0) { const float s0 = w0[lane] * KSC, s1 = w1[lane] * KSC;
#pragma unroll
            for (int e = 0; e < 8; ++e) { d0[(8 * c + e) * 72 + lane] = (bf16)(pk2(x[e] * s0, 0.f) & 0xffffu); d1[(8 * c + e) * 72 + lane] = (bf16)(pk2(x[e] * s1, 0.f) & 0xffffu); }
        } else {
            const unsigned rr[4] = {raw.x, raw.y, raw.z, raw.w};
#pragma unroll
            for (int e = 0; e < 8; ++e) d0[(8 * c + e) * 72 + lane] = (bf16)((rr[e >> 1] >> (16 * (e & 1))) & 0xffffu);
        }
    }
}

__device__ __forceinline__ void unit_mlstm_L(const Args& a, const Ctx& X, int j, int h, int gc) {
    const bf16* U = (const bf16*)(a.ws + WS_U); const float* GT = (const float*)(a.ws + WS_GATES); const bf16* VFM = (const bf16*)(a.ws + WS_VFM);
    float* AG = (float*)(a.ws + WS_AG); float* LT = (float*)(a.ws + WS_LT); float* NL = (float*)(a.ws + WS_NL); float* GQ = (float*)(a.ws + WS_GQ);
    float* wgt = (float*)X.ldsg;
    bf16* KwT = (bf16*)(X.ldsg + 1024);
    const int tid = opaque_v(X.tid), lane = tid & 63, w = opaque_s(X.wave), r = lane & 31, hh = lane >> 5, R0 = gc * 64;
    v4u kraw[2];
#pragma unroll
    for (int i = 0; i < 2; ++i) kraw[i] = *(const v4u*)(U + (size_t)(R0 + lane) * UE + CE_KM + h * 128 + 8 * (w * 2 + i));
    bh8 vf[4][4];
#pragma unroll
    for (int eb = 0; eb < 4; ++eb)
#pragma unroll
        for (int q = 0; q < 4; ++q) vf[eb][q] = ld16(VFM + ((size_t)(((2 * gc + (q >> 1)) * 4 + h) * 8 + eb * 2 + (q & 1))) * 512 + lane * 8);
    if (w < 2) { const int dir = w; const int row = R0 + lane;
        const float lf = logsigmoid_f(GT[(size_t)row * 16 + 8 + dir * 4 + h] + a.in[22][j * 8 + dir * 4 + h]);
        const float ii = GT[(size_t)row * 16 + dir * 4 + h] + a.in[21][j * 8 + dir * 4 + h];
        const float P = scan_incl_sum(lf, lane); const float T = __shfl(P, 63);
        const float dec = (dir == 0 ? (T - P) : (P - lf)) + ii;
        const float am = wave_max(dec);
        wgt[dir * 64 + lane] = expf(dec - am) * KSC;
        if (lane == 0) { AG[((dir * 4 + h) * 96 + gc) * 2] = am; AG[((dir * 4 + h) * 96 + gc) * 2 + 1] = T; }
        const float cum = dir == 0 ? P : (T - P + lf), bv = ii - cum;
        const float pm = dir == 0 ? scan_incl_max(bv, lane) : scan_incl_max_rev(bv, lane);
        *(f32x4*)(GQ + ((size_t)(dir * 4 + h) * NT + row) * 4) = (f32x4){cum, bv, pm, 0.f};
    }
    __syncthreads();
#pragma unroll
    for (int i = 0; i < 2; ++i) { const int c = w * 2 + i; const unsigned rr[4] = {kraw[i].x, kraw[i].y, kraw[i].z, kraw[i].w};
        const float s0 = wgt[lane], s1 = wgt[64 + lane];
#pragma unroll
        for (int e = 0; e < 8; ++e) { const float x = (e & 1) ? bfhi(rr[e >> 1]) : bflo(rr[e >> 1]);
            KwT[(8 * c + e) * 72 + lane] = (bf16)(pk2(x * s0, 0.f) & 0xffffu); KwT[128 * 72 + (8 * c + e) * 72 + lane] = (bf16)(pk2(x * s1, 0.f) & 0xffffu); } }
    __syncthreads();
    { const int dir = w >> 2, db = w & 3; const size_t ub = (size_t)((dir * 4 + h) * 96 + gc);
      bh8 bfr[4];
#pragma unroll
      for (int q = 0; q < 4; ++q) { const bf16* kp = KwT + dir * 128 * 72 + (32 * db + r) * 72 + 16 * q + 4 * hh; bfr[q] = ld2x8(kp, kp + 8); }
#pragma unroll
      for (int eb = 0; eb < 4; ++eb) { f32x16 acc;
#pragma unroll
          for (int i = 0; i < 16; ++i) acc[i] = 0.f;
#pragma unroll
          for (int q = 0; q < 4; ++q) acc = mfma32(vf[eb][q], bfr[q], acc);
          float* dst = LT + ub * 16384 + 32 * db + r;
#pragma unroll
          for (int i = 0; i < 16; ++i) dst[(32 * eb + crow(i, hh)) * 128] = acc[i]; }
      if (tid < 256) { const int dr = tid >> 7, d = tid & 127; const bf16* p = KwT + dr * 128 * 72 + d * 72; float s = 0.f;
#pragma unroll
          for (int q = 0; q < 8; ++q) { const v4u x = *(const v4u*)(p + 8 * q); s += (bflo(x.x) + bfhi(x.x)) + (bflo(x.y) + bfhi(x.y)) + (bflo(x.z) + bfhi(x.z)) + (bflo(x.w) + bfhi(x.w)); }
          NL[(size_t)((dr * 4 + h) * 96 + gc) * 128 + d] = s; } }
    __syncthreads();
}

template <int NC, int NV>
__device__ __forceinline__ void scan_body(const Args& a, int j, int tid, int dir, int h, int gc0, int sl, int initmat  , long outsb  ) {
    const float* AG = (const float*)(a.ws + WS_AG); const float* LT = (const float*)(a.ws + WS_LT); const float* NL = (const float*)(a.ws + WS_NL);
    bf16* CTB = (bf16*)(a.ws + WS_CTB); float* NPV = (float*)(a.ws + WS_NPV); float* MPV = (float*)(a.ws + WS_MPV);
    const size_t ub0 = (size_t)((dir * 4 + h) * 96 + gc0);
    const int e0 = sl * (NV * 2048) + tid * 4;
    f32x4 Lv[NC][NV]; float nl[NC];
    const bool don = tid < 128 && sl == 0;
#pragma unroll
    for (int c = 0; c < NC; ++c) {
#pragma unroll
        for (int i = 0; i < NV; ++i) Lv[c][i] = *(const f32x4*)(LT + (ub0 + c) * 16384 + e0 + 2048 * i);
        nl[c] = don ? NL[(ub0 + c) * 128 + tid] : 0.f; }
    f32x4 Cs[NV]; float ns = 0.f, m = 0.f;
#pragma unroll
    for (int i = 0; i < NV; ++i) Cs[i] = (f32x4){0.f, 0.f, 0.f, 0.f};
    if (initmat >= 0) { const float* c0 = (const float*)(a.ws + WS_C0T) + (size_t)initmat * 16384;
#pragma unroll
        for (int i = 0; i < NV; ++i) Cs[i] = *(const f32x4*)(c0 + e0 + 2048 * i);
        if (don) ns = a.in[6][(size_t)initmat * 128 + tid];
        m = a.in[7][initmat]; }
#pragma unroll
    for (int p = 0; p < NC; ++p) {
        const int c = dir ? NC - 1 - p : p;
        const float ac = AG[(ub0 + c) * 2], Gc = AG[(ub0 + c) * 2 + 1];
#pragma unroll
        for (int i = 0; i < NV; ++i) { const int idx = e0 + 2048 * i; st4bf(CTB + (ub0 + c) * 16384 + idx, Cs[i].x, Cs[i].y, Cs[i].z, Cs[i].w); }
        if (don) NPV[(ub0 + c) * 128 + tid] = ns;
        if (tid == 0 && sl == 0) MPV[ub0 + c] = m;
        const float mn = fmaxf(Gc + m, ac), ws = expf(Gc + m - mn), wl = expf(ac - mn);
#pragma unroll
        for (int i = 0; i < NV; ++i) Cs[i] = Cs[i] * ws + Lv[c][i] * wl;
        ns = ns * ws + nl[c] * wl; m = mn;
    }
    if (outsb >= 0) {
#pragma unroll
        for (int i = 0; i < NV; ++i) { const int idx = e0 + 2048 * i, e = idx >> 7, d = idx & 127; float* o = a.out + O_C + (size_t)outsb * 16384 + e;
            o[(d + 0) * 128] = Cs[i].x; o[(d + 1) * 128] = Cs[i].y; o[(d + 2) * 128] = Cs[i].z; o[(d + 3) * 128] = Cs[i].w; }
        if (don) a.out[O_N + (size_t)outsb * 128 + tid] = ns;
        if (tid == 0 && sl == 0) a.out[O_M + outsb] = m;
    }
}
__device__ __forceinline__ void unit_mlstm_scan(const Args& a, const Ctx& X, int j, int s) {
    const int tid = opaque_v(X.tid);
    if (s < 256) { const int sl = s & 1, q = s >> 1, b = q >> 3, h = (q >> 1) & 3, dir = q & 1;
        scan_body<4, 4>(a, j, tid, dir, h, 4 * b, sl, -1, (long)((b * 2 + j) * 2 + dir) * 4 + h); }
    else { const int v = s - 256, sl = v & 7, q = v >> 3, bs = q >> 3, h = (q >> 1) & 3, dir = q & 1;
        scan_body<16, 1>(a, j, tid, dir, h, 64 + 16 * bs, sl, ((bs * 2 + j) * 2 + dir) * 4 + h, -1); }
}

__device__ __forceinline__ void unit_mlstm_out(const Args& a, const Ctx& X, int j, int h, int gc) {
    const bf16* U = (const bf16*)(a.ws + WS_U);
    const bf16* CTB = (const bf16*)(a.ws + WS_CTB); const float* NPV = (const float*)(a.ws + WS_NPV); const float* MPV = (const float*)(a.ws + WS_MPV);
    bf16* Z = (bf16*)(a.ws + WS_Z);
    unsigned char* L = X.ldsg;
    bf16* Qs = (bf16*)L; bf16* Ks = (bf16*)(L + 17408); bf16* CT = (bf16*)(L + 34816);
    float* ctm = (float*)(L + 137216); float* bb = ctm + 128; float* wint = bb + 128; float* emt = wint + 128;
    float* nprev = emt + 128;
    float* ssq = nprev + 256;
    const int tid = opaque_v(X.tid), lane = tid & 63, w = opaque_s(X.wave), r = lane & 31, hh = lane >> 5, R0 = gc * 64;
    const int tb = w & 1, eb = w >> 1, tau = 32 * tb + r;
    v4u qraw[2], kraw[2], craw[4];
#pragma unroll
    for (int i = 0; i < 2; ++i) { const int q = tid + 512 * i, row = q >> 4, cc = q & 15;
        qraw[i] = *(const v4u*)(U + (size_t)(R0 + row) * UE + CE_QM + h * 128 + 8 * cc);
        kraw[i] = *(const v4u*)(U + (size_t)(R0 + row) * UE + CE_KM + h * 128 + 8 * cc); }
#pragma unroll
    for (int i = 0; i < 4; ++i) { const int q = tid + 512 * i, e = q >> 4, cc = q & 15; craw[i] = *(const v4u*)(CTB + (size_t)((0 * 4 + h) * 96 + gc) * 16384 + e * 128 + 8 * cc); }
    const float npr = tid < 256 ? NPV[(size_t)(((tid >> 7) * 4 + h) * 96 + gc) * 128 + (tid & 127)] : 0.f;
    bh8 vf[4];
#pragma unroll
    for (int q = 0; q < 4; ++q) vf[q] = ld16((const bf16*)(a.ws + WS_VFM) + ((size_t)(((2 * gc + (q >> 1)) * 4 + h) * 8 + eb * 2 + (q & 1))) * 512 + lane * 8);
    f32x4 gq = (f32x4){0.f, 0.f, 0.f, 0.f}; float mp = 0.f;
    if (w < 2) { gq = *(const f32x4*)((const float*)(a.ws + WS_GQ) + ((size_t)(w * 4 + h) * NT + R0 + lane) * 4); mp = MPV[(size_t)((w * 4 + h) * 96 + gc)]; }
    { const int row = R0 + tau; v2u* og = (v2u*)(L + 104448) + tid * 8;
#pragma unroll
      for (int g = 0; g < 4; ++g) { const int e0 = 32 * eb + 8 * g + 4 * hh;
          og[g] = *(const v2u*)(U + (size_t)row * UE + CE_OM + h * 128 + e0); og[4 + g] = *(const v2u*)(U + (size_t)row * UE + CE_GM + h * 128 + e0); } }
#pragma unroll
    for (int i = 0; i < 2; ++i) { const int q = tid + 512 * i, row = q >> 4, cc = q & 15;
        *(v4u*)(Qs + row * 136 + 8 * cc) = qraw[i]; *(v4u*)(Ks + row * 136 + 8 * cc) = kraw[i]; }
#pragma unroll
    for (int i = 0; i < 4; ++i) { const int q = tid + 512 * i, e = q >> 4, cc = q & 15; *(v4u*)(CT + e * 136 + 8 * cc) = craw[i];
        craw[i] = *(const v4u*)(CTB + (size_t)((1 * 4 + h) * 96 + gc) * 16384 + e * 128 + 8 * cc); }
#pragma unroll
    for (int i = 0; i < 4; ++i) { const int q = tid + 512 * i, e = q >> 4, cc = q & 15; *(v4u*)(CT + 128 * 136 + e * 136 + 8 * cc) = craw[i]; }
    if (tid < 256) nprev[tid] = npr;
    if (w < 2) { const int dir = w; const float cum = gq.x, bv = gq.y, pm = gq.z;
        const float mt = cum + fmaxf(mp, pm);
        ctm[dir * 64 + lane] = cum - mt; bb[dir * 64 + lane] = bv; wint[dir * 64 + lane] = expf(cum + mp - mt); emt[dir * 64 + lane] = expf(-mt); }
    __syncthreads();
    const bf16* qp = Qs + (32 * tb + r) * 136 + 8 * hh;
    bh8 qf[8];
#pragma unroll
    for (int ks = 0; ks < 8; ++ks) qf[ks] = ld16(qp + 16 * ks);
    f32x16 hsum;
    for (int rpb_ = 0; rpb_ < RU_OUT_B; ++rpb_) {
#pragma unroll
    for (int i = 0; i < 16; ++i) hsum[i] = 0.f;
#pragma unroll 1
    for (int dir = 0; dir < 2; ++dir) {
        const int sgn = 1 - 2 * dir;
        const bf16* CTd = CT + dir * 128 * 136; const float* npv = nprev + dir * 128;
        const float ct = ctm[dir * 64 + tau], wi = wint[dir * 64 + tau];
        float rs = 0.f, qd = 0.f;
        f32x16 accv;
#pragma unroll
        for (int i = 0; i < 16; ++i) accv[i] = 0.f;
#pragma unroll
        for (int sb = 0; sb < 2; ++sb) {
            bh8 kf[8]; f32x16 ps;
#pragma unroll
            for (int ks = 0; ks < 8; ++ks) kf[ks] = ld16(Ks + (32 * sb + r) * 136 + 16 * ks + 8 * hh);
#pragma unroll
            for (int i = 0; i < 16; ++i) ps[i] = 0.f;
#pragma unroll
            for (int ks = 0; ks < 8; ++ks) ps = mfma32(kf[ks], qf[ks], ps);
#pragma unroll
            for (int g = 0; g < 4; ++g) { const f32x4 b4 = *(const f32x4*)(bb + dir * 64 + 32 * sb + 8 * g + 4 * hh);
#pragma unroll
                for (int e = 0; e < 4; ++e) { const int dd = (32 * sb + 8 * g + 4 * hh + e - tau) * sgn; const bool ok = dd <= 0;
                    const float v = ok ? ps[4 * g + e] * KSC * __expf(ct + b4[e]) : 0.f; ps[4 * g + e] = v; rs += v; } }
            accv = mfma32(vf[2 * sb], pfrag(ps, 0), accv);
            accv = mfma32(vf[2 * sb + 1], pfrag(ps, 1), accv);
            __builtin_amdgcn_sched_barrier(0);
        }
        rs += __shfl_xor(rs, 32);
#pragma unroll
        for (int ks = 0; ks < 8; ++ks) { const v4u qq = __builtin_bit_cast(v4u, qf[ks]); const f32x4 n0 = *(const f32x4*)(npv + 16 * ks + 8 * hh), n1 = *(const f32x4*)(npv + 16 * ks + 8 * hh + 4);
            qd += bflo(qq.x) * n0.x + bfhi(qq.x) * n0.y + bflo(qq.y) * n0.z + bfhi(qq.y) * n0.w + bflo(qq.z) * n1.x + bfhi(qq.z) * n1.y + bflo(qq.w) * n1.z + bfhi(qq.w) * n1.w;
            if ((ks & 1) == 1) __builtin_amdgcn_sched_barrier(0); }
        qd += __shfl_xor(qd, 32);
        __builtin_amdgcn_sched_barrier(0);
        bh8 cf[8];
#pragma unroll
        for (int ks = 0; ks < 8; ++ks) cf[ks] = ld16(CTd + (32 * eb + r) * 136 + 16 * ks + 8 * hh);
        const float qn = wi * qd + rs;
        f32x16 acc;
#pragma unroll
        for (int i = 0; i < 16; ++i) acc[i] = 0.f;
#pragma unroll
        for (int ks = 0; ks < 8; ++ks) acc = mfma32(cf[ks], qf[ks], acc);
#pragma unroll
        for (int i = 0; i < 16; ++i) acc[i] = acc[i] * wi + accv[i];
        const float inv = 1.f / fmaxf(fabsf(qn), emt[dir * 64 + tau]);
#pragma unroll
        for (int i = 0; i < 16; ++i) hsum[i] += acc[i] * inv;
        __builtin_amdgcn_sched_barrier(0);
    }
    }
    { float ss = 0.f;
#pragma unroll
      for (int i = 0; i < 16; ++i) ss += hsum[i] * hsum[i];
      ss += __shfl_xor(ss, 32);
      if (hh == 0) ssq[(tb * 4 + eb) * 32 + r] = ss; }
    __syncthreads();
    { const int tid2 = opaque_v(tid), lane2 = tid2 & 63, w2 = opaque_s(w), r2 = lane2 & 31, hh2 = lane2 >> 5, tb2 = w2 & 1, eb2 = w2 >> 1, tau2 = 32 * tb2 + r2;
    { const float tot = ssq[(tb2 * 4 + 0) * 32 + r2] + ssq[(tb2 * 4 + 1) * 32 + r2] + ssq[(tb2 * 4 + 2) * 32 + r2] + ssq[(tb2 * 4 + 3) * 32 + r2];
      const float rstd = rsqrtf(tot * (1.f / 128.f) + EPS);
      const int row = R0 + tau2; const float* hn = a.in[23] + j * 512 + h * 128;
#pragma unroll
      for (int g = 0; g < 4; ++g) { const int e0 = 32 * eb2 + 8 * g + 4 * hh2; const f32x4 gn = *(const f32x4*)(hn + e0); const v2u om = ((const v2u*)(L + 104448))[tid2 * 8 + g], gm = ((const v2u*)(L + 104448))[tid2 * 8 + 4 + g];
          st4bf(Z + (size_t)row * DM + 512 + h * 128 + e0,
                hsum[4 * g] * rstd * gn.x * sigmoid_f(bflo(om.x)) * silu_f(bflo(gm.x)), hsum[4 * g + 1] * rstd * gn.y * sigmoid_f(bfhi(om.x)) * silu_f(bfhi(gm.x)),
                hsum[4 * g + 2] * rstd * gn.z * sigmoid_f(bflo(om.y)) * silu_f(bflo(gm.y)), hsum[4 * g + 3] * rstd * gn.w * sigmoid_f(bfhi(om.y)) * silu_f(bfhi(gm.y))); } }
    }
    __syncthreads();
}
__device__ __forceinline__ void unit_conv(const Args& a, const Ctx& X, int j, int t) {
    const bf16* U = (const bf16*)(a.ws + WS_U); bf16* Z = (bf16*)(a.ws + WS_Z);
    const int tid = opaque_v(X.tid), cg = (tid & 63) * 8, r0 = t * 32 + (tid >> 6) * 4;
    const int S = r0 < NP ? 256 : 1024; const int s0 = r0 < NP ? (r0 & 255) : ((r0 - NP) & 1023);
    v4u xc[6], cc[6], bc[4], gc[4];
#pragma unroll
    for (int i = 0; i < 6; ++i) { const int s = s0 - 1 + i; const bool ok = s >= 0 && s < S; const bf16* u = U + (size_t)(r0 - 1 + i) * UO;
        xc[i] = ok ? *(const v4u*)(u + CO_XC + cg) : (v4u){0u, 0u, 0u, 0u}; cc[i] = ok ? *(const v4u*)(u + CO_CC + cg) : (v4u){0u, 0u, 0u, 0u}; }
#pragma unroll
    for (int i = 0; i < 4; ++i) { const bf16* u = U + (size_t)(r0 + i) * UO; bc[i] = *(const v4u*)(u + CO_BC + cg); gc[i] = *(const v4u*)(u + CO_GC + cg); }
    float w0[8], w1[8], w2[8], cb[8];
#pragma unroll
    for (int q = 0; q < 2; ++q) { const f32x4 a0 = *(const f32x4*)(a.in[26] + j * 1536 + cg + 4 * q), a1 = *(const f32x4*)(a.in[26] + j * 1536 + 512 + cg + 4 * q),
                                              a2 = *(const f32x4*)(a.in[26] + j * 1536 + 1024 + cg + 4 * q), a3 = *(const f32x4*)(a.in[27] + j * 512 + cg + 4 * q);
#pragma unroll
        for (int e = 0; e < 4; ++e) { w0[4 * q + e] = a0[e]; w1[4 * q + e] = a1[e]; w2[4 * q + e] = a2[e]; cb[4 * q + e] = a3[e]; } }
    float x[6][8];
#pragma unroll
    for (int i = 0; i < 6; ++i) { const unsigned xr[4] = {xc[i].x, xc[i].y, xc[i].z, xc[i].w}, cr[4] = {cc[i].x, cc[i].y, cc[i].z, cc[i].w};
#pragma unroll
        for (int q = 0; q < 4; ++q) { x[i][2 * q] = bflo(xr[q]) * bflo(cr[q]); x[i][2 * q + 1] = bfhi(xr[q]) * bfhi(cr[q]); } }
#pragma unroll
    for (int i = 0; i < 4; ++i) { const unsigned br[4] = {bc[i].x, bc[i].y, bc[i].z, bc[i].w}, gr[4] = {gc[i].x, gc[i].y, gc[i].z, gc[i].w};
        float o[8];
#pragma unroll
        for (int e = 0; e < 8; ++e) { const float bv = (e & 1) ? bfhi(br[e >> 1]) : bflo(br[e >> 1]), gv = (e & 1) ? bfhi(gr[e >> 1]) : bflo(gr[e >> 1]);
            const float cv = x[i][e] * w0[e] + x[i + 1][e] * w1[e] + x[i + 2][e] * w2[e] + cb[e];
            o[e] = bv * cv * silu_f(gv); }
        v4u z; z.x = pk2(o[0], o[1]); z.y = pk2(o[2], o[3]); z.z = pk2(o[4], o[5]); z.w = pk2(o[6], o[7]);
        *(v4u*)(Z + (size_t)(r0 + i) * DM + cg) = z; }
}

constexpr int NPHASES = 21;


#ifndef PROF_ID
#define PROF_ID 0
#endif
#ifndef PROF_K
#define PROF_K 8
#endif
#define PROF_BEGIN(id) unsigned long long pt0_##id = 0; if (PROF_ID == (id)) pt0_##id = __builtin_amdgcn_s_memrealtime();
#define PROF_END(id) if (PROF_ID == (id) && threadIdx.x == 0) { const unsigned dt_ = (unsigned)(__builtin_amdgcn_s_memrealtime() - pt0_##id); ((volatile LAS unsigned*)(X.lds + MISC_OFF))[16] += dt_; }
#ifndef RU_Q
#define RU_Q 1
#endif
#ifndef RU_KV
#define RU_KV 1
#endif
#ifndef RU_L
#define RU_L 1
#endif
#ifndef RU_ATTS
#define RU_ATTS 1
#endif
#ifndef RU_SCAN
#define RU_SCAN 1
#endif
#ifndef RU_OUT
#define RU_OUT 1
#endif
#ifndef RU_ATTP
#define RU_ATTP 1
#endif
#ifndef RU_NA
#define RU_NA 1
#endif
#ifndef RU_OATT
#define RU_OATT 1
#endif
#ifndef RU_CONV
#define RU_CONV 1
#endif
#ifndef RU_SIDE
#define RU_SIDE 1
#endif
#define REPU(n, call) for (int rp_ = 0; rp_ < (n); ++rp_) { call; }
#define PU(id, stmt) { PROF_BEGIN(id) stmt PROF_END(id) }
__device__ __forceinline__ void phase_gemm1(const Args& a, const Ctx& X, int l) {
    const int j = l >> 1; const bool even = (l & 1) == 0;
    pg8::Gemm g{(const bf16*)(a.ws + WS_H), even ? (const bf16*)(a.ws + WS_WTEV) + (size_t)j * 3584 * 1024 : (const bf16*)(a.ws + WS_WTOD) + (size_t)j * 4096 * 1024, NT, even ? UE : UO, DM};
    pg8::StaticOrder S; S.init(NT, even ? UE : UO, X.G, X.bid);
    pg8::EpiU E{(bf16*)(a.ws + WS_U), even ? UE : UO, even ? (float*)(a.ws + WS_GATES) : nullptr, even ? nullptr : (bf16*)(a.ws + WS_VTO), even ? nullptr : (bf16*)(a.ws + WS_KFO), even ? (bf16*)(a.ws + WS_VFM) : nullptr};
    pg8::gemm_phase<pg8::EpiU, pg8::StaticOrder, true, true>(X.lds, g, S, E);
}
__device__ __forceinline__ void phase_gemm2(const Args& a, const Ctx& X, int l) {
    pg8::Gemm g{(const bf16*)(a.ws + WS_Z), (const bf16*)(a.ws + WS_WTOUT) + (size_t)l * 1024 * 1024, NT, DM, DM};
    pg8::StaticOrder S; S.init(NT, DM, X.G, X.bid);
    pg8::EpiY E{a.out, l == 0 ? a.in[0] : a.out, l == 0 ? a.in[1] : a.out + (size_t)NP * DM, (const float*)(a.ws + WS_MOD) + l * 3 * 3072};
    pg8::gemm_phase<pg8::EpiY, pg8::StaticOrder, true, true>(X.lds, g, S, E);
}
__device__ __forceinline__ void phase_e2(const Args& a, const Ctx& X, int j) {
    for (int u = X.bid; u < 584; u += X.G) {
        if (u < 96) PU(10, REPU(RU_Q, unit_mla_q(a, X, j, u)))
        else if (u < 192) PU(11, REPU(RU_KV, unit_mla_kv(a, X, j, u - 96)))
        else if (u < 200) unit_mla_kv(a, X, j, -1 - (u - 192));
        else { const int v = u - 200; PU(12, REPU(RU_L, unit_mlstm_L(a, X, j, v / 96, v % 96))) }
    }
}
__device__ __forceinline__ void phase_e2b(const Args& a, const Ctx& X, int j) {
    for (int u = X.bid; u < 640; u += X.G) {
        if (u < 256) PU(13, REPU(RU_ATTS, unit_mla_attn(a, X, u)))
        else PU(14, REPU(RU_SCAN, unit_mlstm_scan(a, X, j, u - 256)))
    }
}
__device__ __forceinline__ void phase_e3(const Args& a, const Ctx& X, int j) {
    for (int u = X.bid; u < 640; u += X.G) {
        if (u < 384) PU(15, REPU(RU_OUT, unit_mlstm_out(a, X, j, u / 96, u % 96)))
        else PU(16, REPU(RU_ATTP, unit_mla_attn(a, X, u - 384 + 256)))
    }
}
__device__ __forceinline__ void phase_o2(const Args& a, const Ctx& X, int j) {
    for (int u = X.bid; u < 704; u += X.G) {
        if (u < 256) PU(17, REPU(RU_NA, unit_na(a, X, j, u)))
        else if (u < 512) PU(18, REPU(RU_OATT, unit_odd_attn(a, X, j, u - 256)))
        else PU(19, REPU(RU_CONV, unit_conv(a, X, j, u - 512)))
    }
}


#ifndef REP_P0A
#define REP_P0A 1
#endif
#ifndef REP_NORM
#define REP_NORM 1
#endif
#ifndef REP_G1
#define REP_G1 1
#endif
#ifndef REP_E2
#define REP_E2 1
#endif
#ifndef REP_G2L0
#define REP_G2L0 1
#endif
#ifndef REP_E2B
#define REP_E2B 1
#endif
#ifndef REP_E3
#define REP_E3 1
#endif
#ifndef REP_O2
#define REP_O2 1
#endif
#ifndef PHMASK
#define PHMASK 0x7f
#endif
#define PH_NOP(...) ((void)0)
#if PHMASK & 1
#define PH_P0A phase_p0a
#else
#define PH_P0A PH_NOP
#endif
#if PHMASK & 2
#define PH_NORM phase_norm
#else
#define PH_NORM PH_NOP
#endif
#if PHMASK & 4
#define PH_G1 phase_gemm1
#else
#define PH_G1 PH_NOP
#endif
#if PHMASK & 8
#define PH_E2 phase_e2
#else
#define PH_E2 PH_NOP
#endif
#if PHMASK & 16
#define PH_E3 phase_e3
#define PH_E2B phase_e2b
#else
#define PH_E3 PH_NOP
#define PH_E2B PH_NOP
#endif
#if PHMASK & 32
#define PH_O2 phase_o2
#else
#define PH_O2 PH_NOP
#endif
#if PHMASK & 64
#define PH_G2 phase_gemm2
#else
#define PH_G2 PH_NOP
#endif
__global__ void __launch_bounds__(NTHR, 2) mega_fwd(Args args) {
    extern __shared__ __attribute__((aligned(16))) unsigned char lds[];
    Ctx X; X.lds = (LAS unsigned char*)lds; X.ldsg = lds;
    X.tid = threadIdx.x; X.lane = X.tid & 63; X.wave = __builtin_amdgcn_readfirstlane(X.tid >> 6); X.G = gridDim.x; X.bid = blockIdx.x;
    volatile LAS unsigned* MISC = (volatile LAS unsigned*)(X.lds + MISC_OFF);
    if (X.tid < 32) MISC[X.tid] = 0u;
    __syncthreads();
    const int lo = args.ph_lo, hi = args.ph_hi;
    XcdBarrier bar; bar.bar = (unsigned*)(args.ws + WS_CTL) + CW_BAR; bar.x = 0; bar.st = MISC + 8;
    if (hi - lo > 1) bar = xcd_barrier_post((unsigned*)(args.ws + WS_CTL) + CW_BAR, MISC + 8);
    int ph = 0;
#define RUN(pid, n, body) do { if (ph >= lo && ph < hi) { for (int rp = 0; rp < (n); ++rp) { { PROF_BEGIN(pid) body; PROF_END(pid) } if (ph + 1 < hi || rp + 1 < (n)) { PROF_BEGIN(9) xcd_barrier(bar); PROF_END(9) } } } ++ph; } while (0)
    RUN(1, REP_P0A, PH_P0A(args, X));
    RUN(2, REP_NORM, PH_NORM(args, X, 0));
    for (int l = 0; l < 4; ++l) {
        const int j = l >> 1;
        RUN(3, REP_G1, PH_G1(args, X, l));
        if ((l & 1) == 0) { RUN(4, REP_E2, PH_E2(args, X, j)); RUN(5, REP_E2B, PH_E2B(args, X, j)); RUN(6, REP_E3, PH_E3(args, X, j)); }
        else { RUN(7, REP_O2, PH_O2(args, X, j)); }
        RUN(8, l == 0 ? REP_G2L0 : 1, PH_G2(args, X, l));
        if (l < 3) RUN(2, REP_NORM, PH_NORM(args, X, l + 1));
    }
#undef RUN
    if (PROF_ID != 0 && threadIdx.x == 0) { const unsigned long long t0 = __builtin_amdgcn_s_memrealtime(); const unsigned long long w = (unsigned long long)PROF_K * ((volatile LAS unsigned*)(X.lds + MISC_OFF))[16];
        while (__builtin_amdgcn_s_memrealtime() - t0 < w) __builtin_amdgcn_s_sleep(8); }
}

#ifndef MK_SPLIT
#define MK_SPLIT 0
#endif

extern "C" void kernel_launch(void* const* d_in, const int* in_sizes, int n_in, void* d_out, int out_size, void* d_ws, size_t ws_size, hipStream_t stream) {
    static int ready = 0;
    if (!ready) {
        if (hipFuncSetAttribute((const void*)mega_fwd, hipFuncAttributeMaxDynamicSharedMemorySize, LDS_BYTES) != hipSuccess) fprintf(stderr, "kernel_launch: hipFuncSetAttribute failed\n");
        int per_cu = 0;
        if (hipOccupancyMaxActiveBlocksPerMultiprocessor(&per_cu, (const void*)mega_fwd, NTHR, LDS_BYTES) != hipSuccess || per_cu < 1) fprintf(stderr, "kernel_launch: occupancy query says %d blocks per CU\n", per_cu);
        (void)hipGetLastError();
        ready = 1;
    }
    (void)hipMemsetAsync((char*)d_ws + WS_CTL, 0, CTL_ZERO_BYTES, stream);
    Args a{};
    for (int i = 0; i < 32; ++i) a.in[i] = (const float*)d_in[i];
    a.out = (float*)d_out; a.ws = (unsigned char*)d_ws;
#if MK_SPLIT
    for (int p = 0; p < NPHASES; ++p) { a.ph_lo = p; a.ph_hi = p + 1; hipLaunchKernelGGL(mega_fwd, dim3(256), dim3(NTHR), LDS_BYTES, stream, a); }
#else
    a.ph_lo = 0; a.ph_hi = NPHASES;
    hipLaunchKernelGGL(mega_fwd, dim3(256), dim3(NTHR), LDS_BYTES, stream, a);
#endif
}
```

```cpp
#include <hip/hip_runtime.h>
#include <cstdio>
#include <cstdint>
#include <math.h>

#define GAS __attribute__((address_space(1)))
#define LAS __attribute__((address_space(3)))
typedef unsigned short bf16;
typedef unsigned v4u __attribute__((ext_vector_type(4)));
typedef unsigned v2u __attribute__((ext_vector_type(2)));
typedef float f32x4 __attribute__((ext_vector_type(4)));
typedef float f32x2 __attribute__((ext_vector_type(2)));
typedef float f32x16 __attribute__((ext_vector_type(16)));
typedef short bf16x8 __attribute__((ext_vector_type(8)));
typedef __bf16 bh8 __attribute__((ext_vector_type(8)));
typedef __bf16 bh2 __attribute__((ext_vector_type(2)));
typedef GAS unsigned gu32;
#define RLX_AGENT __ATOMIC_RELAXED, __HIP_MEMORY_SCOPE_AGENT
#define LDS_WAIT() asm volatile("s_waitcnt lgkmcnt(0)" ::: "memory")
#define SB_PIN __builtin_amdgcn_sched_barrier(0);
#define VM_WAIT() asm volatile("s_waitcnt vmcnt(0)" ::: "memory")

constexpr int DM = 1024, NP = 4096, NS = 2048, NT = 6144;
constexpr int UE = 3584, UO = 4096;
constexpr float EPS = 1e-6f;
constexpr int CE_QA = 0, CE_KVA = 256, CE_GA = 384, CE_QM = 896, CE_KM = 1408, CE_VM = 1920, CE_OM = 2432, CE_GM = 2944, CE_KPE = 3456;
constexpr int CO_XC = 0, CO_BC = 512, CO_CC = 1024, CO_GC = 1536, CO_QD = 2048, CO_KD = 2560, CO_VD = 3072, CO_GD = 3584;
constexpr size_t O_Y = 0, O_CKV = 6291456, O_KPE = 7340032, O_C = 7602176, O_N = 11796480, O_M = 11829248, O_NK = 11829504, O_NV = 16023808;
constexpr size_t MiB = 1u << 20;
constexpr size_t WS_CTL = 0, CTL_ZERO_BYTES = 65536;
constexpr size_t WS_ROPE = 65536;
constexpr size_t WS_MOD = 131072;
constexpr size_t WS_AG = 327680;
constexpr size_t WS_WTEV = 1 * MiB;
constexpr size_t WS_WTOD = 17 * MiB;
constexpr size_t WS_WTOUT = 33 * MiB;
constexpr size_t WS_WTQB = 41 * MiB;
constexpr size_t WS_WTKVB = 42 * MiB;
constexpr size_t WS_NAKC = 43 * MiB;
constexpr size_t WS_NAVC = 44 * MiB;
constexpr size_t WS_C0T = 45 * MiB;
constexpr size_t WS_H = 47 * MiB;
constexpr size_t WS_U = 59 * MiB;
constexpr size_t WS_Z = 107 * MiB;
constexpr size_t WS_GATES = 119 * MiB;
constexpr size_t WS_Q = 120 * MiB;
constexpr size_t WS_KM = 129 * MiB;
constexpr size_t WS_VTM = 139 * MiB;
constexpr size_t WS_VTO = 146 * MiB;
constexpr size_t WS_LT = 152 * MiB;
constexpr size_t WS_NL = 200 * MiB;
constexpr size_t WS_CTB = 201 * MiB;
constexpr size_t WS_NPV = 225 * MiB;
constexpr size_t WS_MPV = 226 * MiB;
constexpr size_t WS_KFO = 227 * MiB;
constexpr size_t WS_VFM = 234 * MiB;
constexpr size_t WS_GQ = 241 * MiB;
constexpr int KROWS = 6656;

__device__ __forceinline__ unsigned pk2(float lo, float hi) { f32x2 v = {lo, hi}; bh2 b = __builtin_convertvector(v, bh2); return __builtin_bit_cast(unsigned, b); }
__device__ __forceinline__ float bf2f(unsigned u16) { return __builtin_bit_cast(float, u16 << 16); }
__device__ __forceinline__ float bflo(unsigned u) { return __builtin_bit_cast(float, u << 16); }
__device__ __forceinline__ float bfhi(unsigned u) { return __builtin_bit_cast(float, u & 0xffff0000u); }
__device__ __forceinline__ float silu_f(float x) { return x / (1.f + __expf(-x)); }
__device__ __forceinline__ float sigmoid_f(float x) { return 1.f / (1.f + __expf(-x)); }
__device__ __forceinline__ float logsigmoid_f(float x) { return fminf(x, 0.f) - log1pf(expf(-fabsf(x))); }
__device__ __forceinline__ int cond_of_row(int r) { return r < NP ? 0 : 1 + ((r - NP) >> 10); }
__device__ __forceinline__ float wave_sum(float v) {
#pragma unroll
    for (int o = 1; o < 64; o <<= 1) v += __shfl_xor(v, o);
    return v;
}
__device__ __forceinline__ float wave_max(float v) {
#pragma unroll
    for (int o = 1; o < 64; o <<= 1) v = fmaxf(v, __shfl_xor(v, o));
    return v;
}
__device__ __forceinline__ f32x16 mfma32(bh8 a, bh8 b, f32x16 c) { return __builtin_amdgcn_mfma_f32_32x32x16_bf16(a, b, c, 0, 0, 0); }
__device__ __forceinline__ bh8 ld16(const bf16* p) { return *(const bh8*)p; }
__device__ __forceinline__ bh8 ld2x8(const bf16* p0, const bf16* p1) { v2u a = *(const v2u*)p0, b = *(const v2u*)p1; v4u v = {a.x, a.y, b.x, b.y}; return __builtin_bit_cast(bh8, v); }
__device__ __forceinline__ bh8 pfrag(const f32x16& p, int s) {
    v4u v; v.x = pk2(p[8 * s + 0], p[8 * s + 1]); v.y = pk2(p[8 * s + 2], p[8 * s + 3]); v.z = pk2(p[8 * s + 4], p[8 * s + 5]); v.w = pk2(p[8 * s + 6], p[8 * s + 7]);
    return __builtin_bit_cast(bh8, v);
}
__device__ __forceinline__ int crow(int i, int hh) { return (i & 3) + 8 * (i >> 2) + 4 * hh; }
__device__ __forceinline__ void st4bf(bf16* p, float a, float b, float c, float d) { v2u v; v.x = pk2(a, b); v.y = pk2(c, d); *(v2u*)p = v; }

namespace pg8 {
#define PG8_LAS __attribute__((address_space(3)))
typedef unsigned short bf16_t;
typedef short bf16x8 __attribute__((ext_vector_type(8)));
typedef float f32x4 __attribute__((ext_vector_type(4)));
typedef unsigned u32x4 __attribute__((ext_vector_type(4)));
#ifndef PG8_BMA_ROWS
#define PG8_BMA_ROWS 192
#endif
constexpr int BMA = PG8_BMA_ROWS, HA = BMA / 2, MA = HA / 32, WRA = HA / 2;
constexpr int BM = 256, BK = 64, HALF = 128, HTB = HALF * BK * 2  , STAGE_BYTES = 8 * HTB, NXCD = 8, WGM = 8;

__host__ __device__ __forceinline__ int lds_byte(int r, int c) { const int st = (r >> 4) * 2 + (c >> 5), rr = r & 15, cc = c & 31, ob = rr * 64 + cc * 2; return st * 1024 + (ob ^ (((ob >> 9) & 1) << 5)); }
__host__ __device__ __forceinline__ void stage_rc(int b, int& R, int& C) { const int st = b / 1024, sb = b % 1024, swz = sb ^ (((sb >> 9) & 1) << 5); R = (st >> 1) * 16 + swz / 64; C = (st & 1) * 32 + (swz % 64) / 2; }
__host__ __device__ __forceinline__ int perm32(int rho) { const int n = rho >> 4, i = rho & 15; return 8 * (i >> 2) + 4 * n + (i & 3); }

struct Unit { int pm, pn; };
struct Gemm { const bf16_t* A; const bf16_t* Bt; int M, N, K; };

struct StaticOrder {
    int nM, nN, nwg, G, c;
    __host__ __device__ void init(int M, int N, int G_, int c_) { nM = M / BMA; nN = N / BM; nwg = nM * nN; G = G_; c = c_; }
    __host__ __device__ bool next(int i, Unit& u) const {
        const long L = (long)i * G + c; if (L >= nwg) return false;
        int wgid = (int)L; { const int q = nwg / NXCD, r = nwg % NXCD, xcd = wgid % NXCD, off = wgid / NXCD; wgid = (xcd < r ? xcd * (q + 1) : r * (q + 1) + (xcd - r) * q) + off; }
        const int nig = WGM * nN, gid = wgid / nig, fm = gid * WGM, gsz = (nM - fm) < WGM ? (nM - fm) : WGM;
        u.pm = fm + ((wgid % nig) % gsz); u.pn = (wgid % nig) / gsz; return true;
    }
    __device__ __forceinline__ void a_ready(const Unit&) const {}
    __device__ __forceinline__ void done(const Unit&) const {}
};

__device__ __forceinline__ int pg8_opaque(int x) { asm volatile("" : "+v"(x)); return x; }
__device__ __forceinline__ unsigned cvt_pk_bf16(float lo, float hi) { unsigned r; asm volatile("v_cvt_pk_bf16_f32 %0, %1, %2" : "=v"(r) : "v"(lo), "v"(hi)); return r; }

struct EpiU {
    static constexpr bool PERM = true, AFTER_DRAIN = false;
    bf16_t* U; int ldu; float* gates; bf16_t* vto; bf16_t* kfo; bf16_t* vfm;
    __device__ __forceinline__ void operator()(const f32x4 (&acc)[2][2][4][2], const Unit& u, int wr, int wc, int fr, int fq) const {
        const int row0 = u.pm * BMA + wr * WRA + fr, col0 = u.pn * BM + wc * 32 + 8 * fq;
        const bool dog = gates != nullptr && u.pn == 13 && wc == 1 && fq < 2;
        const bool dov = vto != nullptr && (u.pn == 12 || u.pn == 13);
        const bool dok = kfo != nullptr && (u.pn == 10 || u.pn == 11);
        const bool dom = vfm != nullptr && u.pn >= 7 && u.pn <= 9;
#pragma unroll
        for (int ai = 0; ai < 2; ++ai)
#pragma unroll
            for (int m = 0; m < MA; ++m) {
                const int row = row0 + ai * HA + m * 16;
#pragma unroll
                for (int bj = 0; bj < 2; ++bj) {
                    const f32x4 v0 = acc[ai][bj][m][0], v1 = acc[ai][bj][m][1];
                    const int col = col0 + bj * HALF;
                    u32x4 w; w.x = cvt_pk_bf16(v0[0], v0[1]); w.y = cvt_pk_bf16(v0[2], v0[3]); w.z = cvt_pk_bf16(v1[0], v1[1]); w.w = cvt_pk_bf16(v1[2], v1[3]);
                    *(u32x4*)(U + (size_t)row * ldu + col) = w;
                    if (bj == 1 && dog) { float* g = gates + (size_t)row * 16 + 8 * fq; *(f32x4*)g = v0; *(f32x4*)(g + 4) = v1; }
                    if (dom && col >= 1920 && col < 2432) { const int cc = col - 1920, hd = cc >> 7, ev = cc & 127, t16 = row & 15;
                        bf16_t* vp = vfm + ((size_t)((row >> 5) * 4 + hd) * 8 + (ev >> 5) * 2 + ((row >> 4) & 1)) * 512 + (((t16 >> 2) & 1) * 32 + (ev & 31)) * 8 + 4 * (t16 >> 3) + (t16 & 3);
                        vp[0] = (bf16_t)(w.x & 0xffffu); vp[8] = (bf16_t)(w.x >> 16); vp[16] = (bf16_t)(w.y & 0xffffu); vp[24] = (bf16_t)(w.y >> 16);
                        vp[32] = (bf16_t)(w.z & 0xffffu); vp[40] = (bf16_t)(w.z >> 16); vp[48] = (bf16_t)(w.w & 0xffffu); vp[56] = (bf16_t)(w.w >> 16);
                    }
                    if (dok) { const int cc = col - 2560, hd = cc >> 6, d = cc & 63;
                        *(u32x4*)(kfo + ((size_t)((row >> 5) * 8 + hd) * 4 + (d >> 4)) * 512 + (((d >> 3) & 1) * 32 + (row & 31)) * 8) = w; }
                    if (dov) { const int cc = col - 3072, hd = cc >> 6, dv = cc & 63, t16 = row & 15;
                        bf16_t* vp = vto + ((size_t)((row >> 5) * 8 + hd) * 4 + (dv >> 5) * 2 + ((row >> 4) & 1)) * 512 + (((t16 >> 2) & 1) * 32 + (dv & 31)) * 8 + 4 * (t16 >> 3) + (t16 & 3);
                        vp[0] = (bf16_t)(w.x & 0xffffu); vp[8] = (bf16_t)(w.x >> 16); vp[16] = (bf16_t)(w.y & 0xffffu); vp[24] = (bf16_t)(w.y >> 16);
                        vp[32] = (bf16_t)(w.z & 0xffffu); vp[40] = (bf16_t)(w.z >> 16); vp[48] = (bf16_t)(w.w & 0xffffu); vp[56] = (bf16_t)(w.w >> 16);
                    }
                }
            }
    }
};

struct EpiY {
    static constexpr bool PERM = true, AFTER_DRAIN = false;
    float* Y; const float* ysp; const float* yss; const float* mod_l;
    __device__ __forceinline__ void operator()(const f32x4 (&acc)[2][2][4][2], const Unit& u, int wr, int wc, int fr, int fq) const {
        const int row0 = u.pm * BMA + wr * WRA + fr, col0 = u.pn * BM + wc * 32 + 8 * fq;
#pragma unroll
        for (int bj = 0; bj < 2; ++bj) {
            const int col = col0 + bj * HALF;
#pragma unroll
            for (int ai = 0; ai < 2; ++ai)
#pragma unroll
                for (int m = 0; m < MA; ++m) {
                    const int row = row0 + ai * HA + m * 16;
                    const float* gp = mod_l + (row < 4096 ? 0 : (row < 5120 ? 1 : 2)) * 3072 + 2048 + col;
                    const f32x4 g0 = *(const f32x4*)gp, g1 = *(const f32x4*)(gp + 4);
                    const float* src = (row < 4096 ? ysp + (size_t)row * 1024 : yss + (size_t)(row - 4096) * 1024) + col;
                    const f32x4 y0 = *(const f32x4*)src, y1 = *(const f32x4*)(src + 4);
                    float* dst = Y + (size_t)row * 1024 + col;
                    *(f32x4*)dst = y0 + g0 * acc[ai][bj][m][0];
                    *(f32x4*)(dst + 4) = y1 + g1 * acc[ai][bj][m][1];
                }
        }
    }
};

template <class Epi, class Sched, bool ALIGN_EPI = false, bool SP2 = false>
__device__ __forceinline__ void gemm_phase(PG8_LAS unsigned char* lds, const Gemm g, const Sched& S, const Epi& E) {
    const int tid = pg8_opaque((int)threadIdx.x), wid = __builtin_amdgcn_readfirstlane(tid >> 6), lane = tid & 63, wr = wid >> 2, wc = wid & 3, fr = lane & 15, fq = lane >> 4;
    const int K = g.K, nt = K / BK;
    unsigned voffA[2], voffB[2];
#pragma unroll
    for (int i = 0; i < 2; ++i) { int R, C; stage_rc(tid * 16 + i * 8192, R, C); const int Rb = Epi::PERM ? ((R & ~31) + perm32(R & 31)) : R;
        voffA[i] = (unsigned)(R * K + C) * 2u; voffB[i] = (unsigned)(Rb * K + C) * 2u; }
    const size_t kstep = (size_t)(BK * 2);
    const size_t hstep = (size_t)HALF * K * 2;
    const size_t tstep = 2 * hstep;
    const size_t hstepA = (size_t)HA * K * 2, tstepA = 2 * hstepA;
    const unsigned ldsw = (unsigned)wid * 1024u;
    const int aoff = lds_byte(wr * WRA + fr, fq * 8), boff = lds_byte(wc * 32 + fr, fq * 8);
#define PG8_SA(b, h) (((b) * 2 + (h)) * HTB)
#define PG8_SB(b, h) ((4 + (b) * 2 + (h)) * HTB)
#define PG8_STAGE(bufoff, gbase, voff) do { _Pragma("unroll") for (int _i = 0; _i < 2; ++_i) \
        __builtin_amdgcn_global_load_lds((const unsigned*)((const char*)(gbase) + (voff)[_i]), (PG8_LAS unsigned*)(lds + (bufoff) + ldsw + _i * 8192), 16, 0, 0); } while (0)
#define PG8_LDA(dst, b, h) do { _Pragma("unroll") for (int m = 0; m < MA; ++m) _Pragma("unroll") for (int k = 0; k < 2; ++k) dst[m][k] = *(const PG8_LAS bf16x8*)(lds + PG8_SA(b, h) + aoff + m * 2048 + k * 1024); } while (0)
#define PG8_LDB(dst, b, h) do { _Pragma("unroll") for (int n = 0; n < 2; ++n) _Pragma("unroll") for (int k = 0; k < 2; ++k) dst[n][k] = *(const PG8_LAS bf16x8*)(lds + PG8_SB(b, h) + boff + n * 2048 + k * 1024); } while (0)
#define PG8_MMA(ai, bj, At, Bt) do { __builtin_amdgcn_s_setprio(1); _Pragma("unroll") for (int m = 0; m < MA; ++m) _Pragma("unroll") for (int n = 0; n < 2; ++n) _Pragma("unroll") for (int k = 0; k < 2; ++k) \
        acc[ai][bj][m][n] = __builtin_amdgcn_mfma_f32_16x16x32_bf16(Bt[n][k], At[m][k], acc[ai][bj][m][n], 0, 0, 0); __builtin_amdgcn_s_setprio(0); } while (0)
#define PG8_WAIT_V(n) asm volatile("s_waitcnt vmcnt(" #n ")" ::: "memory")
#define PG8_WAIT_L(n) asm volatile("s_waitcnt lgkmcnt(" #n ")" ::: "memory")
#define PG8_BAR __builtin_amdgcn_s_barrier()
#define PG8_SCHED __builtin_amdgcn_sched_barrier(0)
    Unit cur, nxt; int ui = 0;
    if (!S.next(0, cur)) return;
    f32x4 acc[2][2][4][2];
#pragma unroll
    for (int a = 0; a < 2; ++a)
#pragma unroll
        for (int b = 0; b < 2; ++b)
#pragma unroll
            for (int m = 0; m < MA; ++m)
#pragma unroll
                for (int n = 0; n < 2; ++n) acc[a][b][m][n] = (f32x4){0.f, 0.f, 0.f, 0.f};
    bf16x8 At[4][2], B0[2][2], B1[2][2];
    const char* cA = (const char*)g.A + (size_t)cur.pm * tstepA; const char* cB = (const char*)g.Bt + (size_t)cur.pn * tstep;
    S.a_ready(cur);
    if constexpr (SP2) {
        PG8_STAGE(PG8_SB(0, 0), cB, voffB); PG8_STAGE(PG8_SB(0, 1), cB + hstep, voffB); PG8_STAGE(PG8_SA(0, 0), cA, voffA); PG8_STAGE(PG8_SA(0, 1), cA + hstepA, voffA);
        if (wr == 1) PG8_BAR;
        PG8_WAIT_V(2); PG8_BAR;
        PG8_STAGE(PG8_SB(1, 0), cB + kstep, voffB); PG8_STAGE(PG8_SA(1, 0), cA + kstep, voffA); PG8_STAGE(PG8_SB(1, 1), cB + hstep + kstep, voffB);
        PG8_WAIT_V(6); PG8_BAR;
    } else {
        PG8_STAGE(PG8_SB(0, 0), cB, voffB); PG8_STAGE(PG8_SA(0, 0), cA, voffA); PG8_STAGE(PG8_SB(0, 1), cB + hstep, voffB); PG8_STAGE(PG8_SA(0, 1), cA + hstepA, voffA);
        if (wr == 1) PG8_BAR;
        PG8_WAIT_V(4); PG8_BAR;
        PG8_STAGE(PG8_SB(1, 0), cB + kstep, voffB); PG8_STAGE(PG8_SA(1, 0), cA + kstep, voffA); PG8_STAGE(PG8_SB(1, 1), cB + hstep + kstep, voffB);
        PG8_WAIT_V(6); PG8_BAR;
    }
    for (;;) {
        const bool has_next = S.next(ui + 1, nxt);
        const char* nA = has_next ? (const char*)g.A + (size_t)nxt.pm * tstepA : cA; const char* nB = has_next ? (const char*)g.Bt + (size_t)nxt.pn * tstep : cB;
        for (int t = 0; t < nt; t += 2) {
            const bool last = (t == nt - 2);
            const char* a1 = cA + (size_t)(t + 1) * kstep;
            const char* a2 = last ? nA : cA + (size_t)(t + 2) * kstep; const char* b2 = last ? nB : cB + (size_t)(t + 2) * kstep;
            const char* a3 = a2 + kstep; const char* b3 = b2 + kstep;
            if (last && has_next) S.a_ready(nxt);
            if constexpr (SP2) {
            PG8_LDB(B0, 0, 0); PG8_LDB(B1, 0, 1); PG8_SCHED; PG8_LDA(At, 0, 0); PG8_STAGE(PG8_SA(1, 1), a1 + hstepA, voffA);
            PG8_WAIT_V(8); PG8_WAIT_L(0); PG8_BAR; PG8_MMA(0, 0, At, B0); PG8_MMA(0, 1, At, B1); PG8_BAR; PG8_SCHED;
            PG8_LDA(At, 0, 1); PG8_STAGE(PG8_SB(0, 0), b2, voffB); PG8_STAGE(PG8_SB(0, 1), b2 + hstep, voffB); PG8_STAGE(PG8_SA(0, 0), a2, voffA);
            PG8_WAIT_V(8); PG8_WAIT_L(0); PG8_BAR; PG8_MMA(1, 0, At, B0); PG8_MMA(1, 1, At, B1); PG8_BAR; PG8_SCHED;
            PG8_LDB(B0, 1, 0); PG8_LDB(B1, 1, 1); PG8_SCHED; PG8_LDA(At, 1, 0); PG8_STAGE(PG8_SA(0, 1), a2 + hstepA, voffA);
            PG8_WAIT_V(8); PG8_WAIT_L(0); PG8_BAR; PG8_MMA(0, 0, At, B0); PG8_MMA(0, 1, At, B1); PG8_BAR; PG8_SCHED;
            PG8_LDA(At, 1, 1); PG8_STAGE(PG8_SB(1, 0), b3, voffB); PG8_STAGE(PG8_SB(1, 1), b3 + hstep, voffB); PG8_STAGE(PG8_SA(1, 0), a3, voffA);
            PG8_WAIT_V(8); PG8_WAIT_L(0); PG8_BAR; PG8_MMA(1, 0, At, B0); PG8_MMA(1, 1, At, B1); PG8_BAR; PG8_SCHED;
            } else {
            PG8_LDB(B0, 0, 0); PG8_SCHED; PG8_LDA(At, 0, 0); PG8_STAGE(PG8_SA(1, 1), a1 + hstepA, voffA);
            PG8_WAIT_L(8); PG8_BAR; PG8_WAIT_L(0); PG8_MMA(0, 0, At, B0); PG8_BAR; PG8_SCHED;
            PG8_LDB(B1, 0, 1); PG8_STAGE(PG8_SB(0, 0), b2, voffB);
            PG8_BAR; PG8_WAIT_L(0); PG8_MMA(0, 1, At, B1); PG8_BAR;
            PG8_LDA(At, 0, 1); PG8_STAGE(PG8_SA(0, 0), a2, voffA);
            PG8_BAR; PG8_WAIT_L(0); PG8_MMA(1, 0, At, B0); PG8_BAR; PG8_SCHED;
            PG8_STAGE(PG8_SB(0, 1), b2 + hstep, voffB);
            PG8_WAIT_V(6); PG8_BAR; PG8_MMA(1, 1, At, B1); PG8_BAR;
            PG8_LDB(B0, 1, 0); PG8_SCHED; PG8_LDA(At, 1, 0); PG8_STAGE(PG8_SA(0, 1), a2 + hstepA, voffA);
            PG8_WAIT_L(8); PG8_BAR; PG8_WAIT_L(0); PG8_MMA(0, 0, At, B0); PG8_BAR; PG8_SCHED;
            PG8_LDB(B1, 1, 1); PG8_STAGE(PG8_SB(1, 0), b3, voffB);
            PG8_BAR; PG8_WAIT_L(0); PG8_MMA(0, 1, At, B1); PG8_BAR;
            PG8_LDA(At, 1, 1); PG8_STAGE(PG8_SA(1, 0), a3, voffA);
            PG8_BAR; PG8_WAIT_L(0); PG8_MMA(1, 0, At, B0); PG8_BAR; PG8_SCHED;
            PG8_STAGE(PG8_SB(1, 1), b3 + hstep, voffB);
            PG8_WAIT_V(6); PG8_BAR; PG8_MMA(1, 1, At, B1); PG8_BAR;
            }
        }
        if constexpr (ALIGN_EPI) { if (wr == 0) PG8_BAR; }
        if constexpr (!Epi::AFTER_DRAIN) { E(acc, cur, wr, wc, fr, fq); S.done(cur); }
        if (!has_next) break;
#pragma unroll
        for (int a = 0; a < 2; ++a)
#pragma unroll
            for (int b = 0; b < 2; ++b)
#pragma unroll
                for (int m = 0; m < MA; ++m)
#pragma unroll
                    for (int n = 0; n < 2; ++n) acc[a][b][m][n] = (f32x4){0.f, 0.f, 0.f, 0.f};
        cur = nxt; cA = nA; cB = nB; ++ui;
        if constexpr (ALIGN_EPI) { if (wr == 1) PG8_BAR; }
    }
    PG8_WAIT_V(0);
    if constexpr (!ALIGN_EPI) { if (wr == 0) PG8_BAR; }
    PG8_BAR;
    if constexpr (Epi::AFTER_DRAIN) { E.fused(acc, cur, wr, wc, fr, fq, lds, wid, lane); S.done(cur); }
#undef PG8_SA
#undef PG8_SB
#undef PG8_STAGE
#undef PG8_LDA
#undef PG8_LDB
#undef PG8_MMA
#undef PG8_WAIT_V
#undef PG8_WAIT_L
#undef PG8_BAR
#undef PG8_SCHED
}
}
#define XB_TMO      128
#define XB_XCNT(j)  (256  + 64 * (j))
#define XB_XSUB(j)  (1280 + 64 * (j))
#define XB_XGEN(j)  (2304 + 64 * (j))
#define XB_TOP      3328
#define XB_TOPGEN   3392
#define XCD_BAR_WORDS 3456
#define XB_SPIN_CAP (1u << 18)

__device__ __forceinline__ unsigned xb_ld(unsigned* p)              { return __hip_atomic_load(p, __ATOMIC_RELAXED, __HIP_MEMORY_SCOPE_AGENT); }
__device__ __forceinline__ unsigned xb_add(unsigned* p, unsigned v) { return __hip_atomic_fetch_add(p, v, __ATOMIC_RELAXED, __HIP_MEMORY_SCOPE_AGENT); }
__device__ __forceinline__ unsigned xb_xcc_id() { return (unsigned)__builtin_amdgcn_s_getreg((3 << 11) | 20) & 0xFu; }
#define XB_SPIN(cond, bar) do { unsigned _sp = 0; while (cond) { __builtin_amdgcn_s_sleep(1); \
    if ((++_sp & 255u) == 0u) { if (xb_ld(&(bar)[XB_TMO])) break; if (_sp > XB_SPIN_CAP) { atomicAdd(&(bar)[XB_TMO], 1u); break; } } } } while (0)

struct XcdBarrier {
    unsigned* bar; unsigned x;
    volatile LAS unsigned* st;
};

__device__ __forceinline__ XcdBarrier xcd_barrier_post(unsigned* bar, volatile LAS unsigned* st) {
    XcdBarrier b; b.bar = bar; b.x = xb_xcc_id(); b.st = st;
    if (threadIdx.x == 0) (void)xb_add(&bar[XB_XCNT(b.x)], 1u);
    return b;
}
__device__ __forceinline__ void xcd_barrier_complete(unsigned* bar, unsigned x, unsigned& nloc, unsigned& nx) {
    const unsigned G = gridDim.x * gridDim.y * gridDim.z;
    unsigned sum, cnt, mine, sp = 0u;
    for (;;) {
        sum = 0u; cnt = 0u; mine = 0u;
#pragma unroll
        for (unsigned j = 0; j < 16; ++j) { const unsigned c = xb_ld(&bar[XB_XCNT(j)]); sum += c; cnt += (c > 0u) ? 1u : 0u; mine = (j == x) ? c : mine; }
        if (sum == G) break;
        __builtin_amdgcn_s_sleep(1);
        if ((++sp & 255u) == 0u) { if (xb_ld(&bar[XB_TMO])) break; if (sp > XB_SPIN_CAP) { atomicAdd(&bar[XB_TMO], 1u); break; } }
    }
    nloc = mine > 0u ? mine : 1u; nx = cnt > 0u ? cnt : 1u;
}

__device__ __forceinline__ void xcd_barrier(const XcdBarrier& b) {
    asm volatile("s_waitcnt vmcnt(0)" ::: "memory");
    __syncthreads();
    if (threadIdx.x == 0) {
        unsigned* bar = b.bar;
        __builtin_amdgcn_s_waitcnt(0);
        unsigned nloc = b.st[0], nx = b.st[1];
        if (nloc == 0u) { xcd_barrier_complete(bar, b.x, nloc, nx); b.st[0] = nloc; b.st[1] = nx; }
        const unsigned old = xb_add(&bar[XB_XSUB(b.x)], 1u);
        const unsigned gen = old / nloc;
        if (old + 1u == (gen + 1u) * nloc) {
            __builtin_amdgcn_fence(__ATOMIC_RELEASE, "agent");
            asm volatile("s_waitcnt vmcnt(0)" ::: "memory");
            const unsigned og = xb_add(&bar[XB_TOP], 1u);
            const unsigned tg = og / nx;
            if (og + 1u == (tg + 1u) * nx) xb_add(&bar[XB_TOPGEN], 1u);
            else XB_SPIN(xb_ld(&bar[XB_TOPGEN]) == tg, bar);
            __builtin_amdgcn_fence(__ATOMIC_ACQUIRE, "agent");
            xb_add(&bar[XB_XGEN(b.x)], 1u);
            asm volatile("s_waitcnt vmcnt(0)" ::: "memory");
        } else {
            XB_SPIN(xb_ld(&bar[XB_XGEN(b.x)]) == gen, bar);
            __builtin_amdgcn_fence(__ATOMIC_ACQUIRE, "agent");
            asm volatile("s_waitcnt vmcnt(0)" ::: "memory");
        }
    }
    __syncthreads();
}

constexpr int NWAVES = 8, NTHR = 512;
constexpr int LDS_BYTES = 147456;
constexpr int MISC_OFF = 147456 - 256;
constexpr int CW_BAR = 4096;

struct Args {
    const float* in[32];
    float* out;
    unsigned char* ws;
    int ph_lo, ph_hi;
};

struct Ctx {
    LAS unsigned char* lds;
    unsigned char* ldsg;
    int tid, lane, wave, G, bid;
};


#ifndef PROF_ID
#define PROF_ID 0
#endif
#ifndef PROF_K
#define PROF_K 8
#endif
#define PROF_BEGIN(id) unsigned long long pt0_##id = 0; if (PROF_ID == (id)) pt0_##id = __builtin_amdgcn_s_memrealtime();
#define PROF_END(id) if (PROF_ID == (id) && threadIdx.x == 0) { const unsigned dt_ = (unsigned)(__builtin_amdgcn_s_memrealtime() - pt0_##id); ((volatile LAS unsigned*)(X.lds + MISC_OFF))[16] += dt_; }

__device__ __forceinline__ int opaque_v(int x) { asm volatile("" : "+v"(x)); return x; }
__device__ __forceinline__ int opaque_s(int x) { asm volatile("" : "+s"(x)); return x; }
__device__ __forceinline__ int map_even(int dg) {
    if (dg < 24) return dg;
    if (dg < 152) return dg + 2;
    if (dg < 216) return dg + 3;
    if (dg < 218) return dg - 192;
    if (dg == 218) return 154;
    return -1;
}
__device__ __forceinline__ void transpose_item(const float* W, int ldn, int K, bf16* WT, int k0, int n0, int ca, int cb, LAS float* scr, int lane, bool frag = false) {
    const int n = lane & 31; const int sc = (n < 16) ? ca : cb;
    float tv[32];
#pragma unroll
    for (int i = 0; i < 32; ++i) { const int kk = 2 * i + (lane >> 5); tv[i] = sc >= 0 ? W[(size_t)(k0 + kk) * ldn + sc + (n & 15)] : 0.f; }
    SB_PIN
#pragma unroll
    for (int i = 0; i < 32; ++i) { const int kk = 2 * i + (lane >> 5); scr[kk * 33 + n] = tv[i]; }
    LDS_WAIT(); asm volatile("" ::: "memory");
    const int c = lane & 7;
#pragma unroll
    for (int j = 0; j < 4; ++j) { const int nn = (lane >> 3) + 8 * j; const LAS float* s = scr + (8 * c) * 33 + nn;
        v4u o; o.x = pk2(s[0 * 33], s[1 * 33]); o.y = pk2(s[2 * 33], s[3 * 33]); o.z = pk2(s[4 * 33], s[5 * 33]); o.w = pk2(s[6 * 33], s[7 * 33]);
        bf16* dst = frag ? WT + ((size_t)((n0 + nn) >> 5) * (K >> 4) + ((k0 + 8 * c) >> 4)) * 512 + ((((k0 + 8 * c) >> 3) & 1) * 32 + ((n0 + nn) & 31)) * 8 : WT + (size_t)(n0 + nn) * K + k0 + 8 * c;
        *(v4u*)dst = o; }
    LDS_WAIT(); asm volatile("" ::: "memory");
}

__device__ __forceinline__ void mod_unit(const Args& a, const Ctx& X, int l, int chunk, int tid, int lane, int wave) {
    LAS float* scs = (LAS float*)X.lds;
    LAS float* part = scs + 3072;
    const float* c_ctx = a.in[10]; const float* c = a.in[2];
    for (int i = tid; i < 3072; i += NTHR) { const int r = i >> 10, k = i & 1023; const float v = r == 0 ? c_ctx[k] : c[(r - 1) * 1024 + k]; scs[i] = v / (1.f + expf(-v)); }
    __syncthreads();
    const int j0 = chunk * 64;
    const float* w = a.in[12] + (size_t)l * 1024 * 3072 + j0 + lane;
    float a0 = 0.f, a1 = 0.f, a2 = 0.f;
#pragma unroll 32
    for (int kk = 0; kk < 128; ++kk) { const int k = wave * 128 + kk; const float wv = w[(size_t)k * 3072]; a0 += scs[k] * wv; a1 += scs[1024 + k] * wv; a2 += scs[2048 + k] * wv; }
    part[(wave * 3 + 0) * 64 + lane] = a0; part[(wave * 3 + 1) * 64 + lane] = a1; part[(wave * 3 + 2) * 64 + lane] = a2;
    __syncthreads();
    if (tid < 192) { const int r = tid >> 6, cc = tid & 63; float s = 0.f;
#pragma unroll
        for (int w8 = 0; w8 < 8; ++w8) s += part[(w8 * 3 + r) * 64 + cc];
        ((float*)(a.ws + WS_MOD))[(l * 3 + r) * 3072 + j0 + cc] = s + a.in[13][l * 3072 + j0 + cc]; }
    __syncthreads();
}
__device__ __forceinline__ void prep_weights(const Args& a, const Ctx& X, int l, int gw, int NGW, int lane, int wave) {
    unsigned char* ws = a.ws;
    LAS float* scr = (LAS float*)(X.lds + 32768 + wave * 8448);
    const int j = l >> 1;
    if ((l & 1) == 0) {
        for (int it = gw; it < 2464; it += NGW) {
            if (it < 1792) { const int nb = it % 112, kb = it / 112;
                transpose_item(a.in[14] + (size_t)j * 1024 * 3504, 3504, 1024, (bf16*)(ws + WS_WTEV) + (size_t)j * 3584 * 1024, kb * 64, nb * 32,
                               map_even(2 * nb) < 0 ? -1 : map_even(2 * nb) * 16, map_even(2 * nb + 1) < 0 ? -1 : map_even(2 * nb + 1) * 16, scr, lane);
            } else if (it < 2304) { const int r = it - 1792, nb = r % 32, kb = r / 32;
                transpose_item(a.in[24] + (size_t)j * 1024 * 1024, 1024, 1024, (bf16*)(ws + WS_WTOUT) + (size_t)l * 1024 * 1024, kb * 64, nb * 32, nb * 32, nb * 32 + 16, scr, lane);
            } else if (it < 2400) { const int r = it - 2304, nb = r % 24, kb = r / 24;
                transpose_item(a.in[17] + (size_t)j * 256 * 768, 768, 256, (bf16*)(ws + WS_WTQB) + (size_t)j * 768 * 256, kb * 64, nb * 32, nb * 32, nb * 32 + 16, scr, lane, true);
            } else { const int r = it - 2400, nb = r % 32, kb = r / 32;
                transpose_item(a.in[18] + (size_t)j * 128 * 1024, 1024, 128, (bf16*)(ws + WS_WTKVB) + (size_t)j * 1024 * 128, kb * 64, nb * 32, nb * 32, nb * 32 + 16, scr, lane, true);
            }
        }
    } else {
        for (int it = gw; it < 2560; it += NGW) {
            if (it < 2048) { const int nb = it % 128, kb = it / 128;
                transpose_item(a.in[25] + (size_t)j * 1024 * 4096, 4096, 1024, (bf16*)(ws + WS_WTOD) + (size_t)j * 4096 * 1024, kb * 64, nb * 32, nb * 32, nb * 32 + 16, scr, lane);
            } else { const int r = it - 2048, nb = r % 32, kb = r / 32;
                transpose_item(a.in[31] + (size_t)j * 1024 * 1024, 1024, 1024, (bf16*)(ws + WS_WTOUT) + (size_t)l * 1024 * 1024, kb * 64, nb * 32, nb * 32, nb * 32 + 16, scr, lane);
            }
        }
    }
}
__device__ __forceinline__ void phase_p0a(const Args& a, const Ctx& X) {
    unsigned char* ws = a.ws;
    const int tid = opaque_v(X.tid), lane = tid & 63, wave = opaque_s(X.wave);
    if (X.bid < 192) mod_unit(a, X, X.bid / 48, X.bid % 48, tid, lane, wave);
    else if (X.bid == 192) {
        const int pos = tid >> 3, f = tid & 7;
        const float ang = (float)pos * powf(10000.f, -(float)f / 8.f);
        float* rt = (float*)(ws + WS_ROPE);
        rt[pos * 16 + f] = cosf(ang); rt[pos * 16 + 8 + f] = sinf(ang);
    } else {
        const int nb = X.G - 193, b0 = X.bid - 193;
        const float* ck = a.in[8]; const float* cv = a.in[9]; const float* c0 = a.in[5];
        bf16* nakc = (bf16*)(ws + WS_NAKC); bf16* navc = (bf16*)(ws + WS_NAVC); float* c0t = (float*)(ws + WS_C0T);
#pragma unroll 4
        for (int idx = b0 * NTHR + tid; idx < 524288; idx += nb * NTHR) {
            const int d = idx & 63, h = (idx >> 6) & 7, key = (idx >> 9) & 255, bj = idx >> 17;
            { const size_t blk = ((size_t)(bj * 8 + h) * 8 + (key >> 5)) * 4; const int kr = key & 31, t16 = key & 15;
              nakc[(blk + (d >> 4)) * 512 + (((d >> 3) & 1) * 32 + kr) * 8 + (d & 7)] = (bf16)(pk2(ck[idx] / a.in[29][(bj & 1) * 64 + d], 0.f) & 0xffffu);
              navc[(blk + (d >> 5) * 2 + (kr >> 4)) * 512 + (((t16 >> 2) & 1) * 32 + (d & 31)) * 8 + 4 * (t16 >> 3) + (t16 & 3)] = (bf16)(pk2(cv[idx], 0.f) & 0xffffu); }
            const int e = idx & 127, dd = (idx >> 7) & 127, mat = idx >> 14;
            c0t[(size_t)mat * 16384 + e * 128 + dd] = c0[idx];
        }
    }
    for (int l = 0; l < 4; ++l) prep_weights(a, X, l, X.bid * NWAVES + wave, X.G * NWAVES, lane, wave);
}
__device__ __forceinline__ void gemm2_side(const Args& a, const Ctx& X, int l) {
    const int tid = opaque_v(X.tid), lane = tid & 63, wave = opaque_s(X.wave), idx = X.bid - 96;
    if (idx < 48) mod_unit(a, X, l + 1, idx, tid, lane, wave);
    prep_weights(a, X, l + 1, idx * NWAVES + wave, (X.G - 96) * NWAVES, lane, wave);
}

__device__ __forceinline__ void phase_norm(const Args& a, const Ctx& X, int l) {
    const float* ysp = l == 0 ? a.in[0] : a.out; const float* yss = l == 0 ? a.in[1] : a.out + (size_t)NP * DM;
    const float* nw = a.in[11] + l * DM;
    const float* modl = (const float*)(a.ws + WS_MOD) + l * 3 * 3072;
    bf16* H = (bf16*)(a.ws + WS_H);
    const int lane = opaque_v(X.tid) & 63; const int gw = X.bid * NWAVES + opaque_s(X.wave), NGW = X.G * NWAVES;
    f32x4 v[3][4];
#pragma unroll
    for (int q = 0; q < 3; ++q) { const int r = gw + q * NGW; const float* y = r < NP ? ysp + (size_t)r * DM : yss + (size_t)(r - NP) * DM;
#pragma unroll
        for (int j = 0; j < 4; ++j) v[q][j] = r < NT ? *(const f32x4*)(y + 4 * lane + 256 * j) : (f32x4){0.f, 0.f, 0.f, 0.f}; }
    SB_PIN
#pragma unroll
    for (int q = 0; q < 3; ++q) { const int r = gw + q * NGW; if (r < NT) {
        const float* md = modl + cond_of_row(r) * 3072;
        float ss = 0.f;
#pragma unroll
        for (int j = 0; j < 4; ++j) ss += (v[q][j].x * v[q][j].x + v[q][j].y * v[q][j].y) + (v[q][j].z * v[q][j].z + v[q][j].w * v[q][j].w);
        const float rstd = rsqrtf(wave_sum(ss) * (1.f / DM) + EPS);
#pragma unroll
        for (int j = 0; j < 4; ++j) { const int k = 4 * lane + 256 * j;
            const f32x4 g = *(const f32x4*)(nw + k), sh = *(const f32x4*)(md + k), sc = *(const f32x4*)(md + 1024 + k);
            const f32x4 o = v[q][j] * rstd * g * (sc + 1.f) + sh;
            st4bf(H + (size_t)r * DM + k, o.x, o.y, o.z, o.w); }
    } }
}

__device__ __forceinline__ void unit_mla_q(const Args& a, const Ctx& X, int j, int t) {
    const bf16* U = (const bf16*)(a.ws + WS_U); bf16* Q = (bf16*)(a.ws + WS_Q);
    const bf16* Wq = (const bf16*)(a.ws + WS_WTQB) + (size_t)j * 768 * 256;
    const float* rope = (const float*)(a.ws + WS_ROPE);
    const float* qan = a.in[15] + j * 256; const float* qn = a.in[19] + j * 96;
    bf16* Xn = (bf16*)X.ldsg;
    const int tid = opaque_v(X.tid), lane = tid & 63, w = opaque_s(X.wave), r = lane & 31, hh = lane >> 5, R0 = t * 64; (void)tid;
    PROF_BEGIN(20)
    { v2u raw8[8]; const f32x4 g = *(const f32x4*)(qan + 4 * lane);
#pragma unroll
      for (int i = 0; i < 8; ++i) raw8[i] = *(const v2u*)(U + (size_t)(R0 + 8 * w + i) * UE + CE_QA + 4 * lane);
      SB_PIN
#pragma unroll
      for (int i = 0; i < 8; ++i) { const int row = 8 * w + i; const v2u raw = raw8[i];
        const float x0 = bflo(raw.x), x1 = bfhi(raw.x), x2 = bflo(raw.y), x3 = bfhi(raw.y);
        const float rstd = rsqrtf(wave_sum(x0 * x0 + x1 * x1 + x2 * x2 + x3 * x3) * (1.f / 256.f) + EPS);
        st4bf(Xn + row * 264 + 4 * lane, x0 * rstd * g.x, x1 * rstd * g.y, x2 * rstd * g.z, x3 * rstd * g.w); } }
    __syncthreads();
    PROF_END(20)
    PROF_BEGIN(21)
    f32x16 acc[3][2];
#pragma unroll
    for (int fb = 0; fb < 3; ++fb)
#pragma unroll
        for (int tb = 0; tb < 2; ++tb)
#pragma unroll
            for (int i = 0; i < 16; ++i) acc[fb][tb][i] = 0.f;
    const bf16* wp = Wq + (size_t)(w * 3) * 16 * 512 + lane * 8;
    const bf16* xp = Xn + r * 264 + 8 * hh;
#pragma unroll
    for (int kh = 0; kh < 4; ++kh) {
        bh8 af[4][3];
#pragma unroll
        for (int k8 = 0; k8 < 4; ++k8)
#pragma unroll
            for (int fb = 0; fb < 3; ++fb) af[k8][fb] = ld16(wp + (size_t)(fb * 16 + kh * 4 + k8) * 512);
        SB_PIN
#pragma unroll
        for (int k8 = 0; k8 < 4; ++k8) { const int ks = kh * 4 + k8; bh8 bfr[2];
#pragma unroll
            for (int tb = 0; tb < 2; ++tb) bfr[tb] = ld16(xp + tb * 32 * 264 + 16 * ks);
#pragma unroll
            for (int fb = 0; fb < 3; ++fb)
#pragma unroll
                for (int tb = 0; tb < 2; ++tb) acc[fb][tb] = mfma32(af[k8][fb], bfr[tb], acc[fb][tb]); }
        SB_PIN
    }
    PROF_END(21)
    PROF_BEGIN(22)
#pragma unroll
    for (int tb = 0; tb < 2; ++tb) {
        float ss = 0.f;
#pragma unroll
        for (int fb = 0; fb < 3; ++fb)
#pragma unroll
            for (int i = 0; i < 16; ++i) ss += acc[fb][tb][i] * acc[fb][tb][i];
        ss += __shfl_xor(ss, 32);
        const float rstd = rsqrtf(ss * (1.f / 96.f) + EPS) * 0.10206207261596577f;
        const int row = R0 + 32 * tb + r;
        const bool sample = row >= NP; const int tp = (row - NP) & 1023;
#pragma unroll
        for (int fb = 0; fb < 3; ++fb) {
            float v[16];
#pragma unroll
            for (int g = 0; g < 4; ++g) { const f32x4 gn = *(const f32x4*)(qn + 32 * fb + 8 * g + 4 * hh);
                v[4 * g + 0] = acc[fb][tb][4 * g + 0] * rstd * gn.x; v[4 * g + 1] = acc[fb][tb][4 * g + 1] * rstd * gn.y;
                v[4 * g + 2] = acc[fb][tb][4 * g + 2] * rstd * gn.z; v[4 * g + 3] = acc[fb][tb][4 * g + 3] * rstd * gn.w; }
            if (fb == 2 && sample) {
                const float* rr_ = rope + (tp >> 6) * 16 + 4 * hh; const float* rc_ = rope + (tp & 63) * 16 + 4 * hh;
#pragma unroll
                for (int e = 0; e < 4; ++e) {
                    float cs = rr_[e], sn = rr_[8 + e], x1 = v[e], x2 = v[4 + e];
                    v[e] = x1 * cs - x2 * sn; v[4 + e] = x1 * sn + x2 * cs;
                    cs = rc_[e]; sn = rc_[8 + e]; x1 = v[8 + e]; x2 = v[12 + e];
                    v[8 + e] = x1 * cs - x2 * sn; v[12 + e] = x1 * sn + x2 * cs;
                }
            }
#pragma unroll
            for (int g = 0; g < 4; ++g) st4bf(Q + (size_t)row * 768 + w * 96 + 32 * fb + 8 * g + 4 * hh, v[4 * g], v[4 * g + 1], v[4 * g + 2], v[4 * g + 3]);
        }
    }
    __syncthreads();    PROF_END(22)
}

__device__ __forceinline__ void unit_mla_kv(const Args& a, const Ctx& X, int j, int t) {
    const bf16* U = (const bf16*)(a.ws + WS_U); bf16* KM = (bf16*)(a.ws + WS_KM); bf16* VTM = (bf16*)(a.ws + WS_VTM);
    const bf16* Wkv = (const bf16*)(a.ws + WS_WTKVB) + (size_t)j * 1024 * 128;
    const float* rope = (const float*)(a.ws + WS_ROPE);
    const float* kvan = a.in[16] + j * 128; const float* kn = a.in[20] + j * 96;
    bf16* Xc = (bf16*)X.ldsg;
    float* kpes = (float*)(X.ldsg + 17408);
    const int tid = opaque_v(X.tid), lane = tid & 63, w = opaque_s(X.wave), r = lane & 31, hh = lane >> 5; (void)tid;
    const bool own = t >= 0;
    int R0 = 0, krow0, bs = 0;
    if (own) { R0 = t * 64; if (R0 < NP) krow0 = R0; else { bs = (R0 - NP) >> 10; krow0 = NP + bs * 1280 + 256 + ((R0 - NP) & 1023); } }
    else { const int ct = -1 - t; bs = ct >> 2; krow0 = NP + bs * 1280 + (ct & 3) * 64; }
    { unsigned raw8[8]; float kp8[8]; f32x2 c8[8];
      if (own) {
#pragma unroll
          for (int i = 0; i < 8; ++i) { raw8[i] = *(const unsigned*)(U + (size_t)(R0 + 8 * w + i) * UE + CE_KVA + 2 * lane);
              kp8[i] = lane < 32 ? bf2f(U[(size_t)(R0 + 8 * w + i) * UE + CE_KPE + lane]) : 0.f; }
      } else {
#pragma unroll
          for (int i = 0; i < 8; ++i) { const int s = ((-1 - t) & 3) * 64 + 8 * w + i; const size_t o = (size_t)(bs * 2 + j) * 256 + s;
              c8[i] = *(const f32x2*)(a.in[3] + o * 128 + 2 * lane); kp8[i] = lane < 32 ? a.in[4][o * 32 + lane] : 0.f; }
      }
      const f32x2 g = *(const f32x2*)(kvan + 2 * lane);
      SB_PIN
#pragma unroll
      for (int i = 0; i < 8; ++i) { const int row = 8 * w + i;
        if (own) {
            const float x0 = bflo(raw8[i]), x1 = bfhi(raw8[i]);
            const float rstd = rsqrtf(wave_sum(x0 * x0 + x1 * x1) * (1.f / 128.f) + EPS);
            const float c0 = x0 * rstd * g.x, c1 = x1 * rstd * g.y;
            *(unsigned*)(Xc + row * 136 + 2 * lane) = pk2(c0, c1);
            if (lane < 32) kpes[row * 32 + lane] = kp8[i];
            if (R0 < NP) { const int b = (R0 + row) >> 8, s = (R0 + row) & 255; const size_t o = (size_t)(b * 2 + j) * 256 + s;
                *(f32x2*)(a.out + O_CKV + o * 128 + 2 * lane) = (f32x2){c0, c1};
                if (lane < 32) a.out[O_KPE + o * 32 + lane] = kp8[i]; }
        } else {
            *(unsigned*)(Xc + row * 136 + 2 * lane) = pk2(c8[i].x, c8[i].y);
            if (lane < 32) kpes[row * 32 + lane] = kp8[i];
        } } }
    __syncthreads();
    f32x16 ak[2][2], av[2][2];
#pragma unroll
    for (int x = 0; x < 2; ++x)
#pragma unroll
        for (int y = 0; y < 2; ++y)
#pragma unroll
            for (int i = 0; i < 16; ++i) { ak[x][y][i] = 0.f; av[x][y][i] = 0.f; }
    const bf16* wp = Wkv + (size_t)(w * 4) * 8 * 512 + lane * 8;
    const bf16* xp = Xc + r * 136 + 8 * hh;
#pragma unroll
    for (int kh = 0; kh < 2; ++kh) { bh8 wk[4][2], wv[4][2];
#pragma unroll
      for (int k4 = 0; k4 < 4; ++k4)
#pragma unroll
          for (int fb = 0; fb < 2; ++fb) { wk[k4][fb] = ld16(wp + (size_t)(fb * 8 + kh * 4 + k4) * 512); wv[k4][fb] = ld16(wp + (size_t)((2 + fb) * 8 + kh * 4 + k4) * 512); }
      SB_PIN
#pragma unroll
      for (int k4 = 0; k4 < 4; ++k4) { const int ks = kh * 4 + k4; bh8 xf[2];
#pragma unroll
          for (int tb = 0; tb < 2; ++tb) xf[tb] = ld16(xp + tb * 32 * 136 + 16 * ks);
#pragma unroll
          for (int fb = 0; fb < 2; ++fb)
#pragma unroll
              for (int tb = 0; tb < 2; ++tb) { ak[fb][tb] = mfma32(wk[k4][fb], xf[tb], ak[fb][tb]); av[tb][fb] = mfma32(xf[tb], wv[k4][fb], av[tb][fb]); } }
      SB_PIN }
    const bool sample_own = own && R0 >= NP;
#pragma unroll
    for (int tb = 0; tb < 2; ++tb) {
        const int tok = 32 * tb + r;
        float kp[16]; float ss = 0.f;
#pragma unroll
        for (int g = 0; g < 4; ++g) { const f32x4 q4 = *(const f32x4*)(kpes + tok * 32 + 16 * hh + 4 * g); kp[4 * g] = q4.x; kp[4 * g + 1] = q4.y; kp[4 * g + 2] = q4.z; kp[4 * g + 3] = q4.w; }
#pragma unroll
        for (int i = 0; i < 16; ++i) ss += kp[i] * kp[i] + ak[0][tb][i] * ak[0][tb][i] + ak[1][tb][i] * ak[1][tb][i];
        ss += __shfl_xor(ss, 32);
        const float rstd = rsqrtf(ss * (1.f / 96.f) + EPS);
        bf16* kdst = KM + ((size_t)(((krow0 >> 5) + tb) * 8 + w) * 6) * 512 + r * 8;
#pragma unroll
        for (int fb = 0; fb < 2; ++fb)
#pragma unroll
            for (int g = 0; g < 4; ++g) { const int f0 = 32 * fb + 8 * g + 4 * hh; const f32x4 gn = *(const f32x4*)(kn + f0);
                st4bf(kdst + (2 * fb + (g >> 1)) * 512 + (g & 1) * 256 + 4 * hh, ak[fb][tb][4 * g] * rstd * gn.x, ak[fb][tb][4 * g + 1] * rstd * gn.y, ak[fb][tb][4 * g + 2] * rstd * gn.z, ak[fb][tb][4 * g + 3] * rstd * gn.w); }
#pragma unroll
        for (int g = 0; g < 4; ++g) { const f32x4 gn = *(const f32x4*)(kn + 64 + 16 * hh + 4 * g);
            kp[4 * g] *= rstd * gn.x; kp[4 * g + 1] *= rstd * gn.y; kp[4 * g + 2] *= rstd * gn.z; kp[4 * g + 3] *= rstd * gn.w; }
        if (sample_own) {
            const int tp = (R0 - NP + tok) & 1023; const int pos = hh == 0 ? (tp >> 6) : (tp & 63);
            const float* rp = rope + pos * 16;
#pragma unroll
            for (int i = 0; i < 8; ++i) { const float cs = rp[i], sn = rp[8 + i], x1 = kp[i], x2 = kp[8 + i]; kp[i] = x1 * cs - x2 * sn; kp[8 + i] = x1 * sn + x2 * cs; }
        }
#pragma unroll
        for (int g = 0; g < 4; ++g) st4bf(kdst + (4 + hh) * 512 + (g >> 1) * 256 + 4 * (g & 1), kp[4 * g], kp[4 * g + 1], kp[4 * g + 2], kp[4 * g + 3]);
#pragma unroll
        for (int fb = 0; fb < 2; ++fb) { bf16* vdst = VTM + ((size_t)(((krow0 >> 5) + tb) * 8 + w) * 4 + 2 * fb) * 512 + (hh * 32 + r) * 8;
#pragma unroll
            for (int g = 0; g < 4; ++g) st4bf(vdst + (g >> 1) * 512 + 4 * (g & 1), av[tb][fb][4 * g], av[tb][fb][4 * g + 1], av[tb][fb][4 * g + 2], av[tb][fb][4 * g + 3]); }
    }
    __syncthreads();
}

struct AttnState { f32x16 o0, o1; float m, l; };
__device__ __forceinline__ void attn_init(AttnState& st) {
#pragma unroll
    for (int i = 0; i < 16; ++i) { st.o0[i] = 0.f; st.o1[i] = 0.f; }
    st.m = -1e30f; st.l = 0.f;
}
template <int NKS> struct KVf { bh8 k[NKS]; bh8 v[4]; };
template <int NKS> __device__ __forceinline__ void load_kv(KVf<NKS>& f, const bf16* kp, const bf16* vp) {
#pragma unroll
    for (int ks = 0; ks < NKS; ++ks) f.k[ks] = ld16(kp + ks * 512);
#pragma unroll
    for (int q = 0; q < 4; ++q) f.v[q] = ld16(vp + q * 512);
}
template <int NKS>
__device__ __forceinline__ void attn_compute(AttnState& st, const bh8* qf, const KVf<NKS>& f, const float* rk, int hh, bool na, int kc0, int dr, int cq, int c0, const float* rpbs) {
    f32x16 s;
#pragma unroll
    for (int i = 0; i < 16; ++i) s[i] = 0.f;
#pragma unroll
    for (int ks = 0; ks < NKS; ++ks) s = mfma32(f.k[ks], qf[ks], s);
    if (rk) {
#pragma unroll
        for (int g = 0; g < 4; ++g) { const f32x4 rv = *(const f32x4*)(rk + 8 * g + 4 * hh); s[4 * g] *= rv.x; s[4 * g + 1] *= rv.y; s[4 * g + 2] *= rv.z; s[4 * g + 3] *= rv.w; }
    }
    if (na) {
#pragma unroll
        for (int i = 0; i < 16; ++i) { const int kc = kc0 + crow(i, hh); const bool ok = kc >= c0 && kc < c0 + 16;
            int dc = kc - cq; dc = dc < -15 ? -15 : (dc > 15 ? 15 : dc);
            s[i] = ok ? s[i] + rpbs[dr * 31 + dc + 15] : -1e30f; }
    }
    float mx = s[0];
#pragma unroll
    for (int i = 1; i < 16; ++i) mx = fmaxf(mx, s[i]);
    mx = fmaxf(mx, __shfl_xor(mx, 32));
    const float mn = fmaxf(st.m, mx);
    const float alpha = __expf(st.m - mn);
    float ps = 0.f;
#pragma unroll
    for (int i = 0; i < 16; ++i) { float p = __expf(s[i] - mn); p = s[i] > -1e29f ? p : 0.f; s[i] = p; ps += p; }
    st.l = st.l * alpha + ps; st.m = mn;
#pragma unroll
    for (int i = 0; i < 16; ++i) { st.o0[i] *= alpha; st.o1[i] *= alpha; }
    const bh8 p0 = pfrag(s, 0), p1 = pfrag(s, 1);
    st.o0 = mfma32(f.v[0], p0, st.o0); st.o0 = mfma32(f.v[1], p1, st.o0);
    st.o1 = mfma32(f.v[2], p0, st.o1); st.o1 = mfma32(f.v[3], p1, st.o1);
}
template <int KS>
__device__ __forceinline__ void attn_merge_store(AttnState& st, float* part, int w, int lane, const bf16* gp, bf16* zp) {
    const int r = lane & 31, hh = lane >> 5;
    float* mine = part + w * 2048; float* ml = part + 8 * 2048;
#pragma unroll
    for (int i = 0; i < 16; ++i) { mine[crow(i, hh) * 32 + r] = st.o0[i]; mine[(32 + crow(i, hh)) * 32 + r] = st.o1[i]; }
    const float lt = st.l + __shfl_xor(st.l, 32);
    if (hh == 0) { ml[(w * 2) * 32 + r] = st.m; ml[(w * 2 + 1) * 32 + r] = lt; }
    __syncthreads();
    const int qb = w / KS, kp = w % KS;
    float f[KS]; float ms = -1e30f, L = 0.f;
#pragma unroll
    for (int k = 0; k < KS; ++k) ms = fmaxf(ms, ml[((qb * KS + k) * 2) * 32 + r]);
#pragma unroll
    for (int k = 0; k < KS; ++k) { f[k] = __expf(ml[((qb * KS + k) * 2) * 32 + r] - ms); L += f[k] * ml[((qb * KS + k) * 2 + 1) * 32 + r]; }
    const float inv = 1.f / L;
    constexpr int ND = 32 / KS;
    const int dv0 = (64 / KS) * kp + ND * hh;
#pragma unroll
    for (int c = 0; c < ND / 8; ++c) {
        float o[8];
#pragma unroll
        for (int e = 0; e < 8; ++e) { float v = 0.f;
#pragma unroll
            for (int k = 0; k < KS; ++k) v += f[k] * part[(qb * KS + k) * 2048 + (dv0 + 8 * c + e) * 32 + r];
            o[e] = v * inv; }
        const v4u gr = *(const v4u*)(gp + dv0 + 8 * c);
        v4u z; z.x = pk2(o[0] * silu_f(bflo(gr.x)), o[1] * silu_f(bfhi(gr.x))); z.y = pk2(o[2] * silu_f(bflo(gr.y)), o[3] * silu_f(bfhi(gr.y)));
        z.z = pk2(o[4] * silu_f(bflo(gr.z)), o[5] * silu_f(bfhi(gr.z))); z.w = pk2(o[6] * silu_f(bflo(gr.w)), o[7] * silu_f(bfhi(gr.w)));
        *(v4u*)(zp + dv0 + 8 * c) = z;
    }
    __syncthreads();
}

__device__ __forceinline__ void unit_mla_attn(const Args& a, const Ctx& X, int u) {
    const bf16* U = (const bf16*)(a.ws + WS_U); const bf16* Q = (const bf16*)(a.ws + WS_Q); const bf16* KM = (const bf16*)(a.ws + WS_KM); const bf16* VTM = (const bf16*)(a.ws + WS_VTM);
    bf16* Z = (bf16*)(a.ws + WS_Z);
    const int tid = opaque_v(X.tid), lane = tid & 63, w = opaque_s(X.wave), r = lane & 31, hh = lane >> 5;
    int h, q0, kb0, nkb; const bool samp = u < 256;
    if (samp) { const int bs = u >> 7, qg = u & 15; h = (u >> 4) & 7; q0 = NP + bs * 1024 + 64 * qg + 32 * (w >> 2); kb0 = NP + bs * 1280 + 320 * (w & 3); nkb = 10; }
    else { const int v = u - 256, b = v >> 4, qh = v & 1; h = (v >> 1) & 7; q0 = b * 256 + 128 * qh + 32 * (w >> 1); kb0 = b * 256 + 128 * (w & 1); nkb = 4; }
    bh8 qf[6];
#pragma unroll
    for (int ks = 0; ks < 6; ++ks) qf[ks] = ld16(Q + (size_t)(q0 + r) * 768 + h * 96 + 16 * ks + 8 * hh);
    AttnState st; attn_init(st);
    const bf16* kp = KM + ((size_t)((kb0 >> 5) * 8 + h) * 6) * 512 + lane * 8;
    const bf16* vp = VTM + ((size_t)((kb0 >> 5) * 8 + h) * 4) * 512 + lane * 8;
    KVf<6> fa, fb;
    load_kv<6>(fa, kp, vp);
    for (int kb = 0; kb < nkb; kb += 2) {
        load_kv<6>(fb, kp + (size_t)(kb + 1) * 8 * 6 * 512, vp + (size_t)(kb + 1) * 8 * 4 * 512);
        SB_PIN
        attn_compute<6>(st, qf, fa, nullptr, hh, false, 0, 0, 0, 0, nullptr);
        if (kb + 2 < nkb) load_kv<6>(fa, kp + (size_t)(kb + 2) * 8 * 6 * 512, vp + (size_t)(kb + 2) * 8 * 4 * 512);
        SB_PIN
        attn_compute<6>(st, qf, fb, nullptr, hh, false, 0, 0, 0, 0, nullptr);
    }
    const int row = q0 + r;
    if (samp) attn_merge_store<4>(st, (float*)X.ldsg, w, lane, U + (size_t)row * UE + CE_GA + h * 64, Z + (size_t)row * DM + h * 64);
    else attn_merge_store<2>(st, (float*)X.ldsg, w, lane, U + (size_t)row * UE + CE_GA + h * 64, Z + (size_t)row * DM + h * 64);
}

__device__ __forceinline__ void load_q64(const bf16* qrow  , const float* qnorm, const float* knorm, int hh, bh8* qa) {
    float x[4][8]; float ss = 0.f;
#pragma unroll
    for (int ks = 0; ks < 4; ++ks) { const v4u raw = *(const v4u*)(qrow + 16 * ks + 8 * hh);
        x[ks][0] = bflo(raw.x); x[ks][1] = bfhi(raw.x); x[ks][2] = bflo(raw.y); x[ks][3] = bfhi(raw.y); x[ks][4] = bflo(raw.z); x[ks][5] = bfhi(raw.z); x[ks][6] = bflo(raw.w); x[ks][7] = bfhi(raw.w);
#pragma unroll
        for (int e = 0; e < 8; ++e) ss += x[ks][e] * x[ks][e]; }
    ss += __shfl_xor(ss, 32);
    const float rstd = rsqrtf(ss * (1.f / 64.f) + EPS) * 0.125f;
#pragma unroll
    for (int ks = 0; ks < 4; ++ks) { float ya[8];
#pragma unroll
        for (int e = 0; e < 8; ++e) { const int d = 16 * ks + 8 * hh + e; ya[e] = x[ks][e] * rstd * qnorm[d] * knorm[d]; }
        v4u va; va.x = pk2(ya[0], ya[1]); va.y = pk2(ya[2], ya[3]); va.z = pk2(ya[4], ya[5]); va.w = pk2(ya[6], ya[7]);
        qa[ks] = __builtin_bit_cast(bh8, va); }
}

__device__ __forceinline__ void unit_odd_attn(const Args& a, const Ctx& X, int j, int u) {
    const bf16* U = (const bf16*)(a.ws + WS_U); const bf16* VTO = (const bf16*)(a.ws + WS_VTO); bf16* Z = (bf16*)(a.ws + WS_Z);
    const float* qnorm = a.in[28] + j * 64; const float* knorm = a.in[29] + j * 64;
    float* part = (float*)X.ldsg; float* rk = part + 8 * 2048 + 512;
    const int b = u >> 4, h = (u >> 1) & 7, qh = u & 1, tid = opaque_v(X.tid), lane = tid & 63, w = opaque_s(X.wave), r = lane & 31, hh = lane >> 5, R0 = b * 256;
    PROF_BEGIN(26)
    { const int key = tid >> 1, half = tid & 1;
      const bf16* kp = U + (size_t)(R0 + key) * UO + CO_KD + h * 64 + 32 * half;
      float kx[32]; float ss = 0.f;
#pragma unroll
      for (int q = 0; q < 4; ++q) { const v4u kr = *(const v4u*)(kp + 8 * q);
          kx[8 * q] = bflo(kr.x); kx[8 * q + 1] = bfhi(kr.x); kx[8 * q + 2] = bflo(kr.y); kx[8 * q + 3] = bfhi(kr.y); kx[8 * q + 4] = bflo(kr.z); kx[8 * q + 5] = bfhi(kr.z); kx[8 * q + 6] = bflo(kr.w); kx[8 * q + 7] = bfhi(kr.w); }
#pragma unroll
      for (int e = 0; e < 32; ++e) ss += kx[e] * kx[e];
      ss += __shfl_xor(ss, 1);
      const float rstd = rsqrtf(ss * (1.f / 64.f) + EPS);
      if (half == 0) rk[key] = rstd;
      if (qh == 0) {
          const bf16* vp = U + (size_t)(R0 + key) * UO + CO_VD + h * 64 + 32 * half;
          float* ok = a.out + O_NK + ((size_t)(b * 2 + j) * 256 + key) * 512 + h * 64 + 32 * half; float* ov = a.out + O_NV + ((size_t)(b * 2 + j) * 256 + key) * 512 + h * 64 + 32 * half;
#pragma unroll
          for (int q = 0; q < 8; ++q) { const f32x4 g = *(const f32x4*)(knorm + 32 * half + 4 * q);
              *(f32x4*)(ok + 4 * q) = (f32x4){kx[4 * q] * rstd * g.x, kx[4 * q + 1] * rstd * g.y, kx[4 * q + 2] * rstd * g.z, kx[4 * q + 3] * rstd * g.w}; }
#pragma unroll
          for (int q = 0; q < 4; ++q) { const v4u vr = *(const v4u*)(vp + 8 * q);
              *(f32x4*)(ov + 8 * q) = (f32x4){bflo(vr.x), bfhi(vr.x), bflo(vr.y), bfhi(vr.y)}; *(f32x4*)(ov + 8 * q + 4) = (f32x4){bflo(vr.z), bfhi(vr.z), bflo(vr.w), bfhi(vr.w)}; }
      } }
    __syncthreads();
    PROF_END(26)
    PROF_BEGIN(27)
    const int row = R0 + 128 * qh + 32 * (w >> 1) + r, kb0 = R0 + 128 * (w & 1);
    bh8 qa[4];
    load_q64(U + (size_t)row * UO + CO_QD + h * 64, qnorm, knorm, hh, qa);
    AttnState st; attn_init(st);
    const bf16* kp = (const bf16*)(a.ws + WS_KFO) + ((size_t)((kb0 >> 5) * 8 + h) * 4) * 512 + lane * 8;
    const bf16* vp = VTO + ((size_t)((kb0 >> 5) * 8 + h) * 4) * 512 + lane * 8;
    const float* rkp = rk + 128 * (w & 1);
    KVf<4> fa, fb;
    load_kv<4>(fa, kp, vp);
#pragma unroll
    for (int kb = 0; kb < 4; kb += 2) {
        load_kv<4>(fb, kp + (size_t)(kb + 1) * 8 * 4 * 512, vp + (size_t)(kb + 1) * 8 * 4 * 512);
        SB_PIN
        attn_compute<4>(st, qa, fa, rkp + 32 * kb, hh, false, 0, 0, 0, 0, nullptr);
        if (kb + 2 < 4) load_kv<4>(fa, kp + (size_t)(kb + 2) * 8 * 4 * 512, vp + (size_t)(kb + 2) * 8 * 4 * 512);
        SB_PIN
        attn_compute<4>(st, qa, fb, rkp + 32 * (kb + 1), hh, false, 0, 0, 0, 0, nullptr);
    }
    PROF_END(27)
    PROF_BEGIN(28)
    attn_merge_store<2>(st, part, w, lane, U + (size_t)row * UO + CO_GD + h * 64, Z + (size_t)row * DM + 512 + h * 64);
    PROF_END(28)
}

__device__ __forceinline__ void na_block_ptrs(int g, int rb, int R0s, int h, int lane, const bf16* KFO, const bf16* VFO, const bf16* kc, const bf16* vc,
                                              const bf16*& kp, const bf16*& vp, int& rki, bool& win, int& kc0, int& bi) {
    if (g < 8) { kp = kc + (size_t)g * 4 * 512 + lane * 8; vp = vc + (size_t)g * 4 * 512 + lane * 8; rki = 512 + 32 * g; win = false; kc0 = 0; bi = 0; }
    else { const int i = (g - 8) >> 1, xk = g & 1; const int tok0 = (rb + i) * 64 + 32 * xk; const size_t blk = ((size_t)(((R0s + tok0) >> 5) * 8 + h) * 4) * 512 + lane * 8;
        kp = KFO + blk; vp = VFO + blk; rki = i * 64 + 32 * xk; win = true; kc0 = 32 * xk; bi = i; }
}
__device__ __forceinline__ void unit_na(const Args& a, const Ctx& X, int j, int u) {
    const bf16* U = (const bf16*)(a.ws + WS_U); const bf16* VTO = (const bf16*)(a.ws + WS_VTO); bf16* Z = (bf16*)(a.ws + WS_Z);
    const float* qnorm = a.in[28] + j * 64; const float* knorm = a.in[29] + j * 64;
    float* part = (float*)X.ldsg; float* rk = part + 8 * 2048 + 512;
    float* rpbs = rk + 768;
    const int bs = u >> 7, h = (u >> 4) & 7, rr = u & 15, tid = opaque_v(X.tid), lane = tid & 63, w = opaque_s(X.wave), r = lane & 31, hh = lane >> 5, R0s = NP + bs * 1024;
    const int rb = rr - 4 < 0 ? 0 : (rr - 4 > 8 ? 8 : rr - 4);
    { const bf16* kp = U + (size_t)(R0s + rb * 64 + tid) * UO + CO_KD + h * 64; float ss = 0.f;
#pragma unroll
      for (int q = 0; q < 8; ++q) { const v4u kr = *(const v4u*)(kp + 8 * q);
          const float k0 = bflo(kr.x), k1 = bfhi(kr.x), k2 = bflo(kr.y), k3 = bfhi(kr.y), k4 = bflo(kr.z), k5 = bfhi(kr.z), k6 = bflo(kr.w), k7 = bfhi(kr.w);
          ss += (k0 * k0 + k1 * k1) + (k2 * k2 + k3 * k3) + (k4 * k4 + k5 * k5) + (k6 * k6 + k7 * k7); }
      rk[tid] = rsqrtf(ss * (1.f / 64.f) + EPS);
      if (tid < 256) rk[512 + tid] = 1.f;
      if (tid < 465) rpbs[tid] = a.in[30][(size_t)(j * 8 + h) * 465 + tid]; }
    __syncthreads();
    const int xq = w >> 2, kpart = w & 3, tok = rr * 64 + 32 * xq + r, cq = 32 * xq + r;
    const int c0 = cq - 8 < 0 ? 0 : (cq - 8 > 48 ? 48 : cq - 8);
    const int row = R0s + tok;
    bh8 qa[4];
    load_q64(U + (size_t)row * UO + CO_QD + h * 64, qnorm, knorm, hh, qa);
    AttnState st; attn_init(st);
    const bf16* kc = (const bf16*)(a.ws + WS_NAKC) + (size_t)((bs * 2 + j) * 8 + h) * 8 * 4 * 512;
    const bf16* vc = (const bf16*)(a.ws + WS_NAVC) + (size_t)((bs * 2 + j) * 8 + h) * 8 * 4 * 512;
    const bf16* KFO = (const bf16*)(a.ws + WS_KFO);
    const int g0 = 6 * kpart;
    KVf<4> fa, fb;
    const bf16 *kpa, *vpa, *kpb, *vpb; int rka, rkb, kca, kcb, bia, bib; bool wa, wb;
    na_block_ptrs(g0, rb, R0s, h, lane, KFO, VTO, kc, vc, kpa, vpa, rka, wa, kca, bia);
    load_kv<4>(fa, kpa, vpa);
#pragma unroll 1
    for (int g = 0; g < 6; g += 2) {
        na_block_ptrs(g0 + g + 1, rb, R0s, h, lane, KFO, VTO, kc, vc, kpb, vpb, rkb, wb, kcb, bib);
        load_kv<4>(fb, kpb, vpb);
        SB_PIN
        attn_compute<4>(st, qa, fa, rk + rka, hh, wa, kca, rb + bia - rr + 7, cq, c0, rpbs);
        if (g + 2 < 6) { na_block_ptrs(g0 + g + 2, rb, R0s, h, lane, KFO, VTO, kc, vc, kpa, vpa, rka, wa, kca, bia); load_kv<4>(fa, kpa, vpa); }
        SB_PIN
        attn_compute<4>(st, qa, fb, rk + rkb, hh, wb, kcb, rb + bib - rr + 7, cq, c0, rpbs);
    }
    attn_merge_store<4>(st, part, w, lane, U + (size_t)row * UO + CO_GD + h * 64, Z + (size_t)row * DM + 512 + h * 64);
}
#ifndef RU_OUT_A
#define RU_OUT_A 1
#endif
#ifndef RU_OUT_B
#define RU_OUT_B 1
#endif
#ifndef RU_OUT_C
#define RU_OUT_C 1
#endif
__device__ __forceinline__ float scan_incl_sum(float v, int lane) {
#pragma unroll
    for (int o = 1; o < 64; o <<= 1) { const float t = __shfl_up(v, o); if (lane >= o) v += t; }
    return v;
}
__device__ __forceinline__ float scan_incl_max(float v, int lane) {
#pragma unroll
    for (int o = 1; o < 64; o <<= 1) { const float t = __shfl_up(v, o); if (lane >= o) v = fmaxf(v, t); }
    return v;
}
__device__ __forceinline__ float scan_incl_max_rev(float v, int lane) {
#pragma unroll
    for (int o = 1; o < 64; o <<= 1) { const float t = __shfl_down(v, o); if (lane + o < 64) v = fmaxf(v, t); }
    return v;
}
constexpr float KSC = 0.08838834764831845f;

__device__ __forceinline__ void stage_T(const bf16* src  , int pitch, bf16* d0, const float* w0, bf16* d1, const float* w1, int wave, int lane) {
#pragma unroll
    for (int i = 0; i < 2; ++i) { const int c = wave * 2 + i;
        const v4u raw = *(const v4u*)(src + (size_t)lane * pitch + 8 * c);
        float x[8] = {bflo(raw.x), bfhi(raw.x), bflo(raw.y), bfhi(raw.y), bflo(raw.z), bfhi(raw.z), bflo(raw.w), bfhi(raw.w)};
        if (w0) { const float s0 = w0[lane] * KSC, s1 = w1[lane] * KSC;
#pragma unroll
            for (int e = 0; e < 8; ++e) { d0[(8 * c + e) * 72 + lane] = (bf16)(pk2(x[e] * s0, 0.f) & 0xffffu); d1[(8 * c + e) * 72 + lane] = (bf16)(pk2(x[e] * s1, 0.f) & 0xffffu); }
        } else {
            const unsigned rr[4] = {raw.x, raw.y, raw.z, raw.w};
#pragma unroll
            for (int e = 0; e < 8; ++e) d0[(8 * c + e) * 72 + lane] = (bf16)((rr[e >> 1] >> (16 * (e & 1))) & 0xffffu);
        }
    }
}

__device__ __forceinline__ void unit_mlstm_L(const Args& a, const Ctx& X, int j, int h, int gc) {
    const bf16* U = (const bf16*)(a.ws + WS_U); const float* GT = (const float*)(a.ws + WS_GATES); const bf16* VFM = (const bf16*)(a.ws + WS_VFM);
    float* AG = (float*)(a.ws + WS_AG); float* LT = (float*)(a.ws + WS_LT); float* NL = (float*)(a.ws + WS_NL); float* GQ = (float*)(a.ws + WS_GQ);
    float* wgt = (float*)X.ldsg;
    bf16* KwT = (bf16*)(X.ldsg + 1024);
    const int tid = opaque_v(X.tid), lane = tid & 63, w = opaque_s(X.wave), r = lane & 31, hh = lane >> 5, R0 = gc * 64;
    v4u kraw[2];
#pragma unroll
    for (int i = 0; i < 2; ++i) kraw[i] = *(const v4u*)(U + (size_t)(R0 + lane) * UE + CE_KM + h * 128 + 8 * (w * 2 + i));
    bh8 vf[4][4];
#pragma unroll
    for (int eb = 0; eb < 4; ++eb)
#pragma unroll
        for (int q = 0; q < 4; ++q) vf[eb][q] = ld16(VFM + ((size_t)(((2 * gc + (q >> 1)) * 4 + h) * 8 + eb * 2 + (q & 1))) * 512 + lane * 8);
    SB_PIN
    if (w < 2) { const int dir = w; const int row = R0 + lane;
        const float lf = logsigmoid_f(GT[(size_t)row * 16 + 8 + dir * 4 + h] + a.in[22][j * 8 + dir * 4 + h]);
        const float ii = GT[(size_t)row * 16 + dir * 4 + h] + a.in[21][j * 8 + dir * 4 + h];
        const float P = scan_incl_sum(lf, lane); const float T = __shfl(P, 63);
        const float dec = (dir == 0 ? (T - P) : (P - lf)) + ii;
        const float am = wave_max(dec);
        wgt[dir * 64 + lane] = expf(dec - am) * KSC;
        if (lane == 0) { AG[((dir * 4 + h) * 96 + gc) * 2] = am; AG[((dir * 4 + h) * 96 + gc) * 2 + 1] = T; }
        const float cum = dir == 0 ? P : (T - P + lf), bv = ii - cum;
        const float pm = dir == 0 ? scan_incl_max(bv, lane) : scan_incl_max_rev(bv, lane);
        *(f32x4*)(GQ + ((size_t)(dir * 4 + h) * NT + row) * 4) = (f32x4){cum, bv, pm, 0.f};
    }
    __syncthreads();
#pragma unroll
    for (int i = 0; i < 2; ++i) { const int c = w * 2 + i; const unsigned rr[4] = {kraw[i].x, kraw[i].y, kraw[i].z, kraw[i].w};
        const float s0 = wgt[lane], s1 = wgt[64 + lane];
#pragma unroll
        for (int e = 0; e < 8; ++e) { const float x = (e & 1) ? bfhi(rr[e >> 1]) : bflo(rr[e >> 1]);
            KwT[(8 * c + e) * 72 + lane] = (bf16)(pk2(x * s0, 0.f) & 0xffffu); KwT[128 * 72 + (8 * c + e) * 72 + lane] = (bf16)(pk2(x * s1, 0.f) & 0xffffu); } }
    __syncthreads();
    { const int dir = w >> 2, db = w & 3; const size_t ub = (size_t)((dir * 4 + h) * 96 + gc);
      bh8 bfr[4];
#pragma unroll
      for (int q = 0; q < 4; ++q) { const bf16* kp = KwT + dir * 128 * 72 + (32 * db + r) * 72 + 16 * q + 4 * hh; bfr[q] = ld2x8(kp, kp + 8); }
#pragma unroll
      for (int eb = 0; eb < 4; ++eb) { f32x16 acc;
#pragma unroll
          for (int i = 0; i < 16; ++i) acc[i] = 0.f;
#pragma unroll
          for (int q = 0; q < 4; ++q) acc = mfma32(vf[eb][q], bfr[q], acc);
          float* dst = LT + ub * 16384 + 32 * db + r;
#pragma unroll
          for (int i = 0; i < 16; ++i) dst[(32 * eb + crow(i, hh)) * 128] = acc[i]; }
      if (tid < 256) { const int dr = tid >> 7, d = tid & 127; const bf16* p = KwT + dr * 128 * 72 + d * 72; float s = 0.f;
#pragma unroll
          for (int q = 0; q < 8; ++q) { const v4u x = *(const v4u*)(p + 8 * q); s += (bflo(x.x) + bfhi(x.x)) + (bflo(x.y) + bfhi(x.y)) + (bflo(x.z) + bfhi(x.z)) + (bflo(x.w) + bfhi(x.w)); }
          NL[(size_t)((dr * 4 + h) * 96 + gc) * 128 + d] = s; } }
    __syncthreads();
}

template <int NC, int NV>
__device__ __forceinline__ void scan_body(const Args& a, int j, int tid, int dir, int h, int gc0, int sl, int initmat  , long outsb  ) {
    const float* AG = (const float*)(a.ws + WS_AG); const float* LT = (const float*)(a.ws + WS_LT); const float* NL = (const float*)(a.ws + WS_NL);
    bf16* CTB = (bf16*)(a.ws + WS_CTB); float* NPV = (float*)(a.ws + WS_NPV); float* MPV = (float*)(a.ws + WS_MPV);
    const size_t ub0 = (size_t)((dir * 4 + h) * 96 + gc0);
    const int e0 = sl * (NV * 2048) + tid * 4;
    f32x4 Lv[NC][NV]; float nl[NC];
    const bool don = tid < 128 && sl == 0;
#pragma unroll
    for (int c = 0; c < NC; ++c) {
#pragma unroll
        for (int i = 0; i < NV; ++i) Lv[c][i] = *(const f32x4*)(LT + (ub0 + c) * 16384 + e0 + 2048 * i);
        nl[c] = don ? NL[(ub0 + c) * 128 + tid] : 0.f; }
    SB_PIN
    f32x4 Cs[NV]; float ns = 0.f, m = 0.f;
#pragma unroll
    for (int i = 0; i < NV; ++i) Cs[i] = (f32x4){0.f, 0.f, 0.f, 0.f};
    if (initmat >= 0) { const float* c0 = (const float*)(a.ws + WS_C0T) + (size_t)initmat * 16384;
#pragma unroll
        for (int i = 0; i < NV; ++i) Cs[i] = *(const f32x4*)(c0 + e0 + 2048 * i);
        if (don) ns = a.in[6][(size_t)initmat * 128 + tid];
        m = a.in[7][initmat]; }
#pragma unroll
    for (int p = 0; p < NC; ++p) {
        const int c = dir ? NC - 1 - p : p;
        const float ac = AG[(ub0 + c) * 2], Gc = AG[(ub0 + c) * 2 + 1];
#pragma unroll
        for (int i = 0; i < NV; ++i) { const int idx = e0 + 2048 * i; st4bf(CTB + (ub0 + c) * 16384 + idx, Cs[i].x, Cs[i].y, Cs[i].z, Cs[i].w); }
        if (don) NPV[(ub0 + c) * 128 + tid] = ns;
        if (tid == 0 && sl == 0) MPV[ub0 + c] = m;
        const float mn = fmaxf(Gc + m, ac), ws = expf(Gc + m - mn), wl = expf(ac - mn);
#pragma unroll
        for (int i = 0; i < NV; ++i) Cs[i] = Cs[i] * ws + Lv[c][i] * wl;
        ns = ns * ws + nl[c] * wl; m = mn;
    }
    if (outsb >= 0) {
#pragma unroll
        for (int i = 0; i < NV; ++i) { const int idx = e0 + 2048 * i, e = idx >> 7, d = idx & 127; float* o = a.out + O_C + (size_t)outsb * 16384 + e;
            o[(d + 0) * 128] = Cs[i].x; o[(d + 1) * 128] = Cs[i].y; o[(d + 2) * 128] = Cs[i].z; o[(d + 3) * 128] = Cs[i].w; }
        if (don) a.out[O_N + (size_t)outsb * 128 + tid] = ns;
        if (tid == 0 && sl == 0) a.out[O_M + outsb] = m;
    }
}
__device__ __forceinline__ void unit_mlstm_scan(const Args& a, const Ctx& X, int j, int s) {
    const int tid = opaque_v(X.tid);
    if (s < 256) { const int sl = s & 1, q = s >> 1, b = q >> 3, h = (q >> 1) & 3, dir = q & 1;
        scan_body<4, 4>(a, j, tid, dir, h, 4 * b, sl, -1, (long)((b * 2 + j) * 2 + dir) * 4 + h); }
    else { const int v = s - 256, sl = v & 7, q = v >> 3, bs = q >> 3, h = (q >> 1) & 3, dir = q & 1;
        scan_body<16, 1>(a, j, tid, dir, h, 64 + 16 * bs, sl, ((bs * 2 + j) * 2 + dir) * 4 + h, -1); }
}

__device__ __forceinline__ void unit_mlstm_out(const Args& a, const Ctx& X, int j, int h, int gc) {
    const bf16* U = (const bf16*)(a.ws + WS_U);
    const bf16* CTB = (const bf16*)(a.ws + WS_CTB); const float* NPV = (const float*)(a.ws + WS_NPV); const float* MPV = (const float*)(a.ws + WS_MPV);
    bf16* Z = (bf16*)(a.ws + WS_Z);
    unsigned char* L = X.ldsg;
    bf16* Qs = (bf16*)L; bf16* Ks = (bf16*)(L + 17408); bf16* CT = (bf16*)(L + 34816);
    float* ctm = (float*)(L + 137216); float* bb = ctm + 128; float* wint = bb + 128; float* emt = wint + 128;
    float* nprev = emt + 128;
    float* ssq = nprev + 256;
    const int tid = opaque_v(X.tid), lane = tid & 63, w = opaque_s(X.wave), r = lane & 31, hh = lane >> 5, R0 = gc * 64;
    const int tb = w & 1, eb = w >> 1, tau = 32 * tb + r;
    PROF_BEGIN(23)
    v4u qraw[2], kraw[2], craw[4];
#pragma unroll
    for (int i = 0; i < 2; ++i) { const int q = tid + 512 * i, row = q >> 4, cc = q & 15;
        qraw[i] = *(const v4u*)(U + (size_t)(R0 + row) * UE + CE_QM + h * 128 + 8 * cc);
        kraw[i] = *(const v4u*)(U + (size_t)(R0 + row) * UE + CE_KM + h * 128 + 8 * cc); }
#pragma unroll
    for (int i = 0; i < 4; ++i) { const int q = tid + 512 * i, e = q >> 4, cc = q & 15; craw[i] = *(const v4u*)(CTB + (size_t)((0 * 4 + h) * 96 + gc) * 16384 + e * 128 + 8 * cc); }
    const float npr = tid < 256 ? NPV[(size_t)(((tid >> 7) * 4 + h) * 96 + gc) * 128 + (tid & 127)] : 0.f;
    bh8 vf[4];
#pragma unroll
    for (int q = 0; q < 4; ++q) vf[q] = ld16((const bf16*)(a.ws + WS_VFM) + ((size_t)(((2 * gc + (q >> 1)) * 4 + h) * 8 + eb * 2 + (q & 1))) * 512 + lane * 8);
    f32x4 gq = (f32x4){0.f, 0.f, 0.f, 0.f}; float mp = 0.f;
    if (w < 2) { gq = *(const f32x4*)((const float*)(a.ws + WS_GQ) + ((size_t)(w * 4 + h) * NT + R0 + lane) * 4); mp = MPV[(size_t)((w * 4 + h) * 96 + gc)]; }
    { const int row = R0 + tau; v2u* og = (v2u*)(L + 104448) + tid * 8;
#pragma unroll
      for (int g = 0; g < 4; ++g) { const int e0 = 32 * eb + 8 * g + 4 * hh;
          og[g] = *(const v2u*)(U + (size_t)row * UE + CE_OM + h * 128 + e0); og[4 + g] = *(const v2u*)(U + (size_t)row * UE + CE_GM + h * 128 + e0); } }
    SB_PIN
#pragma unroll
    for (int i = 0; i < 2; ++i) { const int q = tid + 512 * i, row = q >> 4, cc = q & 15;
        *(v4u*)(Qs + row * 136 + 8 * cc) = qraw[i]; *(v4u*)(Ks + row * 136 + 8 * cc) = kraw[i]; }
#pragma unroll
    for (int i = 0; i < 4; ++i) { const int q = tid + 512 * i, e = q >> 4, cc = q & 15; *(v4u*)(CT + e * 136 + 8 * cc) = craw[i];
        craw[i] = *(const v4u*)(CTB + (size_t)((1 * 4 + h) * 96 + gc) * 16384 + e * 128 + 8 * cc); }
#pragma unroll
    for (int i = 0; i < 4; ++i) { const int q = tid + 512 * i, e = q >> 4, cc = q & 15; *(v4u*)(CT + 128 * 136 + e * 136 + 8 * cc) = craw[i]; }
    if (tid < 256) nprev[tid] = npr;
    if (w < 2) { const int dir = w; const float cum = gq.x, bv = gq.y, pm = gq.z;
        const float mt = cum + fmaxf(mp, pm);
        ctm[dir * 64 + lane] = cum - mt; bb[dir * 64 + lane] = bv; wint[dir * 64 + lane] = expf(cum + mp - mt); emt[dir * 64 + lane] = expf(-mt); }
    __syncthreads();
    PROF_END(23)
    PROF_BEGIN(24)
    const bf16* qp = Qs + (32 * tb + r) * 136 + 8 * hh;
    bh8 qf[8];
#pragma unroll
    for (int ks = 0; ks < 8; ++ks) qf[ks] = ld16(qp + 16 * ks);
    f32x16 hsum;
    for (int rpb_ = 0; rpb_ < RU_OUT_B; ++rpb_) {
#pragma unroll
    for (int i = 0; i < 16; ++i) hsum[i] = 0.f;
#pragma unroll 1
    for (int dir = 0; dir < 2; ++dir) {
        const int sgn = 1 - 2 * dir;
        const bf16* CTd = CT + dir * 128 * 136; const float* npv = nprev + dir * 128;
        const float ct = ctm[dir * 64 + tau], wi = wint[dir * 64 + tau];
        float rs = 0.f, qd = 0.f;
        f32x16 accv;
#pragma unroll
        for (int i = 0; i < 16; ++i) accv[i] = 0.f;
#pragma unroll
        for (int sb = 0; sb < 2; ++sb) {
            bh8 kf[8]; f32x16 ps;
#pragma unroll
            for (int ks = 0; ks < 8; ++ks) kf[ks] = ld16(Ks + (32 * sb + r) * 136 + 16 * ks + 8 * hh);
#pragma unroll
            for (int i = 0; i < 16; ++i) ps[i] = 0.f;
#pragma unroll
            for (int ks = 0; ks < 8; ++ks) ps = mfma32(kf[ks], qf[ks], ps);
#pragma unroll
            for (int g = 0; g < 4; ++g) { const f32x4 b4 = *(const f32x4*)(bb + dir * 64 + 32 * sb + 8 * g + 4 * hh);
#pragma unroll
                for (int e = 0; e < 4; ++e) { const int dd = (32 * sb + 8 * g + 4 * hh + e - tau) * sgn; const bool ok = dd <= 0;
                    const float v = ok ? ps[4 * g + e] * KSC * __expf(ct + b4[e]) : 0.f; ps[4 * g + e] = v; rs += v; } }
            accv = mfma32(vf[2 * sb], pfrag(ps, 0), accv);
            accv = mfma32(vf[2 * sb + 1], pfrag(ps, 1), accv);
            __builtin_amdgcn_sched_barrier(0);
        }
        rs += __shfl_xor(rs, 32);
#pragma unroll
        for (int ks = 0; ks < 8; ++ks) { const v4u qq = __builtin_bit_cast(v4u, qf[ks]); const f32x4 n0 = *(const f32x4*)(npv + 16 * ks + 8 * hh), n1 = *(const f32x4*)(npv + 16 * ks + 8 * hh + 4);
            qd += bflo(qq.x) * n0.x + bfhi(qq.x) * n0.y + bflo(qq.y) * n0.z + bfhi(qq.y) * n0.w + bflo(qq.z) * n1.x + bfhi(qq.z) * n1.y + bflo(qq.w) * n1.z + bfhi(qq.w) * n1.w;
            if ((ks & 1) == 1) __builtin_amdgcn_sched_barrier(0); }
        qd += __shfl_xor(qd, 32);
        __builtin_amdgcn_sched_barrier(0);
        bh8 cf[8];
#pragma unroll
        for (int ks = 0; ks < 8; ++ks) cf[ks] = ld16(CTd + (32 * eb + r) * 136 + 16 * ks + 8 * hh);
        const float qn = wi * qd + rs;
        f32x16 acc;
#pragma unroll
        for (int i = 0; i < 16; ++i) acc[i] = 0.f;
#pragma unroll
        for (int ks = 0; ks < 8; ++ks) acc = mfma32(cf[ks], qf[ks], acc);
#pragma unroll
        for (int i = 0; i < 16; ++i) acc[i] = acc[i] * wi + accv[i];
        const float inv = 1.f / fmaxf(fabsf(qn), emt[dir * 64 + tau]);
#pragma unroll
        for (int i = 0; i < 16; ++i) hsum[i] += acc[i] * inv;
        __builtin_amdgcn_sched_barrier(0);
    }
    }
    PROF_END(24)
    PROF_BEGIN(25)
    { float ss = 0.f;
#pragma unroll
      for (int i = 0; i < 16; ++i) ss += hsum[i] * hsum[i];
      ss += __shfl_xor(ss, 32);
      if (hh == 0) ssq[(tb * 4 + eb) * 32 + r] = ss; }
    __syncthreads();
    { const int tid2 = opaque_v(tid), lane2 = tid2 & 63, w2 = opaque_s(w), r2 = lane2 & 31, hh2 = lane2 >> 5, tb2 = w2 & 1, eb2 = w2 >> 1, tau2 = 32 * tb2 + r2;
    { const float tot = ssq[(tb2 * 4 + 0) * 32 + r2] + ssq[(tb2 * 4 + 1) * 32 + r2] + ssq[(tb2 * 4 + 2) * 32 + r2] + ssq[(tb2 * 4 + 3) * 32 + r2];
      const float rstd = rsqrtf(tot * (1.f / 128.f) + EPS);
      const int row = R0 + tau2; const float* hn = a.in[23] + j * 512 + h * 128;
#pragma unroll
      for (int g = 0; g < 4; ++g) { const int e0 = 32 * eb2 + 8 * g + 4 * hh2; const f32x4 gn = *(const f32x4*)(hn + e0); const v2u om = ((const v2u*)(L + 104448))[tid2 * 8 + g], gm = ((const v2u*)(L + 104448))[tid2 * 8 + 4 + g];
          st4bf(Z + (size_t)row * DM + 512 + h * 128 + e0,
                hsum[4 * g] * rstd * gn.x * sigmoid_f(bflo(om.x)) * silu_f(bflo(gm.x)), hsum[4 * g + 1] * rstd * gn.y * sigmoid_f(bfhi(om.x)) * silu_f(bfhi(gm.x)),
                hsum[4 * g + 2] * rstd * gn.z * sigmoid_f(bflo(om.y)) * silu_f(bflo(gm.y)), hsum[4 * g + 3] * rstd * gn.w * sigmoid_f(bfhi(om.y)) * silu_f(bfhi(gm.y))); } }
    }
    __syncthreads();
    PROF_END(25)
}
__device__ __forceinline__ void unit_conv(const Args& a, const Ctx& X, int j, int t) {
    const bf16* U = (const bf16*)(a.ws + WS_U); bf16* Z = (bf16*)(a.ws + WS_Z);
    const int tid = opaque_v(X.tid), cg = (tid & 63) * 8, r0 = t * 32 + (tid >> 6) * 4;
    const int S = r0 < NP ? 256 : 1024; const int s0 = r0 < NP ? (r0 & 255) : ((r0 - NP) & 1023);
    v4u xc[6], cc[6], bc[4], gc[4];
#pragma unroll
    for (int i = 0; i < 6; ++i) { const int s = s0 - 1 + i; const bool ok = s >= 0 && s < S; const bf16* u = U + (size_t)(r0 - 1 + i) * UO;
        xc[i] = ok ? *(const v4u*)(u + CO_XC + cg) : (v4u){0u, 0u, 0u, 0u}; cc[i] = ok ? *(const v4u*)(u + CO_CC + cg) : (v4u){0u, 0u, 0u, 0u}; }
#pragma unroll
    for (int i = 0; i < 4; ++i) { const bf16* u = U + (size_t)(r0 + i) * UO; bc[i] = *(const v4u*)(u + CO_BC + cg); gc[i] = *(const v4u*)(u + CO_GC + cg); }
    SB_PIN
    float w0[8], w1[8], w2[8], cb[8];
#pragma unroll
    for (int q = 0; q < 2; ++q) { const f32x4 a0 = *(const f32x4*)(a.in[26] + j * 1536 + cg + 4 * q), a1 = *(const f32x4*)(a.in[26] + j * 1536 + 512 + cg + 4 * q),
                                              a2 = *(const f32x4*)(a.in[26] + j * 1536 + 1024 + cg + 4 * q), a3 = *(const f32x4*)(a.in[27] + j * 512 + cg + 4 * q);
#pragma unroll
        for (int e = 0; e < 4; ++e) { w0[4 * q + e] = a0[e]; w1[4 * q + e] = a1[e]; w2[4 * q + e] = a2[e]; cb[4 * q + e] = a3[e]; } }
    float x[6][8];
#pragma unroll
    for (int i = 0; i < 6; ++i) { const unsigned xr[4] = {xc[i].x, xc[i].y, xc[i].z, xc[i].w}, cr[4] = {cc[i].x, cc[i].y, cc[i].z, cc[i].w};
#pragma unroll
        for (int q = 0; q < 4; ++q) { x[i][2 * q] = bflo(xr[q]) * bflo(cr[q]); x[i][2 * q + 1] = bfhi(xr[q]) * bfhi(cr[q]); } }
#pragma unroll
    for (int i = 0; i < 4; ++i) { const unsigned br[4] = {bc[i].x, bc[i].y, bc[i].z, bc[i].w}, gr[4] = {gc[i].x, gc[i].y, gc[i].z, gc[i].w};
        float o[8];
#pragma unroll
        for (int e = 0; e < 8; ++e) { const float bv = (e & 1) ? bfhi(br[e >> 1]) : bflo(br[e >> 1]), gv = (e & 1) ? bfhi(gr[e >> 1]) : bflo(gr[e >> 1]);
            const float cv = x[i][e] * w0[e] + x[i + 1][e] * w1[e] + x[i + 2][e] * w2[e] + cb[e];
            o[e] = bv * cv * silu_f(gv); }
        v4u z; z.x = pk2(o[0], o[1]); z.y = pk2(o[2], o[3]); z.z = pk2(o[4], o[5]); z.w = pk2(o[6], o[7]);
        *(v4u*)(Z + (size_t)(r0 + i) * DM + cg) = z; }
}

constexpr int NPHASES = 21;


#ifndef RU_Q
#define RU_Q 1
#endif
#ifndef RU_KV
#define RU_KV 1
#endif
#ifndef RU_L
#define RU_L 1
#endif
#ifndef RU_ATTS
#define RU_ATTS 1
#endif
#ifndef RU_SCAN
#define RU_SCAN 1
#endif
#ifndef RU_OUT
#define RU_OUT 1
#endif
#ifndef RU_ATTP
#define RU_ATTP 1
#endif
#ifndef RU_NA
#define RU_NA 1
#endif
#ifndef RU_OATT
#define RU_OATT 1
#endif
#ifndef RU_CONV
#define RU_CONV 1
#endif
#ifndef RU_SIDE
#define RU_SIDE 1
#endif
#define REPU(n, call) for (int rp_ = 0; rp_ < (n); ++rp_) { call; }
#define PU(id, stmt) { PROF_BEGIN(id) stmt PROF_END(id) }
__device__ __forceinline__ void phase_gemm1(const Args& a, const Ctx& X, int l) {
    const int j = l >> 1; const bool even = (l & 1) == 0;
    pg8::Gemm g{(const bf16*)(a.ws + WS_H), even ? (const bf16*)(a.ws + WS_WTEV) + (size_t)j * 3584 * 1024 : (const bf16*)(a.ws + WS_WTOD) + (size_t)j * 4096 * 1024, NT, even ? UE : UO, DM};
    pg8::StaticOrder S; S.init(NT, even ? UE : UO, X.G, X.bid);
    pg8::EpiU E{(bf16*)(a.ws + WS_U), even ? UE : UO, even ? (float*)(a.ws + WS_GATES) : nullptr, even ? nullptr : (bf16*)(a.ws + WS_VTO), even ? nullptr : (bf16*)(a.ws + WS_KFO), even ? (bf16*)(a.ws + WS_VFM) : nullptr};
    pg8::gemm_phase<pg8::EpiU, pg8::StaticOrder, true, true>(X.lds, g, S, E);
}
__device__ __forceinline__ void phase_gemm2(const Args& a, const Ctx& X, int l) {
    pg8::Gemm g{(const bf16*)(a.ws + WS_Z), (const bf16*)(a.ws + WS_WTOUT) + (size_t)l * 1024 * 1024, NT, DM, DM};
    pg8::StaticOrder S; S.init(NT, DM, X.G, X.bid);
    pg8::EpiY E{a.out, l == 0 ? a.in[0] : a.out, l == 0 ? a.in[1] : a.out + (size_t)NP * DM, (const float*)(a.ws + WS_MOD) + l * 3 * 3072};
    pg8::gemm_phase<pg8::EpiY, pg8::StaticOrder, true, true>(X.lds, g, S, E);
}
__device__ __forceinline__ void phase_e2(const Args& a, const Ctx& X, int j) {
    for (int u = X.bid; u < 584; u += X.G) {
        if (u < 96) PU(10, REPU(RU_Q, unit_mla_q(a, X, j, u)))
        else if (u < 192) PU(11, REPU(RU_KV, unit_mla_kv(a, X, j, u - 96)))
        else if (u < 200) unit_mla_kv(a, X, j, -1 - (u - 192));
        else { const int v = u - 200; PU(12, REPU(RU_L, unit_mlstm_L(a, X, j, v / 96, v % 96))) }
    }
}
__device__ __forceinline__ void phase_e2b(const Args& a, const Ctx& X, int j) {
    for (int u = X.bid; u < 640; u += X.G) {
        if (u < 256) PU(13, REPU(RU_ATTS, unit_mla_attn(a, X, u)))
        else PU(14, REPU(RU_SCAN, unit_mlstm_scan(a, X, j, u - 256)))
    }
}
__device__ __forceinline__ void phase_e3(const Args& a, const Ctx& X, int j) {
    for (int u = X.bid; u < 640; u += X.G) {
        if (u < 384) PU(15, REPU(RU_OUT, unit_mlstm_out(a, X, j, u / 96, u % 96)))
        else PU(16, REPU(RU_ATTP, unit_mla_attn(a, X, u - 384 + 256)))
    }
}
__device__ __forceinline__ void phase_o2(const Args& a, const Ctx& X, int j) {
    for (int u = X.bid; u < 704; u += X.G) {
        if (u < 256) PU(17, REPU(RU_NA, unit_na(a, X, j, u)))
        else if (u < 512) PU(18, REPU(RU_OATT, unit_odd_attn(a, X, j, u - 256)))
        else PU(19, REPU(RU_CONV, unit_conv(a, X, j, u - 512)))
    }
}


#ifndef REP_P0A
#define REP_P0A 1
#endif
#ifndef REP_NORM
#define REP_NORM 1
#endif
#ifndef REP_G1
#define REP_G1 1
#endif
#ifndef REP_E2
#define REP_E2 1
#endif
#ifndef REP_G2L0
#define REP_G2L0 1
#endif
#ifndef REP_E2B
#define REP_E2B 1
#endif
#ifndef REP_E3
#define REP_E3 1
#endif
#ifndef REP_O2
#define REP_O2 1
#endif
#ifndef PHMASK
#define PHMASK 0x7f
#endif
#define PH_NOP(...) ((void)0)
#if PHMASK & 1
#define PH_P0A phase_p0a
#else
#define PH_P0A PH_NOP
#endif
#if PHMASK & 2
#define PH_NORM phase_norm
#else
#define PH_NORM PH_NOP
#endif
#if PHMASK & 4
#define PH_G1 phase_gemm1
#else
#define PH_G1 PH_NOP
#endif
#if PHMASK & 8
#define PH_E2 phase_e2
#else
#define PH_E2 PH_NOP
#endif
#if PHMASK & 16
#define PH_E3 phase_e3
#define PH_E2B phase_e2b
#else
#define PH_E3 PH_NOP
#define PH_E2B PH_NOP
#endif
#if PHMASK & 32
#define PH_O2 phase_o2
#else
#define PH_O2 PH_NOP
#endif
#if PHMASK & 64
#define PH_G2 phase_gemm2
#else
#define PH_G2 PH_NOP
#endif
__global__ void __launch_bounds__(NTHR, 2) mega_fwd(Args args) {
    extern __shared__ __attribute__((aligned(16))) unsigned char lds[];
    Ctx X; X.lds = (LAS unsigned char*)lds; X.ldsg = lds;
    X.tid = threadIdx.x; X.lane = X.tid & 63; X.wave = __builtin_amdgcn_readfirstlane(X.tid >> 6); X.G = gridDim.x; X.bid = blockIdx.x;
    volatile LAS unsigned* MISC = (volatile LAS unsigned*)(X.lds + MISC_OFF);
    if (X.tid < 32) MISC[X.tid] = 0u;
    __syncthreads();
    const int lo = args.ph_lo, hi = args.ph_hi;
    XcdBarrier bar; bar.bar = (unsigned*)(args.ws + WS_CTL) + CW_BAR; bar.x = 0; bar.st = MISC + 8;
    if (hi - lo > 1) bar = xcd_barrier_post((unsigned*)(args.ws + WS_CTL) + CW_BAR, MISC + 8);
    int ph = 0;
#define RUN(pid, n, body) do { if (ph >= lo && ph < hi) { for (int rp = 0; rp < (n); ++rp) { { PROF_BEGIN(pid) body; PROF_END(pid) } if (ph + 1 < hi || rp + 1 < (n)) { PROF_BEGIN(9) xcd_barrier(bar); PROF_END(9) } } } ++ph; } while (0)
    RUN(1, REP_P0A, PH_P0A(args, X));
    RUN(2, REP_NORM, PH_NORM(args, X, 0));
    for (int l = 0; l < 4; ++l) {
        const int j = l >> 1;
        RUN(3, REP_G1, PH_G1(args, X, l));
        if ((l & 1) == 0) { RUN(4, REP_E2, PH_E2(args, X, j)); RUN(5, REP_E2B, PH_E2B(args, X, j)); RUN(6, REP_E3, PH_E3(args, X, j)); }
        else { RUN(7, REP_O2, PH_O2(args, X, j)); }
        RUN(8, l == 0 ? REP_G2L0 : 1, PH_G2(args, X, l));
        if (l < 3) RUN(2, REP_NORM, PH_NORM(args, X, l + 1));
    }
#undef RUN
    if (PROF_ID != 0 && threadIdx.x == 0) { const unsigned long long t0 = __builtin_amdgcn_s_memrealtime(); const unsigned long long w = (unsigned long long)PROF_K * ((volatile LAS unsigned*)(X.lds + MISC_OFF))[16];
        while (__builtin_amdgcn_s_memrealtime() - t0 < w) __builtin_amdgcn_s_sleep(8); }
}

#ifndef MK_SPLIT
#define MK_SPLIT 0
#endif

extern "C" void kernel_launch(void* const* d_in, const int* in_sizes, int n_in, void* d_out, int out_size, void* d_ws, size_t ws_size, hipStream_t stream) {
    static int ready = 0;
    if (!ready) {
        if (hipFuncSetAttribute((const void*)mega_fwd, hipFuncAttributeMaxDynamicSharedMemorySize, LDS_BYTES) != hipSuccess) fprintf(stderr, "kernel_launch: hipFuncSetAttribute failed\n");
        int per_cu = 0;
        if (hipOccupancyMaxActiveBlocksPerMultiprocessor(&per_cu, (const void*)mega_fwd, NTHR, LDS_BYTES) != hipSuccess || per_cu < 1) fprintf(stderr, "kernel_launch: occupancy query says %d blocks per CU\n", per_cu);
        (void)hipGetLastError();
        ready = 1;
    }
    (void)hipMemsetAsync((char*)d_ws + WS_CTL, 0, CTL_ZERO_BYTES, stream);
    Args a{};
    for (int i = 0; i < 32; ++i) a.in[i] = (const float*)d_in[i];
    a.out = (float*)d_out; a.ws = (unsigned char*)d_ws;
#if MK_SPLIT
    for (int p = 0; p < NPHASES; ++p) { a.ph_lo = p; a.ph_hi = p + 1; hipLaunchKernelGGL(mega_fwd, dim3(256), dim3(NTHR), LDS_BYTES, stream, a); }
#else
    a.ph_lo = 0; a.ph_hi = NPHASES;
    hipLaunchKernelGGL(mega_fwd, dim3(256), dim3(NTHR), LDS_BYTES, stream, a);
#endif
}
```

```cpp
#include <hip/hip_runtime.h>
#include <cstdio>
#include <cstdint>
#include <math.h>

#define GAS __attribute__((address_space(1)))
#define LAS __attribute__((address_space(3)))
typedef unsigned short bf16;
typedef unsigned v4u __attribute__((ext_vector_type(4)));
typedef unsigned v2u __attribute__((ext_vector_type(2)));
typedef float f32x4 __attribute__((ext_vector_type(4)));
typedef float f32x2 __attribute__((ext_vector_type(2)));
typedef float f32x16 __attribute__((ext_vector_type(16)));
typedef short bf16x8 __attribute__((ext_vector_type(8)));
typedef __bf16 bh8 __attribute__((ext_vector_type(8)));
typedef __bf16 bh2 __attribute__((ext_vector_type(2)));
typedef GAS unsigned gu32;
#define RLX_AGENT __ATOMIC_RELAXED, __HIP_MEMORY_SCOPE_AGENT
#define LDS_WAIT() asm volatile("s_waitcnt lgkmcnt(0)" ::: "memory")
#define SB_PIN __builtin_amdgcn_sched_barrier(0);
#define VM_WAIT() asm volatile("s_waitcnt vmcnt(0)" ::: "memory")

constexpr int DM = 1024, NP = 4096, NS = 2048, NT = 6144;
constexpr int UE = 3584, UO = 4096;
constexpr float EPS = 1e-6f;
constexpr int CE_QA = 0, CE_KVA = 256, CE_GA = 384, CE_QM = 896, CE_KM = 1408, CE_VM = 1920, CE_OM = 2432, CE_GM = 2944, CE_KPE = 3456;
constexpr int CO_XC = 0, CO_BC = 512, CO_CC = 1024, CO_GC = 1536, CO_QD = 2048, CO_KD = 2560, CO_VD = 3072, CO_GD = 3584;
constexpr size_t O_Y = 0, O_CKV = 6291456, O_KPE = 7340032, O_C = 7602176, O_N = 11796480, O_M = 11829248, O_NK = 11829504, O_NV = 16023808;
constexpr size_t MiB = 1u << 20;
constexpr size_t WS_CTL = 0, CTL_ZERO_BYTES = 65536;
constexpr size_t WS_ROPE = 65536;
constexpr size_t WS_MOD = 131072;
constexpr size_t WS_AG = 327680;
constexpr size_t WS_WTEV = 1 * MiB;
constexpr size_t WS_WTOD = 17 * MiB;
constexpr size_t WS_WTOUT = 33 * MiB;
constexpr size_t WS_WTQB = 41 * MiB;
constexpr size_t WS_WTKVB = 42 * MiB;
constexpr size_t WS_NAKC = 43 * MiB;
constexpr size_t WS_NAVC = 44 * MiB;
constexpr size_t WS_C0T = 45 * MiB;
constexpr size_t WS_H = 47 * MiB;
constexpr size_t WS_U = 59 * MiB;
constexpr size_t WS_Z = 107 * MiB;
constexpr size_t WS_GATES = 119 * MiB;
constexpr size_t WS_Q = 120 * MiB;
constexpr size_t WS_KM = 129 * MiB;
constexpr size_t WS_VTM = 139 * MiB;
constexpr size_t WS_VTO = 146 * MiB;
constexpr size_t WS_LT = 152 * MiB;
constexpr size_t WS_NL = 200 * MiB;
constexpr size_t WS_CTB = 201 * MiB;
constexpr size_t WS_NPV = 225 * MiB;
constexpr size_t WS_MPV = 226 * MiB;
constexpr size_t WS_KFO = 227 * MiB;
constexpr size_t WS_VFM = 234 * MiB;
constexpr size_t WS_GQ = 241 * MiB;
constexpr int KROWS = 6656;

__device__ __forceinline__ unsigned pk2(float lo, float hi) { f32x2 v = {lo, hi}; bh2 b = __builtin_convertvector(v, bh2); return __builtin_bit_cast(unsigned, b); }
__device__ __forceinline__ float bf2f(unsigned u16) { return __builtin_bit_cast(float, u16 << 16); }
__device__ __forceinline__ float bflo(unsigned u) { return __builtin_bit_cast(float, u << 16); }
__device__ __forceinline__ float bfhi(unsigned u) { return __builtin_bit_cast(float, u & 0xffff0000u); }
__device__ __forceinline__ float silu_f(float x) { return x / (1.f + __expf(-x)); }
__device__ __forceinline__ float sigmoid_f(float x) { return 1.f / (1.f + __expf(-x)); }
__device__ __forceinline__ float logsigmoid_f(float x) { return fminf(x, 0.f) - log1pf(expf(-fabsf(x))); }
__device__ __forceinline__ int cond_of_row(int r) { return r < NP ? 0 : 1 + ((r - NP) >> 10); }
__device__ __forceinline__ float wave_sum(float v) {
#pragma unroll
    for (int o = 1; o < 64; o <<= 1) v += __shfl_xor(v, o);
    return v;
}
__device__ __forceinline__ float wave_max(float v) {
#pragma unroll
    for (int o = 1; o < 64; o <<= 1) v = fmaxf(v, __shfl_xor(v, o));
    return v;
}
__device__ __forceinline__ f32x16 mfma32(bh8 a, bh8 b, f32x16 c) { return __builtin_amdgcn_mfma_f32_32x32x16_bf16(a, b, c, 0, 0, 0); }
__device__ __forceinline__ bh8 ld16(const bf16* p) { return *(const bh8*)p; }
__device__ __forceinline__ bh8 ld2x8(const bf16* p0, const bf16* p1) { v2u a = *(const v2u*)p0, b = *(const v2u*)p1; v4u v = {a.x, a.y, b.x, b.y}; return __builtin_bit_cast(bh8, v); }
__device__ __forceinline__ bh8 pfrag(const f32x16& p, int s) {
    v4u v; v.x = pk2(p[8 * s + 0], p[8 * s + 1]); v.y = pk2(p[8 * s + 2], p[8 * s + 3]); v.z = pk2(p[8 * s + 4], p[8 * s + 5]); v.w = pk2(p[8 * s + 6], p[8 * s + 7]);
    return __builtin_bit_cast(bh8, v);
}
__device__ __forceinline__ int crow(int i, int hh) { return (i & 3) + 8 * (i >> 2) + 4 * hh; }
__device__ __forceinline__ void st4bf(bf16* p, float a, float b, float c, float d) { v2u v; v.x = pk2(a, b); v.y = pk2(c, d); *(v2u*)p = v; }

namespace pg8 {
#define PG8_LAS __attribute__((address_space(3)))
typedef unsigned short bf16_t;
typedef short bf16x8 __attribute__((ext_vector_type(8)));
typedef float f32x4 __attribute__((ext_vector_type(4)));
typedef unsigned u32x4 __attribute__((ext_vector_type(4)));
constexpr int BM = 256, BK = 64, HALF = 128, HTB = HALF * BK * 2  , STAGE_BYTES = 8 * HTB, NXCD = 8, WGM = 8;

__host__ __device__ __forceinline__ int lds_byte(int r, int c) { const int st = (r >> 4) * 2 + (c >> 5), rr = r & 15, cc = c & 31, ob = rr * 64 + cc * 2; return st * 1024 + (ob ^ (((ob >> 9) & 1) << 5)); }
__host__ __device__ __forceinline__ void stage_rc(int b, int& R, int& C) { const int st = b / 1024, sb = b % 1024, swz = sb ^ (((sb >> 9) & 1) << 5); R = (st >> 1) * 16 + swz / 64; C = (st & 1) * 32 + (swz % 64) / 2; }
__host__ __device__ __forceinline__ int perm32(int rho) { const int n = rho >> 4, i = rho & 15; return 8 * (i >> 2) + 4 * n + (i & 3); }

struct Unit { int pm, pn; };
struct Gemm { const bf16_t* A; const bf16_t* Bt; int M, N, K; };

struct StaticOrder {
    int nM, nN, nwg, G, c;
    __host__ __device__ void init(int M, int N, int G_, int c_, int bma) { nM = M / bma; nN = N / BM; nwg = nM * nN; G = G_; c = c_; }
    __host__ __device__ bool next(int i, Unit& u) const {
        const long L = (long)i * G + c; if (L >= nwg) return false;
        int wgid = (int)L; { const int q = nwg / NXCD, r = nwg % NXCD, xcd = wgid % NXCD, off = wgid / NXCD; wgid = (xcd < r ? xcd * (q + 1) : r * (q + 1) + (xcd - r) * q) + off; }
        const int nig = WGM * nN, gid = wgid / nig, fm = gid * WGM, gsz = (nM - fm) < WGM ? (nM - fm) : WGM;
        u.pm = fm + ((wgid % nig) % gsz); u.pn = (wgid % nig) / gsz; return true;
    }
    __device__ __forceinline__ void a_ready(const Unit&) const {}
    __device__ __forceinline__ void done(const Unit&) const {}
};

__device__ __forceinline__ int pg8_opaque(int x) { asm volatile("" : "+v"(x)); return x; }
__device__ __forceinline__ unsigned cvt_pk_bf16(float lo, float hi) { unsigned r; asm volatile("v_cvt_pk_bf16_f32 %0, %1, %2" : "=v"(r) : "v"(lo), "v"(hi)); return r; }

struct EpiU {
    static constexpr bool PERM = true, AFTER_DRAIN = false; static constexpr int BMA_ROWS = 192, BMA = BMA_ROWS, HA = BMA / 2, MA = HA / 32, WRA = HA / 2;
    bf16_t* U; int ldu; float* gates; bf16_t* vto; bf16_t* kfo; bf16_t* vfm;
    __device__ __forceinline__ void operator()(const f32x4 (&acc)[2][2][4][2], const Unit& u, int wr, int wc, int fr, int fq) const {
        const int row0 = u.pm * BMA + wr * WRA + fr, col0 = u.pn * BM + wc * 32 + 8 * fq;
        const bool dog = gates != nullptr && u.pn == 13 && wc == 1 && fq < 2;
        const bool dov = vto != nullptr && (u.pn == 12 || u.pn == 13);
        const bool dok = kfo != nullptr && (u.pn == 10 || u.pn == 11);
        const bool dom = vfm != nullptr && u.pn >= 7 && u.pn <= 9;
#pragma unroll
        for (int ai = 0; ai < 2; ++ai)
#pragma unroll
            for (int m = 0; m < MA; ++m) {
                const int row = row0 + ai * HA + m * 16;
#pragma unroll
                for (int bj = 0; bj < 2; ++bj) {
                    const f32x4 v0 = acc[ai][bj][m][0], v1 = acc[ai][bj][m][1];
                    const int col = col0 + bj * HALF;
                    u32x4 w; w.x = cvt_pk_bf16(v0[0], v0[1]); w.y = cvt_pk_bf16(v0[2], v0[3]); w.z = cvt_pk_bf16(v1[0], v1[1]); w.w = cvt_pk_bf16(v1[2], v1[3]);
                    *(u32x4*)(U + (size_t)row * ldu + col) = w;
                    if (bj == 1 && dog) { float* g = gates + (size_t)row * 16 + 8 * fq; *(f32x4*)g = v0; *(f32x4*)(g + 4) = v1; }
                    if (dom && col >= 1920 && col < 2432) { const int cc = col - 1920, hd = cc >> 7, ev = cc & 127, t16 = row & 15;
                        bf16_t* vp = vfm + ((size_t)((row >> 5) * 4 + hd) * 8 + (ev >> 5) * 2 + ((row >> 4) & 1)) * 512 + (((t16 >> 2) & 1) * 32 + (ev & 31)) * 8 + 4 * (t16 >> 3) + (t16 & 3);
                        vp[0] = (bf16_t)(w.x & 0xffffu); vp[8] = (bf16_t)(w.x >> 16); vp[16] = (bf16_t)(w.y & 0xffffu); vp[24] = (bf16_t)(w.y >> 16);
                        vp[32] = (bf16_t)(w.z & 0xffffu); vp[40] = (bf16_t)(w.z >> 16); vp[48] = (bf16_t)(w.w & 0xffffu); vp[56] = (bf16_t)(w.w >> 16);
                    }
                    if (dok) { const int cc = col - 2560, hd = cc >> 6, d = cc & 63;
                        *(u32x4*)(kfo + ((size_t)((row >> 5) * 8 + hd) * 4 + (d >> 4)) * 512 + (((d >> 3) & 1) * 32 + (row & 31)) * 8) = w; }
                    if (dov) { const int cc = col - 3072, hd = cc >> 6, dv = cc & 63, t16 = row & 15;
                        bf16_t* vp = vto + ((size_t)((row >> 5) * 8 + hd) * 4 + (dv >> 5) * 2 + ((row >> 4) & 1)) * 512 + (((t16 >> 2) & 1) * 32 + (dv & 31)) * 8 + 4 * (t16 >> 3) + (t16 & 3);
                        vp[0] = (bf16_t)(w.x & 0xffffu); vp[8] = (bf16_t)(w.x >> 16); vp[16] = (bf16_t)(w.y & 0xffffu); vp[24] = (bf16_t)(w.y >> 16);
                        vp[32] = (bf16_t)(w.z & 0xffffu); vp[40] = (bf16_t)(w.z >> 16); vp[48] = (bf16_t)(w.w & 0xffffu); vp[56] = (bf16_t)(w.w >> 16);
                    }
                }
            }
    }
};

struct EpiY {
    static constexpr bool PERM = true, AFTER_DRAIN = false; static constexpr int BMA_ROWS = 128, BMA = BMA_ROWS, HA = BMA / 2, MA = HA / 32, WRA = HA / 2;
    float* Y; const float* ysp; const float* yss; const float* mod_l;
    __device__ __forceinline__ void operator()(const f32x4 (&acc)[2][2][4][2], const Unit& u, int wr, int wc, int fr, int fq) const {
        const int row0 = u.pm * BMA + wr * WRA + fr, col0 = u.pn * BM + wc * 32 + 8 * fq;
#pragma unroll
        for (int bj = 0; bj < 2; ++bj) {
            const int col = col0 + bj * HALF;
#pragma unroll
            for (int ai = 0; ai < 2; ++ai)
#pragma unroll
                for (int m = 0; m < MA; ++m) {
                    const int row = row0 + ai * HA + m * 16;
                    const float* gp = mod_l + (row < 4096 ? 0 : (row < 5120 ? 1 : 2)) * 3072 + 2048 + col;
                    const f32x4 g0 = *(const f32x4*)gp, g1 = *(const f32x4*)(gp + 4);
                    const float* src = (row < 4096 ? ysp + (size_t)row * 1024 : yss + (size_t)(row - 4096) * 1024) + col;
                    const f32x4 y0 = *(const f32x4*)src, y1 = *(const f32x4*)(src + 4);
                    float* dst = Y + (size_t)row * 1024 + col;
                    *(f32x4*)dst = y0 + g0 * acc[ai][bj][m][0];
                    *(f32x4*)(dst + 4) = y1 + g1 * acc[ai][bj][m][1];
                }
        }
    }
};

template <class Epi, class Sched, bool ALIGN_EPI = false, bool SP2 = false>
__device__ __forceinline__ void gemm_phase(PG8_LAS unsigned char* lds, const Gemm g, const Sched& S, const Epi& E) {
    constexpr int BMA = Epi::BMA_ROWS, HA = BMA / 2, MA = HA / 32, WRA = HA / 2;
    const int tid = pg8_opaque((int)threadIdx.x), wid = __builtin_amdgcn_readfirstlane(tid >> 6), lane = tid & 63, wr = wid >> 2, wc = wid & 3, fr = lane & 15, fq = lane >> 4;
    const int K = g.K, nt = K / BK;
    unsigned voffA[2], voffB[2];
#pragma unroll
    for (int i = 0; i < 2; ++i) { int R, C; stage_rc(tid * 16 + i * 8192, R, C); const int Rb = Epi::PERM ? ((R & ~31) + perm32(R & 31)) : R;
        voffA[i] = (unsigned)(R * K + C) * 2u; voffB[i] = (unsigned)(Rb * K + C) * 2u; }
    const size_t kstep = (size_t)(BK * 2);
    const size_t hstep = (size_t)HALF * K * 2;
    const size_t tstep = 2 * hstep;
    const size_t hstepA = (size_t)HA * K * 2, tstepA = 2 * hstepA;
    const unsigned ldsw = (unsigned)wid * 1024u;
    const int aoff = lds_byte(wr * WRA + fr, fq * 8), boff = lds_byte(wc * 32 + fr, fq * 8);
#define PG8_SA(b, h) (((b) * 2 + (h)) * HTB)
#define PG8_SB(b, h) ((4 + (b) * 2 + (h)) * HTB)
#define PG8_STAGE(bufoff, gbase, voff) do { _Pragma("unroll") for (int _i = 0; _i < 2; ++_i) \
        __builtin_amdgcn_global_load_lds((const unsigned*)((const char*)(gbase) + (voff)[_i]), (PG8_LAS unsigned*)(lds + (bufoff) + ldsw + _i * 8192), 16, 0, 0); } while (0)
#define PG8_LDA(dst, b, h) do { _Pragma("unroll") for (int m = 0; m < MA; ++m) _Pragma("unroll") for (int k = 0; k < 2; ++k) dst[m][k] = *(const PG8_LAS bf16x8*)(lds + PG8_SA(b, h) + aoff + m * 2048 + k * 1024); } while (0)
#define PG8_LDB(dst, b, h) do { _Pragma("unroll") for (int n = 0; n < 2; ++n) _Pragma("unroll") for (int k = 0; k < 2; ++k) dst[n][k] = *(const PG8_LAS bf16x8*)(lds + PG8_SB(b, h) + boff + n * 2048 + k * 1024); } while (0)
#define PG8_MMA(ai, bj, At, Bt) do { __builtin_amdgcn_s_setprio(1); _Pragma("unroll") for (int m = 0; m < MA; ++m) _Pragma("unroll") for (int n = 0; n < 2; ++n) _Pragma("unroll") for (int k = 0; k < 2; ++k) \
        acc[ai][bj][m][n] = __builtin_amdgcn_mfma_f32_16x16x32_bf16(Bt[n][k], At[m][k], acc[ai][bj][m][n], 0, 0, 0); __builtin_amdgcn_s_setprio(0); } while (0)
#define PG8_WAIT_V(n) asm volatile("s_waitcnt vmcnt(" #n ")" ::: "memory")
#define PG8_WAIT_L(n) asm volatile("s_waitcnt lgkmcnt(" #n ")" ::: "memory")
#define PG8_BAR __builtin_amdgcn_s_barrier()
#define PG8_SCHED __builtin_amdgcn_sched_barrier(0)
    Unit cur, nxt; int ui = 0;
    if (!S.next(0, cur)) return;
    f32x4 acc[2][2][4][2];
#pragma unroll
    for (int a = 0; a < 2; ++a)
#pragma unroll
        for (int b = 0; b < 2; ++b)
#pragma unroll
            for (int m = 0; m < MA; ++m)
#pragma unroll
                for (int n = 0; n < 2; ++n) acc[a][b][m][n] = (f32x4){0.f, 0.f, 0.f, 0.f};
    bf16x8 At[4][2], B0[2][2], B1[2][2];
    const char* cA = (const char*)g.A + (size_t)cur.pm * tstepA; const char* cB = (const char*)g.Bt + (size_t)cur.pn * tstep;
    S.a_ready(cur);
    if constexpr (SP2) {
        PG8_STAGE(PG8_SB(0, 0), cB, voffB); PG8_STAGE(PG8_SB(0, 1), cB + hstep, voffB); PG8_STAGE(PG8_SA(0, 0), cA, voffA); PG8_STAGE(PG8_SA(0, 1), cA + hstepA, voffA);
        if (wr == 1) PG8_BAR;
        PG8_WAIT_V(2); PG8_BAR;
        PG8_STAGE(PG8_SB(1, 0), cB + kstep, voffB); PG8_STAGE(PG8_SA(1, 0), cA + kstep, voffA); PG8_STAGE(PG8_SB(1, 1), cB + hstep + kstep, voffB);
        PG8_WAIT_V(6); PG8_BAR;
    } else {
        PG8_STAGE(PG8_SB(0, 0), cB, voffB); PG8_STAGE(PG8_SA(0, 0), cA, voffA); PG8_STAGE(PG8_SB(0, 1), cB + hstep, voffB); PG8_STAGE(PG8_SA(0, 1), cA + hstepA, voffA);
        if (wr == 1) PG8_BAR;
        PG8_WAIT_V(4); PG8_BAR;
        PG8_STAGE(PG8_SB(1, 0), cB + kstep, voffB); PG8_STAGE(PG8_SA(1, 0), cA + kstep, voffA); PG8_STAGE(PG8_SB(1, 1), cB + hstep + kstep, voffB);
        PG8_WAIT_V(6); PG8_BAR;
    }
    for (;;) {
        const bool has_next = S.next(ui + 1, nxt);
        const char* nA = has_next ? (const char*)g.A + (size_t)nxt.pm * tstepA : cA; const char* nB = has_next ? (const char*)g.Bt + (size_t)nxt.pn * tstep : cB;
        for (int t = 0; t < nt; t += 2) {
            const bool last = (t == nt - 2);
            const char* a1 = cA + (size_t)(t + 1) * kstep;
            const char* a2 = last ? nA : cA + (size_t)(t + 2) * kstep; const char* b2 = last ? nB : cB + (size_t)(t + 2) * kstep;
            const char* a3 = a2 + kstep; const char* b3 = b2 + kstep;
            if (last && has_next) S.a_ready(nxt);
            if constexpr (SP2) {
            PG8_LDB(B0, 0, 0); PG8_LDB(B1, 0, 1); PG8_SCHED; PG8_LDA(At, 0, 0); PG8_STAGE(PG8_SA(1, 1), a1 + hstepA, voffA);
            PG8_WAIT_V(8); PG8_WAIT_L(0); PG8_BAR; PG8_MMA(0, 0, At, B0); PG8_MMA(0, 1, At, B1); PG8_BAR; PG8_SCHED;
            PG8_LDA(At, 0, 1); PG8_STAGE(PG8_SB(0, 0), b2, voffB); PG8_STAGE(PG8_SB(0, 1), b2 + hstep, voffB); PG8_STAGE(PG8_SA(0, 0), a2, voffA);
            PG8_WAIT_V(8); PG8_WAIT_L(0); PG8_BAR; PG8_MMA(1, 0, At, B0); PG8_MMA(1, 1, At, B1); PG8_BAR; PG8_SCHED;
            PG8_LDB(B0, 1, 0); PG8_LDB(B1, 1, 1); PG8_SCHED; PG8_LDA(At, 1, 0); PG8_STAGE(PG8_SA(0, 1), a2 + hstepA, voffA);
            PG8_WAIT_V(8); PG8_WAIT_L(0); PG8_BAR; PG8_MMA(0, 0, At, B0); PG8_MMA(0, 1, At, B1); PG8_BAR; PG8_SCHED;
            PG8_LDA(At, 1, 1); PG8_STAGE(PG8_SB(1, 0), b3, voffB); PG8_STAGE(PG8_SB(1, 1), b3 + hstep, voffB); PG8_STAGE(PG8_SA(1, 0), a3, voffA);
            PG8_WAIT_V(8); PG8_WAIT_L(0); PG8_BAR; PG8_MMA(1, 0, At, B0); PG8_MMA(1, 1, At, B1); PG8_BAR; PG8_SCHED;
            } else {
            PG8_LDB(B0, 0, 0); PG8_SCHED; PG8_LDA(At, 0, 0); PG8_STAGE(PG8_SA(1, 1), a1 + hstepA, voffA);
            PG8_WAIT_L(8); PG8_BAR; PG8_WAIT_L(0); PG8_MMA(0, 0, At, B0); PG8_BAR; PG8_SCHED;
            PG8_LDB(B1, 0, 1); PG8_STAGE(PG8_SB(0, 0), b2, voffB);
            PG8_BAR; PG8_WAIT_L(0); PG8_MMA(0, 1, At, B1); PG8_BAR;
            PG8_LDA(At, 0, 1); PG8_STAGE(PG8_SA(0, 0), a2, voffA);
            PG8_BAR; PG8_WAIT_L(0); PG8_MMA(1, 0, At, B0); PG8_BAR; PG8_SCHED;
            PG8_STAGE(PG8_SB(0, 1), b2 + hstep, voffB);
            PG8_WAIT_V(6); PG8_BAR; PG8_MMA(1, 1, At, B1); PG8_BAR;
            PG8_LDB(B0, 1, 0); PG8_SCHED; PG8_LDA(At, 1, 0); PG8_STAGE(PG8_SA(0, 1), a2 + hstepA, voffA);
            PG8_WAIT_L(8); PG8_BAR; PG8_WAIT_L(0); PG8_MMA(0, 0, At, B0); PG8_BAR; PG8_SCHED;
            PG8_LDB(B1, 1, 1); PG8_STAGE(PG8_SB(1, 0), b3, voffB);
            PG8_BAR; PG8_WAIT_L(0); PG8_MMA(0, 1, At, B1); PG8_BAR;
            PG8_LDA(At, 1, 1); PG8_STAGE(PG8_SA(1, 0), a3, voffA);
            PG8_BAR; PG8_WAIT_L(0); PG8_MMA(1, 0, At, B0); PG8_BAR; PG8_SCHED;
            PG8_STAGE(PG8_SB(1, 1), b3 + hstep, voffB);
            PG8_WAIT_V(6); PG8_BAR; PG8_MMA(1, 1, At, B1); PG8_BAR;
            }
        }
        if constexpr (ALIGN_EPI) { if (wr == 0) PG8_BAR; }
        if constexpr (!Epi::AFTER_DRAIN) { E(acc, cur, wr, wc, fr, fq); S.done(cur); }
        if (!has_next) break;
#pragma unroll
        for (int a = 0; a < 2; ++a)
#pragma unroll
            for (int b = 0; b < 2; ++b)
#pragma unroll
                for (int m = 0; m < MA; ++m)
#pragma unroll
                    for (int n = 0; n < 2; ++n) acc[a][b][m][n] = (f32x4){0.f, 0.f, 0.f, 0.f};
        cur = nxt; cA = nA; cB = nB; ++ui;
        if constexpr (ALIGN_EPI) { if (wr == 1) PG8_BAR; }
    }
    PG8_WAIT_V(0);
    if constexpr (!ALIGN_EPI) { if (wr == 0) PG8_BAR; }
    PG8_BAR;
    if constexpr (Epi::AFTER_DRAIN) { E.fused(acc, cur, wr, wc, fr, fq, lds, wid, lane); S.done(cur); }
#undef PG8_SA
#undef PG8_SB
#undef PG8_STAGE
#undef PG8_LDA
#undef PG8_LDB
#undef PG8_MMA
#undef PG8_WAIT_V
#undef PG8_WAIT_L
#undef PG8_BAR
#undef PG8_SCHED
}
}
#define XB_TMO      128
#define XB_XCNT(j)  (256  + 64 * (j))
#define XB_XSUB(j)  (1280 + 64 * (j))
#define XB_XGEN(j)  (2304 + 64 * (j))
#define XB_TOP      3328
#define XB_TOPGEN   3392
#define XCD_BAR_WORDS 3456
#define XB_SPIN_CAP (1u << 18)

__device__ __forceinline__ unsigned xb_ld(unsigned* p)              { return __hip_atomic_load(p, __ATOMIC_RELAXED, __HIP_MEMORY_SCOPE_AGENT); }
__device__ __forceinline__ unsigned xb_add(unsigned* p, unsigned v) { return __hip_atomic_fetch_add(p, v, __ATOMIC_RELAXED, __HIP_MEMORY_SCOPE_AGENT); }
__device__ __forceinline__ unsigned xb_xcc_id() { return (unsigned)__builtin_amdgcn_s_getreg((3 << 11) | 20) & 0xFu; }
#define XB_SPIN(cond, bar) do { unsigned _sp = 0; while (cond) { __builtin_amdgcn_s_sleep(1); \
    if ((++_sp & 255u) == 0u) { if (xb_ld(&(bar)[XB_TMO])) break; if (_sp > XB_SPIN_CAP) { atomicAdd(&(bar)[XB_TMO], 1u); break; } } } } while (0)

struct XcdBarrier {
    unsigned* bar; unsigned x;
    volatile LAS unsigned* st;
};

__device__ __forceinline__ XcdBarrier xcd_barrier_post(unsigned* bar, volatile LAS unsigned* st) {
    XcdBarrier b; b.bar = bar; b.x = xb_xcc_id(); b.st = st;
    if (threadIdx.x == 0) (void)xb_add(&bar[XB_XCNT(b.x)], 1u);
    return b;
}
__device__ __forceinline__ void xcd_barrier_complete(unsigned* bar, unsigned x, unsigned& nloc, unsigned& nx) {
    const unsigned G = gridDim.x * gridDim.y * gridDim.z;
    unsigned sum, cnt, mine, sp = 0u;
    for (;;) {
        sum = 0u; cnt = 0u; mine = 0u;
#pragma unroll
        for (unsigned j = 0; j < 16; ++j) { const unsigned c = xb_ld(&bar[XB_XCNT(j)]); sum += c; cnt += (c > 0u) ? 1u : 0u; mine = (j == x) ? c : mine; }
        if (sum == G) break;
        __builtin_amdgcn_s_sleep(1);
        if ((++sp & 255u) == 0u) { if (xb_ld(&bar[XB_TMO])) break; if (sp > XB_SPIN_CAP) { atomicAdd(&bar[XB_TMO], 1u); break; } }
    }
    nloc = mine > 0u ? mine : 1u; nx = cnt > 0u ? cnt : 1u;
}

__device__ __forceinline__ void xcd_barrier(const XcdBarrier& b) {
    asm volatile("s_waitcnt vmcnt(0)" ::: "memory");
    __syncthreads();
    if (threadIdx.x == 0) {
        unsigned* bar = b.bar;
        __builtin_amdgcn_s_waitcnt(0);
        unsigned nloc = b.st[0], nx = b.st[1];
        if (nloc == 0u) { xcd_barrier_complete(bar, b.x, nloc, nx); b.st[0] = nloc; b.st[1] = nx; }
        const unsigned old = xb_add(&bar[XB_XSUB(b.x)], 1u);
        const unsigned gen = old / nloc;
        if (old + 1u == (gen + 1u) * nloc) {
            __builtin_amdgcn_fence(__ATOMIC_RELEASE, "agent");
            asm volatile("s_waitcnt vmcnt(0)" ::: "memory");
            const unsigned og = xb_add(&bar[XB_TOP], 1u);
            const unsigned tg = og / nx;
            if (og + 1u == (tg + 1u) * nx) xb_add(&bar[XB_TOPGEN], 1u);
            else XB_SPIN(xb_ld(&bar[XB_TOPGEN]) == tg, bar);
            __builtin_amdgcn_fence(__ATOMIC_ACQUIRE, "agent");
            xb_add(&bar[XB_XGEN(b.x)], 1u);
            asm volatile("s_waitcnt vmcnt(0)" ::: "memory");
        } else {
            XB_SPIN(xb_ld(&bar[XB_XGEN(b.x)]) == gen, bar);
            __builtin_amdgcn_fence(__ATOMIC_ACQUIRE, "agent");
            asm volatile("s_waitcnt vmcnt(0)" ::: "memory");
        }
    }
    __syncthreads();
}

constexpr int NWAVES = 8, NTHR = 512;
constexpr int LDS_BYTES = 147456;
constexpr int MISC_OFF = 147456 - 256;
constexpr int CW_BAR = 4096;

struct Args {
    const float* in[32];
    float* out;
    unsigned char* ws;
    int ph_lo, ph_hi;
};

struct Ctx {
    LAS unsigned char* lds;
    unsigned char* ldsg;
    int tid, lane, wave, G, bid;
};


#ifndef PROF_ID
#define PROF_ID 0
#endif
#ifndef PROF_K
#define PROF_K 8
#endif
#define PROF_BEGIN(id) unsigned long long pt0_##id = 0; if (PROF_ID == (id)) pt0_##id = __builtin_amdgcn_s_memrealtime();
#define PROF_END(id) if (PROF_ID == (id) && threadIdx.x == 0) { const unsigned dt_ = (unsigned)(__builtin_amdgcn_s_memrealtime() - pt0_##id); ((volatile LAS unsigned*)(X.lds + MISC_OFF))[16] += dt_; }

__device__ __forceinline__ int opaque_v(int x) { asm volatile("" : "+v"(x)); return x; }
__device__ __forceinline__ int opaque_s(int x) { asm volatile("" : "+s"(x)); return x; }
__device__ __forceinline__ int map_even(int dg) {
    if (dg < 24) return dg;
    if (dg < 152) return dg + 2;
    if (dg < 216) return dg + 3;
    if (dg < 218) return dg - 192;
    if (dg == 218) return 154;
    return -1;
}
__device__ __forceinline__ void transpose_item(const float* W, int ldn, int K, bf16* WT, int k0, int n0, int ca, int cb, LAS float* scr, int lane, bool frag = false) {
    const int n = lane & 31; const int sc = (n < 16) ? ca : cb;
    float tv[32];
#pragma unroll
    for (int i = 0; i < 32; ++i) { const int kk = 2 * i + (lane >> 5); tv[i] = sc >= 0 ? W[(size_t)(k0 + kk) * ldn + sc + (n & 15)] : 0.f; }
    SB_PIN
#pragma unroll
    for (int i = 0; i < 32; ++i) { const int kk = 2 * i + (lane >> 5); scr[kk * 33 + n] = tv[i]; }
    LDS_WAIT(); asm volatile("" ::: "memory");
    const int c = lane & 7;
#pragma unroll
    for (int j = 0; j < 4; ++j) { const int nn = (lane >> 3) + 8 * j; const LAS float* s = scr + (8 * c) * 33 + nn;
        v4u o; o.x = pk2(s[0 * 33], s[1 * 33]); o.y = pk2(s[2 * 33], s[3 * 33]); o.z = pk2(s[4 * 33], s[5 * 33]); o.w = pk2(s[6 * 33], s[7 * 33]);
        bf16* dst = frag ? WT + ((size_t)((n0 + nn) >> 5) * (K >> 4) + ((k0 + 8 * c) >> 4)) * 512 + ((((k0 + 8 * c) >> 3) & 1) * 32 + ((n0 + nn) & 31)) * 8 : WT + (size_t)(n0 + nn) * K + k0 + 8 * c;
        *(v4u*)dst = o; }
    LDS_WAIT(); asm volatile("" ::: "memory");
}

__device__ __forceinline__ void mod_unit(const Args& a, const Ctx& X, int l, int chunk, int tid, int lane, int wave) {
    LAS float* scs = (LAS float*)X.lds;
    LAS float* part = scs + 3072;
    const float* c_ctx = a.in[10]; const float* c = a.in[2];
    for (int i = tid; i < 3072; i += NTHR) { const int r = i >> 10, k = i & 1023; const float v = r == 0 ? c_ctx[k] : c[(r - 1) * 1024 + k]; scs[i] = v / (1.f + expf(-v)); }
    __syncthreads();
    const int j0 = chunk * 64;
    const float* w = a.in[12] + (size_t)l * 1024 * 3072 + j0 + lane;
    float a0 = 0.f, a1 = 0.f, a2 = 0.f;
#pragma unroll 32
    for (int kk = 0; kk < 128; ++kk) { const int k = wave * 128 + kk; const float wv = w[(size_t)k * 3072]; a0 += scs[k] * wv; a1 += scs[1024 + k] * wv; a2 += scs[2048 + k] * wv; }
    part[(wave * 3 + 0) * 64 + lane] = a0; part[(wave * 3 + 1) * 64 + lane] = a1; part[(wave * 3 + 2) * 64 + lane] = a2;
    __syncthreads();
    if (tid < 192) { const int r = tid >> 6, cc = tid & 63; float s = 0.f;
#pragma unroll
        for (int w8 = 0; w8 < 8; ++w8) s += part[(w8 * 3 + r) * 64 + cc];
        ((float*)(a.ws + WS_MOD))[(l * 3 + r) * 3072 + j0 + cc] = s + a.in[13][l * 3072 + j0 + cc]; }
    __syncthreads();
}
__device__ __forceinline__ void prep_weights(const Args& a, const Ctx& X, int l, int gw, int NGW, int lane, int wave) {
    unsigned char* ws = a.ws;
    LAS float* scr = (LAS float*)(X.lds + 32768 + wave * 8448);
    const int j = l >> 1;
    if ((l & 1) == 0) {
        for (int it = gw; it < 2464; it += NGW) {
            if (it < 1792) { const int nb = it % 112, kb = it / 112;
                transpose_item(a.in[14] + (size_t)j * 1024 * 3504, 3504, 1024, (bf16*)(ws + WS_WTEV) + (size_t)j * 3584 * 1024, kb * 64, nb * 32,
                               map_even(2 * nb) < 0 ? -1 : map_even(2 * nb) * 16, map_even(2 * nb + 1) < 0 ? -1 : map_even(2 * nb + 1) * 16, scr, lane);
            } else if (it < 2304) { const int r = it - 1792, nb = r % 32, kb = r / 32;
                transpose_item(a.in[24] + (size_t)j * 1024 * 1024, 1024, 1024, (bf16*)(ws + WS_WTOUT) + (size_t)l * 1024 * 1024, kb * 64, nb * 32, nb * 32, nb * 32 + 16, scr, lane);
            } else if (it < 2400) { const int r = it - 2304, nb = r % 24, kb = r / 24;
                transpose_item(a.in[17] + (size_t)j * 256 * 768, 768, 256, (bf16*)(ws + WS_WTQB) + (size_t)j * 768 * 256, kb * 64, nb * 32, nb * 32, nb * 32 + 16, scr, lane, true);
            } else { const int r = it - 2400, nb = r % 32, kb = r / 32;
                transpose_item(a.in[18] + (size_t)j * 128 * 1024, 1024, 128, (bf16*)(ws + WS_WTKVB) + (size_t)j * 1024 * 128, kb * 64, nb * 32, nb * 32, nb * 32 + 16, scr, lane, true);
            }
        }
    } else {
        for (int it = gw; it < 2560; it += NGW) {
            if (it < 2048) { const int nb = it % 128, kb = it / 128;
                transpose_item(a.in[25] + (size_t)j * 1024 * 4096, 4096, 1024, (bf16*)(ws + WS_WTOD) + (size_t)j * 4096 * 1024, kb * 64, nb * 32, nb * 32, nb * 32 + 16, scr, lane);
            } else { const int r = it - 2048, nb = r % 32, kb = r / 32;
                transpose_item(a.in[31] + (size_t)j * 1024 * 1024, 1024, 1024, (bf16*)(ws + WS_WTOUT) + (size_t)l * 1024 * 1024, kb * 64, nb * 32, nb * 32, nb * 32 + 16, scr, lane);
            }
        }
    }
}
__device__ __forceinline__ void phase_p0a(const Args& a, const Ctx& X) {
    unsigned char* ws = a.ws;
    const int tid = opaque_v(X.tid), lane = tid & 63, wave = opaque_s(X.wave);
    if (X.bid < 192) mod_unit(a, X, X.bid / 48, X.bid % 48, tid, lane, wave);
    else if (X.bid == 192) {
        const int pos = tid >> 3, f = tid & 7;
        const float ang = (float)pos * powf(10000.f, -(float)f / 8.f);
        float* rt = (float*)(ws + WS_ROPE);
        rt[pos * 16 + f] = cosf(ang); rt[pos * 16 + 8 + f] = sinf(ang);
    } else {
        const int nb = X.G - 193, b0 = X.bid - 193;
        const float* ck = a.in[8]; const float* cv = a.in[9]; const float* c0 = a.in[5];
        bf16* nakc = (bf16*)(ws + WS_NAKC); bf16* navc = (bf16*)(ws + WS_NAVC); float* c0t = (float*)(ws + WS_C0T);
#pragma unroll 4
        for (int idx = b0 * NTHR + tid; idx < 524288; idx += nb * NTHR) {
            const int d = idx & 63, h = (idx >> 6) & 7, key = (idx >> 9) & 255, bj = idx >> 17;
            { const size_t blk = ((size_t)(bj * 8 + h) * 8 + (key >> 5)) * 4; const int kr = key & 31, t16 = key & 15;
              nakc[(blk + (d >> 4)) * 512 + (((d >> 3) & 1) * 32 + kr) * 8 + (d & 7)] = (bf16)(pk2(ck[idx] / a.in[29][(bj & 1) * 64 + d], 0.f) & 0xffffu);
              navc[(blk + (d >> 5) * 2 + (kr >> 4)) * 512 + (((t16 >> 2) & 1) * 32 + (d & 31)) * 8 + 4 * (t16 >> 3) + (t16 & 3)] = (bf16)(pk2(cv[idx], 0.f) & 0xffffu); }
            const int e = idx & 127, dd = (idx >> 7) & 127, mat = idx >> 14;
            c0t[(size_t)mat * 16384 + e * 128 + dd] = c0[idx];
        }
    }
    for (int l = 0; l < 4; ++l) prep_weights(a, X, l, X.bid * NWAVES + wave, X.G * NWAVES, lane, wave);
}
__device__ __forceinline__ void gemm2_side(const Args& a, const Ctx& X, int l) {
    const int tid = opaque_v(X.tid), lane = tid & 63, wave = opaque_s(X.wave), idx = X.bid - 96;
    if (idx < 48) mod_unit(a, X, l + 1, idx, tid, lane, wave);
    prep_weights(a, X, l + 1, idx * NWAVES + wave, (X.G - 96) * NWAVES, lane, wave);
}

__device__ __forceinline__ void phase_norm(const Args& a, const Ctx& X, int l) {
    const float* ysp = l == 0 ? a.in[0] : a.out; const float* yss = l == 0 ? a.in[1] : a.out + (size_t)NP * DM;
    const float* nw = a.in[11] + l * DM;
    const float* modl = (const float*)(a.ws + WS_MOD) + l * 3 * 3072;
    bf16* H = (bf16*)(a.ws + WS_H);
    const int lane = opaque_v(X.tid) & 63; const int gw = X.bid * NWAVES + opaque_s(X.wave), NGW = X.G * NWAVES;
    f32x4 v[3][4];
#pragma unroll
    for (int q = 0; q < 3; ++q) { const int r = gw + q * NGW; const float* y = r < NP ? ysp + (size_t)r * DM : yss + (size_t)(r - NP) * DM;
#pragma unroll
        for (int j = 0; j < 4; ++j) v[q][j] = r < NT ? *(const f32x4*)(y + 4 * lane + 256 * j) : (f32x4){0.f, 0.f, 0.f, 0.f}; }
    SB_PIN
#pragma unroll
    for (int q = 0; q < 3; ++q) { const int r = gw + q * NGW; if (r < NT) {
        const float* md = modl + cond_of_row(r) * 3072;
        float ss = 0.f;
#pragma unroll
        for (int j = 0; j < 4; ++j) ss += (v[q][j].x * v[q][j].x + v[q][j].y * v[q][j].y) + (v[q][j].z * v[q][j].z + v[q][j].w * v[q][j].w);
        const float rstd = rsqrtf(wave_sum(ss) * (1.f / DM) + EPS);
#pragma unroll
        for (int j = 0; j < 4; ++j) { const int k = 4 * lane + 256 * j;
            const f32x4 g = *(const f32x4*)(nw + k), sh = *(const f32x4*)(md + k), sc = *(const f32x4*)(md + 1024 + k);
            const f32x4 o = v[q][j] * rstd * g * (sc + 1.f) + sh;
            st4bf(H + (size_t)r * DM + k, o.x, o.y, o.z, o.w); }
    } }
}

__device__ __forceinline__ void unit_mla_q(const Args& a, const Ctx& X, int j, int t) {
    const bf16* U = (const bf16*)(a.ws + WS_U); bf16* Q = (bf16*)(a.ws + WS_Q);
    const bf16* Wq = (const bf16*)(a.ws + WS_WTQB) + (size_t)j * 768 * 256;
    const float* rope = (const float*)(a.ws + WS_ROPE);
    const float* qan = a.in[15] + j * 256; const float* qn = a.in[19] + j * 96;
    bf16* Xn = (bf16*)X.ldsg;
    const int tid = opaque_v(X.tid), lane = tid & 63, w = opaque_s(X.wave), r = lane & 31, hh = lane >> 5, R0 = t * 64; (void)tid;
    PROF_BEGIN(20)
    { v2u raw8[8]; const f32x4 g = *(const f32x4*)(qan + 4 * lane);
#pragma unroll
      for (int i = 0; i < 8; ++i) raw8[i] = *(const v2u*)(U + (size_t)(R0 + 8 * w + i) * UE + CE_QA + 4 * lane);
      SB_PIN
#pragma unroll
      for (int i = 0; i < 8; ++i) { const int row = 8 * w + i; const v2u raw = raw8[i];
        const float x0 = bflo(raw.x), x1 = bfhi(raw.x), x2 = bflo(raw.y), x3 = bfhi(raw.y);
        const float rstd = rsqrtf(wave_sum(x0 * x0 + x1 * x1 + x2 * x2 + x3 * x3) * (1.f / 256.f) + EPS);
        st4bf(Xn + row * 264 + 4 * lane, x0 * rstd * g.x, x1 * rstd * g.y, x2 * rstd * g.z, x3 * rstd * g.w); } }
    __syncthreads();
    PROF_END(20)
    PROF_BEGIN(21)
    f32x16 acc[3][2];
#pragma unroll
    for (int fb = 0; fb < 3; ++fb)
#pragma unroll
        for (int tb = 0; tb < 2; ++tb)
#pragma unroll
            for (int i = 0; i < 16; ++i) acc[fb][tb][i] = 0.f;
    const bf16* wp = Wq + (size_t)(w * 3) * 16 * 512 + lane * 8;
    const bf16* xp = Xn + r * 264 + 8 * hh;
#pragma unroll
    for (int kh = 0; kh < 4; ++kh) {
        bh8 af[4][3];
#pragma unroll
        for (int k8 = 0; k8 < 4; ++k8)
#pragma unroll
            for (int fb = 0; fb < 3; ++fb) af[k8][fb] = ld16(wp + (size_t)(fb * 16 + kh * 4 + k8) * 512);
        SB_PIN
#pragma unroll
        for (int k8 = 0; k8 < 4; ++k8) { const int ks = kh * 4 + k8; bh8 bfr[2];
#pragma unroll
            for (int tb = 0; tb < 2; ++tb) bfr[tb] = ld16(xp + tb * 32 * 264 + 16 * ks);
#pragma unroll
            for (int fb = 0; fb < 3; ++fb)
#pragma unroll
                for (int tb = 0; tb < 2; ++tb) acc[fb][tb] = mfma32(af[k8][fb], bfr[tb], acc[fb][tb]); }
        SB_PIN
    }
    PROF_END(21)
    PROF_BEGIN(22)
#pragma unroll
    for (int tb = 0; tb < 2; ++tb) {
        float ss = 0.f;
#pragma unroll
        for (int fb = 0; fb < 3; ++fb)
#pragma unroll
            for (int i = 0; i < 16; ++i) ss += acc[fb][tb][i] * acc[fb][tb][i];
        ss += __shfl_xor(ss, 32);
        const float rstd = rsqrtf(ss * (1.f / 96.f) + EPS) * (0.10206207261596577f * 1.4426950408889634f);
        const int row = R0 + 32 * tb + r;
        const bool sample = row >= NP; const int tp = (row - NP) & 1023;
#pragma unroll
        for (int fb = 0; fb < 3; ++fb) {
            float v[16];
#pragma unroll
            for (int g = 0; g < 4; ++g) { const f32x4 gn = *(const f32x4*)(qn + 32 * fb + 8 * g + 4 * hh);
                v[4 * g + 0] = acc[fb][tb][4 * g + 0] * rstd * gn.x; v[4 * g + 1] = acc[fb][tb][4 * g + 1] * rstd * gn.y;
                v[4 * g + 2] = acc[fb][tb][4 * g + 2] * rstd * gn.z; v[4 * g + 3] = acc[fb][tb][4 * g + 3] * rstd * gn.w; }
            if (fb == 2 && sample) {
                const float* rr_ = rope + (tp >> 6) * 16 + 4 * hh; const float* rc_ = rope + (tp & 63) * 16 + 4 * hh;
#pragma unroll
                for (int e = 0; e < 4; ++e) {
                    float cs = rr_[e], sn = rr_[8 + e], x1 = v[e], x2 = v[4 + e];
                    v[e] = x1 * cs - x2 * sn; v[4 + e] = x1 * sn + x2 * cs;
                    cs = rc_[e]; sn = rc_[8 + e]; x1 = v[8 + e]; x2 = v[12 + e];
                    v[8 + e] = x1 * cs - x2 * sn; v[12 + e] = x1 * sn + x2 * cs;
                }
            }
#pragma unroll
            for (int g = 0; g < 4; ++g) st4bf(Q + (size_t)row * 768 + w * 96 + 32 * fb + 8 * g + 4 * hh, v[4 * g], v[4 * g + 1], v[4 * g + 2], v[4 * g + 3]);
        }
    }
    __syncthreads();    PROF_END(22)
}

__device__ __forceinline__ void unit_mla_kv(const Args& a, const Ctx& X, int j, int t) {
    const bf16* U = (const bf16*)(a.ws + WS_U); bf16* KM = (bf16*)(a.ws + WS_KM); bf16* VTM = (bf16*)(a.ws + WS_VTM);
    const bf16* Wkv = (const bf16*)(a.ws + WS_WTKVB) + (size_t)j * 1024 * 128;
    const float* rope = (const float*)(a.ws + WS_ROPE);
    const float* kvan = a.in[16] + j * 128; const float* kn = a.in[20] + j * 96;
    bf16* Xc = (bf16*)X.ldsg;
    float* kpes = (float*)(X.ldsg + 17408);
    const int tid = opaque_v(X.tid), lane = tid & 63, w = opaque_s(X.wave), r = lane & 31, hh = lane >> 5; (void)tid;
    const bool own = t >= 0;
    int R0 = 0, krow0, bs = 0;
    if (own) { R0 = t * 64; if (R0 < NP) krow0 = R0; else { bs = (R0 - NP) >> 10; krow0 = NP + bs * 1280 + 256 + ((R0 - NP) & 1023); } }
    else { const int ct = -1 - t; bs = ct >> 2; krow0 = NP + bs * 1280 + (ct & 3) * 64; }
    { unsigned raw8[8]; float kp8[8]; f32x2 c8[8];
      if (own) {
#pragma unroll
          for (int i = 0; i < 8; ++i) { raw8[i] = *(const unsigned*)(U + (size_t)(R0 + 8 * w + i) * UE + CE_KVA + 2 * lane);
              kp8[i] = lane < 32 ? bf2f(U[(size_t)(R0 + 8 * w + i) * UE + CE_KPE + lane]) : 0.f; }
      } else {
#pragma unroll
          for (int i = 0; i < 8; ++i) { const int s = ((-1 - t) & 3) * 64 + 8 * w + i; const size_t o = (size_t)(bs * 2 + j) * 256 + s;
              c8[i] = *(const f32x2*)(a.in[3] + o * 128 + 2 * lane); kp8[i] = lane < 32 ? a.in[4][o * 32 + lane] : 0.f; }
      }
      const f32x2 g = *(const f32x2*)(kvan + 2 * lane);
      SB_PIN
#pragma unroll
      for (int i = 0; i < 8; ++i) { const int row = 8 * w + i;
        if (own) {
            const float x0 = bflo(raw8[i]), x1 = bfhi(raw8[i]);
            const float rstd = rsqrtf(wave_sum(x0 * x0 + x1 * x1) * (1.f / 128.f) + EPS);
            const float c0 = x0 * rstd * g.x, c1 = x1 * rstd * g.y;
            *(unsigned*)(Xc + row * 136 + 2 * lane) = pk2(c0, c1);
            if (lane < 32) kpes[row * 32 + lane] = kp8[i];
            if (R0 < NP) { const int b = (R0 + row) >> 8, s = (R0 + row) & 255; const size_t o = (size_t)(b * 2 + j) * 256 + s;
                *(f32x2*)(a.out + O_CKV + o * 128 + 2 * lane) = (f32x2){c0, c1};
                if (lane < 32) a.out[O_KPE + o * 32 + lane] = kp8[i]; }
        } else {
            *(unsigned*)(Xc + row * 136 + 2 * lane) = pk2(c8[i].x, c8[i].y);
            if (lane < 32) kpes[row * 32 + lane] = kp8[i];
        } } }
    __syncthreads();
    f32x16 ak[2][2], av[2][2];
#pragma unroll
    for (int x = 0; x < 2; ++x)
#pragma unroll
        for (int y = 0; y < 2; ++y)
#pragma unroll
            for (int i = 0; i < 16; ++i) { ak[x][y][i] = 0.f; av[x][y][i] = 0.f; }
    const bf16* wp = Wkv + (size_t)(w * 4) * 8 * 512 + lane * 8;
    const bf16* xp = Xc + r * 136 + 8 * hh;
#pragma unroll
    for (int kh = 0; kh < 2; ++kh) { bh8 wk[4][2], wv[4][2];
#pragma unroll
      for (int k4 = 0; k4 < 4; ++k4)
#pragma unroll
          for (int fb = 0; fb < 2; ++fb) { wk[k4][fb] = ld16(wp + (size_t)(fb * 8 + kh * 4 + k4) * 512); wv[k4][fb] = ld16(wp + (size_t)((2 + fb) * 8 + kh * 4 + k4) * 512); }
      SB_PIN
#pragma unroll
      for (int k4 = 0; k4 < 4; ++k4) { const int ks = kh * 4 + k4; bh8 xf[2];
#pragma unroll
          for (int tb = 0; tb < 2; ++tb) xf[tb] = ld16(xp + tb * 32 * 136 + 16 * ks);
#pragma unroll
          for (int fb = 0; fb < 2; ++fb)
#pragma unroll
              for (int tb = 0; tb < 2; ++tb) { ak[fb][tb] = mfma32(wk[k4][fb], xf[tb], ak[fb][tb]); av[tb][fb] = mfma32(xf[tb], wv[k4][fb], av[tb][fb]); } }
      SB_PIN }
    const bool sample_own = own && R0 >= NP;
#pragma unroll
    for (int tb = 0; tb < 2; ++tb) {
        const int tok = 32 * tb + r;
        float kp[16]; float ss = 0.f;
#pragma unroll
        for (int g = 0; g < 4; ++g) { const f32x4 q4 = *(const f32x4*)(kpes + tok * 32 + 16 * hh + 4 * g); kp[4 * g] = q4.x; kp[4 * g + 1] = q4.y; kp[4 * g + 2] = q4.z; kp[4 * g + 3] = q4.w; }
#pragma unroll
        for (int i = 0; i < 16; ++i) ss += kp[i] * kp[i] + ak[0][tb][i] * ak[0][tb][i] + ak[1][tb][i] * ak[1][tb][i];
        ss += __shfl_xor(ss, 32);
        const float rstd = rsqrtf(ss * (1.f / 96.f) + EPS);
        bf16* kdst = KM + ((size_t)(((krow0 >> 5) + tb) * 8 + w) * 6) * 512 + r * 8;
#pragma unroll
        for (int fb = 0; fb < 2; ++fb)
#pragma unroll
            for (int g = 0; g < 4; ++g) { const int f0 = 32 * fb + 8 * g + 4 * hh; const f32x4 gn = *(const f32x4*)(kn + f0);
                st4bf(kdst + (2 * fb + (g >> 1)) * 512 + (g & 1) * 256 + 4 * hh, ak[fb][tb][4 * g] * rstd * gn.x, ak[fb][tb][4 * g + 1] * rstd * gn.y, ak[fb][tb][4 * g + 2] * rstd * gn.z, ak[fb][tb][4 * g + 3] * rstd * gn.w); }
#pragma unroll
        for (int g = 0; g < 4; ++g) { const f32x4 gn = *(const f32x4*)(kn + 64 + 16 * hh + 4 * g);
            kp[4 * g] *= rstd * gn.x; kp[4 * g + 1] *= rstd * gn.y; kp[4 * g + 2] *= rstd * gn.z; kp[4 * g + 3] *= rstd * gn.w; }
        if (sample_own) {
            const int tp = (R0 - NP + tok) & 1023; const int pos = hh == 0 ? (tp >> 6) : (tp & 63);
            const float* rp = rope + pos * 16;
#pragma unroll
            for (int i = 0; i < 8; ++i) { const float cs = rp[i], sn = rp[8 + i], x1 = kp[i], x2 = kp[8 + i]; kp[i] = x1 * cs - x2 * sn; kp[8 + i] = x1 * sn + x2 * cs; }
        }
#pragma unroll
        for (int g = 0; g < 4; ++g) st4bf(kdst + (4 + hh) * 512 + (g >> 1) * 256 + 4 * (g & 1), kp[4 * g], kp[4 * g + 1], kp[4 * g + 2], kp[4 * g + 3]);
#pragma unroll
        for (int fb = 0; fb < 2; ++fb) { bf16* vdst = VTM + ((size_t)(((krow0 >> 5) + tb) * 8 + w) * 4 + 2 * fb) * 512 + (hh * 32 + r) * 8;
#pragma unroll
            for (int g = 0; g < 4; ++g) st4bf(vdst + (g >> 1) * 512 + 4 * (g & 1), av[tb][fb][4 * g], av[tb][fb][4 * g + 1], av[tb][fb][4 * g + 2], av[tb][fb][4 * g + 3]); }
    }
    __syncthreads();
}

struct AttnState { f32x16 o0, o1; float m, l; };
__device__ __forceinline__ void attn_init(AttnState& st) {
#pragma unroll
    for (int i = 0; i < 16; ++i) { st.o0[i] = 0.f; st.o1[i] = 0.f; }
    st.m = -1e30f; st.l = 0.f;
}
template <int NKS> struct KVf { bh8 k[NKS]; bh8 v[4]; };
template <int NKS> __device__ __forceinline__ void load_kv(KVf<NKS>& f, const bf16* kp, const bf16* vp) {
#pragma unroll
    for (int ks = 0; ks < NKS; ++ks) f.k[ks] = ld16(kp + ks * 512);
#pragma unroll
    for (int q = 0; q < 4; ++q) f.v[q] = ld16(vp + q * 512);
}
template <int NKS, bool MASKED>
__device__ __forceinline__ void attn_compute(AttnState& st, const bh8* qf, const KVf<NKS>& f, const float* rk, int hh, bool na, int kc0, int dr, int cq, int c0, const float* rpbs) {
    f32x16 s;
#pragma unroll
    for (int i = 0; i < 16; ++i) s[i] = 0.f;
#pragma unroll
    for (int ks = 0; ks < NKS; ++ks) s = mfma32(f.k[ks], qf[ks], s);
    if (rk) {
#pragma unroll
        for (int g = 0; g < 4; ++g) { const f32x4 rv = *(const f32x4*)(rk + 8 * g + 4 * hh); s[4 * g] *= rv.x; s[4 * g + 1] *= rv.y; s[4 * g + 2] *= rv.z; s[4 * g + 3] *= rv.w; }
    }
    if (MASKED && na) {
#pragma unroll
        for (int i = 0; i < 16; ++i) { const int kc = kc0 + crow(i, hh); const bool ok = kc >= c0 && kc < c0 + 16;
            int dc = kc - cq; dc = dc < -15 ? -15 : (dc > 15 ? 15 : dc);
            s[i] = ok ? s[i] + rpbs[dr * 31 + dc + 15] : -1e30f; }
    }
    float mx = fmaxf(fmaxf(s[0], s[1]), s[2]);
#pragma unroll
    for (int i = 3; i < 15; i += 2) mx = fmaxf(fmaxf(mx, s[i]), s[i + 1]);
    mx = fmaxf(mx, s[15]);
    mx = fmaxf(mx, __shfl_xor(mx, 32));
    const float mn = fmaxf(st.m, mx);
    if (__builtin_amdgcn_ballot_w64(mn > st.m) != 0ull) {
        const float alpha = __builtin_amdgcn_exp2f(st.m - mn);
        st.l *= alpha;
#pragma unroll
        for (int i = 0; i < 16; ++i) { st.o0[i] *= alpha; st.o1[i] *= alpha; }
        st.m = mn;
    }
    float ps = 0.f;
#pragma unroll
    for (int i = 0; i < 16; ++i) { float p = __builtin_amdgcn_exp2f(s[i] - mn); if (MASKED) p = s[i] > -1e29f ? p : 0.f; s[i] = p; ps += p; }
    st.l += ps;
    const bh8 p0 = pfrag(s, 0), p1 = pfrag(s, 1);
    st.o0 = mfma32(f.v[0], p0, st.o0); st.o0 = mfma32(f.v[1], p1, st.o0);
    st.o1 = mfma32(f.v[2], p0, st.o1); st.o1 = mfma32(f.v[3], p1, st.o1);
}
template <int KS>
__device__ __forceinline__ void attn_merge_store(AttnState& st, float* part, int w, int lane, const v4u* gpre, bf16* zp) {
    const int r = lane & 31, hh = lane >> 5;
    float* mine = part + w * 2048; float* ml = part + 8 * 2048;
#pragma unroll
    for (int i = 0; i < 16; ++i) { mine[crow(i, hh) * 32 + r] = st.o0[i]; mine[(32 + crow(i, hh)) * 32 + r] = st.o1[i]; }
    const float lt = st.l + __shfl_xor(st.l, 32);
    if (hh == 0) { ml[(w * 2) * 32 + r] = st.m; ml[(w * 2 + 1) * 32 + r] = lt; }
    __syncthreads();
    const int qb = w / KS, kp = w % KS;
    float f[KS]; float ms = -1e30f, L = 0.f;
#pragma unroll
    for (int k = 0; k < KS; ++k) ms = fmaxf(ms, ml[((qb * KS + k) * 2) * 32 + r]);
#pragma unroll
    for (int k = 0; k < KS; ++k) { f[k] = __builtin_amdgcn_exp2f(ml[((qb * KS + k) * 2) * 32 + r] - ms); L += f[k] * ml[((qb * KS + k) * 2 + 1) * 32 + r]; }
    const float inv = 1.f / L;
    constexpr int ND = 32 / KS;
    const int dv0 = (64 / KS) * kp + ND * hh;
#pragma unroll
    for (int c = 0; c < ND / 8; ++c) {
        float o[8];
#pragma unroll
        for (int e = 0; e < 8; ++e) { float v = 0.f;
#pragma unroll
            for (int k = 0; k < KS; ++k) v += f[k] * part[(qb * KS + k) * 2048 + (dv0 + 8 * c + e) * 32 + r];
            o[e] = v * inv; }
        const v4u gr = gpre[c];
        v4u z; z.x = pk2(o[0] * silu_f(bflo(gr.x)), o[1] * silu_f(bfhi(gr.x))); z.y = pk2(o[2] * silu_f(bflo(gr.y)), o[3] * silu_f(bfhi(gr.y)));
        z.z = pk2(o[4] * silu_f(bflo(gr.z)), o[5] * silu_f(bfhi(gr.z))); z.w = pk2(o[6] * silu_f(bflo(gr.w)), o[7] * silu_f(bfhi(gr.w)));
        *(v4u*)(zp + dv0 + 8 * c) = z;
    }
    __syncthreads();
}

template <int KS> __device__ __forceinline__ void attn_gate_prefetch(v4u* gpre, const bf16* gp, int w, int lane) {
    constexpr int ND = 32 / KS; const int dv0 = (64 / KS) * (w % KS) + ND * (lane >> 5);
#pragma unroll
    for (int c = 0; c < ND / 8; ++c) gpre[c] = *(const v4u*)(gp + dv0 + 8 * c);
}

__device__ __forceinline__ void unit_mla_attn(const Args& a, const Ctx& X, int u) {
    const bf16* U = (const bf16*)(a.ws + WS_U); const bf16* Q = (const bf16*)(a.ws + WS_Q); const bf16* KM = (const bf16*)(a.ws + WS_KM); const bf16* VTM = (const bf16*)(a.ws + WS_VTM);
    bf16* Z = (bf16*)(a.ws + WS_Z);
    const int tid = opaque_v(X.tid), lane = tid & 63, w = opaque_s(X.wave), r = lane & 31, hh = lane >> 5;
    int h, q0, kb0, nkb; const bool samp = u < 256;
    if (samp) { const int bs = u >> 7, qg = u & 15; h = (u >> 4) & 7; q0 = NP + bs * 1024 + 64 * qg + 32 * (w >> 2); kb0 = NP + bs * 1280 + 320 * (w & 3); nkb = 10; }
    else { const int v = u - 256, b = v >> 4, qh = v & 1; h = (v >> 1) & 7; q0 = b * 256 + 128 * qh + 32 * (w >> 1); kb0 = b * 256 + 128 * (w & 1); nkb = 4; }
    PROF_BEGIN(30)
    bh8 qf[6];
#pragma unroll
    for (int ks = 0; ks < 6; ++ks) qf[ks] = ld16(Q + (size_t)(q0 + r) * 768 + h * 96 + 16 * ks + 8 * hh);
    AttnState st; attn_init(st);
    v4u gpre[2];
    { const bf16* gp = U + (size_t)(q0 + r) * UE + CE_GA + h * 64; if (samp) attn_gate_prefetch<4>(gpre, gp, w, lane); else attn_gate_prefetch<2>(gpre, gp, w, lane); }
    const bf16* kp = KM + ((size_t)((kb0 >> 5) * 8 + h) * 6) * 512 + lane * 8;
    const bf16* vp = VTM + ((size_t)((kb0 >> 5) * 8 + h) * 4) * 512 + lane * 8;
    KVf<6> fa, fb;
    load_kv<6>(fa, kp, vp);
    PROF_END(30)
    PROF_BEGIN(31)
    for (int kb = 0; kb < nkb; kb += 2) {
        load_kv<6>(fb, kp + (size_t)(kb + 1) * 8 * 6 * 512, vp + (size_t)(kb + 1) * 8 * 4 * 512);
        SB_PIN
        attn_compute<6, false>(st, qf, fa, nullptr, hh, false, 0, 0, 0, 0, nullptr);
        if (kb + 2 < nkb) load_kv<6>(fa, kp + (size_t)(kb + 2) * 8 * 6 * 512, vp + (size_t)(kb + 2) * 8 * 4 * 512);
        SB_PIN
        attn_compute<6, false>(st, qf, fb, nullptr, hh, false, 0, 0, 0, 0, nullptr);
    }
    PROF_END(31)
    PROF_BEGIN(32)
    const int row = q0 + r;
    if (samp) attn_merge_store<4>(st, (float*)X.ldsg, w, lane, gpre, Z + (size_t)row * DM + h * 64);
    else attn_merge_store<2>(st, (float*)X.ldsg, w, lane, gpre, Z + (size_t)row * DM + h * 64);
    PROF_END(32)
}

__device__ __forceinline__ void load_q64(const bf16* qrow  , const float* qnorm, const float* knorm, int hh, bh8* qa) {
    float x[4][8]; float ss = 0.f;
#pragma unroll
    for (int ks = 0; ks < 4; ++ks) { const v4u raw = *(const v4u*)(qrow + 16 * ks + 8 * hh);
        x[ks][0] = bflo(raw.x); x[ks][1] = bfhi(raw.x); x[ks][2] = bflo(raw.y); x[ks][3] = bfhi(raw.y); x[ks][4] = bflo(raw.z); x[ks][5] = bfhi(raw.z); x[ks][6] = bflo(raw.w); x[ks][7] = bfhi(raw.w);
#pragma unroll
        for (int e = 0; e < 8; ++e) ss += x[ks][e] * x[ks][e]; }
    ss += __shfl_xor(ss, 32);
    const float rstd = rsqrtf(ss * (1.f / 64.f) + EPS) * (0.125f * 1.4426950408889634f);
#pragma unroll
    for (int ks = 0; ks < 4; ++ks) { float ya[8];
#pragma unroll
        for (int e = 0; e < 8; ++e) { const int d = 16 * ks + 8 * hh + e; ya[e] = x[ks][e] * rstd * qnorm[d] * knorm[d]; }
        v4u va; va.x = pk2(ya[0], ya[1]); va.y = pk2(ya[2], ya[3]); va.z = pk2(ya[4], ya[5]); va.w = pk2(ya[6], ya[7]);
        qa[ks] = __builtin_bit_cast(bh8, va); }
}

__device__ __forceinline__ void unit_odd_attn(const Args& a, const Ctx& X, int j, int u) {
    const bf16* U = (const bf16*)(a.ws + WS_U); const bf16* VTO = (const bf16*)(a.ws + WS_VTO); bf16* Z = (bf16*)(a.ws + WS_Z);
    const float* qnorm = a.in[28] + j * 64; const float* knorm = a.in[29] + j * 64;
    float* part = (float*)X.ldsg; float* rk = part + 8 * 2048 + 512;
    const int b = u >> 4, h = (u >> 1) & 7, qh = u & 1, tid = opaque_v(X.tid), lane = tid & 63, w = opaque_s(X.wave), r = lane & 31, hh = lane >> 5, R0 = b * 256;
    PROF_BEGIN(26)
    { const int key = tid >> 1, half = tid & 1;
      const bf16* kp = U + (size_t)(R0 + key) * UO + CO_KD + h * 64 + 32 * half;
      float kx[32]; float ss = 0.f;
#pragma unroll
      for (int q = 0; q < 4; ++q) { const v4u kr = *(const v4u*)(kp + 8 * q);
          kx[8 * q] = bflo(kr.x); kx[8 * q + 1] = bfhi(kr.x); kx[8 * q + 2] = bflo(kr.y); kx[8 * q + 3] = bfhi(kr.y); kx[8 * q + 4] = bflo(kr.z); kx[8 * q + 5] = bfhi(kr.z); kx[8 * q + 6] = bflo(kr.w); kx[8 * q + 7] = bfhi(kr.w); }
#pragma unroll
      for (int e = 0; e < 32; ++e) ss += kx[e] * kx[e];
      ss += __shfl_xor(ss, 1);
      const float rstd = rsqrtf(ss * (1.f / 64.f) + EPS);
      if (half == 0) rk[key] = rstd;
      if (qh == 0) {
          const bf16* vp = U + (size_t)(R0 + key) * UO + CO_VD + h * 64 + 32 * half;
          float* ok = a.out + O_NK + ((size_t)(b * 2 + j) * 256 + key) * 512 + h * 64 + 32 * half; float* ov = a.out + O_NV + ((size_t)(b * 2 + j) * 256 + key) * 512 + h * 64 + 32 * half;
#pragma unroll
          for (int q = 0; q < 8; ++q) { const f32x4 g = *(const f32x4*)(knorm + 32 * half + 4 * q);
              *(f32x4*)(ok + 4 * q) = (f32x4){kx[4 * q] * rstd * g.x, kx[4 * q + 1] * rstd * g.y, kx[4 * q + 2] * rstd * g.z, kx[4 * q + 3] * rstd * g.w}; }
#pragma unroll
          for (int q = 0; q < 4; ++q) { const v4u vr = *(const v4u*)(vp + 8 * q);
              *(f32x4*)(ov + 8 * q) = (f32x4){bflo(vr.x), bfhi(vr.x), bflo(vr.y), bfhi(vr.y)}; *(f32x4*)(ov + 8 * q + 4) = (f32x4){bflo(vr.z), bfhi(vr.z), bflo(vr.w), bfhi(vr.w)}; }
      } }
    __syncthreads();
    PROF_END(26)
    PROF_BEGIN(27)
    const int row = R0 + 128 * qh + 32 * (w >> 1) + r, kb0 = R0 + 128 * (w & 1);
    bh8 qa[4];
    load_q64(U + (size_t)row * UO + CO_QD + h * 64, qnorm, knorm, hh, qa);
    AttnState st; attn_init(st);
    v4u gpre[2]; attn_gate_prefetch<2>(gpre, U + (size_t)row * UO + CO_GD + h * 64, w, lane);
    const bf16* kp = (const bf16*)(a.ws + WS_KFO) + ((size_t)((kb0 >> 5) * 8 + h) * 4) * 512 + lane * 8;
    const bf16* vp = VTO + ((size_t)((kb0 >> 5) * 8 + h) * 4) * 512 + lane * 8;
    const float* rkp = rk + 128 * (w & 1);
    KVf<4> fa, fb;
    load_kv<4>(fa, kp, vp);
#pragma unroll
    for (int kb = 0; kb < 4; kb += 2) {
        load_kv<4>(fb, kp + (size_t)(kb + 1) * 8 * 4 * 512, vp + (size_t)(kb + 1) * 8 * 4 * 512);
        SB_PIN
        attn_compute<4, false>(st, qa, fa, rkp + 32 * kb, hh, false, 0, 0, 0, 0, nullptr);
        if (kb + 2 < 4) load_kv<4>(fa, kp + (size_t)(kb + 2) * 8 * 4 * 512, vp + (size_t)(kb + 2) * 8 * 4 * 512);
        SB_PIN
        attn_compute<4, false>(st, qa, fb, rkp + 32 * (kb + 1), hh, false, 0, 0, 0, 0, nullptr);
    }
    PROF_END(27)
    PROF_BEGIN(28)
    attn_merge_store<2>(st, part, w, lane, gpre, Z + (size_t)row * DM + 512 + h * 64);
    PROF_END(28)
}

__device__ __forceinline__ void na_block_ptrs(int g, int rb, int R0s, int h, int lane, const bf16* KFO, const bf16* VFO, const bf16* kc, const bf16* vc,
                                              const bf16*& kp, const bf16*& vp, int& rki, bool& win, int& kc0, int& bi) {
    if (g < 8) { kp = kc + (size_t)g * 4 * 512 + lane * 8; vp = vc + (size_t)g * 4 * 512 + lane * 8; rki = 512 + 32 * g; win = false; kc0 = 0; bi = 0; }
    else { const int i = (g - 8) >> 1, xk = g & 1; const int tok0 = (rb + i) * 64 + 32 * xk; const size_t blk = ((size_t)(((R0s + tok0) >> 5) * 8 + h) * 4) * 512 + lane * 8;
        kp = KFO + blk; vp = VFO + blk; rki = i * 64 + 32 * xk; win = true; kc0 = 32 * xk; bi = i; }
}
__device__ __forceinline__ void unit_na(const Args& a, const Ctx& X, int j, int u) {
    const bf16* U = (const bf16*)(a.ws + WS_U); const bf16* VTO = (const bf16*)(a.ws + WS_VTO); bf16* Z = (bf16*)(a.ws + WS_Z);
    const float* qnorm = a.in[28] + j * 64; const float* knorm = a.in[29] + j * 64;
    float* part = (float*)X.ldsg; float* rk = part + 8 * 2048 + 512;
    float* rpbs = rk + 768;
    const int bs = u >> 7, h = (u >> 4) & 7, rr = u & 15, tid = opaque_v(X.tid), lane = tid & 63, w = opaque_s(X.wave), r = lane & 31, hh = lane >> 5, R0s = NP + bs * 1024;
    const int rb = rr - 4 < 0 ? 0 : (rr - 4 > 8 ? 8 : rr - 4);
    { const bf16* kp = U + (size_t)(R0s + rb * 64 + tid) * UO + CO_KD + h * 64; float ss = 0.f;
#pragma unroll
      for (int q = 0; q < 8; ++q) { const v4u kr = *(const v4u*)(kp + 8 * q);
          const float k0 = bflo(kr.x), k1 = bfhi(kr.x), k2 = bflo(kr.y), k3 = bfhi(kr.y), k4 = bflo(kr.z), k5 = bfhi(kr.z), k6 = bflo(kr.w), k7 = bfhi(kr.w);
          ss += (k0 * k0 + k1 * k1) + (k2 * k2 + k3 * k3) + (k4 * k4 + k5 * k5) + (k6 * k6 + k7 * k7); }
      rk[tid] = rsqrtf(ss * (1.f / 64.f) + EPS);
      if (tid < 256) rk[512 + tid] = 1.f;
      if (tid < 465) rpbs[tid] = a.in[30][(size_t)(j * 8 + h) * 465 + tid] * 1.4426950408889634f; }
    __syncthreads();
    const int xq = w >> 2, kpart = w & 3, tok = rr * 64 + 32 * xq + r, cq = 32 * xq + r;
    const int c0 = cq - 8 < 0 ? 0 : (cq - 8 > 48 ? 48 : cq - 8);
    const int row = R0s + tok;
    bh8 qa[4];
    load_q64(U + (size_t)row * UO + CO_QD + h * 64, qnorm, knorm, hh, qa);
    AttnState st; attn_init(st);
    v4u gpre[1]; attn_gate_prefetch<4>(gpre, U + (size_t)row * UO + CO_GD + h * 64, w, lane);
    const bf16* kc = (const bf16*)(a.ws + WS_NAKC) + (size_t)((bs * 2 + j) * 8 + h) * 8 * 4 * 512;
    const bf16* vc = (const bf16*)(a.ws + WS_NAVC) + (size_t)((bs * 2 + j) * 8 + h) * 8 * 4 * 512;
    const bf16* KFO = (const bf16*)(a.ws + WS_KFO);
    const int g0 = 6 * kpart;
    KVf<4> fa, fb;
    const bf16 *kpa, *vpa, *kpb, *vpb; int rka, rkb, kca, kcb, bia, bib; bool wa, wb;
    na_block_ptrs(g0, rb, R0s, h, lane, KFO, VTO, kc, vc, kpa, vpa, rka, wa, kca, bia);
    load_kv<4>(fa, kpa, vpa);
#pragma unroll 1
    for (int g = 0; g < 6; g += 2) {
        na_block_ptrs(g0 + g + 1, rb, R0s, h, lane, KFO, VTO, kc, vc, kpb, vpb, rkb, wb, kcb, bib);
        load_kv<4>(fb, kpb, vpb);
        SB_PIN
        attn_compute<4, true>(st, qa, fa, rk + rka, hh, wa, kca, rb + bia - rr + 7, cq, c0, rpbs);
        if (g + 2 < 6) { na_block_ptrs(g0 + g + 2, rb, R0s, h, lane, KFO, VTO, kc, vc, kpa, vpa, rka, wa, kca, bia); load_kv<4>(fa, kpa, vpa); }
        SB_PIN
        attn_compute<4, true>(st, qa, fb, rk + rkb, hh, wb, kcb, rb + bib - rr + 7, cq, c0, rpbs);
    }
    attn_merge_store<4>(st, part, w, lane, gpre, Z + (size_t)row * DM + 512 + h * 64);
}
#ifndef RU_OUT_A
#define RU_OUT_A 1
#endif
#ifndef RU_OUT_B
#define RU_OUT_B 1
#endif
#ifndef RU_OUT_C
#define RU_OUT_C 1
#endif
__device__ __forceinline__ float scan_incl_sum(float v, int lane) {
#pragma unroll
    for (int o = 1; o < 64; o <<= 1) { const float t = __shfl_up(v, o); if (lane >= o) v += t; }
    return v;
}
__device__ __forceinline__ float scan_incl_max(float v, int lane) {
#pragma unroll
    for (int o = 1; o < 64; o <<= 1) { const float t = __shfl_up(v, o); if (lane >= o) v = fmaxf(v, t); }
    return v;
}
__device__ __forceinline__ float scan_incl_max_rev(float v, int lane) {
#pragma unroll
    for (int o = 1; o < 64; o <<= 1) { const float t = __shfl_down(v, o); if (lane + o < 64) v = fmaxf(v, t); }
    return v;
}
constexpr float KSC = 0.08838834764831845f;

__device__ __forceinline__ void stage_T(const bf16* src  , int pitch, bf16* d0, const float* w0, bf16* d1, const float* w1, int wave, int lane) {
#pragma unroll
    for (int i = 0; i < 2; ++i) { const int c = wave * 2 + i;
        const v4u raw = *(const v4u*)(src + (size_t)lane * pitch + 8 * c);
        float x[8] = {bflo(raw.x), bfhi(raw.x), bflo(raw.y), bfhi(raw.y), bflo(raw.z), bfhi(raw.z), bflo(raw.w), bfhi(raw.w)};
        if (w0) { const float s0 = w0[lane] * KSC, s1 = w1[lane] * KSC;
#pragma unroll
            for (int e = 0; e < 8; ++e) { d0[(8 * c + e) * 72 + lane] = (bf16)(pk2(x[e] * s0, 0.f) & 0xffffu); d1[(8 * c + e) * 72 + lane] = (bf16)(pk2(x[e] * s1, 0.f) & 0xffffu); }
        } else {
            const unsigned rr[4] = {raw.x, raw.y, raw.z, raw.w};
#pragma unroll
            for (int e = 0; e < 8; ++e) d0[(8 * c + e) * 72 + lane] = (bf16)((rr[e >> 1] >> (16 * (e & 1))) & 0xffffu);
        }
    }
}

__device__ __forceinline__ void unit_mlstm_L(const Args& a, const Ctx& X, int j, int h, int gc) {
    const bf16* U = (const bf16*)(a.ws + WS_U); const float* GT = (const float*)(a.ws + WS_GATES); const bf16* VFM = (const bf16*)(a.ws + WS_VFM);
    float* AG = (float*)(a.ws + WS_AG); float* LT = (float*)(a.ws + WS_LT); float* NL = (float*)(a.ws + WS_NL); float* GQ = (float*)(a.ws + WS_GQ);
    float* wgt = (float*)X.ldsg;
    bf16* KwT = (bf16*)(X.ldsg + 1024);
    const int tid = opaque_v(X.tid), lane = tid & 63, w = opaque_s(X.wave), r = lane & 31, hh = lane >> 5, R0 = gc * 64;
    v4u kraw[2];
#pragma unroll
    for (int i = 0; i < 2; ++i) kraw[i] = *(const v4u*)(U + (size_t)(R0 + lane) * UE + CE_KM + h * 128 + 8 * (w * 2 + i));
    bh8 vf[4][4];
#pragma unroll
    for (int eb = 0; eb < 4; ++eb)
#pragma unroll
        for (int q = 0; q < 4; ++q) vf[eb][q] = ld16(VFM + ((size_t)(((2 * gc + (q >> 1)) * 4 + h) * 8 + eb * 2 + (q & 1))) * 512 + lane * 8);
    SB_PIN
    if (w < 2) { const int dir = w; const int row = R0 + lane;
        const float lf = logsigmoid_f(GT[(size_t)row * 16 + 8 + dir * 4 + h] + a.in[22][j * 8 + dir * 4 + h]);
        const float ii = GT[(size_t)row * 16 + dir * 4 + h] + a.in[21][j * 8 + dir * 4 + h];
        const float P = scan_incl_sum(lf, lane); const float T = __shfl(P, 63);
        const float dec = (dir == 0 ? (T - P) : (P - lf)) + ii;
        const float am = wave_max(dec);
        wgt[dir * 64 + lane] = expf(dec - am) * KSC;
        if (lane == 0) { AG[((dir * 4 + h) * 96 + gc) * 2] = am; AG[((dir * 4 + h) * 96 + gc) * 2 + 1] = T; }
        const float cum = dir == 0 ? P : (T - P + lf), bv = ii - cum;
        const float pm = dir == 0 ? scan_incl_max(bv, lane) : scan_incl_max_rev(bv, lane);
        *(f32x4*)(GQ + ((size_t)(dir * 4 + h) * NT + row) * 4) = (f32x4){cum, bv, pm, 0.f};
    }
    __syncthreads();
#pragma unroll
    for (int i = 0; i < 2; ++i) { const int c = w * 2 + i; const unsigned rr[4] = {kraw[i].x, kraw[i].y, kraw[i].z, kraw[i].w};
        const float s0 = wgt[lane], s1 = wgt[64 + lane];
#pragma unroll
        for (int e = 0; e < 8; ++e) { const float x = (e & 1) ? bfhi(rr[e >> 1]) : bflo(rr[e >> 1]);
            KwT[(8 * c + e) * 72 + lane] = (bf16)(pk2(x * s0, 0.f) & 0xffffu); KwT[128 * 72 + (8 * c + e) * 72 + lane] = (bf16)(pk2(x * s1, 0.f) & 0xffffu); } }
    __syncthreads();
    { const int dir = w >> 2, db = w & 3; const size_t ub = (size_t)((dir * 4 + h) * 96 + gc);
      bh8 bfr[4];
#pragma unroll
      for (int q = 0; q < 4; ++q) { const bf16* kp = KwT + dir * 128 * 72 + (32 * db + r) * 72 + 16 * q + 4 * hh; bfr[q] = ld2x8(kp, kp + 8); }
#pragma unroll
      for (int eb = 0; eb < 4; ++eb) { f32x16 acc;
#pragma unroll
          for (int i = 0; i < 16; ++i) acc[i] = 0.f;
#pragma unroll
          for (int q = 0; q < 4; ++q) acc = mfma32(vf[eb][q], bfr[q], acc);
          float* dst = LT + ub * 16384 + 32 * db + r;
#pragma unroll
          for (int i = 0; i < 16; ++i) dst[(32 * eb + crow(i, hh)) * 128] = acc[i]; }
      if (tid < 256) { const int dr = tid >> 7, d = tid & 127; const bf16* p = KwT + dr * 128 * 72 + d * 72; float s = 0.f;
#pragma unroll
          for (int q = 0; q < 8; ++q) { const v4u x = *(const v4u*)(p + 8 * q); s += (bflo(x.x) + bfhi(x.x)) + (bflo(x.y) + bfhi(x.y)) + (bflo(x.z) + bfhi(x.z)) + (bflo(x.w) + bfhi(x.w)); }
          NL[(size_t)((dr * 4 + h) * 96 + gc) * 128 + d] = s; } }
    __syncthreads();
}

template <int NC, int NV>
__device__ __forceinline__ void scan_body(const Args& a, int j, int tid, int dir, int h, int gc0, int sl, int initmat  , long outsb  ) {
    const float* AG = (const float*)(a.ws + WS_AG); const float* LT = (const float*)(a.ws + WS_LT); const float* NL = (const float*)(a.ws + WS_NL);
    bf16* CTB = (bf16*)(a.ws + WS_CTB); float* NPV = (float*)(a.ws + WS_NPV); float* MPV = (float*)(a.ws + WS_MPV);
    const size_t ub0 = (size_t)((dir * 4 + h) * 96 + gc0);
    const int e0 = sl * (NV * 2048) + tid * 4;
    f32x4 Lv[NC][NV]; float nl[NC];
    const bool don = tid < 128 && sl == 0;
#pragma unroll
    for (int c = 0; c < NC; ++c) {
#pragma unroll
        for (int i = 0; i < NV; ++i) Lv[c][i] = *(const f32x4*)(LT + (ub0 + c) * 16384 + e0 + 2048 * i);
        nl[c] = don ? NL[(ub0 + c) * 128 + tid] : 0.f; }
    SB_PIN
    f32x4 Cs[NV]; float ns = 0.f, m = 0.f;
#pragma unroll
    for (int i = 0; i < NV; ++i) Cs[i] = (f32x4){0.f, 0.f, 0.f, 0.f};
    if (initmat >= 0) { const float* c0 = (const float*)(a.ws + WS_C0T) + (size_t)initmat * 16384;
#pragma unroll
        for (int i = 0; i < NV; ++i) Cs[i] = *(const f32x4*)(c0 + e0 + 2048 * i);
        if (don) ns = a.in[6][(size_t)initmat * 128 + tid];
        m = a.in[7][initmat]; }
#pragma unroll
    for (int p = 0; p < NC; ++p) {
        const int c = dir ? NC - 1 - p : p;
        const float ac = AG[(ub0 + c) * 2], Gc = AG[(ub0 + c) * 2 + 1];
#pragma unroll
        for (int i = 0; i < NV; ++i) { const int idx = e0 + 2048 * i; st4bf(CTB + (ub0 + c) * 16384 + idx, Cs[i].x, Cs[i].y, Cs[i].z, Cs[i].w); }
        if (don) NPV[(ub0 + c) * 128 + tid] = ns;
        if (tid == 0 && sl == 0) MPV[ub0 + c] = m;
        const float mn = fmaxf(Gc + m, ac), ws = expf(Gc + m - mn), wl = expf(ac - mn);
#pragma unroll
        for (int i = 0; i < NV; ++i) Cs[i] = Cs[i] * ws + Lv[c][i] * wl;
        ns = ns * ws + nl[c] * wl; m = mn;
    }
    if (outsb >= 0) {
#pragma unroll
        for (int i = 0; i < NV; ++i) { const int idx = e0 + 2048 * i, e = idx >> 7, d = idx & 127; float* o = a.out + O_C + (size_t)outsb * 16384 + e;
            o[(d + 0) * 128] = Cs[i].x; o[(d + 1) * 128] = Cs[i].y; o[(d + 2) * 128] = Cs[i].z; o[(d + 3) * 128] = Cs[i].w; }
        if (don) a.out[O_N + (size_t)outsb * 128 + tid] = ns;
        if (tid == 0 && sl == 0) a.out[O_M + outsb] = m;
    }
}
__device__ __forceinline__ void unit_mlstm_scan(const Args& a, const Ctx& X, int j, int s) {
    const int tid = opaque_v(X.tid);
    if (s < 256) { const int sl = s & 1, q = s >> 1, b = q >> 3, h = (q >> 1) & 3, dir = q & 1;
        scan_body<4, 4>(a, j, tid, dir, h, 4 * b, sl, -1, (long)((b * 2 + j) * 2 + dir) * 4 + h); }
    else { const int v = s - 256, sl = v & 7, q = v >> 3, bs = q >> 3, h = (q >> 1) & 3, dir = q & 1;
        scan_body<16, 1>(a, j, tid, dir, h, 64 + 16 * bs, sl, ((bs * 2 + j) * 2 + dir) * 4 + h, -1); }
}

__device__ __forceinline__ void unit_mlstm_out(const Args& a, const Ctx& X, int j, int h, int gc) {
    const bf16* U = (const bf16*)(a.ws + WS_U);
    const bf16* CTB = (const bf16*)(a.ws + WS_CTB); const float* NPV = (const float*)(a.ws + WS_NPV); const float* MPV = (const float*)(a.ws + WS_MPV);
    bf16* Z = (bf16*)(a.ws + WS_Z);
    unsigned char* L = X.ldsg;
    bf16* Qs = (bf16*)L; bf16* Ks = (bf16*)(L + 17408); bf16* CT = (bf16*)(L + 34816);
    float* ctm = (float*)(L + 137216); float* bb = ctm + 128; float* wint = bb + 128; float* emt = wint + 128;
    float* nprev = emt + 128;
    float* ssq = nprev + 256;
    const int tid = opaque_v(X.tid), lane = tid & 63, w = opaque_s(X.wave), r = lane & 31, hh = lane >> 5, R0 = gc * 64;
    const int tb = w & 1, eb = w >> 1, tau = 32 * tb + r;
    PROF_BEGIN(23)
    v4u qraw[2], kraw[2], craw[4];
#pragma unroll
    for (int i = 0; i < 2; ++i) { const int q = tid + 512 * i, row = q >> 4, cc = q & 15;
        qraw[i] = *(const v4u*)(U + (size_t)(R0 + row) * UE + CE_QM + h * 128 + 8 * cc);
        kraw[i] = *(const v4u*)(U + (size_t)(R0 + row) * UE + CE_KM + h * 128 + 8 * cc); }
#pragma unroll
    for (int i = 0; i < 4; ++i) { const int q = tid + 512 * i, e = q >> 4, cc = q & 15; craw[i] = *(const v4u*)(CTB + (size_t)((0 * 4 + h) * 96 + gc) * 16384 + e * 128 + 8 * cc); }
    const float npr = tid < 256 ? NPV[(size_t)(((tid >> 7) * 4 + h) * 96 + gc) * 128 + (tid & 127)] : 0.f;
    bh8 vf[4];
#pragma unroll
    for (int q = 0; q < 4; ++q) vf[q] = ld16((const bf16*)(a.ws + WS_VFM) + ((size_t)(((2 * gc + (q >> 1)) * 4 + h) * 8 + eb * 2 + (q & 1))) * 512 + lane * 8);
    f32x4 gq = (f32x4){0.f, 0.f, 0.f, 0.f}; float mp = 0.f;
    if (w < 2) { gq = *(const f32x4*)((const float*)(a.ws + WS_GQ) + ((size_t)(w * 4 + h) * NT + R0 + lane) * 4); mp = MPV[(size_t)((w * 4 + h) * 96 + gc)]; }
    { const int row = R0 + tau; v2u* og = (v2u*)(L + 104448) + tid * 8;
#pragma unroll
      for (int g = 0; g < 4; ++g) { const int e0 = 32 * eb + 8 * g + 4 * hh;
          og[g] = *(const v2u*)(U + (size_t)row * UE + CE_OM + h * 128 + e0); og[4 + g] = *(const v2u*)(U + (size_t)row * UE + CE_GM + h * 128 + e0); } }
    SB_PIN
#pragma unroll
    for (int i = 0; i < 2; ++i) { const int q = tid + 512 * i, row = q >> 4, cc = q & 15;
        *(v4u*)(Qs + row * 136 + 8 * cc) = qraw[i]; *(v4u*)(Ks + row * 136 + 8 * cc) = kraw[i]; }
#pragma unroll
    for (int i = 0; i < 4; ++i) { const int q = tid + 512 * i, e = q >> 4, cc = q & 15; *(v4u*)(CT + e * 136 + 8 * cc) = craw[i];
        craw[i] = *(const v4u*)(CTB + (size_t)((1 * 4 + h) * 96 + gc) * 16384 + e * 128 + 8 * cc); }
#pragma unroll
    for (int i = 0; i < 4; ++i) { const int q = tid + 512 * i, e = q >> 4, cc = q & 15; *(v4u*)(CT + 128 * 136 + e * 136 + 8 * cc) = craw[i]; }
    if (tid < 256) nprev[tid] = npr;
    if (w < 2) { const int dir = w; const float cum = gq.x, bv = gq.y, pm = gq.z;
        const float mt = cum + fmaxf(mp, pm);
        ctm[dir * 64 + lane] = cum - mt; bb[dir * 64 + lane] = bv; wint[dir * 64 + lane] = expf(cum + mp - mt); emt[dir * 64 + lane] = expf(-mt); }
    __syncthreads();
    PROF_END(23)
    PROF_BEGIN(24)
    const bf16* qp = Qs + (32 * tb + r) * 136 + 8 * hh;
    bh8 qf[8];
#pragma unroll
    for (int ks = 0; ks < 8; ++ks) qf[ks] = ld16(qp + 16 * ks);
    f32x16 hsum;
    for (int rpb_ = 0; rpb_ < RU_OUT_B; ++rpb_) {
#pragma unroll
    for (int i = 0; i < 16; ++i) hsum[i] = 0.f;
#pragma unroll 1
    for (int dir = 0; dir < 2; ++dir) {
        const int sgn = 1 - 2 * dir;
        const bf16* CTd = CT + dir * 128 * 136; const float* npv = nprev + dir * 128;
        const float ct = ctm[dir * 64 + tau], wi = wint[dir * 64 + tau];
        float rs = 0.f, qd = 0.f;
        f32x16 accv;
#pragma unroll
        for (int i = 0; i < 16; ++i) accv[i] = 0.f;
#pragma unroll
        for (int sb = 0; sb < 2; ++sb) {
            bh8 kf[8]; f32x16 ps;
#pragma unroll
            for (int ks = 0; ks < 8; ++ks) kf[ks] = ld16(Ks + (32 * sb + r) * 136 + 16 * ks + 8 * hh);
#pragma unroll
            for (int i = 0; i < 16; ++i) ps[i] = 0.f;
#pragma unroll
            for (int ks = 0; ks < 8; ++ks) ps = mfma32(kf[ks], qf[ks], ps);
#pragma unroll
            for (int g = 0; g < 4; ++g) { const f32x4 b4 = *(const f32x4*)(bb + dir * 64 + 32 * sb + 8 * g + 4 * hh);
#pragma unroll
                for (int e = 0; e < 4; ++e) { const int dd = (32 * sb + 8 * g + 4 * hh + e - tau) * sgn; const bool ok = dd <= 0;
                    const float v = ok ? ps[4 * g + e] * KSC * __expf(ct + b4[e]) : 0.f; ps[4 * g + e] = v; rs += v; } }
            accv = mfma32(vf[2 * sb], pfrag(ps, 0), accv);
            accv = mfma32(vf[2 * sb + 1], pfrag(ps, 1), accv);
            __builtin_amdgcn_sched_barrier(0);
        }
        rs += __shfl_xor(rs, 32);
#pragma unroll
        for (int ks = 0; ks < 8; ++ks) { const v4u qq = __builtin_bit_cast(v4u, qf[ks]); const f32x4 n0 = *(const f32x4*)(npv + 16 * ks + 8 * hh), n1 = *(const f32x4*)(npv + 16 * ks + 8 * hh + 4);
            qd += bflo(qq.x) * n0.x + bfhi(qq.x) * n0.y + bflo(qq.y) * n0.z + bfhi(qq.y) * n0.w + bflo(qq.z) * n1.x + bfhi(qq.z) * n1.y + bflo(qq.w) * n1.z + bfhi(qq.w) * n1.w;
            if ((ks & 1) == 1) __builtin_amdgcn_sched_barrier(0); }
        qd += __shfl_xor(qd, 32);
        __builtin_amdgcn_sched_barrier(0);
        bh8 cf[8];
#pragma unroll
        for (int ks = 0; ks < 8; ++ks) cf[ks] = ld16(CTd + (32 * eb + r) * 136 + 16 * ks + 8 * hh);
        const float qn = wi * qd + rs;
        f32x16 acc;
#pragma unroll
        for (int i = 0; i < 16; ++i) acc[i] = 0.f;
#pragma unroll
        for (int ks = 0; ks < 8; ++ks) acc = mfma32(cf[ks], qf[ks], acc);
#pragma unroll
        for (int i = 0; i < 16; ++i) acc[i] = acc[i] * wi + accv[i];
        const float inv = 1.f / fmaxf(fabsf(qn), emt[dir * 64 + tau]);
#pragma unroll
        for (int i = 0; i < 16; ++i) hsum[i] += acc[i] * inv;
        __builtin_amdgcn_sched_barrier(0);
    }
    }
    PROF_END(24)
    PROF_BEGIN(25)
    { float ss = 0.f;
#pragma unroll
      for (int i = 0; i < 16; ++i) ss += hsum[i] * hsum[i];
      ss += __shfl_xor(ss, 32);
      if (hh == 0) ssq[(tb * 4 + eb) * 32 + r] = ss; }
    __syncthreads();
    { const int tid2 = opaque_v(tid), lane2 = tid2 & 63, w2 = opaque_s(w), r2 = lane2 & 31, hh2 = lane2 >> 5, tb2 = w2 & 1, eb2 = w2 >> 1, tau2 = 32 * tb2 + r2;
    { const float tot = ssq[(tb2 * 4 + 0) * 32 + r2] + ssq[(tb2 * 4 + 1) * 32 + r2] + ssq[(tb2 * 4 + 2) * 32 + r2] + ssq[(tb2 * 4 + 3) * 32 + r2];
      const float rstd = rsqrtf(tot * (1.f / 128.f) + EPS);
      const int row = R0 + tau2; const float* hn = a.in[23] + j * 512 + h * 128;
#pragma unroll
      for (int g = 0; g < 4; ++g) { const int e0 = 32 * eb2 + 8 * g + 4 * hh2; const f32x4 gn = *(const f32x4*)(hn + e0); const v2u om = ((const v2u*)(L + 104448))[tid2 * 8 + g], gm = ((const v2u*)(L + 104448))[tid2 * 8 + 4 + g];
          st4bf(Z + (size_t)row * DM + 512 + h * 128 + e0,
                hsum[4 * g] * rstd * gn.x * sigmoid_f(bflo(om.x)) * silu_f(bflo(gm.x)), hsum[4 * g + 1] * rstd * gn.y * sigmoid_f(bfhi(om.x)) * silu_f(bfhi(gm.x)),
                hsum[4 * g + 2] * rstd * gn.z * sigmoid_f(bflo(om.y)) * silu_f(bflo(gm.y)), hsum[4 * g + 3] * rstd * gn.w * sigmoid_f(bfhi(om.y)) * silu_f(bfhi(gm.y))); } }
    }
    __syncthreads();
    PROF_END(25)
}
__device__ __forceinline__ void unit_conv(const Args& a, const Ctx& X, int j, int t) {
    const bf16* U = (const bf16*)(a.ws + WS_U); bf16* Z = (bf16*)(a.ws + WS_Z);
    const int tid = opaque_v(X.tid), cg = (tid & 63) * 8, r0 = t * 32 + (tid >> 6) * 4;
    const int S = r0 < NP ? 256 : 1024; const int s0 = r0 < NP ? (r0 & 255) : ((r0 - NP) & 1023);
    v4u xc[6], cc[6], bc[4], gc[4];
#pragma unroll
    for (int i = 0; i < 6; ++i) { const int s = s0 - 1 + i; const bool ok = s >= 0 && s < S; const bf16* u = U + (size_t)(r0 - 1 + i) * UO;
        xc[i] = ok ? *(const v4u*)(u + CO_XC + cg) : (v4u){0u, 0u, 0u, 0u}; cc[i] = ok ? *(const v4u*)(u + CO_CC + cg) : (v4u){0u, 0u, 0u, 0u}; }
#pragma unroll
    for (int i = 0; i < 4; ++i) { const bf16* u = U + (size_t)(r0 + i) * UO; bc[i] = *(const v4u*)(u + CO_BC + cg); gc[i] = *(const v4u*)(u + CO_GC + cg); }
    SB_PIN
    float w0[8], w1[8], w2[8], cb[8];
#pragma unroll
    for (int q = 0; q < 2; ++q) { const f32x4 a0 = *(const f32x4*)(a.in[26] + j * 1536 + cg + 4 * q), a1 = *(const f32x4*)(a.in[26] + j * 1536 + 512 + cg + 4 * q),
                                              a2 = *(const f32x4*)(a.in[26] + j * 1536 + 1024 + cg + 4 * q), a3 = *(const f32x4*)(a.in[27] + j * 512 + cg + 4 * q);
#pragma unroll
        for (int e = 0; e < 4; ++e) { w0[4 * q + e] = a0[e]; w1[4 * q + e] = a1[e]; w2[4 * q + e] = a2[e]; cb[4 * q + e] = a3[e]; } }
    float x[6][8];
#pragma unroll
    for (int i = 0; i < 6; ++i) { const unsigned xr[4] = {xc[i].x, xc[i].y, xc[i].z, xc[i].w}, cr[4] = {cc[i].x, cc[i].y, cc[i].z, cc[i].w};
#pragma unroll
        for (int q = 0; q < 4; ++q) { x[i][2 * q] = bflo(xr[q]) * bflo(cr[q]); x[i][2 * q + 1] = bfhi(xr[q]) * bfhi(cr[q]); } }
#pragma unroll
    for (int i = 0; i < 4; ++i) { const unsigned br[4] = {bc[i].x, bc[i].y, bc[i].z, bc[i].w}, gr[4] = {gc[i].x, gc[i].y, gc[i].z, gc[i].w};
        float o[8];
#pragma unroll
        for (int e = 0; e < 8; ++e) { const float bv = (e & 1) ? bfhi(br[e >> 1]) : bflo(br[e >> 1]), gv = (e & 1) ? bfhi(gr[e >> 1]) : bflo(gr[e >> 1]);
            const float cv = x[i][e] * w0[e] + x[i + 1][e] * w1[e] + x[i + 2][e] * w2[e] + cb[e];
            o[e] = bv * cv * silu_f(gv); }
        v4u z; z.x = pk2(o[0], o[1]); z.y = pk2(o[2], o[3]); z.z = pk2(o[4], o[5]); z.w = pk2(o[6], o[7]);
        *(v4u*)(Z + (size_t)(r0 + i) * DM + cg) = z; }
}

constexpr int NPHASES = 21;


#ifndef RU_Q
#define RU_Q 1
#endif
#ifndef RU_KV
#define RU_KV 1
#endif
#ifndef RU_L
#define RU_L 1
#endif
#ifndef RU_ATTS
#define RU_ATTS 1
#endif
#ifndef RU_SCAN
#define RU_SCAN 1
#endif
#ifndef RU_OUT
#define RU_OUT 1
#endif
#ifndef RU_ATTP
#define RU_ATTP 1
#endif
#ifndef RU_NA
#define RU_NA 1
#endif
#ifndef RU_OATT
#define RU_OATT 1
#endif
#ifndef RU_CONV
#define RU_CONV 1
#endif
#ifndef RU_SIDE
#define RU_SIDE 1
#endif
#define REPU(n, call) for (int rp_ = 0; rp_ < (n); ++rp_) { call; }
#define PU(id, stmt) { PROF_BEGIN(id) stmt PROF_END(id) }
__device__ __forceinline__ void phase_gemm1(const Args& a, const Ctx& X, int l) {
    const int j = l >> 1; const bool even = (l & 1) == 0;
    pg8::Gemm g{(const bf16*)(a.ws + WS_H), even ? (const bf16*)(a.ws + WS_WTEV) + (size_t)j * 3584 * 1024 : (const bf16*)(a.ws + WS_WTOD) + (size_t)j * 4096 * 1024, NT, even ? UE : UO, DM};
    pg8::StaticOrder S; S.init(NT, even ? UE : UO, X.G, X.bid, pg8::EpiU::BMA_ROWS);
    pg8::EpiU E{(bf16*)(a.ws + WS_U), even ? UE : UO, even ? (float*)(a.ws + WS_GATES) : nullptr, even ? nullptr : (bf16*)(a.ws + WS_VTO), even ? nullptr : (bf16*)(a.ws + WS_KFO), even ? (bf16*)(a.ws + WS_VFM) : nullptr};
    pg8::gemm_phase<pg8::EpiU, pg8::StaticOrder, true, true>(X.lds, g, S, E);
}
__device__ __forceinline__ void phase_gemm2(const Args& a, const Ctx& X, int l) {
    pg8::Gemm g{(const bf16*)(a.ws + WS_Z), (const bf16*)(a.ws + WS_WTOUT) + (size_t)l * 1024 * 1024, NT, DM, DM};
    pg8::StaticOrder S; S.init(NT, DM, X.G, X.bid, pg8::EpiY::BMA_ROWS);
    pg8::EpiY E{a.out, l == 0 ? a.in[0] : a.out, l == 0 ? a.in[1] : a.out + (size_t)NP * DM, (const float*)(a.ws + WS_MOD) + l * 3 * 3072};
    pg8::gemm_phase<pg8::EpiY, pg8::StaticOrder, true, true>(X.lds, g, S, E);
}
__device__ __forceinline__ void phase_e2(const Args& a, const Ctx& X, int j) {
    for (int u = X.bid; u < 584; u += X.G) {
        if (u < 96) PU(10, REPU(RU_Q, unit_mla_q(a, X, j, u)))
        else if (u < 192) PU(11, REPU(RU_KV, unit_mla_kv(a, X, j, u - 96)))
        else if (u < 200) unit_mla_kv(a, X, j, -1 - (u - 192));
        else { const int v = u - 200; PU(12, REPU(RU_L, unit_mlstm_L(a, X, j, v / 96, v % 96))) }
    }
}
__device__ __forceinline__ void phase_e2b(const Args& a, const Ctx& X, int j) {
    for (int u = X.bid; u < 640; u += X.G) {
        if (u < 256) PU(13, REPU(RU_ATTS, unit_mla_attn(a, X, u)))
        else PU(14, REPU(RU_SCAN, unit_mlstm_scan(a, X, j, u - 256)))
    }
}
__device__ __forceinline__ void phase_e3(const Args& a, const Ctx& X, int j) {
    for (int u = X.bid; u < 640; u += X.G) {
        if (u < 384) PU(15, REPU(RU_OUT, unit_mlstm_out(a, X, j, u / 96, u % 96)))
        else PU(16, REPU(RU_ATTP, unit_mla_attn(a, X, u - 384 + 256)))
    }
}
__device__ __forceinline__ void phase_o2(const Args& a, const Ctx& X, int j) {
    for (int u = X.bid; u < 704; u += X.G) {
        if (u < 256) PU(17, REPU(RU_NA, unit_na(a, X, j, u)))
        else if (u < 512) PU(18, REPU(RU_OATT, unit_odd_attn(a, X, j, u - 256)))
        else PU(19, REPU(RU_CONV, unit_conv(a, X, j, u - 512)))
    }
}


#ifndef REP_P0A
#define REP_P0A 1
#endif
#ifndef REP_NORM
#define REP_NORM 1
#endif
#ifndef REP_G1
#define REP_G1 1
#endif
#ifndef REP_E2
#define REP_E2 1
#endif
#ifndef REP_G2L0
#define REP_G2L0 1
#endif
#ifndef REP_E2B
#define REP_E2B 1
#endif
#ifndef REP_E3
#define REP_E3 1
#endif
#ifndef REP_O2
#define REP_O2 1
#endif
#ifndef PHMASK
#define PHMASK 0x7f
#endif
#define PH_NOP(...) ((void)0)
#if PHMASK & 1
#define PH_P0A phase_p0a
#else
#define PH_P0A PH_NOP
#endif
#if PHMASK & 2
#define PH_NORM phase_norm
#else
#define PH_NORM PH_NOP
#endif
#if PHMASK & 4
#define PH_G1 phase_gemm1
#else
#define PH_G1 PH_NOP
#endif
#if PHMASK & 8
#define PH_E2 phase_e2
#else
#define PH_E2 PH_NOP
#endif
#if PHMASK & 16
#define PH_E3 phase_e3
#define PH_E2B phase_e2b
#else
#define PH_E3 PH_NOP
#define PH_E2B PH_NOP
#endif
#if PHMASK & 32
#define PH_O2 phase_o2
#else
#define PH_O2 PH_NOP
#endif
#if PHMASK & 64
#define PH_G2 phase_gemm2
#else
#define PH_G2 PH_NOP
#endif
__global__ void __launch_bounds__(NTHR, 2) mega_fwd(Args args) {
    extern __shared__ __attribute__((aligned(16))) unsigned char lds[];
    Ctx X; X.lds = (LAS unsigned char*)lds; X.ldsg = lds;
    X.tid = threadIdx.x; X.lane = X.tid & 63; X.wave = __builtin_amdgcn_readfirstlane(X.tid >> 6); X.G = gridDim.x; X.bid = blockIdx.x;
    volatile LAS unsigned* MISC = (volatile LAS unsigned*)(X.lds + MISC_OFF);
    if (X.tid < 32) MISC[X.tid] = 0u;
    __syncthreads();
    const int lo = args.ph_lo, hi = args.ph_hi;
    XcdBarrier bar; bar.bar = (unsigned*)(args.ws + WS_CTL) + CW_BAR; bar.x = 0; bar.st = MISC + 8;
    if (hi - lo > 1) bar = xcd_barrier_post((unsigned*)(args.ws + WS_CTL) + CW_BAR, MISC + 8);
    int ph = 0;
#define RUN(pid, n, body) do { if (ph >= lo && ph < hi) { for (int rp = 0; rp < (n); ++rp) { { PROF_BEGIN(pid) body; PROF_END(pid) } if (ph + 1 < hi || rp + 1 < (n)) { PROF_BEGIN(9) xcd_barrier(bar); PROF_END(9) } } } ++ph; } while (0)
    RUN(1, REP_P0A, PH_P0A(args, X));
    RUN(2, REP_NORM, PH_NORM(args, X, 0));
    for (int l = 0; l < 4; ++l) {
        const int j = l >> 1;
        RUN(3, REP_G1, PH_G1(args, X, l));
        if ((l & 1) == 0) { RUN(4, REP_E2, PH_E2(args, X, j)); RUN(5, REP_E2B, PH_E2B(args, X, j)); RUN(6, REP_E3, PH_E3(args, X, j)); }
        else { RUN(7, REP_O2, PH_O2(args, X, j)); }
        RUN(8, l == 0 ? REP_G2L0 : 1, PH_G2(args, X, l));
        if (l < 3) RUN(2, REP_NORM, PH_NORM(args, X, l + 1));
    }
#undef RUN
    if (PROF_ID != 0 && threadIdx.x == 0) { const unsigned long long t0 = __builtin_amdgcn_s_memrealtime(); const unsigned long long w = (unsigned long long)PROF_K * ((volatile LAS unsigned*)(X.lds + MISC_OFF))[16];
        while (__builtin_amdgcn_s_memrealtime() - t0 < w) __builtin_amdgcn_s_sleep(8); }
}

#ifndef MK_SPLIT
#define MK_SPLIT 0
#endif

extern "C" void kernel_launch(void* const* d_in, const int* in_sizes, int n_in, void* d_out, int out_size, void* d_ws, size_t ws_size, hipStream_t stream) {
    static int ready = 0;
    if (!ready) {
        if (hipFuncSetAttribute((const void*)mega_fwd, hipFuncAttributeMaxDynamicSharedMemorySize, LDS_BYTES) != hipSuccess) fprintf(stderr, "kernel_launch: hipFuncSetAttribute failed\n");
        int per_cu = 0;
        if (hipOccupancyMaxActiveBlocksPerMultiprocessor(&per_cu, (const void*)mega_fwd, NTHR, LDS_BYTES) != hipSuccess || per_cu < 1) fprintf(stderr, "kernel_launch: occupancy query says %d blocks per CU\n", per_cu);
        (void)hipGetLastError();
        ready = 1;
    }
    (void)hipMemsetAsync((char*)d_ws + WS_CTL, 0, CTL_ZERO_BYTES, stream);
    Args a{};
    for (int i = 0; i < 32; ++i) a.in[i] = (const float*)d_in[i];
    a.out = (float*)d_out; a.ws = (unsigned char*)d_ws;
#if MK_SPLIT
    for (int p = 0; p < NPHASES; ++p) { a.ph_lo = p; a.ph_hi = p + 1; hipLaunchKernelGGL(mega_fwd, dim3(256), dim3(NTHR), LDS_BYTES, stream, a); }
#else
    a.ph_lo = 0; a.ph_hi = NPHASES;
    hipLaunchKernelGGL(mega_fwd, dim3(256), dim3(NTHR), LDS_BYTES, stream, a);
#endif
}
```

```cpp
#include <hip/hip_runtime.h>
#include <cstdio>
#include <cstdint>
#include <math.h>

#define GAS __attribute__((address_space(1)))
#define LAS __attribute__((address_space(3)))
typedef unsigned short bf16;
typedef unsigned v4u __attribute__((ext_vector_type(4)));
typedef unsigned v2u __attribute__((ext_vector_type(2)));
typedef float f32x4 __attribute__((ext_vector_type(4)));
typedef float f32x2 __attribute__((ext_vector_type(2)));
typedef float f32x16 __attribute__((ext_vector_type(16)));
typedef short bf16x8 __attribute__((ext_vector_type(8)));
typedef __bf16 bh8 __attribute__((ext_vector_type(8)));
typedef __bf16 bh2 __attribute__((ext_vector_type(2)));
typedef GAS unsigned gu32;
#define RLX_AGENT __ATOMIC_RELAXED, __HIP_MEMORY_SCOPE_AGENT
#define LDS_WAIT() asm volatile("s_waitcnt lgkmcnt(0)" ::: "memory")
#define SB_PIN __builtin_amdgcn_sched_barrier(0);
#define VM_WAIT() asm volatile("s_waitcnt vmcnt(0)" ::: "memory")

constexpr int DM = 1024, NP = 4096, NS = 2048, NT = 6144;
constexpr int UE = 3584, UO = 4096;
constexpr float EPS = 1e-6f;
constexpr int CE_QA = 0, CE_KVA = 256, CE_GA = 384, CE_QM = 896, CE_KM = 1408, CE_VM = 1920, CE_OM = 2432, CE_GM = 2944, CE_KPE = 3456;
constexpr int CO_XC = 0, CO_BC = 512, CO_CC = 1024, CO_GC = 1536, CO_QD = 2048, CO_KD = 2560, CO_VD = 3072, CO_GD = 3584;
constexpr size_t O_Y = 0, O_CKV = 6291456, O_KPE = 7340032, O_C = 7602176, O_N = 11796480, O_M = 11829248, O_NK = 11829504, O_NV = 16023808;
constexpr size_t MiB = 1u << 20;
constexpr size_t WS_CTL = 0, CTL_ZERO_BYTES = 65536;
constexpr size_t WS_ROPE = 65536;
constexpr size_t WS_MOD = 131072;
constexpr size_t WS_AG = 327680;
constexpr size_t WS_WTEV = 1 * MiB;
constexpr size_t WS_WTOD = 17 * MiB;
constexpr size_t WS_WTOUT = 33 * MiB;
constexpr size_t WS_WTQB = 41 * MiB;
constexpr size_t WS_WTKVB = 42 * MiB;
constexpr size_t WS_NAKC = 43 * MiB;
constexpr size_t WS_NAVC = 44 * MiB;
constexpr size_t WS_C0T = 45 * MiB;
constexpr size_t WS_H = 47 * MiB;
constexpr size_t WS_U = 59 * MiB;
constexpr size_t WS_Z = 107 * MiB;
constexpr size_t WS_GATES = 119 * MiB;
constexpr size_t WS_Q = 120 * MiB;
constexpr size_t WS_KM = 129 * MiB;
constexpr size_t WS_VTM = 139 * MiB;
constexpr size_t WS_VTO = 146 * MiB;
constexpr size_t WS_LT = 152 * MiB;
constexpr size_t WS_NL = 200 * MiB;
constexpr size_t WS_CTB = 201 * MiB;
constexpr size_t WS_NPV = 225 * MiB;
constexpr size_t WS_MPV = 226 * MiB;
constexpr size_t WS_KFO = 227 * MiB;
constexpr size_t WS_VFM = 234 * MiB;
constexpr size_t WS_GQ = 241 * MiB;
constexpr int KROWS = 6656;

__device__ __forceinline__ unsigned pk2(float lo, float hi) { f32x2 v = {lo, hi}; bh2 b = __builtin_convertvector(v, bh2); return __builtin_bit_cast(unsigned, b); }
__device__ __forceinline__ float bf2f(unsigned u16) { return __builtin_bit_cast(float, u16 << 16); }
__device__ __forceinline__ float bflo(unsigned u) { return __builtin_bit_cast(float, u << 16); }
__device__ __forceinline__ float bfhi(unsigned u) { return __builtin_bit_cast(float, u & 0xffff0000u); }
__device__ __forceinline__ float silu_f(float x) { return x / (1.f + __expf(-x)); }
__device__ __forceinline__ float sigmoid_f(float x) { return 1.f / (1.f + __expf(-x)); }
__device__ __forceinline__ float logsigmoid_f(float x) { return fminf(x, 0.f) - log1pf(expf(-fabsf(x))); }
__device__ __forceinline__ int cond_of_row(int r) { return r < NP ? 0 : 1 + ((r - NP) >> 10); }
__device__ __forceinline__ float wave_sum(float v) {
#pragma unroll
    for (int o = 1; o < 64; o <<= 1) v += __shfl_xor(v, o);
    return v;
}
__device__ __forceinline__ float wave_max(float v) {
#pragma unroll
    for (int o = 1; o < 64; o <<= 1) v = fmaxf(v, __shfl_xor(v, o));
    return v;
}
__device__ __forceinline__ f32x16 mfma32(bh8 a, bh8 b, f32x16 c) { return __builtin_amdgcn_mfma_f32_32x32x16_bf16(a, b, c, 0, 0, 0); }
__device__ __forceinline__ bh8 ld16(const bf16* p) { return *(const bh8*)p; }
__device__ __forceinline__ bh8 ld2x8(const bf16* p0, const bf16* p1) { v2u a = *(const v2u*)p0, b = *(const v2u*)p1; v4u v = {a.x, a.y, b.x, b.y}; return __builtin_bit_cast(bh8, v); }
__device__ __forceinline__ bh8 pfrag(const f32x16& p, int s) {
    v4u v; v.x = pk2(p[8 * s + 0], p[8 * s + 1]); v.y = pk2(p[8 * s + 2], p[8 * s + 3]); v.z = pk2(p[8 * s + 4], p[8 * s + 5]); v.w = pk2(p[8 * s + 6], p[8 * s + 7]);
    return __builtin_bit_cast(bh8, v);
}
__device__ __forceinline__ int crow(int i, int hh) { return (i & 3) + 8 * (i >> 2) + 4 * hh; }
__device__ __forceinline__ void st4bf(bf16* p, float a, float b, float c, float d) { v2u v; v.x = pk2(a, b); v.y = pk2(c, d); *(v2u*)p = v; }

namespace pg8 {
#define PG8_LAS __attribute__((address_space(3)))
typedef unsigned short bf16_t;
typedef short bf16x8 __attribute__((ext_vector_type(8)));
typedef float f32x4 __attribute__((ext_vector_type(4)));
typedef unsigned u32x4 __attribute__((ext_vector_type(4)));
constexpr int BM = 256, BK = 64, HALF = 128, HTB = HALF * BK * 2  , STAGE_BYTES = 8 * HTB, NXCD = 8, WGM = 8;

__host__ __device__ __forceinline__ int lds_byte(int r, int c) { const int st = (r >> 4) * 2 + (c >> 5), rr = r & 15, cc = c & 31, ob = rr * 64 + cc * 2; return st * 1024 + (ob ^ (((ob >> 9) & 1) << 5)); }
__host__ __device__ __forceinline__ void stage_rc(int b, int& R, int& C) { const int st = b / 1024, sb = b % 1024, swz = sb ^ (((sb >> 9) & 1) << 5); R = (st >> 1) * 16 + swz / 64; C = (st & 1) * 32 + (swz % 64) / 2; }
__host__ __device__ __forceinline__ int perm32(int rho) { const int n = rho >> 4, i = rho & 15; return 8 * (i >> 2) + 4 * n + (i & 3); }

struct Unit { int pm, pn; };
struct Gemm { const bf16_t* A; const bf16_t* Bt; int M, N, K; };

struct StaticOrder {
    int nM, nN, nwg, G, c;
    __host__ __device__ void init(int M, int N, int G_, int c_, int bma) { nM = M / bma; nN = N / BM; nwg = nM * nN; G = G_; c = c_; }
    __host__ __device__ bool next(int i, Unit& u) const {
        const long L = (long)i * G + c; if (L >= nwg) return false;
        int wgid = (int)L; { const int q = nwg / NXCD, r = nwg % NXCD, xcd = wgid % NXCD, off = wgid / NXCD; wgid = (xcd < r ? xcd * (q + 1) : r * (q + 1) + (xcd - r) * q) + off; }
        const int nig = WGM * nN, gid = wgid / nig, fm = gid * WGM, gsz = (nM - fm) < WGM ? (nM - fm) : WGM;
        u.pm = fm + ((wgid % nig) % gsz); u.pn = (wgid % nig) / gsz; return true;
    }
    __device__ __forceinline__ void a_ready(const Unit&) const {}
    __device__ __forceinline__ void done(const Unit&) const {}
};

__device__ __forceinline__ int pg8_opaque(int x) { asm volatile("" : "+v"(x)); return x; }
__device__ __forceinline__ unsigned cvt_pk_bf16(float lo, float hi) { unsigned r; asm volatile("v_cvt_pk_bf16_f32 %0, %1, %2" : "=v"(r) : "v"(lo), "v"(hi)); return r; }

struct EpiU {
    static constexpr bool PERM = true, AFTER_DRAIN = false; static constexpr int BMA_ROWS = 192, BMA = BMA_ROWS, HA = BMA / 2, MA = HA / 32, WRA = HA / 2;
    bf16_t* U; int ldu; float* gates; bf16_t* vto; bf16_t* kfo; bf16_t* vfm;
    __device__ __forceinline__ void operator()(const f32x4 (&acc)[2][2][4][2], const Unit& u, int wr, int wc, int fr, int fq) const {
        const int row0 = u.pm * BMA + wr * WRA + fr, col0 = u.pn * BM + wc * 32 + 8 * fq;
        const bool dog = gates != nullptr && u.pn == 13 && wc == 1 && fq < 2;
        const bool dov = vto != nullptr && (u.pn == 12 || u.pn == 13);
        const bool dok = kfo != nullptr && (u.pn == 10 || u.pn == 11);
        const bool dom = vfm != nullptr && u.pn >= 7 && u.pn <= 9;
#pragma unroll
        for (int ai = 0; ai < 2; ++ai)
#pragma unroll
            for (int m = 0; m < MA; ++m) {
                const int row = row0 + ai * HA + m * 16;
#pragma unroll
                for (int bj = 0; bj < 2; ++bj) {
                    const f32x4 v0 = acc[ai][bj][m][0], v1 = acc[ai][bj][m][1];
                    const int col = col0 + bj * HALF;
                    u32x4 w; w.x = cvt_pk_bf16(v0[0], v0[1]); w.y = cvt_pk_bf16(v0[2], v0[3]); w.z = cvt_pk_bf16(v1[0], v1[1]); w.w = cvt_pk_bf16(v1[2], v1[3]);
                    *(u32x4*)(U + (size_t)row * ldu + col) = w;
                    if (bj == 1 && dog) { float* g = gates + (size_t)row * 16 + 8 * fq; *(f32x4*)g = v0; *(f32x4*)(g + 4) = v1; }
                    if (dom && col >= 1920 && col < 2432) { const int cc = col - 1920, hd = cc >> 7, ev = cc & 127, t16 = row & 15;
                        bf16_t* vp = vfm + ((size_t)((row >> 5) * 4 + hd) * 8 + (ev >> 5) * 2 + ((row >> 4) & 1)) * 512 + (((t16 >> 2) & 1) * 32 + (ev & 31)) * 8 + 4 * (t16 >> 3) + (t16 & 3);
                        vp[0] = (bf16_t)(w.x & 0xffffu); vp[8] = (bf16_t)(w.x >> 16); vp[16] = (bf16_t)(w.y & 0xffffu); vp[24] = (bf16_t)(w.y >> 16);
                        vp[32] = (bf16_t)(w.z & 0xffffu); vp[40] = (bf16_t)(w.z >> 16); vp[48] = (bf16_t)(w.w & 0xffffu); vp[56] = (bf16_t)(w.w >> 16);
                    }
                    if (dok) { const int cc = col - 2560, hd = cc >> 6, d = cc & 63;
                        *(u32x4*)(kfo + ((size_t)((row >> 5) * 8 + hd) * 4 + (d >> 4)) * 512 + (((d >> 3) & 1) * 32 + (row & 31)) * 8) = w; }
                    if (dov) { const int cc = col - 3072, hd = cc >> 6, dv = cc & 63, t16 = row & 15;
                        bf16_t* vp = vto + ((size_t)((row >> 5) * 8 + hd) * 4 + (dv >> 5) * 2 + ((row >> 4) & 1)) * 512 + (((t16 >> 2) & 1) * 32 + (dv & 31)) * 8 + 4 * (t16 >> 3) + (t16 & 3);
                        vp[0] = (bf16_t)(w.x & 0xffffu); vp[8] = (bf16_t)(w.x >> 16); vp[16] = (bf16_t)(w.y & 0xffffu); vp[24] = (bf16_t)(w.y >> 16);
                        vp[32] = (bf16_t)(w.z & 0xffffu); vp[40] = (bf16_t)(w.z >> 16); vp[48] = (bf16_t)(w.w & 0xffffu); vp[56] = (bf16_t)(w.w >> 16);
                    }
                }
            }
    }
};

struct EpiY {
    static constexpr bool PERM = true, AFTER_DRAIN = false; static constexpr int BMA_ROWS = 128, BMA = BMA_ROWS, HA = BMA / 2, MA = HA / 32, WRA = HA / 2;
    float* Y; const float* ysp; const float* yss; const float* mod_l;
    __device__ __forceinline__ void operator()(const f32x4 (&acc)[2][2][4][2], const Unit& u, int wr, int wc, int fr, int fq) const {
        const int row0 = u.pm * BMA + wr * WRA + fr, col0 = u.pn * BM + wc * 32 + 8 * fq;
#pragma unroll
        for (int bj = 0; bj < 2; ++bj) {
            const int col = col0 + bj * HALF;
#pragma unroll
            for (int ai = 0; ai < 2; ++ai)
#pragma unroll
                for (int m = 0; m < MA; ++m) {
                    const int row = row0 + ai * HA + m * 16;
                    const float* gp = mod_l + (row < 4096 ? 0 : (row < 5120 ? 1 : 2)) * 3072 + 2048 + col;
                    const f32x4 g0 = *(const f32x4*)gp, g1 = *(const f32x4*)(gp + 4);
                    const float* src = (row < 4096 ? ysp + (size_t)row * 1024 : yss + (size_t)(row - 4096) * 1024) + col;
                    const f32x4 y0 = *(const f32x4*)src, y1 = *(const f32x4*)(src + 4);
                    float* dst = Y + (size_t)row * 1024 + col;
                    *(f32x4*)dst = y0 + g0 * acc[ai][bj][m][0];
                    *(f32x4*)(dst + 4) = y1 + g1 * acc[ai][bj][m][1];
                }
        }
    }
};

template <class Epi, class Sched, bool ALIGN_EPI = false, bool SP2 = false>
__device__ __forceinline__ void gemm_phase(PG8_LAS unsigned char* lds, const Gemm g, const Sched& S, const Epi& E) {
    constexpr int BMA = Epi::BMA_ROWS, HA = BMA / 2, MA = HA / 32, WRA = HA / 2;
    const int tid = pg8_opaque((int)threadIdx.x), wid = __builtin_amdgcn_readfirstlane(tid >> 6), lane = tid & 63, wr = wid >> 2, wc = wid & 3, fr = lane & 15, fq = lane >> 4;
    const int K = g.K, nt = K / BK;
    unsigned voffA[2], voffB[2];
#pragma unroll
    for (int i = 0; i < 2; ++i) { int R, C; stage_rc(tid * 16 + i * 8192, R, C); const int Rb = Epi::PERM ? ((R & ~31) + perm32(R & 31)) : R;
        voffA[i] = (unsigned)(R * K + C) * 2u; voffB[i] = (unsigned)(Rb * K + C) * 2u; }
    const size_t kstep = (size_t)(BK * 2);
    const size_t hstep = (size_t)HALF * K * 2;
    const size_t tstep = 2 * hstep;
    const size_t hstepA = (size_t)HA * K * 2, tstepA = 2 * hstepA;
    const unsigned ldsw = (unsigned)wid * 1024u;
    const int aoff = lds_byte(wr * WRA + fr, fq * 8), boff = lds_byte(wc * 32 + fr, fq * 8);
#define PG8_SA(b, h) (((b) * 2 + (h)) * HTB)
#define PG8_SB(b, h) ((4 + (b) * 2 + (h)) * HTB)
#define PG8_STAGE(bufoff, gbase, voff) do { _Pragma("unroll") for (int _i = 0; _i < 2; ++_i) \
        __builtin_amdgcn_global_load_lds((const unsigned*)((const char*)(gbase) + (voff)[_i]), (PG8_LAS unsigned*)(lds + (bufoff) + ldsw + _i * 8192), 16, 0, 0); } while (0)
#define PG8_LDA(dst, b, h) do { _Pragma("unroll") for (int m = 0; m < MA; ++m) _Pragma("unroll") for (int k = 0; k < 2; ++k) dst[m][k] = *(const PG8_LAS bf16x8*)(lds + PG8_SA(b, h) + aoff + m * 2048 + k * 1024); } while (0)
#define PG8_LDB(dst, b, h) do { _Pragma("unroll") for (int n = 0; n < 2; ++n) _Pragma("unroll") for (int k = 0; k < 2; ++k) dst[n][k] = *(const PG8_LAS bf16x8*)(lds + PG8_SB(b, h) + boff + n * 2048 + k * 1024); } while (0)
#define PG8_MMA(ai, bj, At, Bt) do { __builtin_amdgcn_s_setprio(1); _Pragma("unroll") for (int m = 0; m < MA; ++m) _Pragma("unroll") for (int n = 0; n < 2; ++n) _Pragma("unroll") for (int k = 0; k < 2; ++k) \
        acc[ai][bj][m][n] = __builtin_amdgcn_mfma_f32_16x16x32_bf16(Bt[n][k], At[m][k], acc[ai][bj][m][n], 0, 0, 0); __builtin_amdgcn_s_setprio(0); } while (0)
#define PG8_WAIT_V(n) asm volatile("s_waitcnt vmcnt(" #n ")" ::: "memory")
#define PG8_WAIT_L(n) asm volatile("s_waitcnt lgkmcnt(" #n ")" ::: "memory")
#define PG8_BAR __builtin_amdgcn_s_barrier()
#define PG8_SCHED __builtin_amdgcn_sched_barrier(0)
    Unit cur, nxt; int ui = 0;
    if (!S.next(0, cur)) return;
    f32x4 acc[2][2][4][2];
#pragma unroll
    for (int a = 0; a < 2; ++a)
#pragma unroll
        for (int b = 0; b < 2; ++b)
#pragma unroll
            for (int m = 0; m < MA; ++m)
#pragma unroll
                for (int n = 0; n < 2; ++n) acc[a][b][m][n] = (f32x4){0.f, 0.f, 0.f, 0.f};
    bf16x8 At[4][2], B0[2][2], B1[2][2];
    const char* cA = (const char*)g.A + (size_t)cur.pm * tstepA; const char* cB = (const char*)g.Bt + (size_t)cur.pn * tstep;
    S.a_ready(cur);
    if constexpr (SP2) {
        PG8_STAGE(PG8_SB(0, 0), cB, voffB); PG8_STAGE(PG8_SB(0, 1), cB + hstep, voffB); PG8_STAGE(PG8_SA(0, 0), cA, voffA); PG8_STAGE(PG8_SA(0, 1), cA + hstepA, voffA);
        if (wr == 1) PG8_BAR;
        PG8_WAIT_V(2); PG8_BAR;
        PG8_STAGE(PG8_SB(1, 0), cB + kstep, voffB); PG8_STAGE(PG8_SA(1, 0), cA + kstep, voffA); PG8_STAGE(PG8_SB(1, 1), cB + hstep + kstep, voffB);
        PG8_WAIT_V(6); PG8_BAR;
    } else {
        PG8_STAGE(PG8_SB(0, 0), cB, voffB); PG8_STAGE(PG8_SA(0, 0), cA, voffA); PG8_STAGE(PG8_SB(0, 1), cB + hstep, voffB); PG8_STAGE(PG8_SA(0, 1), cA + hstepA, voffA);
        if (wr == 1) PG8_BAR;
        PG8_WAIT_V(4); PG8_BAR;
        PG8_STAGE(PG8_SB(1, 0), cB + kstep, voffB); PG8_STAGE(PG8_SA(1, 0), cA + kstep, voffA); PG8_STAGE(PG8_SB(1, 1), cB + hstep + kstep, voffB);
        PG8_WAIT_V(6); PG8_BAR;
    }
    for (;;) {
        const bool has_next = S.next(ui + 1, nxt);
        const char* nA = has_next ? (const char*)g.A + (size_t)nxt.pm * tstepA : cA; const char* nB = has_next ? (const char*)g.Bt + (size_t)nxt.pn * tstep : cB;
        for (int t = 0; t < nt; t += 2) {
            const bool last = (t == nt - 2);
            const char* a1 = cA + (size_t)(t + 1) * kstep;
            const char* a2 = last ? nA : cA + (size_t)(t + 2) * kstep; const char* b2 = last ? nB : cB + (size_t)(t + 2) * kstep;
            const char* a3 = a2 + kstep; const char* b3 = b2 + kstep;
            if (last && has_next) S.a_ready(nxt);
            if constexpr (SP2) {
            PG8_LDB(B0, 0, 0); PG8_LDB(B1, 0, 1); PG8_SCHED; PG8_LDA(At, 0, 0); PG8_STAGE(PG8_SA(1, 1), a1 + hstepA, voffA);
            PG8_WAIT_V(8); PG8_WAIT_L(0); PG8_BAR; PG8_MMA(0, 0, At, B0); PG8_MMA(0, 1, At, B1); PG8_BAR; PG8_SCHED;
            PG8_LDA(At, 0, 1); PG8_STAGE(PG8_SB(0, 0), b2, voffB); PG8_STAGE(PG8_SB(0, 1), b2 + hstep, voffB); PG8_STAGE(PG8_SA(0, 0), a2, voffA);
            PG8_WAIT_V(8); PG8_WAIT_L(0); PG8_BAR; PG8_MMA(1, 0, At, B0); PG8_MMA(1, 1, At, B1); PG8_BAR; PG8_SCHED;
            PG8_LDB(B0, 1, 0); PG8_LDB(B1, 1, 1); PG8_SCHED; PG8_LDA(At, 1, 0); PG8_STAGE(PG8_SA(0, 1), a2 + hstepA, voffA);
            PG8_WAIT_V(8); PG8_WAIT_L(0); PG8_BAR; PG8_MMA(0, 0, At, B0); PG8_MMA(0, 1, At, B1); PG8_BAR; PG8_SCHED;
            PG8_LDA(At, 1, 1); PG8_STAGE(PG8_SB(1, 0), b3, voffB); PG8_STAGE(PG8_SB(1, 1), b3 + hstep, voffB); PG8_STAGE(PG8_SA(1, 0), a3, voffA);
            PG8_WAIT_V(8); PG8_WAIT_L(0); PG8_BAR; PG8_MMA(1, 0, At, B0); PG8_MMA(1, 1, At, B1); PG8_BAR; PG8_SCHED;
            } else {
            PG8_LDB(B0, 0, 0); PG8_SCHED; PG8_LDA(At, 0, 0); PG8_STAGE(PG8_SA(1, 1), a1 + hstepA, voffA);
            PG8_WAIT_L(8); PG8_BAR; PG8_WAIT_L(0); PG8_MMA(0, 0, At, B0); PG8_BAR; PG8_SCHED;
            PG8_LDB(B1, 0, 1); PG8_STAGE(PG8_SB(0, 0), b2, voffB);
            PG8_BAR; PG8_WAIT_L(0); PG8_MMA(0, 1, At, B1); PG8_BAR;
            PG8_LDA(At, 0, 1); PG8_STAGE(PG8_SA(0, 0), a2, voffA);
            PG8_BAR; PG8_WAIT_L(0); PG8_MMA(1, 0, At, B0); PG8_BAR; PG8_SCHED;
            PG8_STAGE(PG8_SB(0, 1), b2 + hstep, voffB);
            PG8_WAIT_V(6); PG8_BAR; PG8_MMA(1, 1, At, B1); PG8_BAR;
            PG8_LDB(B0, 1, 0); PG8_SCHED; PG8_LDA(At, 1, 0); PG8_STAGE(PG8_SA(0, 1), a2 + hstepA, voffA);
            PG8_WAIT_L(8); PG8_BAR; PG8_WAIT_L(0); PG8_MMA(0, 0, At, B0); PG8_BAR; PG8_SCHED;
            PG8_LDB(B1, 1, 1); PG8_STAGE(PG8_SB(1, 0), b3, voffB);
            PG8_BAR; PG8_WAIT_L(0); PG8_MMA(0, 1, At, B1); PG8_BAR;
            PG8_LDA(At, 1, 1); PG8_STAGE(PG8_SA(1, 0), a3, voffA);
            PG8_BAR; PG8_WAIT_L(0); PG8_MMA(1, 0, At, B0); PG8_BAR; PG8_SCHED;
            PG8_STAGE(PG8_SB(1, 1), b3 + hstep, voffB);
            PG8_WAIT_V(6); PG8_BAR; PG8_MMA(1, 1, At, B1); PG8_BAR;
            }
        }
        if constexpr (ALIGN_EPI) { if (wr == 0) PG8_BAR; }
        if constexpr (!Epi::AFTER_DRAIN) { E(acc, cur, wr, wc, fr, fq); S.done(cur); }
        if (!has_next) break;
#pragma unroll
        for (int a = 0; a < 2; ++a)
#pragma unroll
            for (int b = 0; b < 2; ++b)
#pragma unroll
                for (int m = 0; m < MA; ++m)
#pragma unroll
                    for (int n = 0; n < 2; ++n) acc[a][b][m][n] = (f32x4){0.f, 0.f, 0.f, 0.f};
        cur = nxt; cA = nA; cB = nB; ++ui;
        if constexpr (ALIGN_EPI) { if (wr == 1) PG8_BAR; }
    }
    PG8_WAIT_V(0);
    if constexpr (!ALIGN_EPI) { if (wr == 0) PG8_BAR; }
    PG8_BAR;
    if constexpr (Epi::AFTER_DRAIN) { E.fused(acc, cur, wr, wc, fr, fq, lds, wid, lane); S.done(cur); }
#undef PG8_SA
#undef PG8_SB
#undef PG8_STAGE
#undef PG8_LDA
#undef PG8_LDB
#undef PG8_MMA
#undef PG8_WAIT_V
#undef PG8_WAIT_L
#undef PG8_BAR
#undef PG8_SCHED
}
}
#define XB_TMO      128
#define XB_XCNT(j)  (256  + 64 * (j))
#define XB_XSUB(j)  (1280 + 64 * (j))
#define XB_XGEN(j)  (2304 + 64 * (j))
#define XB_TOP      3328
#define XB_TOPGEN   3392
#define XCD_BAR_WORDS 3456
#define XB_SPIN_CAP (1u << 18)

__device__ __forceinline__ unsigned xb_ld(unsigned* p)              { return __hip_atomic_load(p, __ATOMIC_RELAXED, __HIP_MEMORY_SCOPE_AGENT); }
__device__ __forceinline__ unsigned xb_add(unsigned* p, unsigned v) { return __hip_atomic_fetch_add(p, v, __ATOMIC_RELAXED, __HIP_MEMORY_SCOPE_AGENT); }
__device__ __forceinline__ unsigned xb_xcc_id() { return (unsigned)__builtin_amdgcn_s_getreg((3 << 11) | 20) & 0xFu; }
#define XB_SPIN(cond, bar) do { unsigned _sp = 0; while (cond) { __builtin_amdgcn_s_sleep(1); \
    if ((++_sp & 255u) == 0u) { if (xb_ld(&(bar)[XB_TMO])) break; if (_sp > XB_SPIN_CAP) { atomicAdd(&(bar)[XB_TMO], 1u); break; } } } } while (0)

struct XcdBarrier {
    unsigned* bar; unsigned x;
    volatile LAS unsigned* st;
};

__device__ __forceinline__ XcdBarrier xcd_barrier_post(unsigned* bar, volatile LAS unsigned* st) {
    XcdBarrier b; b.bar = bar; b.x = xb_xcc_id(); b.st = st;
    if (threadIdx.x == 0) (void)xb_add(&bar[XB_XCNT(b.x)], 1u);
    return b;
}
__device__ __forceinline__ void xcd_barrier_complete(unsigned* bar, unsigned x, unsigned& nloc, unsigned& nx) {
    const unsigned G = gridDim.x * gridDim.y * gridDim.z;
    unsigned sum, cnt, mine, sp = 0u;
    for (;;) {
        sum = 0u; cnt = 0u; mine = 0u;
#pragma unroll
        for (unsigned j = 0; j < 16; ++j) { const unsigned c = xb_ld(&bar[XB_XCNT(j)]); sum += c; cnt += (c > 0u) ? 1u : 0u; mine = (j == x) ? c : mine; }
        if (sum == G) break;
        __builtin_amdgcn_s_sleep(1);
        if ((++sp & 255u) == 0u) { if (xb_ld(&bar[XB_TMO])) break; if (sp > XB_SPIN_CAP) { atomicAdd(&bar[XB_TMO], 1u); break; } }
    }
    nloc = mine > 0u ? mine : 1u; nx = cnt > 0u ? cnt : 1u;
}

__device__ __forceinline__ void xcd_barrier(const XcdBarrier& b) {
    asm volatile("s_waitcnt vmcnt(0)" ::: "memory");
    __syncthreads();
    if (threadIdx.x == 0) {
        unsigned* bar = b.bar;
        __builtin_amdgcn_s_waitcnt(0);
        unsigned nloc = b.st[0], nx = b.st[1];
        if (nloc == 0u) { xcd_barrier_complete(bar, b.x, nloc, nx); b.st[0] = nloc; b.st[1] = nx; }
        const unsigned old = xb_add(&bar[XB_XSUB(b.x)], 1u);
        const unsigned gen = old / nloc;
        if (old + 1u == (gen + 1u) * nloc) {
            __builtin_amdgcn_fence(__ATOMIC_RELEASE, "agent");
            asm volatile("s_waitcnt vmcnt(0)" ::: "memory");
            const unsigned og = xb_add(&bar[XB_TOP], 1u);
            const unsigned tg = og / nx;
            if (og + 1u == (tg + 1u) * nx) xb_add(&bar[XB_TOPGEN], 1u);
            else XB_SPIN(xb_ld(&bar[XB_TOPGEN]) == tg, bar);
            __builtin_amdgcn_fence(__ATOMIC_ACQUIRE, "agent");
            xb_add(&bar[XB_XGEN(b.x)], 1u);
            asm volatile("s_waitcnt vmcnt(0)" ::: "memory");
        } else {
            XB_SPIN(xb_ld(&bar[XB_XGEN(b.x)]) == gen, bar);
            __builtin_amdgcn_fence(__ATOMIC_ACQUIRE, "agent");
            asm volatile("s_waitcnt vmcnt(0)" ::: "memory");
        }
    }
    __syncthreads();
}

constexpr int NWAVES = 8, NTHR = 512;
constexpr int LDS_BYTES = 147456;
constexpr int MISC_OFF = 147456 - 256;
constexpr int CW_BAR = 4096;

struct Args {
    const float* in[32];
    float* out;
    unsigned char* ws;
    int ph_lo, ph_hi;
};

struct Ctx {
    LAS unsigned char* lds;
    unsigned char* ldsg;
    int tid, lane, wave, G, bid;
};


#ifndef PROF_ID
#define PROF_ID 0
#endif
#ifndef PROF_K
#define PROF_K 8
#endif
#define PROF_BEGIN(id) unsigned long long pt0_##id = 0; if (PROF_ID == (id)) pt0_##id = __builtin_amdgcn_s_memrealtime();
#define PROF_END(id) if (PROF_ID == (id) && threadIdx.x == 0) { const unsigned dt_ = (unsigned)(__builtin_amdgcn_s_memrealtime() - pt0_##id); ((volatile LAS unsigned*)(X.lds + MISC_OFF))[16] += dt_; }

__device__ __forceinline__ int opaque_v(int x) { asm volatile("" : "+v"(x)); return x; }
__device__ __forceinline__ int opaque_s(int x) { asm volatile("" : "+s"(x)); return x; }
__device__ __forceinline__ int map_even(int dg) {
    if (dg < 24) return dg;
    if (dg < 152) return dg + 2;
    if (dg < 216) return dg + 3;
    if (dg < 218) return dg - 192;
    if (dg == 218) return 154;
    return -1;
}
__device__ __forceinline__ void transpose_item(const float* W, int ldn, int K, bf16* WT, int k0, int n0, int ca, int cb, LAS float* scr, int lane, bool frag = false) {
    const int n = lane & 31; const int sc = (n < 16) ? ca : cb;
    float tv[32];
#pragma unroll
    for (int i = 0; i < 32; ++i) { const int kk = 2 * i + (lane >> 5); tv[i] = sc >= 0 ? W[(size_t)(k0 + kk) * ldn + sc + (n & 15)] : 0.f; }
    SB_PIN
#pragma unroll
    for (int i = 0; i < 32; ++i) { const int kk = 2 * i + (lane >> 5); scr[kk * 33 + n] = tv[i]; }
    LDS_WAIT(); asm volatile("" ::: "memory");
    const int c = lane & 7;
#pragma unroll
    for (int j = 0; j < 4; ++j) { const int nn = (lane >> 3) + 8 * j; const LAS float* s = scr + (8 * c) * 33 + nn;
        v4u o; o.x = pk2(s[0 * 33], s[1 * 33]); o.y = pk2(s[2 * 33], s[3 * 33]); o.z = pk2(s[4 * 33], s[5 * 33]); o.w = pk2(s[6 * 33], s[7 * 33]);
        bf16* dst = frag ? WT + ((size_t)((n0 + nn) >> 5) * (K >> 4) + ((k0 + 8 * c) >> 4)) * 512 + ((((k0 + 8 * c) >> 3) & 1) * 32 + ((n0 + nn) & 31)) * 8 : WT + (size_t)(n0 + nn) * K + k0 + 8 * c;
        *(v4u*)dst = o; }
    LDS_WAIT(); asm volatile("" ::: "memory");
}

__device__ __forceinline__ void mod_unit(const Args& a, const Ctx& X, int l, int chunk, int tid, int lane, int wave) {
    LAS float* scs = (LAS float*)X.lds;
    LAS float* part = scs + 3072;
    const float* c_ctx = a.in[10]; const float* c = a.in[2];
    for (int i = tid; i < 3072; i += NTHR) { const int r = i >> 10, k = i & 1023; const float v = r == 0 ? c_ctx[k] : c[(r - 1) * 1024 + k]; scs[i] = v / (1.f + expf(-v)); }
    __syncthreads();
    const int j0 = chunk * 64;
    const float* w = a.in[12] + (size_t)l * 1024 * 3072 + j0 + lane;
    float a0 = 0.f, a1 = 0.f, a2 = 0.f;
#pragma unroll 32
    for (int kk = 0; kk < 128; ++kk) { const int k = wave * 128 + kk; const float wv = w[(size_t)k * 3072]; a0 += scs[k] * wv; a1 += scs[1024 + k] * wv; a2 += scs[2048 + k] * wv; }
    part[(wave * 3 + 0) * 64 + lane] = a0; part[(wave * 3 + 1) * 64 + lane] = a1; part[(wave * 3 + 2) * 64 + lane] = a2;
    __syncthreads();
    if (tid < 192) { const int r = tid >> 6, cc = tid & 63; float s = 0.f;
#pragma unroll
        for (int w8 = 0; w8 < 8; ++w8) s += part[(w8 * 3 + r) * 64 + cc];
        ((float*)(a.ws + WS_MOD))[(l * 3 + r) * 3072 + j0 + cc] = s + a.in[13][l * 3072 + j0 + cc]; }
    __syncthreads();
}
__device__ __forceinline__ void prep_weights(const Args& a, const Ctx& X, int l, int gw, int NGW, int lane, int wave) {
    unsigned char* ws = a.ws;
    LAS float* scr = (LAS float*)(X.lds + 32768 + wave * 8448);
    const int j = l >> 1;
    if ((l & 1) == 0) {
        for (int it = gw; it < 2464; it += NGW) {
            if (it < 1792) { const int nb = it % 112, kb = it / 112;
                transpose_item(a.in[14] + (size_t)j * 1024 * 3504, 3504, 1024, (bf16*)(ws + WS_WTEV) + (size_t)j * 3584 * 1024, kb * 64, nb * 32,
                               map_even(2 * nb) < 0 ? -1 : map_even(2 * nb) * 16, map_even(2 * nb + 1) < 0 ? -1 : map_even(2 * nb + 1) * 16, scr, lane);
            } else if (it < 2304) { const int r = it - 1792, nb = r % 32, kb = r / 32;
                transpose_item(a.in[24] + (size_t)j * 1024 * 1024, 1024, 1024, (bf16*)(ws + WS_WTOUT) + (size_t)l * 1024 * 1024, kb * 64, nb * 32, nb * 32, nb * 32 + 16, scr, lane);
            } else if (it < 2400) { const int r = it - 2304, nb = r % 24, kb = r / 24;
                transpose_item(a.in[17] + (size_t)j * 256 * 768, 768, 256, (bf16*)(ws + WS_WTQB) + (size_t)j * 768 * 256, kb * 64, nb * 32, nb * 32, nb * 32 + 16, scr, lane, true);
            } else { const int r = it - 2400, nb = r % 32, kb = r / 32;
                transpose_item(a.in[18] + (size_t)j * 128 * 1024, 1024, 128, (bf16*)(ws + WS_WTKVB) + (size_t)j * 1024 * 128, kb * 64, nb * 32, nb * 32, nb * 32 + 16, scr, lane, true);
            }
        }
    } else {
        for (int it = gw; it < 2560; it += NGW) {
            if (it < 2048) { const int nb = it % 128, kb = it / 128;
                transpose_item(a.in[25] + (size_t)j * 1024 * 4096, 4096, 1024, (bf16*)(ws + WS_WTOD) + (size_t)j * 4096 * 1024, kb * 64, nb * 32, nb * 32, nb * 32 + 16, scr, lane);
            } else { const int r = it - 2048, nb = r % 32, kb = r / 32;
                transpose_item(a.in[31] + (size_t)j * 1024 * 1024, 1024, 1024, (bf16*)(ws + WS_WTOUT) + (size_t)l * 1024 * 1024, kb * 64, nb * 32, nb * 32, nb * 32 + 16, scr, lane);
            }
        }
    }
}
__device__ __forceinline__ void phase_p0a(const Args& a, const Ctx& X) {
    unsigned char* ws = a.ws;
    const int tid = opaque_v(X.tid), lane = tid & 63, wave = opaque_s(X.wave);
    if (X.bid < 192) mod_unit(a, X, X.bid / 48, X.bid % 48, tid, lane, wave);
    else if (X.bid == 192) {
        const int pos = tid >> 3, f = tid & 7;
        const float ang = (float)pos * powf(10000.f, -(float)f / 8.f);
        float* rt = (float*)(ws + WS_ROPE);
        rt[pos * 16 + f] = cosf(ang); rt[pos * 16 + 8 + f] = sinf(ang);
    } else {
        const int nb = X.G - 193, b0 = X.bid - 193;
        const float* ck = a.in[8]; const float* cv = a.in[9]; const float* c0 = a.in[5];
        bf16* nakc = (bf16*)(ws + WS_NAKC); bf16* navc = (bf16*)(ws + WS_NAVC); float* c0t = (float*)(ws + WS_C0T);
#pragma unroll 4
        for (int idx = b0 * NTHR + tid; idx < 524288; idx += nb * NTHR) {
            const int d = idx & 63, h = (idx >> 6) & 7, key = (idx >> 9) & 255, bj = idx >> 17;
            { const size_t blk = ((size_t)(bj * 8 + h) * 8 + (key >> 5)) * 4; const int kr = key & 31, t16 = key & 15;
              nakc[(blk + (d >> 4)) * 512 + (((d >> 3) & 1) * 32 + kr) * 8 + (d & 7)] = (bf16)(pk2(ck[idx] / a.in[29][(bj & 1) * 64 + d], 0.f) & 0xffffu);
              navc[(blk + (d >> 5) * 2 + (kr >> 4)) * 512 + (((t16 >> 2) & 1) * 32 + (d & 31)) * 8 + 4 * (t16 >> 3) + (t16 & 3)] = (bf16)(pk2(cv[idx], 0.f) & 0xffffu); }
            const int e = idx & 127, dd = (idx >> 7) & 127, mat = idx >> 14;
            c0t[(size_t)mat * 16384 + e * 128 + dd] = c0[idx];
        }
    }
    for (int l = 0; l < 4; ++l) prep_weights(a, X, l, X.bid * NWAVES + wave, X.G * NWAVES, lane, wave);
}
__device__ __forceinline__ void gemm2_side(const Args& a, const Ctx& X, int l) {
    const int tid = opaque_v(X.tid), lane = tid & 63, wave = opaque_s(X.wave), idx = X.bid - 96;
    if (idx < 48) mod_unit(a, X, l + 1, idx, tid, lane, wave);
    prep_weights(a, X, l + 1, idx * NWAVES + wave, (X.G - 96) * NWAVES, lane, wave);
}

__device__ __forceinline__ void phase_norm(const Args& a, const Ctx& X, int l) {
    const float* ysp = l == 0 ? a.in[0] : a.out; const float* yss = l == 0 ? a.in[1] : a.out + (size_t)NP * DM;
    const float* nw = a.in[11] + l * DM;
    const float* modl = (const float*)(a.ws + WS_MOD) + l * 3 * 3072;
    bf16* H = (bf16*)(a.ws + WS_H);
    const int lane = opaque_v(X.tid) & 63; const int gw = X.bid * NWAVES + opaque_s(X.wave), NGW = X.G * NWAVES;
    f32x4 v[3][4];
#pragma unroll
    for (int q = 0; q < 3; ++q) { const int r = gw + q * NGW; const float* y = r < NP ? ysp + (size_t)r * DM : yss + (size_t)(r - NP) * DM;
#pragma unroll
        for (int j = 0; j < 4; ++j) v[q][j] = r < NT ? *(const f32x4*)(y + 4 * lane + 256 * j) : (f32x4){0.f, 0.f, 0.f, 0.f}; }
    SB_PIN
#pragma unroll
    for (int q = 0; q < 3; ++q) { const int r = gw + q * NGW; if (r < NT) {
        const float* md = modl + cond_of_row(r) * 3072;
        float ss = 0.f;
#pragma unroll
        for (int j = 0; j < 4; ++j) ss += (v[q][j].x * v[q][j].x + v[q][j].y * v[q][j].y) + (v[q][j].z * v[q][j].z + v[q][j].w * v[q][j].w);
        const float rstd = rsqrtf(wave_sum(ss) * (1.f / DM) + EPS);
#pragma unroll
        for (int j = 0; j < 4; ++j) { const int k = 4 * lane + 256 * j;
            const f32x4 g = *(const f32x4*)(nw + k), sh = *(const f32x4*)(md + k), sc = *(const f32x4*)(md + 1024 + k);
            const f32x4 o = v[q][j] * rstd * g * (sc + 1.f) + sh;
            st4bf(H + (size_t)r * DM + k, o.x, o.y, o.z, o.w); }
    } }
}

__device__ __forceinline__ void unit_mla_q(const Args& a, const Ctx& X, int j, int t) {
    const bf16* U = (const bf16*)(a.ws + WS_U); bf16* Q = (bf16*)(a.ws + WS_Q);
    const bf16* Wq = (const bf16*)(a.ws + WS_WTQB) + (size_t)j * 768 * 256;
    const float* rope = (const float*)(a.ws + WS_ROPE);
    const float* qan = a.in[15] + j * 256; const float* qn = a.in[19] + j * 96;
    bf16* Xn = (bf16*)X.ldsg;
    const int tid = opaque_v(X.tid), lane = tid & 63, w = opaque_s(X.wave), r = lane & 31, hh = lane >> 5, R0 = t * 64; (void)tid;
    PROF_BEGIN(20)
    { v2u raw8[8]; const f32x4 g = *(const f32x4*)(qan + 4 * lane);
#pragma unroll
      for (int i = 0; i < 8; ++i) raw8[i] = *(const v2u*)(U + (size_t)(R0 + 8 * w + i) * UE + CE_QA + 4 * lane);
      SB_PIN
#pragma unroll
      for (int i = 0; i < 8; ++i) { const int row = 8 * w + i; const v2u raw = raw8[i];
        const float x0 = bflo(raw.x), x1 = bfhi(raw.x), x2 = bflo(raw.y), x3 = bfhi(raw.y);
        const float rstd = rsqrtf(wave_sum(x0 * x0 + x1 * x1 + x2 * x2 + x3 * x3) * (1.f / 256.f) + EPS);
        st4bf(Xn + row * 264 + 4 * lane, x0 * rstd * g.x, x1 * rstd * g.y, x2 * rstd * g.z, x3 * rstd * g.w); } }
    __syncthreads();
    PROF_END(20)
    PROF_BEGIN(21)
    f32x16 acc[3][2];
#pragma unroll
    for (int fb = 0; fb < 3; ++fb)
#pragma unroll
        for (int tb = 0; tb < 2; ++tb)
#pragma unroll
            for (int i = 0; i < 16; ++i) acc[fb][tb][i] = 0.f;
    const bf16* wp = Wq + (size_t)(w * 3) * 16 * 512 + lane * 8;
    const bf16* xp = Xn + r * 264 + 8 * hh;
#pragma unroll
    for (int kh = 0; kh < 4; ++kh) {
        bh8 af[4][3];
#pragma unroll
        for (int k8 = 0; k8 < 4; ++k8)
#pragma unroll
            for (int fb = 0; fb < 3; ++fb) af[k8][fb] = ld16(wp + (size_t)(fb * 16 + kh * 4 + k8) * 512);
        SB_PIN
#pragma unroll
        for (int k8 = 0; k8 < 4; ++k8) { const int ks = kh * 4 + k8; bh8 bfr[2];
#pragma unroll
            for (int tb = 0; tb < 2; ++tb) bfr[tb] = ld16(xp + tb * 32 * 264 + 16 * ks);
#pragma unroll
            for (int fb = 0; fb < 3; ++fb)
#pragma unroll
                for (int tb = 0; tb < 2; ++tb) acc[fb][tb] = mfma32(af[k8][fb], bfr[tb], acc[fb][tb]); }
        SB_PIN
    }
    PROF_END(21)
    PROF_BEGIN(22)
#pragma unroll
    for (int tb = 0; tb < 2; ++tb) {
        float ss = 0.f;
#pragma unroll
        for (int fb = 0; fb < 3; ++fb)
#pragma unroll
            for (int i = 0; i < 16; ++i) ss += acc[fb][tb][i] * acc[fb][tb][i];
        ss += __shfl_xor(ss, 32);
        const float rstd = rsqrtf(ss * (1.f / 96.f) + EPS) * (0.10206207261596577f * 1.4426950408889634f);
        const int row = R0 + 32 * tb + r;
        const bool sample = row >= NP; const int tp = (row - NP) & 1023;
#pragma unroll
        for (int fb = 0; fb < 3; ++fb) {
            float v[16];
#pragma unroll
            for (int g = 0; g < 4; ++g) { const f32x4 gn = *(const f32x4*)(qn + 32 * fb + 8 * g + 4 * hh);
                v[4 * g + 0] = acc[fb][tb][4 * g + 0] * rstd * gn.x; v[4 * g + 1] = acc[fb][tb][4 * g + 1] * rstd * gn.y;
                v[4 * g + 2] = acc[fb][tb][4 * g + 2] * rstd * gn.z; v[4 * g + 3] = acc[fb][tb][4 * g + 3] * rstd * gn.w; }
            if (fb == 2 && sample) {
                const float* rr_ = rope + (tp >> 6) * 16 + 4 * hh; const float* rc_ = rope + (tp & 63) * 16 + 4 * hh;
#pragma unroll
                for (int e = 0; e < 4; ++e) {
                    float cs = rr_[e], sn = rr_[8 + e], x1 = v[e], x2 = v[4 + e];
                    v[e] = x1 * cs - x2 * sn; v[4 + e] = x1 * sn + x2 * cs;
                    cs = rc_[e]; sn = rc_[8 + e]; x1 = v[8 + e]; x2 = v[12 + e];
                    v[8 + e] = x1 * cs - x2 * sn; v[12 + e] = x1 * sn + x2 * cs;
                }
            }
#pragma unroll
            for (int g = 0; g < 4; ++g) st4bf(Q + (size_t)row * 768 + w * 96 + 32 * fb + 8 * g + 4 * hh, v[4 * g], v[4 * g + 1], v[4 * g + 2], v[4 * g + 3]);
        }
    }
    __syncthreads();    PROF_END(22)
}

__device__ __forceinline__ void unit_mla_kv(const Args& a, const Ctx& X, int j, int t) {
    const bf16* U = (const bf16*)(a.ws + WS_U); bf16* KM = (bf16*)(a.ws + WS_KM); bf16* VTM = (bf16*)(a.ws + WS_VTM);
    const bf16* Wkv = (const bf16*)(a.ws + WS_WTKVB) + (size_t)j * 1024 * 128;
    const float* rope = (const float*)(a.ws + WS_ROPE);
    const float* kvan = a.in[16] + j * 128; const float* kn = a.in[20] + j * 96;
    bf16* Xc = (bf16*)X.ldsg;
    float* kpes = (float*)(X.ldsg + 17408);
    const int tid = opaque_v(X.tid), lane = tid & 63, w = opaque_s(X.wave), r = lane & 31, hh = lane >> 5; (void)tid;
    const bool own = t >= 0;
    int R0 = 0, krow0, bs = 0;
    if (own) { R0 = t * 64; if (R0 < NP) krow0 = R0; else { bs = (R0 - NP) >> 10; krow0 = NP + bs * 1280 + 256 + ((R0 - NP) & 1023); } }
    else { const int ct = -1 - t; bs = ct >> 2; krow0 = NP + bs * 1280 + (ct & 3) * 64; }
    { unsigned raw8[8]; float kp8[8]; f32x2 c8[8];
      if (own) {
#pragma unroll
          for (int i = 0; i < 8; ++i) { raw8[i] = *(const unsigned*)(U + (size_t)(R0 + 8 * w + i) * UE + CE_KVA + 2 * lane);
              kp8[i] = lane < 32 ? bf2f(U[(size_t)(R0 + 8 * w + i) * UE + CE_KPE + lane]) : 0.f; }
      } else {
#pragma unroll
          for (int i = 0; i < 8; ++i) { const int s = ((-1 - t) & 3) * 64 + 8 * w + i; const size_t o = (size_t)(bs * 2 + j) * 256 + s;
              c8[i] = *(const f32x2*)(a.in[3] + o * 128 + 2 * lane); kp8[i] = lane < 32 ? a.in[4][o * 32 + lane] : 0.f; }
      }
      const f32x2 g = *(const f32x2*)(kvan + 2 * lane);
      SB_PIN
#pragma unroll
      for (int i = 0; i < 8; ++i) { const int row = 8 * w + i;
        if (own) {
            const float x0 = bflo(raw8[i]), x1 = bfhi(raw8[i]);
            const float rstd = rsqrtf(wave_sum(x0 * x0 + x1 * x1) * (1.f / 128.f) + EPS);
            const float c0 = x0 * rstd * g.x, c1 = x1 * rstd * g.y;
            *(unsigned*)(Xc + row * 136 + 2 * lane) = pk2(c0, c1);
            if (lane < 32) kpes[row * 32 + lane] = kp8[i];
            if (R0 < NP) { const int b = (R0 + row) >> 8, s = (R0 + row) & 255; const size_t o = (size_t)(b * 2 + j) * 256 + s;
                *(f32x2*)(a.out + O_CKV + o * 128 + 2 * lane) = (f32x2){c0, c1};
                if (lane < 32) a.out[O_KPE + o * 32 + lane] = kp8[i]; }
        } else {
            *(unsigned*)(Xc + row * 136 + 2 * lane) = pk2(c8[i].x, c8[i].y);
            if (lane < 32) kpes[row * 32 + lane] = kp8[i];
        } } }
    __syncthreads();
    f32x16 ak[2][2], av[2][2];
#pragma unroll
    for (int x = 0; x < 2; ++x)
#pragma unroll
        for (int y = 0; y < 2; ++y)
#pragma unroll
            for (int i = 0; i < 16; ++i) { ak[x][y][i] = 0.f; av[x][y][i] = 0.f; }
    const bf16* wp = Wkv + (size_t)(w * 4) * 8 * 512 + lane * 8;
    const bf16* xp = Xc + r * 136 + 8 * hh;
#pragma unroll
    for (int kh = 0; kh < 2; ++kh) { bh8 wk[4][2], wv[4][2];
#pragma unroll
      for (int k4 = 0; k4 < 4; ++k4)
#pragma unroll
          for (int fb = 0; fb < 2; ++fb) { wk[k4][fb] = ld16(wp + (size_t)(fb * 8 + kh * 4 + k4) * 512); wv[k4][fb] = ld16(wp + (size_t)((2 + fb) * 8 + kh * 4 + k4) * 512); }
      SB_PIN
#pragma unroll
      for (int k4 = 0; k4 < 4; ++k4) { const int ks = kh * 4 + k4; bh8 xf[2];
#pragma unroll
          for (int tb = 0; tb < 2; ++tb) xf[tb] = ld16(xp + tb * 32 * 136 + 16 * ks);
#pragma unroll
          for (int fb = 0; fb < 2; ++fb)
#pragma unroll
              for (int tb = 0; tb < 2; ++tb) { ak[fb][tb] = mfma32(wk[k4][fb], xf[tb], ak[fb][tb]); av[tb][fb] = mfma32(xf[tb], wv[k4][fb], av[tb][fb]); } }
      SB_PIN }
    const bool sample_own = own && R0 >= NP;
#pragma unroll
    for (int tb = 0; tb < 2; ++tb) {
        const int tok = 32 * tb + r;
        float kp[16]; float ss = 0.f;
#pragma unroll
        for (int g = 0; g < 4; ++g) { const f32x4 q4 = *(const f32x4*)(kpes + tok * 32 + 16 * hh + 4 * g); kp[4 * g] = q4.x; kp[4 * g + 1] = q4.y; kp[4 * g + 2] = q4.z; kp[4 * g + 3] = q4.w; }
#pragma unroll
        for (int i = 0; i < 16; ++i) ss += kp[i] * kp[i] + ak[0][tb][i] * ak[0][tb][i] + ak[1][tb][i] * ak[1][tb][i];
        ss += __shfl_xor(ss, 32);
        const float rstd = rsqrtf(ss * (1.f / 96.f) + EPS);
        bf16* kdst = KM + ((size_t)(((krow0 >> 5) + tb) * 8 + w) * 6) * 512 + r * 8;
#pragma unroll
        for (int fb = 0; fb < 2; ++fb)
#pragma unroll
            for (int g = 0; g < 4; ++g) { const int f0 = 32 * fb + 8 * g + 4 * hh; const f32x4 gn = *(const f32x4*)(kn + f0);
                st4bf(kdst + (2 * fb + (g >> 1)) * 512 + (g & 1) * 256 + 4 * hh, ak[fb][tb][4 * g] * rstd * gn.x, ak[fb][tb][4 * g + 1] * rstd * gn.y, ak[fb][tb][4 * g + 2] * rstd * gn.z, ak[fb][tb][4 * g + 3] * rstd * gn.w); }
#pragma unroll
        for (int g = 0; g < 4; ++g) { const f32x4 gn = *(const f32x4*)(kn + 64 + 16 * hh + 4 * g);
            kp[4 * g] *= rstd * gn.x; kp[4 * g + 1] *= rstd * gn.y; kp[4 * g + 2] *= rstd * gn.z; kp[4 * g + 3] *= rstd * gn.w; }
        if (sample_own) {
            const int tp = (R0 - NP + tok) & 1023; const int pos = hh == 0 ? (tp >> 6) : (tp & 63);
            const float* rp = rope + pos * 16;
#pragma unroll
            for (int i = 0; i < 8; ++i) { const float cs = rp[i], sn = rp[8 + i], x1 = kp[i], x2 = kp[8 + i]; kp[i] = x1 * cs - x2 * sn; kp[8 + i] = x1 * sn + x2 * cs; }
        }
#pragma unroll
        for (int g = 0; g < 4; ++g) st4bf(kdst + (4 + hh) * 512 + (g >> 1) * 256 + 4 * (g & 1), kp[4 * g], kp[4 * g + 1], kp[4 * g + 2], kp[4 * g + 3]);
#pragma unroll
        for (int fb = 0; fb < 2; ++fb) { bf16* vdst = VTM + ((size_t)(((krow0 >> 5) + tb) * 8 + w) * 4 + 2 * fb) * 512 + (hh * 32 + r) * 8;
#pragma unroll
            for (int g = 0; g < 4; ++g) st4bf(vdst + (g >> 1) * 512 + 4 * (g & 1), av[tb][fb][4 * g], av[tb][fb][4 * g + 1], av[tb][fb][4 * g + 2], av[tb][fb][4 * g + 3]); }
    }
    __syncthreads();
}

struct AttnState { f32x16 o0, o1; float m, l; };
__device__ __forceinline__ void attn_init(AttnState& st) {
#pragma unroll
    for (int i = 0; i < 16; ++i) { st.o0[i] = 0.f; st.o1[i] = 0.f; }
    st.m = -1e30f; st.l = 0.f;
}
template <int NKS> struct KVf { bh8 k[NKS]; bh8 v[4]; };
template <int NKS> __device__ __forceinline__ void load_kv(KVf<NKS>& f, const bf16* kp, const bf16* vp) {
#pragma unroll
    for (int ks = 0; ks < NKS; ++ks) f.k[ks] = ld16(kp + ks * 512);
#pragma unroll
    for (int q = 0; q < 4; ++q) f.v[q] = ld16(vp + q * 512);
}
template <int NKS, bool MASKED>
__device__ __forceinline__ void attn_compute(AttnState& st, const bh8* qf, const KVf<NKS>& f, const float* rk, int hh, bool na, int kc0, int dr, int cq, int c0, const float* rpbs) {
    f32x16 s;
#pragma unroll
    for (int i = 0; i < 16; ++i) s[i] = 0.f;
#pragma unroll
    for (int ks = 0; ks < NKS; ++ks) s = mfma32(f.k[ks], qf[ks], s);
    if (rk) {
#pragma unroll
        for (int g = 0; g < 4; ++g) { const f32x4 rv = *(const f32x4*)(rk + 8 * g + 4 * hh); s[4 * g] *= rv.x; s[4 * g + 1] *= rv.y; s[4 * g + 2] *= rv.z; s[4 * g + 3] *= rv.w; }
    }
    if (MASKED && na) {
#pragma unroll
        for (int i = 0; i < 16; ++i) { const int kc = kc0 + crow(i, hh); const bool ok = kc >= c0 && kc < c0 + 16;
            int dc = kc - cq; dc = dc < -15 ? -15 : (dc > 15 ? 15 : dc);
            s[i] = ok ? s[i] + rpbs[dr * 31 + dc + 15] : -1e30f; }
    }
    float mx = fmaxf(fmaxf(s[0], s[1]), s[2]);
#pragma unroll
    for (int i = 3; i < 15; i += 2) mx = fmaxf(fmaxf(mx, s[i]), s[i + 1]);
    mx = fmaxf(mx, s[15]);
    mx = fmaxf(mx, __shfl_xor(mx, 32));
    const float mn = fmaxf(st.m, mx);
    if (__builtin_amdgcn_ballot_w64(mn > st.m) != 0ull) {
        const float alpha = __builtin_amdgcn_exp2f(st.m - mn);
        st.l *= alpha;
#pragma unroll
        for (int i = 0; i < 16; ++i) { st.o0[i] *= alpha; st.o1[i] *= alpha; }
        st.m = mn;
    }
    float ps = 0.f;
#pragma unroll
    for (int i = 0; i < 16; ++i) { float p = __builtin_amdgcn_exp2f(s[i] - mn); if (MASKED) p = s[i] > -1e29f ? p : 0.f; s[i] = p; ps += p; }
    st.l += ps;
    const bh8 p0 = pfrag(s, 0), p1 = pfrag(s, 1);
    st.o0 = mfma32(f.v[0], p0, st.o0); st.o0 = mfma32(f.v[1], p1, st.o0);
    st.o1 = mfma32(f.v[2], p0, st.o1); st.o1 = mfma32(f.v[3], p1, st.o1);
}
template <int KS>
__device__ __forceinline__ void attn_merge_store(AttnState& st, float* part, int w, int lane, const v4u* gpre, bf16* zp) {
    const int r = lane & 31, hh = lane >> 5;
    float* mine = part + w * 2048; float* ml = part + 8 * 2048;
#pragma unroll
    for (int i = 0; i < 16; ++i) { mine[crow(i, hh) * 32 + r] = st.o0[i]; mine[(32 + crow(i, hh)) * 32 + r] = st.o1[i]; }
    const float lt = st.l + __shfl_xor(st.l, 32);
    if (hh == 0) { ml[(w * 2) * 32 + r] = st.m; ml[(w * 2 + 1) * 32 + r] = lt; }
    __syncthreads();
    const int qb = w / KS, kp = w % KS;
    float f[KS]; float ms = -1e30f, L = 0.f;
#pragma unroll
    for (int k = 0; k < KS; ++k) ms = fmaxf(ms, ml[((qb * KS + k) * 2) * 32 + r]);
#pragma unroll
    for (int k = 0; k < KS; ++k) { f[k] = __builtin_amdgcn_exp2f(ml[((qb * KS + k) * 2) * 32 + r] - ms); L += f[k] * ml[((qb * KS + k) * 2 + 1) * 32 + r]; }
    const float inv = 1.f / L;
    constexpr int ND = 32 / KS;
    const int dv0 = (64 / KS) * kp + ND * hh;
#pragma unroll
    for (int c = 0; c < ND / 8; ++c) {
        float o[8];
#pragma unroll
        for (int e = 0; e < 8; ++e) { float v = 0.f;
#pragma unroll
            for (int k = 0; k < KS; ++k) v += f[k] * part[(qb * KS + k) * 2048 + (dv0 + 8 * c + e) * 32 + r];
            o[e] = v * inv; }
        const v4u gr = gpre[c];
        v4u z; z.x = pk2(o[0] * silu_f(bflo(gr.x)), o[1] * silu_f(bfhi(gr.x))); z.y = pk2(o[2] * silu_f(bflo(gr.y)), o[3] * silu_f(bfhi(gr.y)));
        z.z = pk2(o[4] * silu_f(bflo(gr.z)), o[5] * silu_f(bfhi(gr.z))); z.w = pk2(o[6] * silu_f(bflo(gr.w)), o[7] * silu_f(bfhi(gr.w)));
        *(v4u*)(zp + dv0 + 8 * c) = z;
    }
    __syncthreads();
}

template <int KS> __device__ __forceinline__ void attn_gate_prefetch(v4u* gpre, const bf16* gp, int w, int lane) {
    constexpr int ND = 32 / KS; const int dv0 = (64 / KS) * (w % KS) + ND * (lane >> 5);
#pragma unroll
    for (int c = 0; c < ND / 8; ++c) gpre[c] = *(const v4u*)(gp + dv0 + 8 * c);
}

__device__ __forceinline__ void unit_mla_attn(const Args& a, const Ctx& X, int u) {
    const bf16* U = (const bf16*)(a.ws + WS_U); const bf16* Q = (const bf16*)(a.ws + WS_Q); const bf16* KM = (const bf16*)(a.ws + WS_KM); const bf16* VTM = (const bf16*)(a.ws + WS_VTM);
    bf16* Z = (bf16*)(a.ws + WS_Z);
    const int tid = opaque_v(X.tid), lane = tid & 63, w = opaque_s(X.wave), r = lane & 31, hh = lane >> 5;
    int h, q0, kb0, nkb; const bool samp = u < 256;
    if (samp) { const int bs = u >> 7, qg = u & 15; h = (u >> 4) & 7; q0 = NP + bs * 1024 + 64 * qg + 32 * (w >> 2); kb0 = NP + bs * 1280 + 320 * (w & 3); nkb = 10; }
    else { const int v = u - 256, b = v >> 4, qh = v & 1; h = (v >> 1) & 7; q0 = b * 256 + 128 * qh + 32 * (w >> 1); kb0 = b * 256 + 128 * (w & 1); nkb = 4; }
    PROF_BEGIN(30)
    bh8 qf[6];
#pragma unroll
    for (int ks = 0; ks < 6; ++ks) qf[ks] = ld16(Q + (size_t)(q0 + r) * 768 + h * 96 + 16 * ks + 8 * hh);
    AttnState st; attn_init(st);
    v4u gpre[2];
    { const bf16* gp = U + (size_t)(q0 + r) * UE + CE_GA + h * 64; if (samp) attn_gate_prefetch<4>(gpre, gp, w, lane); else attn_gate_prefetch<2>(gpre, gp, w, lane); }
    const bf16* kp = KM + ((size_t)((kb0 >> 5) * 8 + h) * 6) * 512 + lane * 8;
    const bf16* vp = VTM + ((size_t)((kb0 >> 5) * 8 + h) * 4) * 512 + lane * 8;
    KVf<6> fa, fb;
    load_kv<6>(fa, kp, vp);
    PROF_END(30)
    PROF_BEGIN(31)
    for (int kb = 0; kb < nkb; kb += 2) {
        load_kv<6>(fb, kp + (size_t)(kb + 1) * 8 * 6 * 512, vp + (size_t)(kb + 1) * 8 * 4 * 512);
        SB_PIN
        attn_compute<6, false>(st, qf, fa, nullptr, hh, false, 0, 0, 0, 0, nullptr);
        if (kb + 2 < nkb) load_kv<6>(fa, kp + (size_t)(kb + 2) * 8 * 6 * 512, vp + (size_t)(kb + 2) * 8 * 4 * 512);
        SB_PIN
        attn_compute<6, false>(st, qf, fb, nullptr, hh, false, 0, 0, 0, 0, nullptr);
    }
    PROF_END(31)
    PROF_BEGIN(32)
    const int row = q0 + r;
    if (samp) attn_merge_store<4>(st, (float*)X.ldsg, w, lane, gpre, Z + (size_t)row * DM + h * 64);
    else attn_merge_store<2>(st, (float*)X.ldsg, w, lane, gpre, Z + (size_t)row * DM + h * 64);
    PROF_END(32)
}

__device__ __forceinline__ void load_q64(const bf16* qrow  , const float* qnorm, const float* knorm, int hh, bh8* qa) {
    float x[4][8]; float ss = 0.f;
#pragma unroll
    for (int ks = 0; ks < 4; ++ks) { const v4u raw = *(const v4u*)(qrow + 16 * ks + 8 * hh);
        x[ks][0] = bflo(raw.x); x[ks][1] = bfhi(raw.x); x[ks][2] = bflo(raw.y); x[ks][3] = bfhi(raw.y); x[ks][4] = bflo(raw.z); x[ks][5] = bfhi(raw.z); x[ks][6] = bflo(raw.w); x[ks][7] = bfhi(raw.w);
#pragma unroll
        for (int e = 0; e < 8; ++e) ss += x[ks][e] * x[ks][e]; }
    ss += __shfl_xor(ss, 32);
    const float rstd = rsqrtf(ss * (1.f / 64.f) + EPS) * (0.125f * 1.4426950408889634f);
#pragma unroll
    for (int ks = 0; ks < 4; ++ks) { float ya[8];
#pragma unroll
        for (int e = 0; e < 8; ++e) { const int d = 16 * ks + 8 * hh + e; ya[e] = x[ks][e] * rstd * qnorm[d] * knorm[d]; }
        v4u va; va.x = pk2(ya[0], ya[1]); va.y = pk2(ya[2], ya[3]); va.z = pk2(ya[4], ya[5]); va.w = pk2(ya[6], ya[7]);
        qa[ks] = __builtin_bit_cast(bh8, va); }
}

__device__ __forceinline__ void unit_odd_attn(const Args& a, const Ctx& X, int j, int u) {
    const bf16* U = (const bf16*)(a.ws + WS_U); const bf16* VTO = (const bf16*)(a.ws + WS_VTO); bf16* Z = (bf16*)(a.ws + WS_Z);
    const float* qnorm = a.in[28] + j * 64; const float* knorm = a.in[29] + j * 64;
    float* part = (float*)X.ldsg; float* rk = part + 8 * 2048 + 512;
    const int b = u >> 4, h = (u >> 1) & 7, qh = u & 1, tid = opaque_v(X.tid), lane = tid & 63, w = opaque_s(X.wave), r = lane & 31, hh = lane >> 5, R0 = b * 256;
    PROF_BEGIN(26)
    { const int key = tid >> 1, half = tid & 1;
      const bf16* kp = U + (size_t)(R0 + key) * UO + CO_KD + h * 64 + 32 * half;
      float kx[32]; float ss = 0.f;
#pragma unroll
      for (int q = 0; q < 4; ++q) { const v4u kr = *(const v4u*)(kp + 8 * q);
          kx[8 * q] = bflo(kr.x); kx[8 * q + 1] = bfhi(kr.x); kx[8 * q + 2] = bflo(kr.y); kx[8 * q + 3] = bfhi(kr.y); kx[8 * q + 4] = bflo(kr.z); kx[8 * q + 5] = bfhi(kr.z); kx[8 * q + 6] = bflo(kr.w); kx[8 * q + 7] = bfhi(kr.w); }
#pragma unroll
      for (int e = 0; e < 32; ++e) ss += kx[e] * kx[e];
      ss += __shfl_xor(ss, 1);
      const float rstd = rsqrtf(ss * (1.f / 64.f) + EPS);
      if (half == 0) rk[key] = rstd;
      if (qh == 0) {
          const bf16* vp = U + (size_t)(R0 + key) * UO + CO_VD + h * 64 + 32 * half;
          float* ok = a.out + O_NK + ((size_t)(b * 2 + j) * 256 + key) * 512 + h * 64 + 32 * half; float* ov = a.out + O_NV + ((size_t)(b * 2 + j) * 256 + key) * 512 + h * 64 + 32 * half;
#pragma unroll
          for (int q = 0; q < 8; ++q) { const f32x4 g = *(const f32x4*)(knorm + 32 * half + 4 * q);
              *(f32x4*)(ok + 4 * q) = (f32x4){kx[4 * q] * rstd * g.x, kx[4 * q + 1] * rstd * g.y, kx[4 * q + 2] * rstd * g.z, kx[4 * q + 3] * rstd * g.w}; }
#pragma unroll
          for (int q = 0; q < 4; ++q) { const v4u vr = *(const v4u*)(vp + 8 * q);
              *(f32x4*)(ov + 8 * q) = (f32x4){bflo(vr.x), bfhi(vr.x), bflo(vr.y), bfhi(vr.y)}; *(f32x4*)(ov + 8 * q + 4) = (f32x4){bflo(vr.z), bfhi(vr.z), bflo(vr.w), bfhi(vr.w)}; }
      } }
    __syncthreads();
    PROF_END(26)
    PROF_BEGIN(27)
    const int row = R0 + 128 * qh + 32 * (w >> 1) + r, kb0 = R0 + 128 * (w & 1);
    bh8 qa[4];
    load_q64(U + (size_t)row * UO + CO_QD + h * 64, qnorm, knorm, hh, qa);
    AttnState st; attn_init(st);
    v4u gpre[2]; attn_gate_prefetch<2>(gpre, U + (size_t)row * UO + CO_GD + h * 64, w, lane);
    const bf16* kp = (const bf16*)(a.ws + WS_KFO) + ((size_t)((kb0 >> 5) * 8 + h) * 4) * 512 + lane * 8;
    const bf16* vp = VTO + ((size_t)((kb0 >> 5) * 8 + h) * 4) * 512 + lane * 8;
    const float* rkp = rk + 128 * (w & 1);
    KVf<4> fa, fb;
    load_kv<4>(fa, kp, vp);
#pragma unroll
    for (int kb = 0; kb < 4; kb += 2) {
        load_kv<4>(fb, kp + (size_t)(kb + 1) * 8 * 4 * 512, vp + (size_t)(kb + 1) * 8 * 4 * 512);
        SB_PIN
        attn_compute<4, false>(st, qa, fa, rkp + 32 * kb, hh, false, 0, 0, 0, 0, nullptr);
        if (kb + 2 < 4) load_kv<4>(fa, kp + (size_t)(kb + 2) * 8 * 4 * 512, vp + (size_t)(kb + 2) * 8 * 4 * 512);
        SB_PIN
        attn_compute<4, false>(st, qa, fb, rkp + 32 * (kb + 1), hh, false, 0, 0, 0, 0, nullptr);
    }
    PROF_END(27)
    PROF_BEGIN(28)
    attn_merge_store<2>(st, part, w, lane, gpre, Z + (size_t)row * DM + 512 + h * 64);
    PROF_END(28)
}

__device__ __forceinline__ void na_block_ptrs(int g, int rb, int R0s, int h, int lane, const bf16* KFO, const bf16* VFO, const bf16* kc, const bf16* vc,
                                              const bf16*& kp, const bf16*& vp, int& rki, bool& win, int& kc0, int& bi) {
    if (g < 8) { kp = kc + (size_t)g * 4 * 512 + lane * 8; vp = vc + (size_t)g * 4 * 512 + lane * 8; rki = 512 + 32 * g; win = false; kc0 = 0; bi = 0; }
    else { const int i = (g - 8) >> 1, xk = g & 1; const int tok0 = (rb + i) * 64 + 32 * xk; const size_t blk = ((size_t)(((R0s + tok0) >> 5) * 8 + h) * 4) * 512 + lane * 8;
        kp = KFO + blk; vp = VFO + blk; rki = i * 64 + 32 * xk; win = true; kc0 = 32 * xk; bi = i; }
}
__device__ __forceinline__ void unit_na(const Args& a, const Ctx& X, int j, int u) {
    const bf16* U = (const bf16*)(a.ws + WS_U); const bf16* VTO = (const bf16*)(a.ws + WS_VTO); bf16* Z = (bf16*)(a.ws + WS_Z);
    const float* qnorm = a.in[28] + j * 64; const float* knorm = a.in[29] + j * 64;
    float* part = (float*)X.ldsg; float* rk = part + 8 * 2048 + 512;
    float* rpbs = rk + 768;
    const int bs = u >> 7, h = (u >> 4) & 7, rr = u & 15, tid = opaque_v(X.tid), lane = tid & 63, w = opaque_s(X.wave), r = lane & 31, hh = lane >> 5, R0s = NP + bs * 1024;
    const int rb = rr - 4 < 0 ? 0 : (rr - 4 > 8 ? 8 : rr - 4);
    { const bf16* kp = U + (size_t)(R0s + rb * 64 + tid) * UO + CO_KD + h * 64; float ss = 0.f;
#pragma unroll
      for (int q = 0; q < 8; ++q) { const v4u kr = *(const v4u*)(kp + 8 * q);
          const float k0 = bflo(kr.x), k1 = bfhi(kr.x), k2 = bflo(kr.y), k3 = bfhi(kr.y), k4 = bflo(kr.z), k5 = bfhi(kr.z), k6 = bflo(kr.w), k7 = bfhi(kr.w);
          ss += (k0 * k0 + k1 * k1) + (k2 * k2 + k3 * k3) + (k4 * k4 + k5 * k5) + (k6 * k6 + k7 * k7); }
      rk[tid] = rsqrtf(ss * (1.f / 64.f) + EPS);
      if (tid < 256) rk[512 + tid] = 1.f;
      if (tid < 465) rpbs[tid] = a.in[30][(size_t)(j * 8 + h) * 465 + tid] * 1.4426950408889634f; }
    __syncthreads();
    const int xq = w >> 2, kpart = w & 3, tok = rr * 64 + 32 * xq + r, cq = 32 * xq + r;
    const int c0 = cq - 8 < 0 ? 0 : (cq - 8 > 48 ? 48 : cq - 8);
    const int row = R0s + tok;
    bh8 qa[4];
    load_q64(U + (size_t)row * UO + CO_QD + h * 64, qnorm, knorm, hh, qa);
    AttnState st; attn_init(st);
    v4u gpre[1]; attn_gate_prefetch<4>(gpre, U + (size_t)row * UO + CO_GD + h * 64, w, lane);
    const bf16* kc = (const bf16*)(a.ws + WS_NAKC) + (size_t)((bs * 2 + j) * 8 + h) * 8 * 4 * 512;
    const bf16* vc = (const bf16*)(a.ws + WS_NAVC) + (size_t)((bs * 2 + j) * 8 + h) * 8 * 4 * 512;
    const bf16* KFO = (const bf16*)(a.ws + WS_KFO);
    const int g0 = 6 * kpart;
    KVf<4> fa, fb;
    const bf16 *kpa, *vpa, *kpb, *vpb; int rka, rkb, kca, kcb, bia, bib; bool wa, wb;
    na_block_ptrs(g0, rb, R0s, h, lane, KFO, VTO, kc, vc, kpa, vpa, rka, wa, kca, bia);
    load_kv<4>(fa, kpa, vpa);
#pragma unroll 1
    for (int g = 0; g < 6; g += 2) {
        na_block_ptrs(g0 + g + 1, rb, R0s, h, lane, KFO, VTO, kc, vc, kpb, vpb, rkb, wb, kcb, bib);
        load_kv<4>(fb, kpb, vpb);
        SB_PIN
        attn_compute<4, true>(st, qa, fa, rk + rka, hh, wa, kca, rb + bia - rr + 7, cq, c0, rpbs);
        if (g + 2 < 6) { na_block_ptrs(g0 + g + 2, rb, R0s, h, lane, KFO, VTO, kc, vc, kpa, vpa, rka, wa, kca, bia); load_kv<4>(fa, kpa, vpa); }
        SB_PIN
        attn_compute<4, true>(st, qa, fb, rk + rkb, hh, wb, kcb, rb + bib - rr + 7, cq, c0, rpbs);
    }
    attn_merge_store<4>(st, part, w, lane, gpre, Z + (size_t)row * DM + 512 + h * 64);
}
#ifndef RU_OUT_A
#define RU_OUT_A 1
#endif
#ifndef RU_OUT_B
#define RU_OUT_B 1
#endif
#ifndef RU_OUT_C
#define RU_OUT_C 1
#endif
__device__ __forceinline__ float scan_incl_sum(float v, int lane) {
#pragma unroll
    for (int o = 1; o < 64; o <<= 1) { const float t = __shfl_up(v, o); if (lane >= o) v += t; }
    return v;
}
__device__ __forceinline__ float scan_incl_max(float v, int lane) {
#pragma unroll
    for (int o = 1; o < 64; o <<= 1) { const float t = __shfl_up(v, o); if (lane >= o) v = fmaxf(v, t); }
    return v;
}
__device__ __forceinline__ float scan_incl_max_rev(float v, int lane) {
#pragma unroll
    for (int o = 1; o < 64; o <<= 1) { const float t = __shfl_down(v, o); if (lane + o < 64) v = fmaxf(v, t); }
    return v;
}
constexpr float KSC = 0.08838834764831845f;

__device__ __forceinline__ void stage_T(const bf16* src  , int pitch, bf16* d0, const float* w0, bf16* d1, const float* w1, int wave, int lane) {
#pragma unroll
    for (int i = 0; i < 2; ++i) { const int c = wave * 2 + i;
        const v4u raw = *(const v4u*)(src + (size_t)lane * pitch + 8 * c);
        float x[8] = {bflo(raw.x), bfhi(raw.x), bflo(raw.y), bfhi(raw.y), bflo(raw.z), bfhi(raw.z), bflo(raw.w), bfhi(raw.w)};
        if (w0) { const float s0 = w0[lane] * KSC, s1 = w1[lane] * KSC;
#pragma unroll
            for (int e = 0; e < 8; ++e) { d0[(8 * c + e) * 72 + lane] = (bf16)(pk2(x[e] * s0, 0.f) & 0xffffu); d1[(8 * c + e) * 72 + lane] = (bf16)(pk2(x[e] * s1, 0.f) & 0xffffu); }
        } else {
            const unsigned rr[4] = {raw.x, raw.y, raw.z, raw.w};
#pragma unroll
            for (int e = 0; e < 8; ++e) d0[(8 * c + e) * 72 + lane] = (bf16)((rr[e >> 1] >> (16 * (e & 1))) & 0xffffu);
        }
    }
}

__device__ __forceinline__ void unit_mlstm_L(const Args& a, const Ctx& X, int j, int h, int gc) {
    const bf16* U = (const bf16*)(a.ws + WS_U); const float* GT = (const float*)(a.ws + WS_GATES); const bf16* VFM = (const bf16*)(a.ws + WS_VFM);
    float* AG = (float*)(a.ws + WS_AG); float* LT = (float*)(a.ws + WS_LT); float* NL = (float*)(a.ws + WS_NL); float* GQ = (float*)(a.ws + WS_GQ);
    float* wgt = (float*)X.ldsg;
    bf16* KwT = (bf16*)(X.ldsg + 1024);
    const int tid = opaque_v(X.tid), lane = tid & 63, w = opaque_s(X.wave), r = lane & 31, hh = lane >> 5, R0 = gc * 64;
    v4u kraw[2];
#pragma unroll
    for (int i = 0; i < 2; ++i) kraw[i] = *(const v4u*)(U + (size_t)(R0 + lane) * UE + CE_KM + h * 128 + 8 * (w * 2 + i));
    bh8 vf[4][4];
#pragma unroll
    for (int eb = 0; eb < 4; ++eb)
#pragma unroll
        for (int q = 0; q < 4; ++q) vf[eb][q] = ld16(VFM + ((size_t)(((2 * gc + (q >> 1)) * 4 + h) * 8 + eb * 2 + (q & 1))) * 512 + lane * 8);
    SB_PIN
    if (w < 2) { const int dir = w; const int row = R0 + lane;
        const float lf = logsigmoid_f(GT[(size_t)row * 16 + 8 + dir * 4 + h] + a.in[22][j * 8 + dir * 4 + h]);
        const float ii = GT[(size_t)row * 16 + dir * 4 + h] + a.in[21][j * 8 + dir * 4 + h];
        const float P = scan_incl_sum(lf, lane); const float T = __shfl(P, 63);
        const float dec = (dir == 0 ? (T - P) : (P - lf)) + ii;
        const float am = wave_max(dec);
        wgt[dir * 64 + lane] = expf(dec - am) * KSC;
        if (lane == 0) { AG[((dir * 4 + h) * 96 + gc) * 2] = am; AG[((dir * 4 + h) * 96 + gc) * 2 + 1] = T; }
        const float cum = dir == 0 ? P : (T - P + lf), bv = ii - cum;
        const float pm = dir == 0 ? scan_incl_max(bv, lane) : scan_incl_max_rev(bv, lane);
        *(f32x4*)(GQ + ((size_t)(dir * 4 + h) * NT + row) * 4) = (f32x4){cum, bv, pm, 0.f};
    }
    __syncthreads();
#pragma unroll
    for (int i = 0; i < 2; ++i) { const int c = w * 2 + i; const unsigned rr[4] = {kraw[i].x, kraw[i].y, kraw[i].z, kraw[i].w};
        const float s0 = wgt[lane], s1 = wgt[64 + lane];
#pragma unroll
        for (int e = 0; e < 8; ++e) { const float x = (e & 1) ? bfhi(rr[e >> 1]) : bflo(rr[e >> 1]);
            KwT[(8 * c + e) * 72 + lane] = (bf16)(pk2(x * s0, 0.f) & 0xffffu); KwT[128 * 72 + (8 * c + e) * 72 + lane] = (bf16)(pk2(x * s1, 0.f) & 0xffffu); } }
    __syncthreads();
    { const int dir = w >> 2, db = w & 3; const size_t ub = (size_t)((dir * 4 + h) * 96 + gc);
      bh8 bfr[4];
#pragma unroll
      for (int q = 0; q < 4; ++q) { const bf16* kp = KwT + dir * 128 * 72 + (32 * db + r) * 72 + 16 * q + 4 * hh; bfr[q] = ld2x8(kp, kp + 8); }
#pragma unroll
      for (int eb = 0; eb < 4; ++eb) { f32x16 acc;
#pragma unroll
          for (int i = 0; i < 16; ++i) acc[i] = 0.f;
#pragma unroll
          for (int q = 0; q < 4; ++q) acc = mfma32(vf[eb][q], bfr[q], acc);
          float* dst = LT + ub * 16384 + 32 * db + r;
#pragma unroll
          for (int i = 0; i < 16; ++i) dst[(32 * eb + crow(i, hh)) * 128] = acc[i]; }
      if (tid < 256) { const int dr = tid >> 7, d = tid & 127; const bf16* p = KwT + dr * 128 * 72 + d * 72; float s = 0.f;
#pragma unroll
          for (int q = 0; q < 8; ++q) { const v4u x = *(const v4u*)(p + 8 * q); s += (bflo(x.x) + bfhi(x.x)) + (bflo(x.y) + bfhi(x.y)) + (bflo(x.z) + bfhi(x.z)) + (bflo(x.w) + bfhi(x.w)); }
          NL[(size_t)((dr * 4 + h) * 96 + gc) * 128 + d] = s; } }
    __syncthreads();
}

template <int NC, int NV>
__device__ __forceinline__ void scan_body(const Args& a, int j, int tid, int dir, int h, int gc0, int sl, int initmat  , long outsb  ) {
    const float* AG = (const float*)(a.ws + WS_AG); const float* LT = (const float*)(a.ws + WS_LT); const float* NL = (const float*)(a.ws + WS_NL);
    bf16* CTB = (bf16*)(a.ws + WS_CTB); float* NPV = (float*)(a.ws + WS_NPV); float* MPV = (float*)(a.ws + WS_MPV);
    const size_t ub0 = (size_t)((dir * 4 + h) * 96 + gc0);
    const int e0 = sl * (NV * 2048) + tid * 4;
    f32x4 Lv[NC][NV]; float nl[NC];
    const bool don = tid < 128 && sl == 0;
#pragma unroll
    for (int c = 0; c < NC; ++c) {
#pragma unroll
        for (int i = 0; i < NV; ++i) Lv[c][i] = *(const f32x4*)(LT + (ub0 + c) * 16384 + e0 + 2048 * i);
        nl[c] = don ? NL[(ub0 + c) * 128 + tid] : 0.f; }
    SB_PIN
    f32x4 Cs[NV]; float ns = 0.f, m = 0.f;
#pragma unroll
    for (int i = 0; i < NV; ++i) Cs[i] = (f32x4){0.f, 0.f, 0.f, 0.f};
    if (initmat >= 0) { const float* c0 = (const float*)(a.ws + WS_C0T) + (size_t)initmat * 16384;
#pragma unroll
        for (int i = 0; i < NV; ++i) Cs[i] = *(const f32x4*)(c0 + e0 + 2048 * i);
        if (don) ns = a.in[6][(size_t)initmat * 128 + tid];
        m = a.in[7][initmat]; }
#pragma unroll
    for (int p = 0; p < NC; ++p) {
        const int c = dir ? NC - 1 - p : p;
        const float ac = AG[(ub0 + c) * 2], Gc = AG[(ub0 + c) * 2 + 1];
#pragma unroll
        for (int i = 0; i < NV; ++i) { const int idx = e0 + 2048 * i; st4bf(CTB + (ub0 + c) * 16384 + idx, Cs[i].x, Cs[i].y, Cs[i].z, Cs[i].w); }
        if (don) NPV[(ub0 + c) * 128 + tid] = ns;
        if (tid == 0 && sl == 0) MPV[ub0 + c] = m;
        const float mn = fmaxf(Gc + m, ac), ws = expf(Gc + m - mn), wl = expf(ac - mn);
#pragma unroll
        for (int i = 0; i < NV; ++i) Cs[i] = Cs[i] * ws + Lv[c][i] * wl;
        ns = ns * ws + nl[c] * wl; m = mn;
    }
    if (outsb >= 0) {
#pragma unroll
        for (int i = 0; i < NV; ++i) { const int idx = e0 + 2048 * i, e = idx >> 7, d = idx & 127; float* o = a.out + O_C + (size_t)outsb * 16384 + e;
            o[(d + 0) * 128] = Cs[i].x; o[(d + 1) * 128] = Cs[i].y; o[(d + 2) * 128] = Cs[i].z; o[(d + 3) * 128] = Cs[i].w; }
        if (don) a.out[O_N + (size_t)outsb * 128 + tid] = ns;
        if (tid == 0 && sl == 0) a.out[O_M + outsb] = m;
    }
}
__device__ __forceinline__ void unit_mlstm_scan(const Args& a, const Ctx& X, int j, int s) {
    const int tid = opaque_v(X.tid);
    if (s < 256) { const int sl = s & 1, q = s >> 1, b = q >> 3, h = (q >> 1) & 3, dir = q & 1;
        scan_body<4, 4>(a, j, tid, dir, h, 4 * b, sl, -1, (long)((b * 2 + j) * 2 + dir) * 4 + h); }
    else { const int v = s - 256, sl = v & 7, q = v >> 3, bs = q >> 3, h = (q >> 1) & 3, dir = q & 1;
        scan_body<16, 1>(a, j, tid, dir, h, 64 + 16 * bs, sl, ((bs * 2 + j) * 2 + dir) * 4 + h, -1); }
}

__device__ __forceinline__ void unit_mlstm_out(const Args& a, const Ctx& X, int j, int h, int gc) {
    const bf16* U = (const bf16*)(a.ws + WS_U);
    const bf16* CTB = (const bf16*)(a.ws + WS_CTB); const float* NPV = (const float*)(a.ws + WS_NPV); const float* MPV = (const float*)(a.ws + WS_MPV);
    bf16* Z = (bf16*)(a.ws + WS_Z);
    unsigned char* L = X.ldsg;
    bf16* Qs = (bf16*)L; bf16* Ks = (bf16*)(L + 17408); bf16* CT = (bf16*)(L + 34816);
    float* ctm = (float*)(L + 137216); float* bb = ctm + 128; float* wint = bb + 128; float* emt = wint + 128;
    float* nprev = emt + 128;
    float* ssq = nprev + 256;
    const int tid = opaque_v(X.tid), lane = tid & 63, w = opaque_s(X.wave), r = lane & 31, hh = lane >> 5, R0 = gc * 64;
    const int tb = w & 1, eb = w >> 1, tau = 32 * tb + r;
    PROF_BEGIN(23)
    v4u qraw[2], kraw[2], craw[4];
#pragma unroll
    for (int i = 0; i < 2; ++i) { const int q = tid + 512 * i, row = q >> 4, cc = q & 15;
        qraw[i] = *(const v4u*)(U + (size_t)(R0 + row) * UE + CE_QM + h * 128 + 8 * cc);
        kraw[i] = *(const v4u*)(U + (size_t)(R0 + row) * UE + CE_KM + h * 128 + 8 * cc); }
#pragma unroll
    for (int i = 0; i < 4; ++i) { const int q = tid + 512 * i, e = q >> 4, cc = q & 15; craw[i] = *(const v4u*)(CTB + (size_t)((0 * 4 + h) * 96 + gc) * 16384 + e * 128 + 8 * cc); }
    const float npr = tid < 256 ? NPV[(size_t)(((tid >> 7) * 4 + h) * 96 + gc) * 128 + (tid & 127)] : 0.f;
    bh8 vf[4];
#pragma unroll
    for (int q = 0; q < 4; ++q) vf[q] = ld16((const bf16*)(a.ws + WS_VFM) + ((size_t)(((2 * gc + (q >> 1)) * 4 + h) * 8 + eb * 2 + (q & 1))) * 512 + lane * 8);
    f32x4 gq = (f32x4){0.f, 0.f, 0.f, 0.f}; float mp = 0.f;
    if (w < 2) { gq = *(const f32x4*)((const float*)(a.ws + WS_GQ) + ((size_t)(w * 4 + h) * NT + R0 + lane) * 4); mp = MPV[(size_t)((w * 4 + h) * 96 + gc)]; }
    { const int row = R0 + tau; v2u* og = (v2u*)(L + 104448) + tid * 8;
#pragma unroll
      for (int g = 0; g < 4; ++g) { const int e0 = 32 * eb + 8 * g + 4 * hh;
          og[g] = *(const v2u*)(U + (size_t)row * UE + CE_OM + h * 128 + e0); og[4 + g] = *(const v2u*)(U + (size_t)row * UE + CE_GM + h * 128 + e0); } }
    SB_PIN
#pragma unroll
    for (int i = 0; i < 2; ++i) { const int q = tid + 512 * i, row = q >> 4, cc = q & 15;
        *(v4u*)(Qs + row * 136 + 8 * cc) = qraw[i]; *(v4u*)(Ks + row * 136 + 8 * cc) = kraw[i]; }
#pragma unroll
    for (int i = 0; i < 4; ++i) { const int q = tid + 512 * i, e = q >> 4, cc = q & 15; *(v4u*)(CT + e * 136 + 8 * cc) = craw[i];
        craw[i] = *(const v4u*)(CTB + (size_t)((1 * 4 + h) * 96 + gc) * 16384 + e * 128 + 8 * cc); }
#pragma unroll
    for (int i = 0; i < 4; ++i) { const int q = tid + 512 * i, e = q >> 4, cc = q & 15; *(v4u*)(CT + 128 * 136 + e * 136 + 8 * cc) = craw[i]; }
    if (tid < 256) nprev[tid] = npr;
    if (w < 2) { const int dir = w; const float cum = gq.x, bv = gq.y, pm = gq.z;
        const float mt = cum + fmaxf(mp, pm);
        ctm[dir * 64 + lane] = cum - mt; bb[dir * 64 + lane] = bv; wint[dir * 64 + lane] = expf(cum + mp - mt); emt[dir * 64 + lane] = expf(-mt); }
    __syncthreads();
    PROF_END(23)
    PROF_BEGIN(24)
    const bf16* qp = Qs + (32 * tb + r) * 136 + 8 * hh;
    bh8 qf[8];
#pragma unroll
    for (int ks = 0; ks < 8; ++ks) qf[ks] = ld16(qp + 16 * ks);
    f32x16 hsum;
    for (int rpb_ = 0; rpb_ < RU_OUT_B; ++rpb_) {
#pragma unroll
    for (int i = 0; i < 16; ++i) hsum[i] = 0.f;
#pragma unroll 1
    for (int dir = 0; dir < 2; ++dir) {
        const int sgn = 1 - 2 * dir;
        const bf16* CTd = CT + dir * 128 * 136; const float* npv = nprev + dir * 128;
        const float ct = ctm[dir * 64 + tau], wi = wint[dir * 64 + tau];
        float rs = 0.f, qd = 0.f;
        f32x16 accv;
#pragma unroll
        for (int i = 0; i < 16; ++i) accv[i] = 0.f;
#pragma unroll
        for (int sb = 0; sb < 2; ++sb) {
            bh8 kf[8]; f32x16 ps;
#pragma unroll
            for (int ks = 0; ks < 8; ++ks) kf[ks] = ld16(Ks + (32 * sb + r) * 136 + 16 * ks + 8 * hh);
#pragma unroll
            for (int i = 0; i < 16; ++i) ps[i] = 0.f;
#pragma unroll
            for (int ks = 0; ks < 8; ++ks) ps = mfma32(kf[ks], qf[ks], ps);
#pragma unroll
            for (int g = 0; g < 4; ++g) { const f32x4 b4 = *(const f32x4*)(bb + dir * 64 + 32 * sb + 8 * g + 4 * hh);
#pragma unroll
                for (int e = 0; e < 4; ++e) { const int dd = (32 * sb + 8 * g + 4 * hh + e - tau) * sgn; const bool ok = dd <= 0;
                    const float v = ok ? ps[4 * g + e] * KSC * __expf(ct + b4[e]) : 0.f; ps[4 * g + e] = v; rs += v; } }
            accv = mfma32(vf[2 * sb], pfrag(ps, 0), accv);
            accv = mfma32(vf[2 * sb + 1], pfrag(ps, 1), accv);
            __builtin_amdgcn_sched_barrier(0);
        }
        rs += __shfl_xor(rs, 32);
#pragma unroll
        for (int ks = 0; ks < 8; ++ks) { const v4u qq = __builtin_bit_cast(v4u, qf[ks]); const f32x4 n0 = *(const f32x4*)(npv + 16 * ks + 8 * hh), n1 = *(const f32x4*)(npv + 16 * ks + 8 * hh + 4);
            qd += bflo(qq.x) * n0.x + bfhi(qq.x) * n0.y + bflo(qq.y) * n0.z + bfhi(qq.y) * n0.w + bflo(qq.z) * n1.x + bfhi(qq.z) * n1.y + bflo(qq.w) * n1.z + bfhi(qq.w) * n1.w;
            if ((ks & 1) == 1) __builtin_amdgcn_sched_barrier(0); }
        qd += __shfl_xor(qd, 32);
        __builtin_amdgcn_sched_barrier(0);
        bh8 cf[8];
#pragma unroll
        for (int ks = 0; ks < 8; ++ks) cf[ks] = ld16(CTd + (32 * eb + r) * 136 + 16 * ks + 8 * hh);
        const float qn = wi * qd + rs;
        f32x16 acc;
#pragma unroll
        for (int i = 0; i < 16; ++i) acc[i] = 0.f;
#pragma unroll
        for (int ks = 0; ks < 8; ++ks) acc = mfma32(cf[ks], qf[ks], acc);
#pragma unroll
        for (int i = 0; i < 16; ++i) acc[i] = acc[i] * wi + accv[i];
        const float inv = 1.f / fmaxf(fabsf(qn), emt[dir * 64 + tau]);
#pragma unroll
        for (int i = 0; i < 16; ++i) hsum[i] += acc[i] * inv;
        __builtin_amdgcn_sched_barrier(0);
    }
    }
    PROF_END(24)
    PROF_BEGIN(25)
    { float ss = 0.f;
#pragma unroll
      for (int i = 0; i < 16; ++i) ss += hsum[i] * hsum[i];
      ss += __shfl_xor(ss, 32);
      if (hh == 0) ssq[(tb * 4 + eb) * 32 + r] = ss; }
    __syncthreads();
    { const int tid2 = opaque_v(tid), lane2 = tid2 & 63, w2 = opaque_s(w), r2 = lane2 & 31, hh2 = lane2 >> 5, tb2 = w2 & 1, eb2 = w2 >> 1, tau2 = 32 * tb2 + r2;
    { const float tot = ssq[(tb2 * 4 + 0) * 32 + r2] + ssq[(tb2 * 4 + 1) * 32 + r2] + ssq[(tb2 * 4 + 2) * 32 + r2] + ssq[(tb2 * 4 + 3) * 32 + r2];
      const float rstd = rsqrtf(tot * (1.f / 128.f) + EPS);
      const int row = R0 + tau2; const float* hn = a.in[23] + j * 512 + h * 128;
#pragma unroll
      for (int g = 0; g < 4; ++g) { const int e0 = 32 * eb2 + 8 * g + 4 * hh2; const f32x4 gn = *(const f32x4*)(hn + e0); const v2u om = ((const v2u*)(L + 104448))[tid2 * 8 + g], gm = ((const v2u*)(L + 104448))[tid2 * 8 + 4 + g];
          st4bf(Z + (size_t)row * DM + 512 + h * 128 + e0,
                hsum[4 * g] * rstd * gn.x * sigmoid_f(bflo(om.x)) * silu_f(bflo(gm.x)), hsum[4 * g + 1] * rstd * gn.y * sigmoid_f(bfhi(om.x)) * silu_f(bfhi(gm.x)),
                hsum[4 * g + 2] * rstd * gn.z * sigmoid_f(bflo(om.y)) * silu_f(bflo(gm.y)), hsum[4 * g + 3] * rstd * gn.w * sigmoid_f(bfhi(om.y)) * silu_f(bfhi(gm.y))); } }
    }
    __syncthreads();
    PROF_END(25)
}
__device__ __forceinline__ void unit_conv(const Args& a, const Ctx& X, int j, int t) {
    const bf16* U = (const bf16*)(a.ws + WS_U); bf16* Z = (bf16*)(a.ws + WS_Z);
    const int tid = opaque_v(X.tid), cg = (tid & 63) * 8, r0 = t * 32 + (tid >> 6) * 4;
    const int S = r0 < NP ? 256 : 1024; const int s0 = r0 < NP ? (r0 & 255) : ((r0 - NP) & 1023);
    v4u xc[6], cc[6], bc[4], gc[4];
#pragma unroll
    for (int i = 0; i < 6; ++i) { const int s = s0 - 1 + i; const bool ok = s >= 0 && s < S; const bf16* u = U + (size_t)(r0 - 1 + i) * UO;
        xc[i] = ok ? *(const v4u*)(u + CO_XC + cg) : (v4u){0u, 0u, 0u, 0u}; cc[i] = ok ? *(const v4u*)(u + CO_CC + cg) : (v4u){0u, 0u, 0u, 0u}; }
#pragma unroll
    for (int i = 0; i < 4; ++i) { const bf16* u = U + (size_t)(r0 + i) * UO; bc[i] = *(const v4u*)(u + CO_BC + cg); gc[i] = *(const v4u*)(u + CO_GC + cg); }
    SB_PIN
    float w0[8], w1[8], w2[8], cb[8];
#pragma unroll
    for (int q = 0; q < 2; ++q) { const f32x4 a0 = *(const f32x4*)(a.in[26] + j * 1536 + cg + 4 * q), a1 = *(const f32x4*)(a.in[26] + j * 1536 + 512 + cg + 4 * q),
                                              a2 = *(const f32x4*)(a.in[26] + j * 1536 + 1024 + cg + 4 * q), a3 = *(const f32x4*)(a.in[27] + j * 512 + cg + 4 * q);
#pragma unroll
        for (int e = 0; e < 4; ++e) { w0[4 * q + e] = a0[e]; w1[4 * q + e] = a1[e]; w2[4 * q + e] = a2[e]; cb[4 * q + e] = a3[e]; } }
    float x[6][8];
#pragma unroll
    for (int i = 0; i < 6; ++i) { const unsigned xr[4] = {xc[i].x, xc[i].y, xc[i].z, xc[i].w}, cr[4] = {cc[i].x, cc[i].y, cc[i].z, cc[i].w};
#pragma unroll
        for (int q = 0; q < 4; ++q) { x[i][2 * q] = bflo(xr[q]) * bflo(cr[q]); x[i][2 * q + 1] = bfhi(xr[q]) * bfhi(cr[q]); } }
#pragma unroll
    for (int i = 0; i < 4; ++i) { const unsigned br[4] = {bc[i].x, bc[i].y, bc[i].z, bc[i].w}, gr[4] = {gc[i].x, gc[i].y, gc[i].z, gc[i].w};
        float o[8];
#pragma unroll
        for (int e = 0; e < 8; ++e) { const float bv = (e & 1) ? bfhi(br[e >> 1]) : bflo(br[e >> 1]), gv = (e & 1) ? bfhi(gr[e >> 1]) : bflo(gr[e >> 1]);
            const float cv = x[i][e] * w0[e] + x[i + 1][e] * w1[e] + x[i + 2][e] * w2[e] + cb[e];
            o[e] = bv * cv * silu_f(gv); }
        v4u z; z.x = pk2(o[0], o[1]); z.y = pk2(o[2], o[3]); z.z = pk2(o[4], o[5]); z.w = pk2(o[6], o[7]);
        *(v4u*)(Z + (size_t)(r0 + i) * DM + cg) = z; }
}

constexpr int NPHASES = 21;


#ifndef RU_Q
#define RU_Q 1
#endif
#ifndef RU_KV
#define RU_KV 1
#endif
#ifndef RU_L
#define RU_L 1
#endif
#ifndef RU_ATTS
#define RU_ATTS 1
#endif
#ifndef RU_SCAN
#define RU_SCAN 1
#endif
#ifndef RU_OUT
#define RU_OUT 1
#endif
#ifndef RU_ATTP
#define RU_ATTP 1
#endif
#ifndef RU_NA
#define RU_NA 1
#endif
#ifndef RU_OATT
#define RU_OATT 1
#endif
#ifndef RU_CONV
#define RU_CONV 1
#endif
#ifndef RU_SIDE
#define RU_SIDE 1
#endif
#define REPU(n, call) for (int rp_ = 0; rp_ < (n); ++rp_) { call; }
#define PU(id, stmt) { PROF_BEGIN(id) stmt PROF_END(id) }
__device__ __forceinline__ void phase_gemm1(const Args& a, const Ctx& X, int l) {
    const int j = l >> 1; const bool even = (l & 1) == 0;
    pg8::Gemm g{(const bf16*)(a.ws + WS_H), even ? (const bf16*)(a.ws + WS_WTEV) + (size_t)j * 3584 * 1024 : (const bf16*)(a.ws + WS_WTOD) + (size_t)j * 4096 * 1024, NT, even ? UE : UO, DM};
    pg8::StaticOrder S; S.init(NT, even ? UE : UO, X.G, X.bid, pg8::EpiU::BMA_ROWS);
    pg8::EpiU E{(bf16*)(a.ws + WS_U), even ? UE : UO, even ? (float*)(a.ws + WS_GATES) : nullptr, even ? nullptr : (bf16*)(a.ws + WS_VTO), even ? nullptr : (bf16*)(a.ws + WS_KFO), even ? (bf16*)(a.ws + WS_VFM) : nullptr};
    pg8::gemm_phase<pg8::EpiU, pg8::StaticOrder, true, true>(X.lds, g, S, E);
}
__device__ __forceinline__ void phase_gemm2(const Args& a, const Ctx& X, int l) {
    pg8::Gemm g{(const bf16*)(a.ws + WS_Z), (const bf16*)(a.ws + WS_WTOUT) + (size_t)l * 1024 * 1024, NT, DM, DM};
    pg8::StaticOrder S; S.init(NT, DM, X.G, X.bid, pg8::EpiY::BMA_ROWS);
    pg8::EpiY E{a.out, l == 0 ? a.in[0] : a.out, l == 0 ? a.in[1] : a.out + (size_t)NP * DM, (const float*)(a.ws + WS_MOD) + l * 3 * 3072};
    pg8::gemm_phase<pg8::EpiY, pg8::StaticOrder, true, true>(X.lds, g, S, E);
}
__device__ __forceinline__ void phase_e2(const Args& a, const Ctx& X, int j) {
    const int b = X.bid;
    for (int s = 0; s < 4; ++s) {
        int u;
        if (b < 200) { if (s == 0) u = b; else if (s == 1) u = 200 + b; else break; }
        else { u = 400 + (b - 200) + 56 * s; if (u >= 584) break; }
        if (u < 96) PU(10, REPU(RU_Q, unit_mla_q(a, X, j, u)))
        else if (u < 200) PU(11, REPU(RU_KV, unit_mla_kv(a, X, j, u < 192 ? u - 96 : -1 - (u - 192))))
        else { const int v = u - 200; PU(12, REPU(RU_L, unit_mlstm_L(a, X, j, v / 96, v % 96))) }
    }
}
__device__ __forceinline__ void phase_e2b(const Args& a, const Ctx& X, int j) {
    for (int u = X.bid; u < 640; u += X.G) {
        if (u < 256) PU(13, REPU(RU_ATTS, unit_mla_attn(a, X, u)))
        else PU(14, REPU(RU_SCAN, unit_mlstm_scan(a, X, j, u - 256)))
    }
}
__device__ __forceinline__ void phase_e3(const Args& a, const Ctx& X, int j) {
    const int b = X.bid;
    for (int s = 0; s < 3; ++s) {
        int u;
        if (s == 0) u = b; else if (b < 128) { if (s == 1) u = 256 + b; else break; } else u = 384 + (b - 128) + 128 * (s - 1);
        if (u < 384) PU(15, REPU(RU_OUT, unit_mlstm_out(a, X, j, u / 96, u % 96)))
        else PU(16, REPU(RU_ATTP, unit_mla_attn(a, X, u - 384 + 256)))
    }
}
__device__ __forceinline__ void phase_o2(const Args& a, const Ctx& X, int j) {
    for (int u = X.bid; u < 704; u += X.G) {
        if (u < 256) PU(17, REPU(RU_NA, unit_na(a, X, j, u)))
        else if (u < 512) PU(18, REPU(RU_OATT, unit_odd_attn(a, X, j, u - 256)))
        else PU(19, REPU(RU_CONV, unit_conv(a, X, j, u - 512)))
    }
}


#ifndef REP_P0A
#define REP_P0A 1
#endif
#ifndef REP_NORM
#define REP_NORM 1
#endif
#ifndef REP_G1
#define REP_G1 1
#endif
#ifndef REP_E2
#define REP_E2 1
#endif
#ifndef REP_G2L0
#define REP_G2L0 1
#endif
#ifndef REP_E2B
#define REP_E2B 1
#endif
#ifndef REP_E3
#define REP_E3 1
#endif
#ifndef REP_O2
#define REP_O2 1
#endif
#ifndef PHMASK
#define PHMASK 0x7f
#endif
#define PH_NOP(...) ((void)0)
#if PHMASK & 1
#define PH_P0A phase_p0a
#else
#define PH_P0A PH_NOP
#endif
#if PHMASK & 2
#define PH_NORM phase_norm
#else
#define PH_NORM PH_NOP
#endif
#if PHMASK & 4
#define PH_G1 phase_gemm1
#else
#define PH_G1 PH_NOP
#endif
#if PHMASK & 8
#define PH_E2 phase_e2
#else
#define PH_E2 PH_NOP
#endif
#if PHMASK & 16
#define PH_E3 phase_e3
#define PH_E2B phase_e2b
#else
#define PH_E3 PH_NOP
#define PH_E2B PH_NOP
#endif
#if PHMASK & 32
#define PH_O2 phase_o2
#else
#define PH_O2 PH_NOP
#endif
#if PHMASK & 64
#define PH_G2 phase_gemm2
#else
#define PH_G2 PH_NOP
#endif
__global__ void __launch_bounds__(NTHR, 2) mega_fwd(Args args) {
    extern __shared__ __attribute__((aligned(16))) unsigned char lds[];
    Ctx X; X.lds = (LAS unsigned char*)lds; X.ldsg = lds;
    X.tid = threadIdx.x; X.lane = X.tid & 63; X.wave = __builtin_amdgcn_readfirstlane(X.tid >> 6); X.G = gridDim.x; X.bid = blockIdx.x;
    volatile LAS unsigned* MISC = (volatile LAS unsigned*)(X.lds + MISC_OFF);
    if (X.tid < 32) MISC[X.tid] = 0u;
    __syncthreads();
    const int lo = args.ph_lo, hi = args.ph_hi;
    XcdBarrier bar; bar.bar = (unsigned*)(args.ws + WS_CTL) + CW_BAR; bar.x = 0; bar.st = MISC + 8;
    if (hi - lo > 1) bar = xcd_barrier_post((unsigned*)(args.ws + WS_CTL) + CW_BAR, MISC + 8);
    int ph = 0;
#define RUN(pid, n, body) do { if (ph >= lo && ph < hi) { for (int rp = 0; rp < (n); ++rp) { { PROF_BEGIN(pid) body; PROF_END(pid) } if (ph + 1 < hi || rp + 1 < (n)) { PROF_BEGIN(9) xcd_barrier(bar); PROF_END(9) } } } ++ph; } while (0)
    RUN(1, REP_P0A, PH_P0A(args, X));
    RUN(2, REP_NORM, PH_NORM(args, X, 0));
    for (int l = 0; l < 4; ++l) {
        const int j = l >> 1;
        RUN(3, REP_G1, PH_G1(args, X, l));
        if ((l & 1) == 0) { RUN(4, REP_E2, PH_E2(args, X, j)); RUN(5, REP_E2B, PH_E2B(args, X, j)); RUN(6, REP_E3, PH_E3(args, X, j)); }
        else { RUN(7, REP_O2, PH_O2(args, X, j)); }
        RUN(8, l == 0 ? REP_G2L0 : 1, PH_G2(args, X, l));
        if (l < 3) RUN(2, REP_NORM, PH_NORM(args, X, l + 1));
    }
#undef RUN
    if (PROF_ID != 0 && threadIdx.x == 0) { const unsigned long long t0 = __builtin_amdgcn_s_memrealtime(); const unsigned long long w = (unsigned long long)PROF_K * ((volatile LAS unsigned*)(X.lds + MISC_OFF))[16];
        while (__builtin_amdgcn_s_memrealtime() - t0 < w) __builtin_amdgcn_s_sleep(8); }
}

#ifndef MK_SPLIT
#define MK_SPLIT 0
#endif

extern "C" void kernel_launch(void* const* d_in, const int* in_sizes, int n_in, void* d_out, int out_size, void* d_ws, size_t ws_size, hipStream_t stream) {
    static int ready = 0;
    if (!ready) {
        if (hipFuncSetAttribute((const void*)mega_fwd, hipFuncAttributeMaxDynamicSharedMemorySize, LDS_BYTES) != hipSuccess) fprintf(stderr, "kernel_launch: hipFuncSetAttribute failed\n");
        int per_cu = 0;
        if (hipOccupancyMaxActiveBlocksPerMultiprocessor(&per_cu, (const void*)mega_fwd, NTHR, LDS_BYTES) != hipSuccess || per_cu < 1) fprintf(stderr, "kernel_launch: occupancy query says %d blocks per CU\n", per_cu);
        (void)hipGetLastError();
        ready = 1;
    }
    (void)hipMemsetAsync((char*)d_ws + WS_CTL, 0, CTL_ZERO_BYTES, stream);
    Args a{};
    for (int i = 0; i < 32; ++i) a.in[i] = (const float*)d_in[i];
    a.out = (float*)d_out; a.ws = (unsigned char*)d_ws;
#if MK_SPLIT
    for (int p = 0; p < NPHASES; ++p) { a.ph_lo = p; a.ph_hi = p + 1; hipLaunchKernelGGL(mega_fwd, dim3(256), dim3(NTHR), LDS_BYTES, stream, a); }
#else
    a.ph_lo = 0; a.ph_hi = NPHASES;
    hipLaunchKernelGGL(mega_fwd, dim3(256), dim3(NTHR), LDS_BYTES, stream, a);
#endif
}
```

```cpp
#include <hip/hip_runtime.h>
#include <cstdio>
#include <cstdint>
#include <math.h>

#define GAS __attribute__((address_space(1)))
#define LAS __attribute__((address_space(3)))
typedef unsigned short bf16;
typedef unsigned v4u __attribute__((ext_vector_type(4)));
typedef unsigned v2u __attribute__((ext_vector_type(2)));
typedef float f32x4 __attribute__((ext_vector_type(4)));
typedef float f32x2 __attribute__((ext_vector_type(2)));
typedef float f32x16 __attribute__((ext_vector_type(16)));
typedef short bf16x8 __attribute__((ext_vector_type(8)));
typedef __bf16 bh8 __attribute__((ext_vector_type(8)));
typedef __bf16 bh2 __attribute__((ext_vector_type(2)));
typedef GAS unsigned gu32;
#define RLX_AGENT __ATOMIC_RELAXED, __HIP_MEMORY_SCOPE_AGENT
#define LDS_WAIT() asm volatile("s_waitcnt lgkmcnt(0)" ::: "memory")
#define SB_PIN __builtin_amdgcn_sched_barrier(0);
#define VM_WAIT() asm volatile("s_waitcnt vmcnt(0)" ::: "memory")

constexpr int DM = 1024, NP = 4096, NS = 2048, NT = 6144;
constexpr int UE = 3584, UO = 4096;
constexpr float EPS = 1e-6f;
constexpr int CE_QA = 0, CE_KVA = 256, CE_GA = 384, CE_QM = 896, CE_KM = 1408, CE_VM = 1920, CE_OM = 2432, CE_GM = 2944, CE_KPE = 3456;
constexpr int CO_XC = 0, CO_BC = 512, CO_CC = 1024, CO_GC = 1536, CO_QD = 2048, CO_KD = 2560, CO_VD = 3072, CO_GD = 3584;
constexpr size_t O_Y = 0, O_CKV = 6291456, O_KPE = 7340032, O_C = 7602176, O_N = 11796480, O_M = 11829248, O_NK = 11829504, O_NV = 16023808;
constexpr size_t MiB = 1u << 20;
constexpr size_t WS_CTL = 0, CTL_ZERO_BYTES = 65536;
constexpr size_t WS_ROPE = 65536;
constexpr size_t WS_MOD = 131072;
constexpr size_t WS_AG = 327680;
constexpr size_t WS_WTEV = 1 * MiB;
constexpr size_t WS_WTOD = 17 * MiB;
constexpr size_t WS_WTOUT = 33 * MiB;
constexpr size_t WS_WTQB = 41 * MiB;
constexpr size_t WS_WTKVB = 42 * MiB;
constexpr size_t WS_NAKC = 43 * MiB;
constexpr size_t WS_NAVC = 44 * MiB;
constexpr size_t WS_C0T = 45 * MiB;
constexpr size_t WS_H = 47 * MiB;
constexpr size_t WS_U = 59 * MiB;
constexpr size_t WS_Z = 107 * MiB;
constexpr size_t WS_GATES = 119 * MiB;
constexpr size_t WS_Q = 120 * MiB;
constexpr size_t WS_KM = 129 * MiB;
constexpr size_t WS_VTM = 139 * MiB;
constexpr size_t WS_VTO = 146 * MiB;
constexpr size_t WS_LT = 152 * MiB;
constexpr size_t WS_NL = 200 * MiB;
constexpr size_t WS_CTB = 201 * MiB;
constexpr size_t WS_NPV = 225 * MiB;
constexpr size_t WS_MPV = 226 * MiB;
constexpr size_t WS_KFO = 227 * MiB;
constexpr size_t WS_VFM = 234 * MiB;
constexpr size_t WS_GQ = 241 * MiB;
constexpr size_t WS_XS = 242 * MiB;
constexpr size_t CTL_NCNT = 32768;
constexpr int KROWS = 6656;

__device__ __forceinline__ unsigned pk2(float lo, float hi) { f32x2 v = {lo, hi}; bh2 b = __builtin_convertvector(v, bh2); return __builtin_bit_cast(unsigned, b); }
__device__ __forceinline__ float bf2f(unsigned u16) { return __builtin_bit_cast(float, u16 << 16); }
__device__ __forceinline__ float bflo(unsigned u) { return __builtin_bit_cast(float, u << 16); }
__device__ __forceinline__ float bfhi(unsigned u) { return __builtin_bit_cast(float, u & 0xffff0000u); }
__device__ __forceinline__ float silu_f(float x) { return x / (1.f + __expf(-x)); }
__device__ __forceinline__ float sigmoid_f(float x) { return 1.f / (1.f + __expf(-x)); }
__device__ __forceinline__ float logsigmoid_f(float x) { return fminf(x, 0.f) - log1pf(expf(-fabsf(x))); }
__device__ __forceinline__ int cond_of_row(int r) { return r < NP ? 0 : 1 + ((r - NP) >> 10); }
__device__ __forceinline__ float wave_sum(float v) {
#pragma unroll
    for (int o = 1; o < 64; o <<= 1) v += __shfl_xor(v, o);
    return v;
}
__device__ __forceinline__ float wave_max(float v) {
#pragma unroll
    for (int o = 1; o < 64; o <<= 1) v = fmaxf(v, __shfl_xor(v, o));
    return v;
}
__device__ __forceinline__ f32x16 mfma32(bh8 a, bh8 b, f32x16 c) { return __builtin_amdgcn_mfma_f32_32x32x16_bf16(a, b, c, 0, 0, 0); }
__device__ __forceinline__ bh8 ld16(const bf16* p) { return *(const bh8*)p; }
__device__ __forceinline__ bh8 ld2x8(const bf16* p0, const bf16* p1) { v2u a = *(const v2u*)p0, b = *(const v2u*)p1; v4u v = {a.x, a.y, b.x, b.y}; return __builtin_bit_cast(bh8, v); }
__device__ __forceinline__ bh8 pfrag(const f32x16& p, int s) {
    v4u v; v.x = pk2(p[8 * s + 0], p[8 * s + 1]); v.y = pk2(p[8 * s + 2], p[8 * s + 3]); v.z = pk2(p[8 * s + 4], p[8 * s + 5]); v.w = pk2(p[8 * s + 6], p[8 * s + 7]);
    return __builtin_bit_cast(bh8, v);
}
__device__ __forceinline__ int crow(int i, int hh) { return (i & 3) + 8 * (i >> 2) + 4 * hh; }
__device__ __forceinline__ void st4bf(bf16* p, float a, float b, float c, float d) { v2u v; v.x = pk2(a, b); v.y = pk2(c, d); *(v2u*)p = v; }

namespace pg8 {
#define PG8_LAS __attribute__((address_space(3)))
typedef unsigned short bf16_t;
typedef short bf16x8 __attribute__((ext_vector_type(8)));
typedef float f32x4 __attribute__((ext_vector_type(4)));
typedef unsigned u32x4 __attribute__((ext_vector_type(4)));
constexpr int BM = 256, BK = 64, HALF = 128, HTB = HALF * BK * 2  , STAGE_BYTES = 8 * HTB, NXCD = 8, WGM = 8;

__host__ __device__ __forceinline__ int lds_byte(int r, int c) { const int st = (r >> 4) * 2 + (c >> 5), rr = r & 15, cc = c & 31, ob = rr * 64 + cc * 2; return st * 1024 + (ob ^ (((ob >> 9) & 1) << 5)); }
__host__ __device__ __forceinline__ void stage_rc(int b, int& R, int& C) { const int st = b / 1024, sb = b % 1024, swz = sb ^ (((sb >> 9) & 1) << 5); R = (st >> 1) * 16 + swz / 64; C = (st & 1) * 32 + (swz % 64) / 2; }
__host__ __device__ __forceinline__ int perm32(int rho) { const int n = rho >> 4, i = rho & 15; return 8 * (i >> 2) + 4 * n + (i & 3); }

struct Unit { int pm, pn; };
struct Gemm { const bf16_t* A; const bf16_t* Bt; int M, N, K; };

struct StaticOrder {
    int nM, nN, nwg, G, c;
    __host__ __device__ void init(int M, int N, int G_, int c_, int bma) { nM = M / bma; nN = N / BM; nwg = nM * nN; G = G_; c = c_; }
    __host__ __device__ bool next(int i, Unit& u) const {
        const long L = (long)i * G + c; if (L >= nwg) return false;
        int wgid = (int)L; { const int q = nwg / NXCD, r = nwg % NXCD, xcd = wgid % NXCD, off = wgid / NXCD; wgid = (xcd < r ? xcd * (q + 1) : r * (q + 1) + (xcd - r) * q) + off; }
        const int nig = WGM * nN, gid = wgid / nig, fm = gid * WGM, gsz = (nM - fm) < WGM ? (nM - fm) : WGM;
        u.pm = fm + ((wgid % nig) % gsz); u.pn = (wgid % nig) / gsz; return true;
    }
    __device__ __forceinline__ void a_ready(const Unit&) const {}
    __device__ __forceinline__ void done(const Unit&) const {}
};

__device__ __forceinline__ int pg8_opaque(int x) { asm volatile("" : "+v"(x)); return x; }
__device__ __forceinline__ unsigned cvt_pk_bf16(float lo, float hi) { unsigned r; asm volatile("v_cvt_pk_bf16_f32 %0, %1, %2" : "=v"(r) : "v"(lo), "v"(hi)); return r; }

struct EpiU {
    static constexpr bool PERM = true, AFTER_DRAIN = false; static constexpr int BMA_ROWS = 192, BMA = BMA_ROWS, HA = BMA / 2, MA = HA / 32, WRA = HA / 2;
    bf16_t* U; int ldu; float* gates; bf16_t* vto; bf16_t* kfo; bf16_t* vfm;
    __device__ __forceinline__ void operator()(const f32x4 (&acc)[2][2][4][2], const Unit& u, int wr, int wc, int fr, int fq) const {
        const int row0 = u.pm * BMA + wr * WRA + fr, col0 = u.pn * BM + wc * 32 + 8 * fq;
        const bool dog = gates != nullptr && u.pn == 13 && wc == 1 && fq < 2;
        const bool dov = vto != nullptr && (u.pn == 12 || u.pn == 13);
        const bool dok = kfo != nullptr && (u.pn == 10 || u.pn == 11);
        const bool dom = vfm != nullptr && u.pn >= 7 && u.pn <= 9;
#pragma unroll
        for (int ai = 0; ai < 2; ++ai)
#pragma unroll
            for (int m = 0; m < MA; ++m) {
                const int row = row0 + ai * HA + m * 16;
#pragma unroll
                for (int bj = 0; bj < 2; ++bj) {
                    const f32x4 v0 = acc[ai][bj][m][0], v1 = acc[ai][bj][m][1];
                    const int col = col0 + bj * HALF;
                    u32x4 w; w.x = cvt_pk_bf16(v0[0], v0[1]); w.y = cvt_pk_bf16(v0[2], v0[3]); w.z = cvt_pk_bf16(v1[0], v1[1]); w.w = cvt_pk_bf16(v1[2], v1[3]);
                    *(u32x4*)(U + (size_t)row * ldu + col) = w;
                    if (bj == 1 && dog) { float* g = gates + (size_t)row * 16 + 8 * fq; *(f32x4*)g = v0; *(f32x4*)(g + 4) = v1; }
                    if (dom && col >= 1920 && col < 2432) { const int cc = col - 1920, hd = cc >> 7, ev = cc & 127, t16 = row & 15;
                        bf16_t* vp = vfm + ((size_t)((row >> 5) * 4 + hd) * 8 + (ev >> 5) * 2 + ((row >> 4) & 1)) * 512 + (((t16 >> 2) & 1) * 32 + (ev & 31)) * 8 + 4 * (t16 >> 3) + (t16 & 3);
                        vp[0] = (bf16_t)(w.x & 0xffffu); vp[8] = (bf16_t)(w.x >> 16); vp[16] = (bf16_t)(w.y & 0xffffu); vp[24] = (bf16_t)(w.y >> 16);
                        vp[32] = (bf16_t)(w.z & 0xffffu); vp[40] = (bf16_t)(w.z >> 16); vp[48] = (bf16_t)(w.w & 0xffffu); vp[56] = (bf16_t)(w.w >> 16);
                    }
                    if (dok) { const int cc = col - 2560, hd = cc >> 6, d = cc & 63;
                        *(u32x4*)(kfo + ((size_t)((row >> 5) * 8 + hd) * 4 + (d >> 4)) * 512 + (((d >> 3) & 1) * 32 + (row & 31)) * 8) = w; }
                    if (dov) { const int cc = col - 3072, hd = cc >> 6, dv = cc & 63, t16 = row & 15;
                        bf16_t* vp = vto + ((size_t)((row >> 5) * 8 + hd) * 4 + (dv >> 5) * 2 + ((row >> 4) & 1)) * 512 + (((t16 >> 2) & 1) * 32 + (dv & 31)) * 8 + 4 * (t16 >> 3) + (t16 & 3);
                        vp[0] = (bf16_t)(w.x & 0xffffu); vp[8] = (bf16_t)(w.x >> 16); vp[16] = (bf16_t)(w.y & 0xffffu); vp[24] = (bf16_t)(w.y >> 16);
                        vp[32] = (bf16_t)(w.z & 0xffffu); vp[40] = (bf16_t)(w.z >> 16); vp[48] = (bf16_t)(w.w & 0xffffu); vp[56] = (bf16_t)(w.w >> 16);
                    }
                }
            }
    }
};

struct EpiY {
    static constexpr bool PERM = true, AFTER_DRAIN = false; static constexpr int BMA_ROWS = 128, BMA = BMA_ROWS, HA = BMA / 2, MA = HA / 32, WRA = HA / 2;
    float* Y; const float* ysp; const float* yss; const float* mod_l;
    __device__ __forceinline__ void operator()(const f32x4 (&acc)[2][2][4][2], const Unit& u, int wr, int wc, int fr, int fq) const {
        const int row0 = u.pm * BMA + wr * WRA + fr, col0 = u.pn * BM + wc * 32 + 8 * fq;
#pragma unroll
        for (int bj = 0; bj < 2; ++bj) {
            const int col = col0 + bj * HALF;
#pragma unroll
            for (int ai = 0; ai < 2; ++ai)
#pragma unroll
                for (int m = 0; m < MA; ++m) {
                    const int row = row0 + ai * HA + m * 16;
                    const float* gp = mod_l + (row < 4096 ? 0 : (row < 5120 ? 1 : 2)) * 3072 + 2048 + col;
                    const f32x4 g0 = *(const f32x4*)gp, g1 = *(const f32x4*)(gp + 4);
                    const float* src = (row < 4096 ? ysp + (size_t)row * 1024 : yss + (size_t)(row - 4096) * 1024) + col;
                    const f32x4 y0 = *(const f32x4*)src, y1 = *(const f32x4*)(src + 4);
                    float* dst = Y + (size_t)row * 1024 + col;
                    *(f32x4*)dst = y0 + g0 * acc[ai][bj][m][0];
                    *(f32x4*)(dst + 4) = y1 + g1 * acc[ai][bj][m][1];
                }
        }
    }
};


struct EpiYN {
    static constexpr bool PERM = true, AFTER_DRAIN = true; static constexpr int BMA_ROWS = 128, BMA = BMA_ROWS, HA = BMA / 2, MA = HA / 32, WRA = HA / 2;
    float* Y; const float* ysp; const float* yss; const float* mod_l;
    bf16_t* H; const float* nw; const float* mod_n;
    unsigned* xs; unsigned* cnt;
    __device__ __forceinline__ void operator()(const f32x4 (&)[2][2][4][2], const Unit&, int, int, int, int) const {}
    __device__ __forceinline__ void fused(f32x4 (&acc)[2][2][4][2], const Unit& u, int wr, int wc, int fr, int fq, PG8_LAS unsigned char* lds, int wid, int lane) const {
        const int tid = wid * 64 + lane;
        PG8_LAS float* part = (PG8_LAS float*)lds; PG8_LAS float* rstds = part + 512;
        const int row0 = u.pm * BMA + wr * WRA + fr, col0 = u.pn * BM + wc * 32 + 8 * fq;
        const int cond = u.pm < 32 ? 0 : (u.pm < 40 ? 1 : 2);
        float ss[2][2] = {{0.f, 0.f}, {0.f, 0.f}};
#pragma unroll
        for (int bj = 0; bj < 2; ++bj) {
            const int col = col0 + bj * HALF;
            const float* gp = mod_l + cond * 3072 + 2048 + col;
            const f32x4 g0 = *(const f32x4*)gp, g1 = *(const f32x4*)(gp + 4);
#pragma unroll
            for (int ai = 0; ai < 2; ++ai)
#pragma unroll
                for (int m = 0; m < MA; ++m) {
                    const int row = row0 + ai * HA + m * 16;
                    const float* src = (row < 4096 ? ysp + (size_t)row * 1024 : yss + (size_t)(row - 4096) * 1024) + col;
                    const f32x4 v0 = *(const f32x4*)src + g0 * acc[ai][bj][m][0], v1 = *(const f32x4*)(src + 4) + g1 * acc[ai][bj][m][1];
                    float* dst = Y + (size_t)row * 1024 + col;
                    *(f32x4*)dst = v0; *(f32x4*)(dst + 4) = v1;
                    acc[ai][bj][m][0] = v0; acc[ai][bj][m][1] = v1;
                    ss[ai][m] += (v0[0] * v0[0] + v0[1] * v0[1]) + (v0[2] * v0[2] + v0[3] * v0[3]) + (v1[0] * v1[0] + v1[1] * v1[1]) + (v1[2] * v1[2] + v1[3] * v1[3]);
                }
        }
#pragma unroll
        for (int ai = 0; ai < 2; ++ai)
#pragma unroll
            for (int m = 0; m < MA; ++m) { float s = ss[ai][m]; s += __shfl_xor(s, 16); s += __shfl_xor(s, 32);
                if (fq == 0) part[wc * 128 + ai * HA + wr * WRA + m * 16 + fr] = s; }
        __syncthreads();
        if (tid < 128) { const float t = part[tid] + part[128 + tid] + part[256 + tid] + part[384 + tid];
            __hip_atomic_store(xs + (size_t)(u.pm * 4 + u.pn) * 128 + tid, __builtin_bit_cast(unsigned, t), __ATOMIC_RELAXED, __HIP_MEMORY_SCOPE_AGENT); }
        asm volatile("s_waitcnt vmcnt(0)" ::: "memory");
        __syncthreads();
        if (tid == 0) { unsigned* c = cnt + 16 * u.pm;
            __hip_atomic_fetch_add(c, 1u, __ATOMIC_RELAXED, __HIP_MEMORY_SCOPE_AGENT);
            unsigned sp = 0; while (__hip_atomic_load(c, __ATOMIC_RELAXED, __HIP_MEMORY_SCOPE_AGENT) < 4u && ++sp < (1u << 20)) __builtin_amdgcn_s_sleep(1); }
        __syncthreads();
        if (tid < 128) { float t = 0.f;
#pragma unroll
            for (int p = 0; p < 4; ++p) t += __builtin_bit_cast(float, __hip_atomic_load(xs + (size_t)(u.pm * 4 + p) * 128 + tid, __ATOMIC_RELAXED, __HIP_MEMORY_SCOPE_AGENT));
            rstds[tid] = rsqrtf(t * (1.f / 1024.f) + 1e-6f); }
        __syncthreads();
#pragma unroll
        for (int bj = 0; bj < 2; ++bj) {
            const int col = col0 + bj * HALF;
            const float* mp = mod_n + cond * 3072 + col;
            const f32x4 n0 = *(const f32x4*)(nw + col), n1 = *(const f32x4*)(nw + col + 4), sh0 = *(const f32x4*)mp, sh1 = *(const f32x4*)(mp + 4), sc0 = *(const f32x4*)(mp + 1024), sc1 = *(const f32x4*)(mp + 1028);
            const f32x4 m0 = n0 * (sc0 + 1.f), m1 = n1 * (sc1 + 1.f);
#pragma unroll
            for (int ai = 0; ai < 2; ++ai)
#pragma unroll
                for (int m = 0; m < MA; ++m) {
                    const int rl = ai * HA + wr * WRA + m * 16 + fr; const float r = rstds[rl];
                    const f32x4 h0 = acc[ai][bj][m][0] * r * m0 + sh0, h1 = acc[ai][bj][m][1] * r * m1 + sh1;
                    u32x4 w; w.x = cvt_pk_bf16(h0[0], h0[1]); w.y = cvt_pk_bf16(h0[2], h0[3]); w.z = cvt_pk_bf16(h1[0], h1[1]); w.w = cvt_pk_bf16(h1[2], h1[3]);
                    *(u32x4*)(H + (size_t)(u.pm * BMA + rl) * 1024 + col) = w;
                }
        }
    }
};
template <class Epi, class Sched, bool ALIGN_EPI = false, bool SP2 = false>
__device__ __forceinline__ void gemm_phase(PG8_LAS unsigned char* lds, const Gemm g, const Sched& S, const Epi& E) {
    constexpr int BMA = Epi::BMA_ROWS, HA = BMA / 2, MA = HA / 32, WRA = HA / 2;
    const int tid = pg8_opaque((int)threadIdx.x), wid = __builtin_amdgcn_readfirstlane(tid >> 6), lane = tid & 63, wr = wid >> 2, wc = wid & 3, fr = lane & 15, fq = lane >> 4;
    const int K = g.K, nt = K / BK;
    unsigned voffA[2], voffB[2];
#pragma unroll
    for (int i = 0; i < 2; ++i) { int R, C; stage_rc(tid * 16 + i * 8192, R, C); const int Rb = Epi::PERM ? ((R & ~31) + perm32(R & 31)) : R;
        voffA[i] = (unsigned)(R * K + C) * 2u; voffB[i] = (unsigned)(Rb * K + C) * 2u; }
    const size_t kstep = (size_t)(BK * 2);
    const size_t hstep = (size_t)HALF * K * 2;
    const size_t tstep = 2 * hstep;
    const size_t hstepA = (size_t)HA * K * 2, tstepA = 2 * hstepA;
    const unsigned ldsw = (unsigned)wid * 1024u;
    const int aoff = lds_byte(wr * WRA + fr, fq * 8), boff = lds_byte(wc * 32 + fr, fq * 8);
#define PG8_SA(b, h) (((b) * 2 + (h)) * HTB)
#define PG8_SB(b, h) ((4 + (b) * 2 + (h)) * HTB)
#define PG8_STAGE(bufoff, gbase, voff) do { _Pragma("unroll") for (int _i = 0; _i < 2; ++_i) \
        __builtin_amdgcn_global_load_lds((const unsigned*)((const char*)(gbase) + (voff)[_i]), (PG8_LAS unsigned*)(lds + (bufoff) + ldsw + _i * 8192), 16, 0, 0); } while (0)
#define PG8_LDA(dst, b, h) do { _Pragma("unroll") for (int m = 0; m < MA; ++m) _Pragma("unroll") for (int k = 0; k < 2; ++k) dst[m][k] = *(const PG8_LAS bf16x8*)(lds + PG8_SA(b, h) + aoff + m * 2048 + k * 1024); } while (0)
#define PG8_LDB(dst, b, h) do { _Pragma("unroll") for (int n = 0; n < 2; ++n) _Pragma("unroll") for (int k = 0; k < 2; ++k) dst[n][k] = *(const PG8_LAS bf16x8*)(lds + PG8_SB(b, h) + boff + n * 2048 + k * 1024); } while (0)
#define PG8_MMA(ai, bj, At, Bt) do { __builtin_amdgcn_s_setprio(1); _Pragma("unroll") for (int m = 0; m < MA; ++m) _Pragma("unroll") for (int n = 0; n < 2; ++n) _Pragma("unroll") for (int k = 0; k < 2; ++k) \
        acc[ai][bj][m][n] = __builtin_amdgcn_mfma_f32_16x16x32_bf16(Bt[n][k], At[m][k], acc[ai][bj][m][n], 0, 0, 0); __builtin_amdgcn_s_setprio(0); } while (0)
#define PG8_WAIT_V(n) asm volatile("s_waitcnt vmcnt(" #n ")" ::: "memory")
#define PG8_WAIT_L(n) asm volatile("s_waitcnt lgkmcnt(" #n ")" ::: "memory")
#define PG8_BAR __builtin_amdgcn_s_barrier()
#define PG8_SCHED __builtin_amdgcn_sched_barrier(0)
    Unit cur, nxt; int ui = 0;
    if (!S.next(0, cur)) return;
    f32x4 acc[2][2][4][2];
#pragma unroll
    for (int a = 0; a < 2; ++a)
#pragma unroll
        for (int b = 0; b < 2; ++b)
#pragma unroll
            for (int m = 0; m < MA; ++m)
#pragma unroll
                for (int n = 0; n < 2; ++n) acc[a][b][m][n] = (f32x4){0.f, 0.f, 0.f, 0.f};
    bf16x8 At[4][2], B0[2][2], B1[2][2];
    const char* cA = (const char*)g.A + (size_t)cur.pm * tstepA; const char* cB = (const char*)g.Bt + (size_t)cur.pn * tstep;
    S.a_ready(cur);
    if constexpr (SP2) {
        PG8_STAGE(PG8_SB(0, 0), cB, voffB); PG8_STAGE(PG8_SB(0, 1), cB + hstep, voffB); PG8_STAGE(PG8_SA(0, 0), cA, voffA); PG8_STAGE(PG8_SA(0, 1), cA + hstepA, voffA);
        if (wr == 1) PG8_BAR;
        PG8_WAIT_V(2); PG8_BAR;
        PG8_STAGE(PG8_SB(1, 0), cB + kstep, voffB); PG8_STAGE(PG8_SA(1, 0), cA + kstep, voffA); PG8_STAGE(PG8_SB(1, 1), cB + hstep + kstep, voffB);
        PG8_WAIT_V(6); PG8_BAR;
    } else {
        PG8_STAGE(PG8_SB(0, 0), cB, voffB); PG8_STAGE(PG8_SA(0, 0), cA, voffA); PG8_STAGE(PG8_SB(0, 1), cB + hstep, voffB); PG8_STAGE(PG8_SA(0, 1), cA + hstepA, voffA);
        if (wr == 1) PG8_BAR;
        PG8_WAIT_V(4); PG8_BAR;
        PG8_STAGE(PG8_SB(1, 0), cB + kstep, voffB); PG8_STAGE(PG8_SA(1, 0), cA + kstep, voffA); PG8_STAGE(PG8_SB(1, 1), cB + hstep + kstep, voffB);
        PG8_WAIT_V(6); PG8_BAR;
    }
    for (;;) {
        const bool has_next = S.next(ui + 1, nxt);
        const char* nA = has_next ? (const char*)g.A + (size_t)nxt.pm * tstepA : cA; const char* nB = has_next ? (const char*)g.Bt + (size_t)nxt.pn * tstep : cB;
        for (int t = 0; t < nt; t += 2) {
            const bool last = (t == nt - 2);
            const char* a1 = cA + (size_t)(t + 1) * kstep;
            const char* a2 = last ? nA : cA + (size_t)(t + 2) * kstep; const char* b2 = last ? nB : cB + (size_t)(t + 2) * kstep;
            const char* a3 = a2 + kstep; const char* b3 = b2 + kstep;
            if (last && has_next) S.a_ready(nxt);
            if constexpr (SP2) {
            PG8_LDB(B0, 0, 0); PG8_LDB(B1, 0, 1); PG8_SCHED; PG8_LDA(At, 0, 0); PG8_STAGE(PG8_SA(1, 1), a1 + hstepA, voffA);
            PG8_WAIT_V(8); PG8_WAIT_L(0); PG8_BAR; PG8_MMA(0, 0, At, B0); PG8_MMA(0, 1, At, B1); PG8_BAR; PG8_SCHED;
            PG8_LDA(At, 0, 1); PG8_STAGE(PG8_SB(0, 0), b2, voffB); PG8_STAGE(PG8_SB(0, 1), b2 + hstep, voffB); PG8_STAGE(PG8_SA(0, 0), a2, voffA);
            PG8_WAIT_V(8); PG8_WAIT_L(0); PG8_BAR; PG8_MMA(1, 0, At, B0); PG8_MMA(1, 1, At, B1); PG8_BAR; PG8_SCHED;
            PG8_LDB(B0, 1, 0); PG8_LDB(B1, 1, 1); PG8_SCHED; PG8_LDA(At, 1, 0); PG8_STAGE(PG8_SA(0, 1), a2 + hstepA, voffA);
            PG8_WAIT_V(8); PG8_WAIT_L(0); PG8_BAR; PG8_MMA(0, 0, At, B0); PG8_MMA(0, 1, At, B1); PG8_BAR; PG8_SCHED;
            PG8_LDA(At, 1, 1); PG8_STAGE(PG8_SB(1, 0), b3, voffB); PG8_STAGE(PG8_SB(1, 1), b3 + hstep, voffB); PG8_STAGE(PG8_SA(1, 0), a3, voffA);
            PG8_WAIT_V(8); PG8_WAIT_L(0); PG8_BAR; PG8_MMA(1, 0, At, B0); PG8_MMA(1, 1, At, B1); PG8_BAR; PG8_SCHED;
            } else {
            PG8_LDB(B0, 0, 0); PG8_SCHED; PG8_LDA(At, 0, 0); PG8_STAGE(PG8_SA(1, 1), a1 + hstepA, voffA);
            PG8_WAIT_L(8); PG8_BAR; PG8_WAIT_L(0); PG8_MMA(0, 0, At, B0); PG8_BAR; PG8_SCHED;
            PG8_LDB(B1, 0, 1); PG8_STAGE(PG8_SB(0, 0), b2, voffB);
            PG8_BAR; PG8_WAIT_L(0); PG8_MMA(0, 1, At, B1); PG8_BAR;
            PG8_LDA(At, 0, 1); PG8_STAGE(PG8_SA(0, 0), a2, voffA);
            PG8_BAR; PG8_WAIT_L(0); PG8_MMA(1, 0, At, B0); PG8_BAR; PG8_SCHED;
            PG8_STAGE(PG8_SB(0, 1), b2 + hstep, voffB);
            PG8_WAIT_V(6); PG8_BAR; PG8_MMA(1, 1, At, B1); PG8_BAR;
            PG8_LDB(B0, 1, 0); PG8_SCHED; PG8_LDA(At, 1, 0); PG8_STAGE(PG8_SA(0, 1), a2 + hstepA, voffA);
            PG8_WAIT_L(8); PG8_BAR; PG8_WAIT_L(0); PG8_MMA(0, 0, At, B0); PG8_BAR; PG8_SCHED;
            PG8_LDB(B1, 1, 1); PG8_STAGE(PG8_SB(1, 0), b3, voffB);
            PG8_BAR; PG8_WAIT_L(0); PG8_MMA(0, 1, At, B1); PG8_BAR;
            PG8_LDA(At, 1, 1); PG8_STAGE(PG8_SA(1, 0), a3, voffA);
            PG8_BAR; PG8_WAIT_L(0); PG8_MMA(1, 0, At, B0); PG8_BAR; PG8_SCHED;
            PG8_STAGE(PG8_SB(1, 1), b3 + hstep, voffB);
            PG8_WAIT_V(6); PG8_BAR; PG8_MMA(1, 1, At, B1); PG8_BAR;
            }
        }
        if constexpr (ALIGN_EPI) { if (wr == 0) PG8_BAR; }
        if constexpr (!Epi::AFTER_DRAIN) { E(acc, cur, wr, wc, fr, fq); S.done(cur); }
        if (!has_next) break;
#pragma unroll
        for (int a = 0; a < 2; ++a)
#pragma unroll
            for (int b = 0; b < 2; ++b)
#pragma unroll
                for (int m = 0; m < MA; ++m)
#pragma unroll
                    for (int n = 0; n < 2; ++n) acc[a][b][m][n] = (f32x4){0.f, 0.f, 0.f, 0.f};
        cur = nxt; cA = nA; cB = nB; ++ui;
        if constexpr (ALIGN_EPI) { if (wr == 1) PG8_BAR; }
    }
    PG8_WAIT_V(0);
    if constexpr (!ALIGN_EPI) { if (wr == 0) PG8_BAR; }
    PG8_BAR;
    if constexpr (Epi::AFTER_DRAIN) { E.fused(acc, cur, wr, wc, fr, fq, lds, wid, lane); S.done(cur); }
#undef PG8_SA
#undef PG8_SB
#undef PG8_STAGE
#undef PG8_LDA
#undef PG8_LDB
#undef PG8_MMA
#undef PG8_WAIT_V
#undef PG8_WAIT_L
#undef PG8_BAR
#undef PG8_SCHED
}
}
#define XB_TMO      128
#define XB_XCNT(j)  (256  + 64 * (j))
#define XB_XSUB(j)  (1280 + 64 * (j))
#define XB_XGEN(j)  (2304 + 64 * (j))
#define XB_TOP      3328
#define XB_TOPGEN   3392
#define XCD_BAR_WORDS 3456
#define XB_SPIN_CAP (1u << 18)

__device__ __forceinline__ unsigned xb_ld(unsigned* p)              { return __hip_atomic_load(p, __ATOMIC_RELAXED, __HIP_MEMORY_SCOPE_AGENT); }
__device__ __forceinline__ unsigned xb_add(unsigned* p, unsigned v) { return __hip_atomic_fetch_add(p, v, __ATOMIC_RELAXED, __HIP_MEMORY_SCOPE_AGENT); }
__device__ __forceinline__ unsigned xb_xcc_id() { return (unsigned)__builtin_amdgcn_s_getreg((3 << 11) | 20) & 0xFu; }
#define XB_SPIN(cond, bar) do { unsigned _sp = 0; while (cond) { __builtin_amdgcn_s_sleep(1); \
    if ((++_sp & 255u) == 0u) { if (xb_ld(&(bar)[XB_TMO])) break; if (_sp > XB_SPIN_CAP) { atomicAdd(&(bar)[XB_TMO], 1u); break; } } } } while (0)

struct XcdBarrier {
    unsigned* bar; unsigned x;
    volatile LAS unsigned* st;
};

__device__ __forceinline__ XcdBarrier xcd_barrier_post(unsigned* bar, volatile LAS unsigned* st) {
    XcdBarrier b; b.bar = bar; b.x = xb_xcc_id(); b.st = st;
    if (threadIdx.x == 0) (void)xb_add(&bar[XB_XCNT(b.x)], 1u);
    return b;
}
__device__ __forceinline__ void xcd_barrier_complete(unsigned* bar, unsigned x, unsigned& nloc, unsigned& nx) {
    const unsigned G = gridDim.x * gridDim.y * gridDim.z;
    unsigned sum, cnt, mine, sp = 0u;
    for (;;) {
        sum = 0u; cnt = 0u; mine = 0u;
#pragma unroll
        for (unsigned j = 0; j < 16; ++j) { const unsigned c = xb_ld(&bar[XB_XCNT(j)]); sum += c; cnt += (c > 0u) ? 1u : 0u; mine = (j == x) ? c : mine; }
        if (sum == G) break;
        __builtin_amdgcn_s_sleep(1);
        if ((++sp & 255u) == 0u) { if (xb_ld(&bar[XB_TMO])) break; if (sp > XB_SPIN_CAP) { atomicAdd(&bar[XB_TMO], 1u); break; } }
    }
    nloc = mine > 0u ? mine : 1u; nx = cnt > 0u ? cnt : 1u;
}

__device__ __forceinline__ void xcd_barrier(const XcdBarrier& b) {
    asm volatile("s_waitcnt vmcnt(0)" ::: "memory");
    __syncthreads();
    if (threadIdx.x == 0) {
        unsigned* bar = b.bar;
        __builtin_amdgcn_s_waitcnt(0);
        unsigned nloc = b.st[0], nx = b.st[1];
        if (nloc == 0u) { xcd_barrier_complete(bar, b.x, nloc, nx); b.st[0] = nloc; b.st[1] = nx; }
        const unsigned old = xb_add(&bar[XB_XSUB(b.x)], 1u);
        const unsigned gen = old / nloc;
        if (old + 1u == (gen + 1u) * nloc) {
            __builtin_amdgcn_fence(__ATOMIC_RELEASE, "agent");
            asm volatile("s_waitcnt vmcnt(0)" ::: "memory");
            const unsigned og = xb_add(&bar[XB_TOP], 1u);
            const unsigned tg = og / nx;
            if (og + 1u == (tg + 1u) * nx) xb_add(&bar[XB_TOPGEN], 1u);
            else XB_SPIN(xb_ld(&bar[XB_TOPGEN]) == tg, bar);
            __builtin_amdgcn_fence(__ATOMIC_ACQUIRE, "agent");
            xb_add(&bar[XB_XGEN(b.x)], 1u);
            asm volatile("s_waitcnt vmcnt(0)" ::: "memory");
        } else {
            XB_SPIN(xb_ld(&bar[XB_XGEN(b.x)]) == gen, bar);
            __builtin_amdgcn_fence(__ATOMIC_ACQUIRE, "agent");
            asm volatile("s_waitcnt vmcnt(0)" ::: "memory");
        }
    }
    __syncthreads();
}

constexpr int NWAVES = 8, NTHR = 512;
constexpr int LDS_BYTES = 147456;
constexpr int MISC_OFF = 147456 - 256;
constexpr int CW_BAR = 4096;

struct Args {
    const float* in[32];
    float* out;
    unsigned char* ws;
    int ph_lo, ph_hi;
};

struct Ctx {
    LAS unsigned char* lds;
    unsigned char* ldsg;
    int tid, lane, wave, G, bid;
};


#ifndef PROF_ID
#define PROF_ID 0
#endif
#ifndef PROF_K
#define PROF_K 8
#endif
#define PROF_BEGIN(id) unsigned long long pt0_##id = 0; if (PROF_ID == (id)) pt0_##id = __builtin_amdgcn_s_memrealtime();
#define PROF_END(id) if (PROF_ID == (id) && threadIdx.x == 0) { const unsigned dt_ = (unsigned)(__builtin_amdgcn_s_memrealtime() - pt0_##id); ((volatile LAS unsigned*)(X.lds + MISC_OFF))[16] += dt_; }

__device__ __forceinline__ int opaque_v(int x) { asm volatile("" : "+v"(x)); return x; }
__device__ __forceinline__ int opaque_s(int x) { asm volatile("" : "+s"(x)); return x; }
__device__ __forceinline__ int map_even(int dg) {
    if (dg < 24) return dg;
    if (dg < 152) return dg + 2;
    if (dg < 216) return dg + 3;
    if (dg < 218) return dg - 192;
    if (dg == 218) return 154;
    return -1;
}
__device__ __forceinline__ void transpose_item(const float* W, int ldn, int K, bf16* WT, int k0, int n0, int ca, int cb, LAS float* scr, int lane, bool frag = false) {
    const int n = lane & 31; const int sc = (n < 16) ? ca : cb;
    float tv[32];
#pragma unroll
    for (int i = 0; i < 32; ++i) { const int kk = 2 * i + (lane >> 5); tv[i] = sc >= 0 ? W[(size_t)(k0 + kk) * ldn + sc + (n & 15)] : 0.f; }
    SB_PIN
#pragma unroll
    for (int i = 0; i < 32; ++i) { const int kk = 2 * i + (lane >> 5); scr[kk * 33 + n] = tv[i]; }
    LDS_WAIT(); asm volatile("" ::: "memory");
    const int c = lane & 7;
#pragma unroll
    for (int j = 0; j < 4; ++j) { const int nn = (lane >> 3) + 8 * j; const LAS float* s = scr + (8 * c) * 33 + nn;
        v4u o; o.x = pk2(s[0 * 33], s[1 * 33]); o.y = pk2(s[2 * 33], s[3 * 33]); o.z = pk2(s[4 * 33], s[5 * 33]); o.w = pk2(s[6 * 33], s[7 * 33]);
        bf16* dst = frag ? WT + ((size_t)((n0 + nn) >> 5) * (K >> 4) + ((k0 + 8 * c) >> 4)) * 512 + ((((k0 + 8 * c) >> 3) & 1) * 32 + ((n0 + nn) & 31)) * 8 : WT + (size_t)(n0 + nn) * K + k0 + 8 * c;
        *(v4u*)dst = o; }
    LDS_WAIT(); asm volatile("" ::: "memory");
}

__device__ __forceinline__ void mod_unit(const Args& a, const Ctx& X, int l, int chunk, int tid, int lane, int wave) {
    LAS float* scs = (LAS float*)X.lds;
    LAS float* part = scs + 3072;
    const float* c_ctx = a.in[10]; const float* c = a.in[2];
    for (int i = tid; i < 3072; i += NTHR) { const int r = i >> 10, k = i & 1023; const float v = r == 0 ? c_ctx[k] : c[(r - 1) * 1024 + k]; scs[i] = v / (1.f + expf(-v)); }
    __syncthreads();
    const int j0 = chunk * 64;
    const float* w = a.in[12] + (size_t)l * 1024 * 3072 + j0 + lane;
    float a0 = 0.f, a1 = 0.f, a2 = 0.f;
#pragma unroll 32
    for (int kk = 0; kk < 128; ++kk) { const int k = wave * 128 + kk; const float wv = w[(size_t)k * 3072]; a0 += scs[k] * wv; a1 += scs[1024 + k] * wv; a2 += scs[2048 + k] * wv; }
    part[(wave * 3 + 0) * 64 + lane] = a0; part[(wave * 3 + 1) * 64 + lane] = a1; part[(wave * 3 + 2) * 64 + lane] = a2;
    __syncthreads();
    if (tid < 192) { const int r = tid >> 6, cc = tid & 63; float s = 0.f;
#pragma unroll
        for (int w8 = 0; w8 < 8; ++w8) s += part[(w8 * 3 + r) * 64 + cc];
        ((float*)(a.ws + WS_MOD))[(l * 3 + r) * 3072 + j0 + cc] = s + a.in[13][l * 3072 + j0 + cc]; }
    __syncthreads();
}
__device__ __forceinline__ void prep_weights(const Args& a, const Ctx& X, int l, int gw, int NGW, int lane, int wave) {
    unsigned char* ws = a.ws;
    LAS float* scr = (LAS float*)(X.lds + 32768 + wave * 8448);
    const int j = l >> 1;
    if ((l & 1) == 0) {
        for (int it = gw; it < 2464; it += NGW) {
            if (it < 1792) { const int nb = it % 112, kb = it / 112;
                transpose_item(a.in[14] + (size_t)j * 1024 * 3504, 3504, 1024, (bf16*)(ws + WS_WTEV) + (size_t)j * 3584 * 1024, kb * 64, nb * 32,
                               map_even(2 * nb) < 0 ? -1 : map_even(2 * nb) * 16, map_even(2 * nb + 1) < 0 ? -1 : map_even(2 * nb + 1) * 16, scr, lane);
            } else if (it < 2304) { const int r = it - 1792, nb = r % 32, kb = r / 32;
                transpose_item(a.in[24] + (size_t)j * 1024 * 1024, 1024, 1024, (bf16*)(ws + WS_WTOUT) + (size_t)l * 1024 * 1024, kb * 64, nb * 32, nb * 32, nb * 32 + 16, scr, lane);
            } else if (it < 2400) { const int r = it - 2304, nb = r % 24, kb = r / 24;
                transpose_item(a.in[17] + (size_t)j * 256 * 768, 768, 256, (bf16*)(ws + WS_WTQB) + (size_t)j * 768 * 256, kb * 64, nb * 32, nb * 32, nb * 32 + 16, scr, lane, true);
            } else { const int r = it - 2400, nb = r % 32, kb = r / 32;
                transpose_item(a.in[18] + (size_t)j * 128 * 1024, 1024, 128, (bf16*)(ws + WS_WTKVB) + (size_t)j * 1024 * 128, kb * 64, nb * 32, nb * 32, nb * 32 + 16, scr, lane, true);
            }
        }
    } else {
        for (int it = gw; it < 2560; it += NGW) {
            if (it < 2048) { const int nb = it % 128, kb = it / 128;
                transpose_item(a.in[25] + (size_t)j * 1024 * 4096, 4096, 1024, (bf16*)(ws + WS_WTOD) + (size_t)j * 4096 * 1024, kb * 64, nb * 32, nb * 32, nb * 32 + 16, scr, lane);
            } else { const int r = it - 2048, nb = r % 32, kb = r / 32;
                transpose_item(a.in[31] + (size_t)j * 1024 * 1024, 1024, 1024, (bf16*)(ws + WS_WTOUT) + (size_t)l * 1024 * 1024, kb * 64, nb * 32, nb * 32, nb * 32 + 16, scr, lane);
            }
        }
    }
}
__device__ __forceinline__ void phase_p0a(const Args& a, const Ctx& X) {
    unsigned char* ws = a.ws;
    const int tid = opaque_v(X.tid), lane = tid & 63, wave = opaque_s(X.wave);
    if (X.bid < 192) mod_unit(a, X, X.bid / 48, X.bid % 48, tid, lane, wave);
    else if (X.bid == 192) {
        const int pos = tid >> 3, f = tid & 7;
        const float ang = (float)pos * powf(10000.f, -(float)f / 8.f);
        float* rt = (float*)(ws + WS_ROPE);
        rt[pos * 16 + f] = cosf(ang); rt[pos * 16 + 8 + f] = sinf(ang);
    } else {
        const int nb = X.G - 193, b0 = X.bid - 193;
        const float* ck = a.in[8]; const float* cv = a.in[9]; const float* c0 = a.in[5];
        bf16* nakc = (bf16*)(ws + WS_NAKC); bf16* navc = (bf16*)(ws + WS_NAVC); float* c0t = (float*)(ws + WS_C0T);
#pragma unroll 4
        for (int idx = b0 * NTHR + tid; idx < 524288; idx += nb * NTHR) {
            const int d = idx & 63, h = (idx >> 6) & 7, key = (idx >> 9) & 255, bj = idx >> 17;
            { const size_t blk = ((size_t)(bj * 8 + h) * 8 + (key >> 5)) * 4; const int kr = key & 31, t16 = key & 15;
              nakc[(blk + (d >> 4)) * 512 + (((d >> 3) & 1) * 32 + kr) * 8 + (d & 7)] = (bf16)(pk2(ck[idx] / a.in[29][(bj & 1) * 64 + d], 0.f) & 0xffffu);
              navc[(blk + (d >> 5) * 2 + (kr >> 4)) * 512 + (((t16 >> 2) & 1) * 32 + (d & 31)) * 8 + 4 * (t16 >> 3) + (t16 & 3)] = (bf16)(pk2(cv[idx], 0.f) & 0xffffu); }
            const int e = idx & 127, dd = (idx >> 7) & 127, mat = idx >> 14;
            c0t[(size_t)mat * 16384 + e * 128 + dd] = c0[idx];
        }
    }
    for (int l = 0; l < 4; ++l) prep_weights(a, X, l, X.bid * NWAVES + wave, X.G * NWAVES, lane, wave);
}
__device__ __forceinline__ void gemm2_side(const Args& a, const Ctx& X, int l) {
    const int tid = opaque_v(X.tid), lane = tid & 63, wave = opaque_s(X.wave), idx = X.bid - 96;
    if (idx < 48) mod_unit(a, X, l + 1, idx, tid, lane, wave);
    prep_weights(a, X, l + 1, idx * NWAVES + wave, (X.G - 96) * NWAVES, lane, wave);
}

__device__ __forceinline__ void phase_norm(const Args& a, const Ctx& X, int l) {
    const float* ysp = l == 0 ? a.in[0] : a.out; const float* yss = l == 0 ? a.in[1] : a.out + (size_t)NP * DM;
    const float* nw = a.in[11] + l * DM;
    const float* modl = (const float*)(a.ws + WS_MOD) + l * 3 * 3072;
    bf16* H = (bf16*)(a.ws + WS_H);
    const int lane = opaque_v(X.tid) & 63; const int gw = X.bid * NWAVES + opaque_s(X.wave), NGW = X.G * NWAVES;
    f32x4 v[3][4];
#pragma unroll
    for (int q = 0; q < 3; ++q) { const int r = gw + q * NGW; const float* y = r < NP ? ysp + (size_t)r * DM : yss + (size_t)(r - NP) * DM;
#pragma unroll
        for (int j = 0; j < 4; ++j) v[q][j] = r < NT ? *(const f32x4*)(y + 4 * lane + 256 * j) : (f32x4){0.f, 0.f, 0.f, 0.f}; }
    SB_PIN
#pragma unroll
    for (int q = 0; q < 3; ++q) { const int r = gw + q * NGW; if (r < NT) {
        const float* md = modl + cond_of_row(r) * 3072;
        float ss = 0.f;
#pragma unroll
        for (int j = 0; j < 4; ++j) ss += (v[q][j].x * v[q][j].x + v[q][j].y * v[q][j].y) + (v[q][j].z * v[q][j].z + v[q][j].w * v[q][j].w);
        const float rstd = rsqrtf(wave_sum(ss) * (1.f / DM) + EPS);
#pragma unroll
        for (int j = 0; j < 4; ++j) { const int k = 4 * lane + 256 * j;
            const f32x4 g = *(const f32x4*)(nw + k), sh = *(const f32x4*)(md + k), sc = *(const f32x4*)(md + 1024 + k);
            const f32x4 o = v[q][j] * rstd * g * (sc + 1.f) + sh;
            st4bf(H + (size_t)r * DM + k, o.x, o.y, o.z, o.w); }
    } }
}

__device__ __forceinline__ void unit_mla_q(const Args& a, const Ctx& X, int j, int t) {
    const bf16* U = (const bf16*)(a.ws + WS_U); bf16* Q = (bf16*)(a.ws + WS_Q);
    const bf16* Wq = (const bf16*)(a.ws + WS_WTQB) + (size_t)j * 768 * 256;
    const float* rope = (const float*)(a.ws + WS_ROPE);
    const float* qan = a.in[15] + j * 256; const float* qn = a.in[19] + j * 96;
    bf16* Xn = (bf16*)X.ldsg;
    const int tid = opaque_v(X.tid), lane = tid & 63, w = opaque_s(X.wave), r = lane & 31, hh = lane >> 5, R0 = t * 64; (void)tid;
    PROF_BEGIN(20)
    { v2u raw8[8]; const f32x4 g = *(const f32x4*)(qan + 4 * lane);
#pragma unroll
      for (int i = 0; i < 8; ++i) raw8[i] = *(const v2u*)(U + (size_t)(R0 + 8 * w + i) * UE + CE_QA + 4 * lane);
      SB_PIN
#pragma unroll
      for (int i = 0; i < 8; ++i) { const int row = 8 * w + i; const v2u raw = raw8[i];
        const float x0 = bflo(raw.x), x1 = bfhi(raw.x), x2 = bflo(raw.y), x3 = bfhi(raw.y);
        const float rstd = rsqrtf(wave_sum(x0 * x0 + x1 * x1 + x2 * x2 + x3 * x3) * (1.f / 256.f) + EPS);
        st4bf(Xn + row * 264 + 4 * lane, x0 * rstd * g.x, x1 * rstd * g.y, x2 * rstd * g.z, x3 * rstd * g.w); } }
    __syncthreads();
    PROF_END(20)
    PROF_BEGIN(21)
    f32x16 acc[3][2];
#pragma unroll
    for (int fb = 0; fb < 3; ++fb)
#pragma unroll
        for (int tb = 0; tb < 2; ++tb)
#pragma unroll
            for (int i = 0; i < 16; ++i) acc[fb][tb][i] = 0.f;
    const bf16* wp = Wq + (size_t)(w * 3) * 16 * 512 + lane * 8;
    const bf16* xp = Xn + r * 264 + 8 * hh;
#pragma unroll
    for (int kh = 0; kh < 4; ++kh) {
        bh8 af[4][3];
#pragma unroll
        for (int k8 = 0; k8 < 4; ++k8)
#pragma unroll
            for (int fb = 0; fb < 3; ++fb) af[k8][fb] = ld16(wp + (size_t)(fb * 16 + kh * 4 + k8) * 512);
        SB_PIN
#pragma unroll
        for (int k8 = 0; k8 < 4; ++k8) { const int ks = kh * 4 + k8; bh8 bfr[2];
#pragma unroll
            for (int tb = 0; tb < 2; ++tb) bfr[tb] = ld16(xp + tb * 32 * 264 + 16 * ks);
#pragma unroll
            for (int fb = 0; fb < 3; ++fb)
#pragma unroll
                for (int tb = 0; tb < 2; ++tb) acc[fb][tb] = mfma32(af[k8][fb], bfr[tb], acc[fb][tb]); }
        SB_PIN
    }
    PROF_END(21)
    PROF_BEGIN(22)
#pragma unroll
    for (int tb = 0; tb < 2; ++tb) {
        float ss = 0.f;
#pragma unroll
        for (int fb = 0; fb < 3; ++fb)
#pragma unroll
            for (int i = 0; i < 16; ++i) ss += acc[fb][tb][i] * acc[fb][tb][i];
        ss += __shfl_xor(ss, 32);
        const float rstd = rsqrtf(ss * (1.f / 96.f) + EPS) * (0.10206207261596577f * 1.4426950408889634f);
        const int row = R0 + 32 * tb + r;
        const bool sample = row >= NP; const int tp = (row - NP) & 1023;
#pragma unroll
        for (int fb = 0; fb < 3; ++fb) {
            float v[16];
#pragma unroll
            for (int g = 0; g < 4; ++g) { const f32x4 gn = *(const f32x4*)(qn + 32 * fb + 8 * g + 4 * hh);
                v[4 * g + 0] = acc[fb][tb][4 * g + 0] * rstd * gn.x; v[4 * g + 1] = acc[fb][tb][4 * g + 1] * rstd * gn.y;
                v[4 * g + 2] = acc[fb][tb][4 * g + 2] * rstd * gn.z; v[4 * g + 3] = acc[fb][tb][4 * g + 3] * rstd * gn.w; }
            if (fb == 2 && sample) {
                const float* rr_ = rope + (tp >> 6) * 16 + 4 * hh; const float* rc_ = rope + (tp & 63) * 16 + 4 * hh;
#pragma unroll
                for (int e = 0; e < 4; ++e) {
                    float cs = rr_[e], sn = rr_[8 + e], x1 = v[e], x2 = v[4 + e];
                    v[e] = x1 * cs - x2 * sn; v[4 + e] = x1 * sn + x2 * cs;
                    cs = rc_[e]; sn = rc_[8 + e]; x1 = v[8 + e]; x2 = v[12 + e];
                    v[8 + e] = x1 * cs - x2 * sn; v[12 + e] = x1 * sn + x2 * cs;
                }
            }
#pragma unroll
            for (int g = 0; g < 4; ++g) st4bf(Q + (size_t)row * 768 + w * 96 + 32 * fb + 8 * g + 4 * hh, v[4 * g], v[4 * g + 1], v[4 * g + 2], v[4 * g + 3]);
        }
    }
    __syncthreads();    PROF_END(22)
}

__device__ __forceinline__ void unit_mla_kv(const Args& a, const Ctx& X, int j, int t) {
    const bf16* U = (const bf16*)(a.ws + WS_U); bf16* KM = (bf16*)(a.ws + WS_KM); bf16* VTM = (bf16*)(a.ws + WS_VTM);
    const bf16* Wkv = (const bf16*)(a.ws + WS_WTKVB) + (size_t)j * 1024 * 128;
    const float* rope = (const float*)(a.ws + WS_ROPE);
    const float* kvan = a.in[16] + j * 128; const float* kn = a.in[20] + j * 96;
    bf16* Xc = (bf16*)X.ldsg;
    float* kpes = (float*)(X.ldsg + 17408);
    const int tid = opaque_v(X.tid), lane = tid & 63, w = opaque_s(X.wave), r = lane & 31, hh = lane >> 5; (void)tid;
    const bool own = t >= 0;
    int R0 = 0, krow0, bs = 0;
    if (own) { R0 = t * 64; if (R0 < NP) krow0 = R0; else { bs = (R0 - NP) >> 10; krow0 = NP + bs * 1280 + 256 + ((R0 - NP) & 1023); } }
    else { const int ct = -1 - t; bs = ct >> 2; krow0 = NP + bs * 1280 + (ct & 3) * 64; }
    { unsigned raw8[8]; float kp8[8]; f32x2 c8[8];
      if (own) {
#pragma unroll
          for (int i = 0; i < 8; ++i) { raw8[i] = *(const unsigned*)(U + (size_t)(R0 + 8 * w + i) * UE + CE_KVA + 2 * lane);
              kp8[i] = lane < 32 ? bf2f(U[(size_t)(R0 + 8 * w + i) * UE + CE_KPE + lane]) : 0.f; }
      } else {
#pragma unroll
          for (int i = 0; i < 8; ++i) { const int s = ((-1 - t) & 3) * 64 + 8 * w + i; const size_t o = (size_t)(bs * 2 + j) * 256 + s;
              c8[i] = *(const f32x2*)(a.in[3] + o * 128 + 2 * lane); kp8[i] = lane < 32 ? a.in[4][o * 32 + lane] : 0.f; }
      }
      const f32x2 g = *(const f32x2*)(kvan + 2 * lane);
      SB_PIN
#pragma unroll
      for (int i = 0; i < 8; ++i) { const int row = 8 * w + i;
        if (own) {
            const float x0 = bflo(raw8[i]), x1 = bfhi(raw8[i]);
            const float rstd = rsqrtf(wave_sum(x0 * x0 + x1 * x1) * (1.f / 128.f) + EPS);
            const float c0 = x0 * rstd * g.x, c1 = x1 * rstd * g.y;
            *(unsigned*)(Xc + row * 136 + 2 * lane) = pk2(c0, c1);
            if (lane < 32) kpes[row * 32 + lane] = kp8[i];
            if (R0 < NP) { const int b = (R0 + row) >> 8, s = (R0 + row) & 255; const size_t o = (size_t)(b * 2 + j) * 256 + s;
                *(f32x2*)(a.out + O_CKV + o * 128 + 2 * lane) = (f32x2){c0, c1};
                if (lane < 32) a.out[O_KPE + o * 32 + lane] = kp8[i]; }
        } else {
            *(unsigned*)(Xc + row * 136 + 2 * lane) = pk2(c8[i].x, c8[i].y);
            if (lane < 32) kpes[row * 32 + lane] = kp8[i];
        } } }
    __syncthreads();
    f32x16 ak[2][2], av[2][2];
#pragma unroll
    for (int x = 0; x < 2; ++x)
#pragma unroll
        for (int y = 0; y < 2; ++y)
#pragma unroll
            for (int i = 0; i < 16; ++i) { ak[x][y][i] = 0.f; av[x][y][i] = 0.f; }
    const bf16* wp = Wkv + (size_t)(w * 4) * 8 * 512 + lane * 8;
    const bf16* xp = Xc + r * 136 + 8 * hh;
#pragma unroll
    for (int kh = 0; kh < 2; ++kh) { bh8 wk[4][2], wv[4][2];
#pragma unroll
      for (int k4 = 0; k4 < 4; ++k4)
#pragma unroll
          for (int fb = 0; fb < 2; ++fb) { wk[k4][fb] = ld16(wp + (size_t)(fb * 8 + kh * 4 + k4) * 512); wv[k4][fb] = ld16(wp + (size_t)((2 + fb) * 8 + kh * 4 + k4) * 512); }
      SB_PIN
#pragma unroll
      for (int k4 = 0; k4 < 4; ++k4) { const int ks = kh * 4 + k4; bh8 xf[2];
#pragma unroll
          for (int tb = 0; tb < 2; ++tb) xf[tb] = ld16(xp + tb * 32 * 136 + 16 * ks);
#pragma unroll
          for (int fb = 0; fb < 2; ++fb)
#pragma unroll
              for (int tb = 0; tb < 2; ++tb) { ak[fb][tb] = mfma32(wk[k4][fb], xf[tb], ak[fb][tb]); av[tb][fb] = mfma32(xf[tb], wv[k4][fb], av[tb][fb]); } }
      SB_PIN }
    const bool sample_own = own && R0 >= NP;
#pragma unroll
    for (int tb = 0; tb < 2; ++tb) {
        const int tok = 32 * tb + r;
        float kp[16]; float ss = 0.f;
#pragma unroll
        for (int g = 0; g < 4; ++g) { const f32x4 q4 = *(const f32x4*)(kpes + tok * 32 + 16 * hh + 4 * g); kp[4 * g] = q4.x; kp[4 * g + 1] = q4.y; kp[4 * g + 2] = q4.z; kp[4 * g + 3] = q4.w; }
#pragma unroll
        for (int i = 0; i < 16; ++i) ss += kp[i] * kp[i] + ak[0][tb][i] * ak[0][tb][i] + ak[1][tb][i] * ak[1][tb][i];
        ss += __shfl_xor(ss, 32);
        const float rstd = rsqrtf(ss * (1.f / 96.f) + EPS);
        bf16* kdst = KM + ((size_t)(((krow0 >> 5) + tb) * 8 + w) * 6) * 512 + r * 8;
#pragma unroll
        for (int fb = 0; fb < 2; ++fb)
#pragma unroll
            for (int g = 0; g < 4; ++g) { const int f0 = 32 * fb + 8 * g + 4 * hh; const f32x4 gn = *(const f32x4*)(kn + f0);
                st4bf(kdst + (2 * fb + (g >> 1)) * 512 + (g & 1) * 256 + 4 * hh, ak[fb][tb][4 * g] * rstd * gn.x, ak[fb][tb][4 * g + 1] * rstd * gn.y, ak[fb][tb][4 * g + 2] * rstd * gn.z, ak[fb][tb][4 * g + 3] * rstd * gn.w); }
#pragma unroll
        for (int g = 0; g < 4; ++g) { const f32x4 gn = *(const f32x4*)(kn + 64 + 16 * hh + 4 * g);
            kp[4 * g] *= rstd * gn.x; kp[4 * g + 1] *= rstd * gn.y; kp[4 * g + 2] *= rstd * gn.z; kp[4 * g + 3] *= rstd * gn.w; }
        if (sample_own) {
            const int tp = (R0 - NP + tok) & 1023; const int pos = hh == 0 ? (tp >> 6) : (tp & 63);
            const float* rp = rope + pos * 16;
#pragma unroll
            for (int i = 0; i < 8; ++i) { const float cs = rp[i], sn = rp[8 + i], x1 = kp[i], x2 = kp[8 + i]; kp[i] = x1 * cs - x2 * sn; kp[8 + i] = x1 * sn + x2 * cs; }
        }
#pragma unroll
        for (int g = 0; g < 4; ++g) st4bf(kdst + (4 + hh) * 512 + (g >> 1) * 256 + 4 * (g & 1), kp[4 * g], kp[4 * g + 1], kp[4 * g + 2], kp[4 * g + 3]);
#pragma unroll
        for (int fb = 0; fb < 2; ++fb) { bf16* vdst = VTM + ((size_t)(((krow0 >> 5) + tb) * 8 + w) * 4 + 2 * fb) * 512 + (hh * 32 + r) * 8;
#pragma unroll
            for (int g = 0; g < 4; ++g) st4bf(vdst + (g >> 1) * 512 + 4 * (g & 1), av[tb][fb][4 * g], av[tb][fb][4 * g + 1], av[tb][fb][4 * g + 2], av[tb][fb][4 * g + 3]); }
    }
    __syncthreads();
}

struct AttnState { f32x16 o0, o1; float m, l; };
__device__ __forceinline__ void attn_init(AttnState& st) {
#pragma unroll
    for (int i = 0; i < 16; ++i) { st.o0[i] = 0.f; st.o1[i] = 0.f; }
    st.m = -1e30f; st.l = 0.f;
}
template <int NKS> struct KVf { bh8 k[NKS]; bh8 v[4]; };
template <int NKS> __device__ __forceinline__ void load_kv(KVf<NKS>& f, const bf16* kp, const bf16* vp) {
#pragma unroll
    for (int ks = 0; ks < NKS; ++ks) f.k[ks] = ld16(kp + ks * 512);
#pragma unroll
    for (int q = 0; q < 4; ++q) f.v[q] = ld16(vp + q * 512);
}
template <int NKS, bool MASKED>
__device__ __forceinline__ void attn_compute(AttnState& st, const bh8* qf, const KVf<NKS>& f, const float* rk, int hh, bool na, int kc0, int dr, int cq, int c0, const float* rpbs) {
    f32x16 s;
#pragma unroll
    for (int i = 0; i < 16; ++i) s[i] = 0.f;
#pragma unroll
    for (int ks = 0; ks < NKS; ++ks) s = mfma32(f.k[ks], qf[ks], s);
    if (rk) {
#pragma unroll
        for (int g = 0; g < 4; ++g) { const f32x4 rv = *(const f32x4*)(rk + 8 * g + 4 * hh); s[4 * g] *= rv.x; s[4 * g + 1] *= rv.y; s[4 * g + 2] *= rv.z; s[4 * g + 3] *= rv.w; }
    }
    if (MASKED && na) {
#pragma unroll
        for (int i = 0; i < 16; ++i) { const int kc = kc0 + crow(i, hh); const bool ok = kc >= c0 && kc < c0 + 16;
            int dc = kc - cq; dc = dc < -15 ? -15 : (dc > 15 ? 15 : dc);
            s[i] = ok ? s[i] + rpbs[dr * 31 + dc + 15] : -1e30f; }
    }
    float mx = fmaxf(fmaxf(s[0], s[1]), s[2]);
#pragma unroll
    for (int i = 3; i < 15; i += 2) mx = fmaxf(fmaxf(mx, s[i]), s[i + 1]);
    mx = fmaxf(mx, s[15]);
    mx = fmaxf(mx, __shfl_xor(mx, 32));
    const float mn = fmaxf(st.m, mx);
    if (__builtin_amdgcn_ballot_w64(mn > st.m) != 0ull) {
        const float alpha = __builtin_amdgcn_exp2f(st.m - mn);
        st.l *= alpha;
#pragma unroll
        for (int i = 0; i < 16; ++i) { st.o0[i] *= alpha; st.o1[i] *= alpha; }
        st.m = mn;
    }
    float ps = 0.f;
#pragma unroll
    for (int i = 0; i < 16; ++i) { float p = __builtin_amdgcn_exp2f(s[i] - mn); if (MASKED) p = s[i] > -1e29f ? p : 0.f; s[i] = p; ps += p; }
    st.l += ps;
    const bh8 p0 = pfrag(s, 0), p1 = pfrag(s, 1);
    st.o0 = mfma32(f.v[0], p0, st.o0); st.o0 = mfma32(f.v[1], p1, st.o0);
    st.o1 = mfma32(f.v[2], p0, st.o1); st.o1 = mfma32(f.v[3], p1, st.o1);
}
template <int KS>
__device__ __forceinline__ void attn_merge_store(AttnState& st, float* part, int w, int lane, const v4u* gpre, bf16* zp) {
    const int r = lane & 31, hh = lane >> 5;
    float* mine = part + w * 2048; float* ml = part + 8 * 2048;
#pragma unroll
    for (int i = 0; i < 16; ++i) { mine[crow(i, hh) * 32 + r] = st.o0[i]; mine[(32 + crow(i, hh)) * 32 + r] = st.o1[i]; }
    const float lt = st.l + __shfl_xor(st.l, 32);
    if (hh == 0) { ml[(w * 2) * 32 + r] = st.m; ml[(w * 2 + 1) * 32 + r] = lt; }
    __syncthreads();
    const int qb = w / KS, kp = w % KS;
    float f[KS]; float ms = -1e30f, L = 0.f;
#pragma unroll
    for (int k = 0; k < KS; ++k) ms = fmaxf(ms, ml[((qb * KS + k) * 2) * 32 + r]);
#pragma unroll
    for (int k = 0; k < KS; ++k) { f[k] = __builtin_amdgcn_exp2f(ml[((qb * KS + k) * 2) * 32 + r] - ms); L += f[k] * ml[((qb * KS + k) * 2 + 1) * 32 + r]; }
    const float inv = 1.f / L;
    constexpr int ND = 32 / KS;
    const int dv0 = (64 / KS) * kp + ND * hh;
#pragma unroll
    for (int c = 0; c < ND / 8; ++c) {
        float o[8];
#pragma unroll
        for (int e = 0; e < 8; ++e) { float v = 0.f;
#pragma unroll
            for (int k = 0; k < KS; ++k) v += f[k] * part[(qb * KS + k) * 2048 + (dv0 + 8 * c + e) * 32 + r];
            o[e] = v * inv; }
        const v4u gr = gpre[c];
        v4u z; z.x = pk2(o[0] * silu_f(bflo(gr.x)), o[1] * silu_f(bfhi(gr.x))); z.y = pk2(o[2] * silu_f(bflo(gr.y)), o[3] * silu_f(bfhi(gr.y)));
        z.z = pk2(o[4] * silu_f(bflo(gr.z)), o[5] * silu_f(bfhi(gr.z))); z.w = pk2(o[6] * silu_f(bflo(gr.w)), o[7] * silu_f(bfhi(gr.w)));
        *(v4u*)(zp + dv0 + 8 * c) = z;
    }
    __syncthreads();
}

template <int KS> __device__ __forceinline__ void attn_gate_prefetch(v4u* gpre, const bf16* gp, int w, int lane) {
    constexpr int ND = 32 / KS; const int dv0 = (64 / KS) * (w % KS) + ND * (lane >> 5);
#pragma unroll
    for (int c = 0; c < ND / 8; ++c) gpre[c] = *(const v4u*)(gp + dv0 + 8 * c);
}

__device__ __forceinline__ void unit_mla_attn(const Args& a, const Ctx& X, int u) {
    const bf16* U = (const bf16*)(a.ws + WS_U); const bf16* Q = (const bf16*)(a.ws + WS_Q); const bf16* KM = (const bf16*)(a.ws + WS_KM); const bf16* VTM = (const bf16*)(a.ws + WS_VTM);
    bf16* Z = (bf16*)(a.ws + WS_Z);
    const int tid = opaque_v(X.tid), lane = tid & 63, w = opaque_s(X.wave), r = lane & 31, hh = lane >> 5;
    int h, q0, kb0, nkb; const bool samp = u < 256;
    if (samp) { const int bs = u >> 7, qg = u & 15; h = (u >> 4) & 7; q0 = NP + bs * 1024 + 64 * qg + 32 * (w >> 2); kb0 = NP + bs * 1280 + 320 * (w & 3); nkb = 10; }
    else { const int v = u - 256, b = v >> 4, qh = v & 1; h = (v >> 1) & 7; q0 = b * 256 + 128 * qh + 32 * (w >> 1); kb0 = b * 256 + 128 * (w & 1); nkb = 4; }
    PROF_BEGIN(30)
    bh8 qf[6];
#pragma unroll
    for (int ks = 0; ks < 6; ++ks) qf[ks] = ld16(Q + (size_t)(q0 + r) * 768 + h * 96 + 16 * ks + 8 * hh);
    AttnState st; attn_init(st);
    v4u gpre[2];
    { const bf16* gp = U + (size_t)(q0 + r) * UE + CE_GA + h * 64; if (samp) attn_gate_prefetch<4>(gpre, gp, w, lane); else attn_gate_prefetch<2>(gpre, gp, w, lane); }
    const bf16* kp = KM + ((size_t)((kb0 >> 5) * 8 + h) * 6) * 512 + lane * 8;
    const bf16* vp = VTM + ((size_t)((kb0 >> 5) * 8 + h) * 4) * 512 + lane * 8;
    KVf<6> fa, fb;
    load_kv<6>(fa, kp, vp);
    PROF_END(30)
    PROF_BEGIN(31)
    for (int kb = 0; kb < nkb; kb += 2) {
        load_kv<6>(fb, kp + (size_t)(kb + 1) * 8 * 6 * 512, vp + (size_t)(kb + 1) * 8 * 4 * 512);
        SB_PIN
        attn_compute<6, false>(st, qf, fa, nullptr, hh, false, 0, 0, 0, 0, nullptr);
        if (kb + 2 < nkb) load_kv<6>(fa, kp + (size_t)(kb + 2) * 8 * 6 * 512, vp + (size_t)(kb + 2) * 8 * 4 * 512);
        SB_PIN
        attn_compute<6, false>(st, qf, fb, nullptr, hh, false, 0, 0, 0, 0, nullptr);
    }
    PROF_END(31)
    PROF_BEGIN(32)
    const int row = q0 + r;
    if (samp) attn_merge_store<4>(st, (float*)X.ldsg, w, lane, gpre, Z + (size_t)row * DM + h * 64);
    else attn_merge_store<2>(st, (float*)X.ldsg, w, lane, gpre, Z + (size_t)row * DM + h * 64);
    PROF_END(32)
}

__device__ __forceinline__ void load_q64(const bf16* qrow  , const float* qnorm, const float* knorm, int hh, bh8* qa) {
    float x[4][8]; float ss = 0.f;
#pragma unroll
    for (int ks = 0; ks < 4; ++ks) { const v4u raw = *(const v4u*)(qrow + 16 * ks + 8 * hh);
        x[ks][0] = bflo(raw.x); x[ks][1] = bfhi(raw.x); x[ks][2] = bflo(raw.y); x[ks][3] = bfhi(raw.y); x[ks][4] = bflo(raw.z); x[ks][5] = bfhi(raw.z); x[ks][6] = bflo(raw.w); x[ks][7] = bfhi(raw.w);
#pragma unroll
        for (int e = 0; e < 8; ++e) ss += x[ks][e] * x[ks][e]; }
    ss += __shfl_xor(ss, 32);
    const float rstd = rsqrtf(ss * (1.f / 64.f) + EPS) * (0.125f * 1.4426950408889634f);
#pragma unroll
    for (int ks = 0; ks < 4; ++ks) { float ya[8];
#pragma unroll
        for (int e = 0; e < 8; ++e) { const int d = 16 * ks + 8 * hh + e; ya[e] = x[ks][e] * rstd * qnorm[d] * knorm[d]; }
        v4u va; va.x = pk2(ya[0], ya[1]); va.y = pk2(ya[2], ya[3]); va.z = pk2(ya[4], ya[5]); va.w = pk2(ya[6], ya[7]);
        qa[ks] = __builtin_bit_cast(bh8, va); }
}

__device__ __forceinline__ void unit_odd_attn(const Args& a, const Ctx& X, int j, int u) {
    const bf16* U = (const bf16*)(a.ws + WS_U); const bf16* VTO = (const bf16*)(a.ws + WS_VTO); bf16* Z = (bf16*)(a.ws + WS_Z);
    const float* qnorm = a.in[28] + j * 64; const float* knorm = a.in[29] + j * 64;
    float* part = (float*)X.ldsg; float* rk = part + 8 * 2048 + 512;
    const int b = u >> 4, h = (u >> 1) & 7, qh = u & 1, tid = opaque_v(X.tid), lane = tid & 63, w = opaque_s(X.wave), r = lane & 31, hh = lane >> 5, R0 = b * 256;
    PROF_BEGIN(26)
    { const int key = tid >> 1, half = tid & 1;
      const bf16* kp = U + (size_t)(R0 + key) * UO + CO_KD + h * 64 + 32 * half;
      float kx[32]; float ss = 0.f;
#pragma unroll
      for (int q = 0; q < 4; ++q) { const v4u kr = *(const v4u*)(kp + 8 * q);
          kx[8 * q] = bflo(kr.x); kx[8 * q + 1] = bfhi(kr.x); kx[8 * q + 2] = bflo(kr.y); kx[8 * q + 3] = bfhi(kr.y); kx[8 * q + 4] = bflo(kr.z); kx[8 * q + 5] = bfhi(kr.z); kx[8 * q + 6] = bflo(kr.w); kx[8 * q + 7] = bfhi(kr.w); }
#pragma unroll
      for (int e = 0; e < 32; ++e) ss += kx[e] * kx[e];
      ss += __shfl_xor(ss, 1);
      const float rstd = rsqrtf(ss * (1.f / 64.f) + EPS);
      if (half == 0) rk[key] = rstd;
      if (qh == 0) {
          const bf16* vp = U + (size_t)(R0 + key) * UO + CO_VD + h * 64 + 32 * half;
          float* ok = a.out + O_NK + ((size_t)(b * 2 + j) * 256 + key) * 512 + h * 64 + 32 * half; float* ov = a.out + O_NV + ((size_t)(b * 2 + j) * 256 + key) * 512 + h * 64 + 32 * half;
#pragma unroll
          for (int q = 0; q < 8; ++q) { const f32x4 g = *(const f32x4*)(knorm + 32 * half + 4 * q);
              *(f32x4*)(ok + 4 * q) = (f32x4){kx[4 * q] * rstd * g.x, kx[4 * q + 1] * rstd * g.y, kx[4 * q + 2] * rstd * g.z, kx[4 * q + 3] * rstd * g.w}; }
#pragma unroll
          for (int q = 0; q < 4; ++q) { const v4u vr = *(const v4u*)(vp + 8 * q);
              *(f32x4*)(ov + 8 * q) = (f32x4){bflo(vr.x), bfhi(vr.x), bflo(vr.y), bfhi(vr.y)}; *(f32x4*)(ov + 8 * q + 4) = (f32x4){bflo(vr.z), bfhi(vr.z), bflo(vr.w), bfhi(vr.w)}; }
      } }
    __syncthreads();
    PROF_END(26)
    PROF_BEGIN(27)
    const int row = R0 + 128 * qh + 32 * (w >> 1) + r, kb0 = R0 + 128 * (w & 1);
    bh8 qa[4];
    load_q64(U + (size_t)row * UO + CO_QD + h * 64, qnorm, knorm, hh, qa);
    AttnState st; attn_init(st);
    v4u gpre[2]; attn_gate_prefetch<2>(gpre, U + (size_t)row * UO + CO_GD + h * 64, w, lane);
    const bf16* kp = (const bf16*)(a.ws + WS_KFO) + ((size_t)((kb0 >> 5) * 8 + h) * 4) * 512 + lane * 8;
    const bf16* vp = VTO + ((size_t)((kb0 >> 5) * 8 + h) * 4) * 512 + lane * 8;
    const float* rkp = rk + 128 * (w & 1);
    KVf<4> fa, fb;
    load_kv<4>(fa, kp, vp);
#pragma unroll
    for (int kb = 0; kb < 4; kb += 2) {
        load_kv<4>(fb, kp + (size_t)(kb + 1) * 8 * 4 * 512, vp + (size_t)(kb + 1) * 8 * 4 * 512);
        SB_PIN
        attn_compute<4, false>(st, qa, fa, rkp + 32 * kb, hh, false, 0, 0, 0, 0, nullptr);
        if (kb + 2 < 4) load_kv<4>(fa, kp + (size_t)(kb + 2) * 8 * 4 * 512, vp + (size_t)(kb + 2) * 8 * 4 * 512);
        SB_PIN
        attn_compute<4, false>(st, qa, fb, rkp + 32 * (kb + 1), hh, false, 0, 0, 0, 0, nullptr);
    }
    PROF_END(27)
    PROF_BEGIN(28)
    attn_merge_store<2>(st, part, w, lane, gpre, Z + (size_t)row * DM + 512 + h * 64);
    PROF_END(28)
}

__device__ __forceinline__ void na_block_ptrs(int g, int rb, int R0s, int h, int lane, const bf16* KFO, const bf16* VFO, const bf16* kc, const bf16* vc,
                                              const bf16*& kp, const bf16*& vp, int& rki, bool& win, int& kc0, int& bi) {
    if (g < 8) { kp = kc + (size_t)g * 4 * 512 + lane * 8; vp = vc + (size_t)g * 4 * 512 + lane * 8; rki = 512 + 32 * g; win = false; kc0 = 0; bi = 0; }
    else { const int i = (g - 8) >> 1, xk = g & 1; const int tok0 = (rb + i) * 64 + 32 * xk; const size_t blk = ((size_t)(((R0s + tok0) >> 5) * 8 + h) * 4) * 512 + lane * 8;
        kp = KFO + blk; vp = VFO + blk; rki = i * 64 + 32 * xk; win = true; kc0 = 32 * xk; bi = i; }
}
__device__ __forceinline__ void unit_na(const Args& a, const Ctx& X, int j, int u) {
    const bf16* U = (const bf16*)(a.ws + WS_U); const bf16* VTO = (const bf16*)(a.ws + WS_VTO); bf16* Z = (bf16*)(a.ws + WS_Z);
    const float* qnorm = a.in[28] + j * 64; const float* knorm = a.in[29] + j * 64;
    float* part = (float*)X.ldsg; float* rk = part + 8 * 2048 + 512;
    float* rpbs = rk + 768;
    const int bs = u >> 7, h = (u >> 4) & 7, rr = u & 15, tid = opaque_v(X.tid), lane = tid & 63, w = opaque_s(X.wave), r = lane & 31, hh = lane >> 5, R0s = NP + bs * 1024;
    const int rb = rr - 4 < 0 ? 0 : (rr - 4 > 8 ? 8 : rr - 4);
    { const bf16* kp = U + (size_t)(R0s + rb * 64 + tid) * UO + CO_KD + h * 64; float ss = 0.f;
#pragma unroll
      for (int q = 0; q < 8; ++q) { const v4u kr = *(const v4u*)(kp + 8 * q);
          const float k0 = bflo(kr.x), k1 = bfhi(kr.x), k2 = bflo(kr.y), k3 = bfhi(kr.y), k4 = bflo(kr.z), k5 = bfhi(kr.z), k6 = bflo(kr.w), k7 = bfhi(kr.w);
          ss += (k0 * k0 + k1 * k1) + (k2 * k2 + k3 * k3) + (k4 * k4 + k5 * k5) + (k6 * k6 + k7 * k7); }
      rk[tid] = rsqrtf(ss * (1.f / 64.f) + EPS);
      if (tid < 256) rk[512 + tid] = 1.f;
      if (tid < 465) rpbs[tid] = a.in[30][(size_t)(j * 8 + h) * 465 + tid] * 1.4426950408889634f; }
    __syncthreads();
    const int xq = w >> 2, kpart = w & 3, tok = rr * 64 + 32 * xq + r, cq = 32 * xq + r;
    const int c0 = cq - 8 < 0 ? 0 : (cq - 8 > 48 ? 48 : cq - 8);
    const int row = R0s + tok;
    bh8 qa[4];
    load_q64(U + (size_t)row * UO + CO_QD + h * 64, qnorm, knorm, hh, qa);
    AttnState st; attn_init(st);
    v4u gpre[1]; attn_gate_prefetch<4>(gpre, U + (size_t)row * UO + CO_GD + h * 64, w, lane);
    const bf16* kc = (const bf16*)(a.ws + WS_NAKC) + (size_t)((bs * 2 + j) * 8 + h) * 8 * 4 * 512;
    const bf16* vc = (const bf16*)(a.ws + WS_NAVC) + (size_t)((bs * 2 + j) * 8 + h) * 8 * 4 * 512;
    const bf16* KFO = (const bf16*)(a.ws + WS_KFO);
    const int g0 = 6 * kpart;
    KVf<4> fa, fb;
    const bf16 *kpa, *vpa, *kpb, *vpb; int rka, rkb, kca, kcb, bia, bib; bool wa, wb;
    na_block_ptrs(g0, rb, R0s, h, lane, KFO, VTO, kc, vc, kpa, vpa, rka, wa, kca, bia);
    load_kv<4>(fa, kpa, vpa);
#pragma unroll 1
    for (int g = 0; g < 6; g += 2) {
        na_block_ptrs(g0 + g + 1, rb, R0s, h, lane, KFO, VTO, kc, vc, kpb, vpb, rkb, wb, kcb, bib);
        load_kv<4>(fb, kpb, vpb);
        SB_PIN
        attn_compute<4, true>(st, qa, fa, rk + rka, hh, wa, kca, rb + bia - rr + 7, cq, c0, rpbs);
        if (g + 2 < 6) { na_block_ptrs(g0 + g + 2, rb, R0s, h, lane, KFO, VTO, kc, vc, kpa, vpa, rka, wa, kca, bia); load_kv<4>(fa, kpa, vpa); }
        SB_PIN
        attn_compute<4, true>(st, qa, fb, rk + rkb, hh, wb, kcb, rb + bib - rr + 7, cq, c0, rpbs);
    }
    attn_merge_store<4>(st, part, w, lane, gpre, Z + (size_t)row * DM + 512 + h * 64);
}
#ifndef RU_OUT_A
#define RU_OUT_A 1
#endif
#ifndef RU_OUT_B
#define RU_OUT_B 1
#endif
#ifndef RU_OUT_C
#define RU_OUT_C 1
#endif
__device__ __forceinline__ float scan_incl_sum(float v, int lane) {
#pragma unroll
    for (int o = 1; o < 64; o <<= 1) { const float t = __shfl_up(v, o); if (lane >= o) v += t; }
    return v;
}
__device__ __forceinline__ float scan_incl_max(float v, int lane) {
#pragma unroll
    for (int o = 1; o < 64; o <<= 1) { const float t = __shfl_up(v, o); if (lane >= o) v = fmaxf(v, t); }
    return v;
}
__device__ __forceinline__ float scan_incl_max_rev(float v, int lane) {
#pragma unroll
    for (int o = 1; o < 64; o <<= 1) { const float t = __shfl_down(v, o); if (lane + o < 64) v = fmaxf(v, t); }
    return v;
}
constexpr float KSC = 0.08838834764831845f;

__device__ __forceinline__ void stage_T(const bf16* src  , int pitch, bf16* d0, const float* w0, bf16* d1, const float* w1, int wave, int lane) {
#pragma unroll
    for (int i = 0; i < 2; ++i) { const int c = wave * 2 + i;
        const v4u raw = *(const v4u*)(src + (size_t)lane * pitch + 8 * c);
        float x[8] = {bflo(raw.x), bfhi(raw.x), bflo(raw.y), bfhi(raw.y), bflo(raw.z), bfhi(raw.z), bflo(raw.w), bfhi(raw.w)};
        if (w0) { const float s0 = w0[lane] * KSC, s1 = w1[lane] * KSC;
#pragma unroll
            for (int e = 0; e < 8; ++e) { d0[(8 * c + e) * 72 + lane] = (bf16)(pk2(x[e] * s0, 0.f) & 0xffffu); d1[(8 * c + e) * 72 + lane] = (bf16)(pk2(x[e] * s1, 0.f) & 0xffffu); }
        } else {
            const unsigned rr[4] = {raw.x, raw.y, raw.z, raw.w};
#pragma unroll
            for (int e = 0; e < 8; ++e) d0[(8 * c + e) * 72 + lane] = (bf16)((rr[e >> 1] >> (16 * (e & 1))) & 0xffffu);
        }
    }
}

__device__ __forceinline__ void unit_mlstm_L(const Args& a, const Ctx& X, int j, int h, int gc) {
    const bf16* U = (const bf16*)(a.ws + WS_U); const float* GT = (const float*)(a.ws + WS_GATES); const bf16* VFM = (const bf16*)(a.ws + WS_VFM);
    float* AG = (float*)(a.ws + WS_AG); float* LT = (float*)(a.ws + WS_LT); float* NL = (float*)(a.ws + WS_NL); float* GQ = (float*)(a.ws + WS_GQ);
    float* wgt = (float*)X.ldsg;
    bf16* KwT = (bf16*)(X.ldsg + 1024);
    const int tid = opaque_v(X.tid), lane = tid & 63, w = opaque_s(X.wave), r = lane & 31, hh = lane >> 5, R0 = gc * 64;
    v4u kraw[2];
#pragma unroll
    for (int i = 0; i < 2; ++i) kraw[i] = *(const v4u*)(U + (size_t)(R0 + lane) * UE + CE_KM + h * 128 + 8 * (w * 2 + i));
    bh8 vf[4][4];
#pragma unroll
    for (int eb = 0; eb < 4; ++eb)
#pragma unroll
        for (int q = 0; q < 4; ++q) vf[eb][q] = ld16(VFM + ((size_t)(((2 * gc + (q >> 1)) * 4 + h) * 8 + eb * 2 + (q & 1))) * 512 + lane * 8);
    SB_PIN
    if (w < 2) { const int dir = w; const int row = R0 + lane;
        const float lf = logsigmoid_f(GT[(size_t)row * 16 + 8 + dir * 4 + h] + a.in[22][j * 8 + dir * 4 + h]);
        const float ii = GT[(size_t)row * 16 + dir * 4 + h] + a.in[21][j * 8 + dir * 4 + h];
        const float P = scan_incl_sum(lf, lane); const float T = __shfl(P, 63);
        const float dec = (dir == 0 ? (T - P) : (P - lf)) + ii;
        const float am = wave_max(dec);
        wgt[dir * 64 + lane] = expf(dec - am) * KSC;
        if (lane == 0) { AG[((dir * 4 + h) * 96 + gc) * 2] = am; AG[((dir * 4 + h) * 96 + gc) * 2 + 1] = T; }
        const float cum = dir == 0 ? P : (T - P + lf), bv = ii - cum;
        const float pm = dir == 0 ? scan_incl_max(bv, lane) : scan_incl_max_rev(bv, lane);
        *(f32x4*)(GQ + ((size_t)(dir * 4 + h) * NT + row) * 4) = (f32x4){cum, bv, pm, 0.f};
    }
    __syncthreads();
#pragma unroll
    for (int i = 0; i < 2; ++i) { const int c = w * 2 + i; const unsigned rr[4] = {kraw[i].x, kraw[i].y, kraw[i].z, kraw[i].w};
        const float s0 = wgt[lane], s1 = wgt[64 + lane];
#pragma unroll
        for (int e = 0; e < 8; ++e) { const float x = (e & 1) ? bfhi(rr[e >> 1]) : bflo(rr[e >> 1]);
            KwT[(8 * c + e) * 72 + lane] = (bf16)(pk2(x * s0, 0.f) & 0xffffu); KwT[128 * 72 + (8 * c + e) * 72 + lane] = (bf16)(pk2(x * s1, 0.f) & 0xffffu); } }
    __syncthreads();
    { const int dir = w >> 2, db = w & 3; const size_t ub = (size_t)((dir * 4 + h) * 96 + gc);
      bh8 bfr[4];
#pragma unroll
      for (int q = 0; q < 4; ++q) { const bf16* kp = KwT + dir * 128 * 72 + (32 * db + r) * 72 + 16 * q + 4 * hh; bfr[q] = ld2x8(kp, kp + 8); }
#pragma unroll
      for (int eb = 0; eb < 4; ++eb) { f32x16 acc;
#pragma unroll
          for (int i = 0; i < 16; ++i) acc[i] = 0.f;
#pragma unroll
          for (int q = 0; q < 4; ++q) acc = mfma32(vf[eb][q], bfr[q], acc);
          float* dst = LT + ub * 16384 + 32 * db + r;
#pragma unroll
          for (int i = 0; i < 16; ++i) dst[(32 * eb + crow(i, hh)) * 128] = acc[i]; }
      if (tid < 256) { const int dr = tid >> 7, d = tid & 127; const bf16* p = KwT + dr * 128 * 72 + d * 72; float s = 0.f;
#pragma unroll
          for (int q = 0; q < 8; ++q) { const v4u x = *(const v4u*)(p + 8 * q); s += (bflo(x.x) + bfhi(x.x)) + (bflo(x.y) + bfhi(x.y)) + (bflo(x.z) + bfhi(x.z)) + (bflo(x.w) + bfhi(x.w)); }
          NL[(size_t)((dr * 4 + h) * 96 + gc) * 128 + d] = s; } }
    __syncthreads();
}

template <int NC, int NV>
__device__ __forceinline__ void scan_body(const Args& a, int j, int tid, int dir, int h, int gc0, int sl, int initmat  , long outsb  ) {
    const float* AG = (const float*)(a.ws + WS_AG); const float* LT = (const float*)(a.ws + WS_LT); const float* NL = (const float*)(a.ws + WS_NL);
    bf16* CTB = (bf16*)(a.ws + WS_CTB); float* NPV = (float*)(a.ws + WS_NPV); float* MPV = (float*)(a.ws + WS_MPV);
    const size_t ub0 = (size_t)((dir * 4 + h) * 96 + gc0);
    const int e0 = sl * (NV * 2048) + tid * 4;
    f32x4 Lv[NC][NV]; float nl[NC];
    const bool don = tid < 128 && sl == 0;
#pragma unroll
    for (int c = 0; c < NC; ++c) {
#pragma unroll
        for (int i = 0; i < NV; ++i) Lv[c][i] = *(const f32x4*)(LT + (ub0 + c) * 16384 + e0 + 2048 * i);
        nl[c] = don ? NL[(ub0 + c) * 128 + tid] : 0.f; }
    SB_PIN
    f32x4 Cs[NV]; float ns = 0.f, m = 0.f;
#pragma unroll
    for (int i = 0; i < NV; ++i) Cs[i] = (f32x4){0.f, 0.f, 0.f, 0.f};
    if (initmat >= 0) { const float* c0 = (const float*)(a.ws + WS_C0T) + (size_t)initmat * 16384;
#pragma unroll
        for (int i = 0; i < NV; ++i) Cs[i] = *(const f32x4*)(c0 + e0 + 2048 * i);
        if (don) ns = a.in[6][(size_t)initmat * 128 + tid];
        m = a.in[7][initmat]; }
#pragma unroll
    for (int p = 0; p < NC; ++p) {
        const int c = dir ? NC - 1 - p : p;
        const float ac = AG[(ub0 + c) * 2], Gc = AG[(ub0 + c) * 2 + 1];
#pragma unroll
        for (int i = 0; i < NV; ++i) { const int idx = e0 + 2048 * i; st4bf(CTB + (ub0 + c) * 16384 + idx, Cs[i].x, Cs[i].y, Cs[i].z, Cs[i].w); }
        if (don) NPV[(ub0 + c) * 128 + tid] = ns;
        if (tid == 0 && sl == 0) MPV[ub0 + c] = m;
        const float mn = fmaxf(Gc + m, ac), ws = expf(Gc + m - mn), wl = expf(ac - mn);
#pragma unroll
        for (int i = 0; i < NV; ++i) Cs[i] = Cs[i] * ws + Lv[c][i] * wl;
        ns = ns * ws + nl[c] * wl; m = mn;
    }
    if (outsb >= 0) {
#pragma unroll
        for (int i = 0; i < NV; ++i) { const int idx = e0 + 2048 * i, e = idx >> 7, d = idx & 127; float* o = a.out + O_C + (size_t)outsb * 16384 + e;
            o[(d + 0) * 128] = Cs[i].x; o[(d + 1) * 128] = Cs[i].y; o[(d + 2) * 128] = Cs[i].z; o[(d + 3) * 128] = Cs[i].w; }
        if (don) a.out[O_N + (size_t)outsb * 128 + tid] = ns;
        if (tid == 0 && sl == 0) a.out[O_M + outsb] = m;
    }
}
__device__ __forceinline__ void unit_mlstm_scan(const Args& a, const Ctx& X, int j, int s) {
    const int tid = opaque_v(X.tid);
    if (s < 256) { const int sl = s & 1, q = s >> 1, b = q >> 3, h = (q >> 1) & 3, dir = q & 1;
        scan_body<4, 4>(a, j, tid, dir, h, 4 * b, sl, -1, (long)((b * 2 + j) * 2 + dir) * 4 + h); }
    else { const int v = s - 256, sl = v & 7, q = v >> 3, bs = q >> 3, h = (q >> 1) & 3, dir = q & 1;
        scan_body<16, 1>(a, j, tid, dir, h, 64 + 16 * bs, sl, ((bs * 2 + j) * 2 + dir) * 4 + h, -1); }
}

__device__ __forceinline__ void unit_mlstm_out(const Args& a, const Ctx& X, int j, int h, int gc) {
    const bf16* U = (const bf16*)(a.ws + WS_U);
    const bf16* CTB = (const bf16*)(a.ws + WS_CTB); const float* NPV = (const float*)(a.ws + WS_NPV); const float* MPV = (const float*)(a.ws + WS_MPV);
    bf16* Z = (bf16*)(a.ws + WS_Z);
    unsigned char* L = X.ldsg;
    bf16* Qs = (bf16*)L; bf16* Ks = (bf16*)(L + 17408); bf16* CT = (bf16*)(L + 34816);
    float* ctm = (float*)(L + 137216); float* bb = ctm + 128; float* wint = bb + 128; float* emt = wint + 128;
    float* nprev = emt + 128;
    float* ssq = nprev + 256;
    const int tid = opaque_v(X.tid), lane = tid & 63, w = opaque_s(X.wave), r = lane & 31, hh = lane >> 5, R0 = gc * 64;
    const int tb = w & 1, eb = w >> 1, tau = 32 * tb + r;
    PROF_BEGIN(23)
    v4u qraw[2], kraw[2], craw[4];
#pragma unroll
    for (int i = 0; i < 2; ++i) { const int q = tid + 512 * i, row = q >> 4, cc = q & 15;
        qraw[i] = *(const v4u*)(U + (size_t)(R0 + row) * UE + CE_QM + h * 128 + 8 * cc);
        kraw[i] = *(const v4u*)(U + (size_t)(R0 + row) * UE + CE_KM + h * 128 + 8 * cc); }
#pragma unroll
    for (int i = 0; i < 4; ++i) { const int q = tid + 512 * i, e = q >> 4, cc = q & 15; craw[i] = *(const v4u*)(CTB + (size_t)((0 * 4 + h) * 96 + gc) * 16384 + e * 128 + 8 * cc); }
    const float npr = tid < 256 ? NPV[(size_t)(((tid >> 7) * 4 + h) * 96 + gc) * 128 + (tid & 127)] : 0.f;
    bh8 vf[4];
#pragma unroll
    for (int q = 0; q < 4; ++q) vf[q] = ld16((const bf16*)(a.ws + WS_VFM) + ((size_t)(((2 * gc + (q >> 1)) * 4 + h) * 8 + eb * 2 + (q & 1))) * 512 + lane * 8);
    f32x4 gq = (f32x4){0.f, 0.f, 0.f, 0.f}; float mp = 0.f;
    if (w < 2) { gq = *(const f32x4*)((const float*)(a.ws + WS_GQ) + ((size_t)(w * 4 + h) * NT + R0 + lane) * 4); mp = MPV[(size_t)((w * 4 + h) * 96 + gc)]; }
    { const int row = R0 + tau; v2u* og = (v2u*)(L + 104448) + tid * 8;
#pragma unroll
      for (int g = 0; g < 4; ++g) { const int e0 = 32 * eb + 8 * g + 4 * hh;
          og[g] = *(const v2u*)(U + (size_t)row * UE + CE_OM + h * 128 + e0); og[4 + g] = *(const v2u*)(U + (size_t)row * UE + CE_GM + h * 128 + e0); } }
    SB_PIN
#pragma unroll
    for (int i = 0; i < 2; ++i) { const int q = tid + 512 * i, row = q >> 4, cc = q & 15;
        *(v4u*)(Qs + row * 136 + 8 * cc) = qraw[i]; *(v4u*)(Ks + row * 136 + 8 * cc) = kraw[i]; }
#pragma unroll
    for (int i = 0; i < 4; ++i) { const int q = tid + 512 * i, e = q >> 4, cc = q & 15; *(v4u*)(CT + e * 136 + 8 * cc) = craw[i];
        craw[i] = *(const v4u*)(CTB + (size_t)((1 * 4 + h) * 96 + gc) * 16384 + e * 128 + 8 * cc); }
#pragma unroll
    for (int i = 0; i < 4; ++i) { const int q = tid + 512 * i, e = q >> 4, cc = q & 15; *(v4u*)(CT + 128 * 136 + e * 136 + 8 * cc) = craw[i]; }
    if (tid < 256) nprev[tid] = npr;
    if (w < 2) { const int dir = w; const float cum = gq.x, bv = gq.y, pm = gq.z;
        const float mt = cum + fmaxf(mp, pm);
        ctm[dir * 64 + lane] = cum - mt; bb[dir * 64 + lane] = bv; wint[dir * 64 + lane] = expf(cum + mp - mt); emt[dir * 64 + lane] = expf(-mt); }
    __syncthreads();
    PROF_END(23)
    PROF_BEGIN(24)
    const bf16* qp = Qs + (32 * tb + r) * 136 + 8 * hh;
    bh8 qf[8];
#pragma unroll
    for (int ks = 0; ks < 8; ++ks) qf[ks] = ld16(qp + 16 * ks);
    f32x16 hsum;
    for (int rpb_ = 0; rpb_ < RU_OUT_B; ++rpb_) {
#pragma unroll
    for (int i = 0; i < 16; ++i) hsum[i] = 0.f;
#pragma unroll 1
    for (int dir = 0; dir < 2; ++dir) {
        const int sgn = 1 - 2 * dir;
        const bf16* CTd = CT + dir * 128 * 136; const float* npv = nprev + dir * 128;
        const float ct = ctm[dir * 64 + tau], wi = wint[dir * 64 + tau];
        float rs = 0.f, qd = 0.f;
        f32x16 accv;
#pragma unroll
        for (int i = 0; i < 16; ++i) accv[i] = 0.f;
#pragma unroll
        for (int sb = 0; sb < 2; ++sb) {
            bh8 kf[8]; f32x16 ps;
#pragma unroll
            for (int ks = 0; ks < 8; ++ks) kf[ks] = ld16(Ks + (32 * sb + r) * 136 + 16 * ks + 8 * hh);
#pragma unroll
            for (int i = 0; i < 16; ++i) ps[i] = 0.f;
#pragma unroll
            for (int ks = 0; ks < 8; ++ks) ps = mfma32(kf[ks], qf[ks], ps);
#pragma unroll
            for (int g = 0; g < 4; ++g) { const f32x4 b4 = *(const f32x4*)(bb + dir * 64 + 32 * sb + 8 * g + 4 * hh);
#pragma unroll
                for (int e = 0; e < 4; ++e) { const int dd = (32 * sb + 8 * g + 4 * hh + e - tau) * sgn; const bool ok = dd <= 0;
                    const float v = ok ? ps[4 * g + e] * KSC * __expf(ct + b4[e]) : 0.f; ps[4 * g + e] = v; rs += v; } }
            accv = mfma32(vf[2 * sb], pfrag(ps, 0), accv);
            accv = mfma32(vf[2 * sb + 1], pfrag(ps, 1), accv);
            __builtin_amdgcn_sched_barrier(0);
        }
        rs += __shfl_xor(rs, 32);
#pragma unroll
        for (int ks = 0; ks < 8; ++ks) { const v4u qq = __builtin_bit_cast(v4u, qf[ks]); const f32x4 n0 = *(const f32x4*)(npv + 16 * ks + 8 * hh), n1 = *(const f32x4*)(npv + 16 * ks + 8 * hh + 4);
            qd += bflo(qq.x) * n0.x + bfhi(qq.x) * n0.y + bflo(qq.y) * n0.z + bfhi(qq.y) * n0.w + bflo(qq.z) * n1.x + bfhi(qq.z) * n1.y + bflo(qq.w) * n1.z + bfhi(qq.w) * n1.w;
            if ((ks & 1) == 1) __builtin_amdgcn_sched_barrier(0); }
        qd += __shfl_xor(qd, 32);
        __builtin_amdgcn_sched_barrier(0);
        bh8 cf[8];
#pragma unroll
        for (int ks = 0; ks < 8; ++ks) cf[ks] = ld16(CTd + (32 * eb + r) * 136 + 16 * ks + 8 * hh);
        const float qn = wi * qd + rs;
        f32x16 acc;
#pragma unroll
        for (int i = 0; i < 16; ++i) acc[i] = 0.f;
#pragma unroll
        for (int ks = 0; ks < 8; ++ks) acc = mfma32(cf[ks], qf[ks], acc);
#pragma unroll
        for (int i = 0; i < 16; ++i) acc[i] = acc[i] * wi + accv[i];
        const float inv = 1.f / fmaxf(fabsf(qn), emt[dir * 64 + tau]);
#pragma unroll
        for (int i = 0; i < 16; ++i) hsum[i] += acc[i] * inv;
        __builtin_amdgcn_sched_barrier(0);
    }
    }
    PROF_END(24)
    PROF_BEGIN(25)
    { float ss = 0.f;
#pragma unroll
      for (int i = 0; i < 16; ++i) ss += hsum[i] * hsum[i];
      ss += __shfl_xor(ss, 32);
      if (hh == 0) ssq[(tb * 4 + eb) * 32 + r] = ss; }
    __syncthreads();
    { const int tid2 = opaque_v(tid), lane2 = tid2 & 63, w2 = opaque_s(w), r2 = lane2 & 31, hh2 = lane2 >> 5, tb2 = w2 & 1, eb2 = w2 >> 1, tau2 = 32 * tb2 + r2;
    { const float tot = ssq[(tb2 * 4 + 0) * 32 + r2] + ssq[(tb2 * 4 + 1) * 32 + r2] + ssq[(tb2 * 4 + 2) * 32 + r2] + ssq[(tb2 * 4 + 3) * 32 + r2];
      const float rstd = rsqrtf(tot * (1.f / 128.f) + EPS);
      const int row = R0 + tau2; const float* hn = a.in[23] + j * 512 + h * 128;
#pragma unroll
      for (int g = 0; g < 4; ++g) { const int e0 = 32 * eb2 + 8 * g + 4 * hh2; const f32x4 gn = *(const f32x4*)(hn + e0); const v2u om = ((const v2u*)(L + 104448))[tid2 * 8 + g], gm = ((const v2u*)(L + 104448))[tid2 * 8 + 4 + g];
          st4bf(Z + (size_t)row * DM + 512 + h * 128 + e0,
                hsum[4 * g] * rstd * gn.x * sigmoid_f(bflo(om.x)) * silu_f(bflo(gm.x)), hsum[4 * g + 1] * rstd * gn.y * sigmoid_f(bfhi(om.x)) * silu_f(bfhi(gm.x)),
                hsum[4 * g + 2] * rstd * gn.z * sigmoid_f(bflo(om.y)) * silu_f(bflo(gm.y)), hsum[4 * g + 3] * rstd * gn.w * sigmoid_f(bfhi(om.y)) * silu_f(bfhi(gm.y))); } }
    }
    __syncthreads();
    PROF_END(25)
}
__device__ __forceinline__ void unit_conv(const Args& a, const Ctx& X, int j, int t) {
    const bf16* U = (const bf16*)(a.ws + WS_U); bf16* Z = (bf16*)(a.ws + WS_Z);
    const int tid = opaque_v(X.tid), cg = (tid & 63) * 8, r0 = t * 32 + (tid >> 6) * 4;
    const int S = r0 < NP ? 256 : 1024; const int s0 = r0 < NP ? (r0 & 255) : ((r0 - NP) & 1023);
    v4u xc[6], cc[6], bc[4], gc[4];
#pragma unroll
    for (int i = 0; i < 6; ++i) { const int s = s0 - 1 + i; const bool ok = s >= 0 && s < S; const bf16* u = U + (size_t)(r0 - 1 + i) * UO;
        xc[i] = ok ? *(const v4u*)(u + CO_XC + cg) : (v4u){0u, 0u, 0u, 0u}; cc[i] = ok ? *(const v4u*)(u + CO_CC + cg) : (v4u){0u, 0u, 0u, 0u}; }
#pragma unroll
    for (int i = 0; i < 4; ++i) { const bf16* u = U + (size_t)(r0 + i) * UO; bc[i] = *(const v4u*)(u + CO_BC + cg); gc[i] = *(const v4u*)(u + CO_GC + cg); }
    SB_PIN
    float w0[8], w1[8], w2[8], cb[8];
#pragma unroll
    for (int q = 0; q < 2; ++q) { const f32x4 a0 = *(const f32x4*)(a.in[26] + j * 1536 + cg + 4 * q), a1 = *(const f32x4*)(a.in[26] + j * 1536 + 512 + cg + 4 * q),
                                              a2 = *(const f32x4*)(a.in[26] + j * 1536 + 1024 + cg + 4 * q), a3 = *(const f32x4*)(a.in[27] + j * 512 + cg + 4 * q);
#pragma unroll
        for (int e = 0; e < 4; ++e) { w0[4 * q + e] = a0[e]; w1[4 * q + e] = a1[e]; w2[4 * q + e] = a2[e]; cb[4 * q + e] = a3[e]; } }
    float x[6][8];
#pragma unroll
    for (int i = 0; i < 6; ++i) { const unsigned xr[4] = {xc[i].x, xc[i].y, xc[i].z, xc[i].w}, cr[4] = {cc[i].x, cc[i].y, cc[i].z, cc[i].w};
#pragma unroll
        for (int q = 0; q < 4; ++q) { x[i][2 * q] = bflo(xr[q]) * bflo(cr[q]); x[i][2 * q + 1] = bfhi(xr[q]) * bfhi(cr[q]); } }
#pragma unroll
    for (int i = 0; i < 4; ++i) { const unsigned br[4] = {bc[i].x, bc[i].y, bc[i].z, bc[i].w}, gr[4] = {gc[i].x, gc[i].y, gc[i].z, gc[i].w};
        float o[8];
#pragma unroll
        for (int e = 0; e < 8; ++e) { const float bv = (e & 1) ? bfhi(br[e >> 1]) : bflo(br[e >> 1]), gv = (e & 1) ? bfhi(gr[e >> 1]) : bflo(gr[e >> 1]);
            const float cv = x[i][e] * w0[e] + x[i + 1][e] * w1[e] + x[i + 2][e] * w2[e] + cb[e];
            o[e] = bv * cv * silu_f(gv); }
        v4u z; z.x = pk2(o[0], o[1]); z.y = pk2(o[2], o[3]); z.z = pk2(o[4], o[5]); z.w = pk2(o[6], o[7]);
        *(v4u*)(Z + (size_t)(r0 + i) * DM + cg) = z; }
}

constexpr int NPHASES = 18;


#ifndef G1_ALIGN
#define G1_ALIGN true
#endif
#ifndef G1_SP2
#define G1_SP2 true
#endif
#ifndef G2_ALIGN
#define G2_ALIGN true
#endif
#ifndef G2_SP2
#define G2_SP2 true
#endif
#ifndef RU_Q
#define RU_Q 1
#endif
#ifndef RU_KV
#define RU_KV 1
#endif
#ifndef RU_L
#define RU_L 1
#endif
#ifndef RU_ATTS
#define RU_ATTS 1
#endif
#ifndef RU_SCAN
#define RU_SCAN 1
#endif
#ifndef RU_OUT
#define RU_OUT 1
#endif
#ifndef RU_ATTP
#define RU_ATTP 1
#endif
#ifndef RU_NA
#define RU_NA 1
#endif
#ifndef RU_OATT
#define RU_OATT 1
#endif
#ifndef RU_CONV
#define RU_CONV 1
#endif
#ifndef RU_SIDE
#define RU_SIDE 1
#endif
#define REPU(n, call) for (int rp_ = 0; rp_ < (n); ++rp_) { call; }
#define PU(id, stmt) { PROF_BEGIN(id) stmt PROF_END(id) }
__device__ __forceinline__ void phase_gemm1(const Args& a, const Ctx& X, int l) {
    const int j = l >> 1; const bool even = (l & 1) == 0;
    pg8::Gemm g{(const bf16*)(a.ws + WS_H), even ? (const bf16*)(a.ws + WS_WTEV) + (size_t)j * 3584 * 1024 : (const bf16*)(a.ws + WS_WTOD) + (size_t)j * 4096 * 1024, NT, even ? UE : UO, DM};
    pg8::StaticOrder S; S.init(NT, even ? UE : UO, X.G, X.bid, pg8::EpiU::BMA_ROWS);
    pg8::EpiU E{(bf16*)(a.ws + WS_U), even ? UE : UO, even ? (float*)(a.ws + WS_GATES) : nullptr, even ? nullptr : (bf16*)(a.ws + WS_VTO), even ? nullptr : (bf16*)(a.ws + WS_KFO), even ? (bf16*)(a.ws + WS_VFM) : nullptr};
    pg8::gemm_phase<pg8::EpiU, pg8::StaticOrder, G1_ALIGN, G1_SP2>(X.lds, g, S, E);
}
__device__ __forceinline__ void phase_gemm2(const Args& a, const Ctx& X, int l) {
    pg8::Gemm g{(const bf16*)(a.ws + WS_Z), (const bf16*)(a.ws + WS_WTOUT) + (size_t)l * 1024 * 1024, NT, DM, DM};
    pg8::StaticOrder S; S.init(NT, DM, X.G, X.bid, pg8::EpiY::BMA_ROWS);
    const float* ysp = l == 0 ? a.in[0] : a.out; const float* yss = l == 0 ? a.in[1] : a.out + (size_t)NP * DM;
    const float* modl = (const float*)(a.ws + WS_MOD) + l * 3 * 3072;
    if (l < 3) {
        pg8::EpiYN E{a.out, ysp, yss, modl, (bf16*)(a.ws + WS_H), a.in[11] + (l + 1) * DM, modl + 3 * 3072,
                     (unsigned*)(a.ws + WS_XS) + (size_t)l * 48 * 4 * 128, (unsigned*)(a.ws + WS_CTL + CTL_NCNT) + l * 48 * 16};
        pg8::gemm_phase<pg8::EpiYN, pg8::StaticOrder, false, G2_SP2>(X.lds, g, S, E);
    } else {
        pg8::EpiY E{a.out, ysp, yss, modl};
        pg8::gemm_phase<pg8::EpiY, pg8::StaticOrder, G2_ALIGN, G2_SP2>(X.lds, g, S, E);
    }
}
__device__ __forceinline__ void phase_e2(const Args& a, const Ctx& X, int j) {
    const int b = X.bid;
    for (int s = 0; s < 4; ++s) {
        int u;
        if (b < 200) { if (s == 0) u = b; else if (s == 1) u = 200 + b; else break; }
        else { u = 400 + (b - 200) + 56 * s; if (u >= 584) break; }
        if (u < 96) PU(10, REPU(RU_Q, unit_mla_q(a, X, j, u)))
        else if (u < 200) PU(11, REPU(RU_KV, unit_mla_kv(a, X, j, u < 192 ? u - 96 : -1 - (u - 192))))
        else { const int v = u - 200; PU(12, REPU(RU_L, unit_mlstm_L(a, X, j, v / 96, v % 96))) }
    }
}
__device__ __forceinline__ void phase_e2b(const Args& a, const Ctx& X, int j) {
    for (int u = X.bid; u < 640; u += X.G) {
        if (u < 256) PU(13, REPU(RU_ATTS, unit_mla_attn(a, X, u)))
        else PU(14, REPU(RU_SCAN, unit_mlstm_scan(a, X, j, u - 256)))
    }
}
__device__ __forceinline__ void phase_e3(const Args& a, const Ctx& X, int j) {
    const int b = X.bid;
    for (int s = 0; s < 3; ++s) {
        int u;
        if (s == 0) u = b; else if (b < 128) { if (s == 1) u = 256 + b; else break; } else u = 384 + (b - 128) + 128 * (s - 1);
        if (u < 384) PU(15, REPU(RU_OUT, unit_mlstm_out(a, X, j, u / 96, u % 96)))
        else PU(16, REPU(RU_ATTP, unit_mla_attn(a, X, u - 384 + 256)))
    }
}
__device__ __forceinline__ void phase_o2(const Args& a, const Ctx& X, int j) {
    for (int u = X.bid; u < 704; u += X.G) {
        if (u < 256) PU(17, REPU(RU_NA, unit_na(a, X, j, u)))
        else if (u < 512) PU(18, REPU(RU_OATT, unit_odd_attn(a, X, j, u - 256)))
        else PU(19, REPU(RU_CONV, unit_conv(a, X, j, u - 512)))
    }
}


#ifndef REP_P0A
#define REP_P0A 1
#endif
#ifndef REP_NORM
#define REP_NORM 1
#endif
#ifndef REP_G1
#define REP_G1 1
#endif
#ifndef REP_E2
#define REP_E2 1
#endif
#ifndef REP_G2L0
#define REP_G2L0 1
#endif
#ifndef REP_E2B
#define REP_E2B 1
#endif
#ifndef REP_E3
#define REP_E3 1
#endif
#ifndef REP_O2
#define REP_O2 1
#endif
#ifndef PHMASK
#define PHMASK 0x7f
#endif
#define PH_NOP(...) ((void)0)
#if PHMASK & 1
#define PH_P0A phase_p0a
#else
#define PH_P0A PH_NOP
#endif
#if PHMASK & 2
#define PH_NORM phase_norm
#else
#define PH_NORM PH_NOP
#endif
#if PHMASK & 4
#define PH_G1 phase_gemm1
#else
#define PH_G1 PH_NOP
#endif
#if PHMASK & 8
#define PH_E2 phase_e2
#else
#define PH_E2 PH_NOP
#endif
#if PHMASK & 16
#define PH_E3 phase_e3
#define PH_E2B phase_e2b
#else
#define PH_E3 PH_NOP
#define PH_E2B PH_NOP
#endif
#if PHMASK & 32
#define PH_O2 phase_o2
#else
#define PH_O2 PH_NOP
#endif
#if PHMASK & 64
#define PH_G2 phase_gemm2
#else
#define PH_G2 PH_NOP
#endif
__global__ void __launch_bounds__(NTHR, 2) mega_fwd(Args args) {
    extern __shared__ __attribute__((aligned(16))) unsigned char lds[];
    Ctx X; X.lds = (LAS unsigned char*)lds; X.ldsg = lds;
    X.tid = threadIdx.x; X.lane = X.tid & 63; X.wave = __builtin_amdgcn_readfirstlane(X.tid >> 6); X.G = gridDim.x; X.bid = blockIdx.x;
    volatile LAS unsigned* MISC = (volatile LAS unsigned*)(X.lds + MISC_OFF);
    if (X.tid < 32) MISC[X.tid] = 0u;
    __syncthreads();
    const int lo = args.ph_lo, hi = args.ph_hi;
    XcdBarrier bar; bar.bar = (unsigned*)(args.ws + WS_CTL) + CW_BAR; bar.x = 0; bar.st = MISC + 8;
    if (hi - lo > 1) bar = xcd_barrier_post((unsigned*)(args.ws + WS_CTL) + CW_BAR, MISC + 8);
    int ph = 0;
#define RUN(pid, n, body) do { if (ph >= lo && ph < hi) { for (int rp = 0; rp < (n); ++rp) { { PROF_BEGIN(pid) body; PROF_END(pid) } if (ph + 1 < hi || rp + 1 < (n)) { PROF_BEGIN(9) xcd_barrier(bar); PROF_END(9) } } } ++ph; } while (0)
    RUN(1, REP_P0A, PH_P0A(args, X));
    RUN(2, REP_NORM, PH_NORM(args, X, 0));
    for (int l = 0; l < 4; ++l) {
        const int j = l >> 1;
        RUN(3, REP_G1, PH_G1(args, X, l));
        if ((l & 1) == 0) { RUN(4, REP_E2, PH_E2(args, X, j)); RUN(5, REP_E2B, PH_E2B(args, X, j)); RUN(6, REP_E3, PH_E3(args, X, j)); }
        else { RUN(7, REP_O2, PH_O2(args, X, j)); }
        RUN(8, l == 0 ? REP_G2L0 : 1, PH_G2(args, X, l));
    }
#undef RUN
    if (PROF_ID != 0 && threadIdx.x == 0) { const unsigned long long t0 = __builtin_amdgcn_s_memrealtime(); const unsigned long long w = (unsigned long long)PROF_K * ((volatile LAS unsigned*)(X.lds + MISC_OFF))[16];
        while (__builtin_amdgcn_s_memrealtime() - t0 < w) __builtin_amdgcn_s_sleep(8); }
}

#ifndef MK_SPLIT
#define MK_SPLIT 0
#endif

extern "C" void kernel_launch(void* const* d_in, const int* in_sizes, int n_in, void* d_out, int out_size, void* d_ws, size_t ws_size, hipStream_t stream) {
    static int ready = 0;
    if (!ready) {
        if (hipFuncSetAttribute((const void*)mega_fwd, hipFuncAttributeMaxDynamicSharedMemorySize, LDS_BYTES) != hipSuccess) fprintf(stderr, "kernel_launch: hipFuncSetAttribute failed\n");
        int per_cu = 0;
        if (hipOccupancyMaxActiveBlocksPerMultiprocessor(&per_cu, (const void*)mega_fwd, NTHR, LDS_BYTES) != hipSuccess || per_cu < 1) fprintf(stderr, "kernel_launch: occupancy query says %d blocks per CU\n", per_cu);
        (void)hipGetLastError();
        ready = 1;
    }
    (void)hipMemsetAsync((char*)d_ws + WS_CTL, 0, CTL_ZERO_BYTES, stream);
    Args a{};
    for (int i = 0; i < 32; ++i) a.in[i] = (const float*)d_in[i];
    a.out = (float*)d_out; a.ws = (unsigned char*)d_ws;
#if MK_SPLIT
    for (int p = 0; p < NPHASES; ++p) { a.ph_lo = p; a.ph_hi = p + 1; hipLaunchKernelGGL(mega_fwd, dim3(256), dim3(NTHR), LDS_BYTES, stream, a); }
#else
    a.ph_lo = 0; a.ph_hi = NPHASES;
    hipLaunchKernelGGL(mega_fwd, dim3(256), dim3(NTHR), LDS_BYTES, stream, a);
#endif
}
```

```cpp
#include <hip/hip_runtime.h>
#include <cstdio>
#include <cstdint>
#include <math.h>

#define GAS __attribute__((address_space(1)))
#define LAS __attribute__((address_space(3)))
typedef unsigned short bf16;
typedef unsigned v4u __attribute__((ext_vector_type(4)));
typedef unsigned v2u __attribute__((ext_vector_type(2)));
typedef float f32x4 __attribute__((ext_vector_type(4)));
typedef float f32x2 __attribute__((ext_vector_type(2)));
typedef float f32x16 __attribute__((ext_vector_type(16)));
typedef short bf16x8 __attribute__((ext_vector_type(8)));
typedef __bf16 bh8 __attribute__((ext_vector_type(8)));
typedef __bf16 bh2 __attribute__((ext_vector_type(2)));
typedef GAS unsigned gu32;
#define RLX_AGENT __ATOMIC_RELAXED, __HIP_MEMORY_SCOPE_AGENT
#define LDS_WAIT() asm volatile("s_waitcnt lgkmcnt(0)" ::: "memory")
#define SB_PIN __builtin_amdgcn_sched_barrier(0);
#define VM_WAIT() asm volatile("s_waitcnt vmcnt(0)" ::: "memory")

constexpr int DM = 1024, NP = 4096, NS = 2048, NT = 6144;
constexpr int UE = 3584, UO = 4096;
constexpr float EPS = 1e-6f;
constexpr int CE_QA = 0, CE_KVA = 256, CE_GA = 384, CE_QM = 896, CE_KM = 1408, CE_VM = 1920, CE_OM = 2432, CE_GM = 2944, CE_KPE = 3456;
constexpr int CO_XC = 0, CO_BC = 512, CO_CC = 1024, CO_GC = 1536, CO_QD = 2048, CO_KD = 2560, CO_VD = 3072, CO_GD = 3584;
constexpr size_t O_Y = 0, O_CKV = 6291456, O_KPE = 7340032, O_C = 7602176, O_N = 11796480, O_M = 11829248, O_NK = 11829504, O_NV = 16023808;
constexpr size_t MiB = 1u << 20;
constexpr size_t WS_CTL = 0, CTL_ZERO_BYTES = 65536;
constexpr size_t WS_ROPE = 65536;
constexpr size_t WS_MOD = 131072;
constexpr size_t WS_AG = 327680;
constexpr size_t WS_WTEV = 1 * MiB;
constexpr size_t WS_WTOD = 17 * MiB;
constexpr size_t WS_WTOUT = 33 * MiB;
constexpr size_t WS_WTQB = 41 * MiB;
constexpr size_t WS_WTKVB = 42 * MiB;
constexpr size_t WS_NAKC = 43 * MiB;
constexpr size_t WS_NAVC = 44 * MiB;
constexpr size_t WS_C0T = 45 * MiB;
constexpr size_t WS_H = 47 * MiB;
constexpr size_t WS_U = 59 * MiB;
constexpr size_t WS_Z = 107 * MiB;
constexpr size_t WS_GATES = 119 * MiB;
constexpr size_t WS_Q = 120 * MiB;
constexpr size_t WS_KM = 129 * MiB;
constexpr size_t WS_VTM = 139 * MiB;
constexpr size_t WS_VTO = 146 * MiB;
constexpr size_t WS_LT = 152 * MiB;
constexpr size_t WS_NL = 200 * MiB;
constexpr size_t WS_CTB = 201 * MiB;
constexpr size_t WS_NPV = 225 * MiB;
constexpr size_t WS_MPV = 226 * MiB;
constexpr size_t WS_KFO = 227 * MiB;
constexpr size_t WS_VFM = 234 * MiB;
constexpr size_t WS_GQ = 241 * MiB;
constexpr size_t WS_XS = 242 * MiB;
constexpr size_t CTL_NCNT = 32768;
constexpr size_t CTL_MODCNT = 49152;
constexpr int KROWS = 6656;

__device__ __forceinline__ unsigned pk2(float lo, float hi) { f32x2 v = {lo, hi}; bh2 b = __builtin_convertvector(v, bh2); return __builtin_bit_cast(unsigned, b); }
__device__ __forceinline__ float bf2f(unsigned u16) { return __builtin_bit_cast(float, u16 << 16); }
__device__ __forceinline__ float bflo(unsigned u) { return __builtin_bit_cast(float, u << 16); }
__device__ __forceinline__ float bfhi(unsigned u) { return __builtin_bit_cast(float, u & 0xffff0000u); }
__device__ __forceinline__ float silu_f(float x) { return x / (1.f + __expf(-x)); }
__device__ __forceinline__ float sigmoid_f(float x) { return 1.f / (1.f + __expf(-x)); }
__device__ __forceinline__ float logsigmoid_f(float x) { return fminf(x, 0.f) - log1pf(expf(-fabsf(x))); }
__device__ __forceinline__ int cond_of_row(int r) { return r < NP ? 0 : 1 + ((r - NP) >> 10); }
__device__ __forceinline__ float wave_sum(float v) {
#pragma unroll
    for (int o = 1; o < 64; o <<= 1) v += __shfl_xor(v, o);
    return v;
}
__device__ __forceinline__ float wave_max(float v) {
#pragma unroll
    for (int o = 1; o < 64; o <<= 1) v = fmaxf(v, __shfl_xor(v, o));
    return v;
}
__device__ __forceinline__ f32x16 mfma32(bh8 a, bh8 b, f32x16 c) { return __builtin_amdgcn_mfma_f32_32x32x16_bf16(a, b, c, 0, 0, 0); }
__device__ __forceinline__ bh8 ld16(const bf16* p) { return *(const bh8*)p; }
__device__ __forceinline__ bh8 ld2x8(const bf16* p0, const bf16* p1) { v2u a = *(const v2u*)p0, b = *(const v2u*)p1; v4u v = {a.x, a.y, b.x, b.y}; return __builtin_bit_cast(bh8, v); }
__device__ __forceinline__ bh8 pfrag(const f32x16& p, int s) {
    v4u v; v.x = pk2(p[8 * s + 0], p[8 * s + 1]); v.y = pk2(p[8 * s + 2], p[8 * s + 3]); v.z = pk2(p[8 * s + 4], p[8 * s + 5]); v.w = pk2(p[8 * s + 6], p[8 * s + 7]);
    return __builtin_bit_cast(bh8, v);
}
__device__ __forceinline__ int crow(int i, int hh) { return (i & 3) + 8 * (i >> 2) + 4 * hh; }
__device__ __forceinline__ void st4bf(bf16* p, float a, float b, float c, float d) { v2u v; v.x = pk2(a, b); v.y = pk2(c, d); *(v2u*)p = v; }

namespace pg8 {
#define PG8_LAS __attribute__((address_space(3)))
typedef unsigned short bf16_t;
typedef short bf16x8 __attribute__((ext_vector_type(8)));
typedef float f32x4 __attribute__((ext_vector_type(4)));
typedef unsigned u32x4 __attribute__((ext_vector_type(4)));
constexpr int BM = 256, BK = 64, HALF = 128, HTB = HALF * BK * 2  , STAGE_BYTES = 8 * HTB, NXCD = 8, WGM = 8;

__host__ __device__ __forceinline__ int lds_byte(int r, int c) { const int st = (r >> 4) * 2 + (c >> 5), rr = r & 15, cc = c & 31, ob = rr * 64 + cc * 2; return st * 1024 + (ob ^ (((ob >> 9) & 1) << 5)); }
__host__ __device__ __forceinline__ void stage_rc(int b, int& R, int& C) { const int st = b / 1024, sb = b % 1024, swz = sb ^ (((sb >> 9) & 1) << 5); R = (st >> 1) * 16 + swz / 64; C = (st & 1) * 32 + (swz % 64) / 2; }
__host__ __device__ __forceinline__ int perm32(int rho) { const int n = rho >> 4, i = rho & 15; return 8 * (i >> 2) + 4 * n + (i & 3); }

struct Unit { int pm, pn; };
struct Gemm { const bf16_t* A; const bf16_t* Bt; int M, N, K; };

struct StaticOrder {
    int nM, nN, nwg, G, c;
    __host__ __device__ void init(int M, int N, int G_, int c_, int bma) { nM = M / bma; nN = N / BM; nwg = nM * nN; G = G_; c = c_; }
    __host__ __device__ bool next(int i, Unit& u) const {
        const long L = (long)i * G + c; if (L >= nwg) return false;
        int wgid = (int)L; { const int q = nwg / NXCD, r = nwg % NXCD, xcd = wgid % NXCD, off = wgid / NXCD; wgid = (xcd < r ? xcd * (q + 1) : r * (q + 1) + (xcd - r) * q) + off; }
        const int nig = WGM * nN, gid = wgid / nig, fm = gid * WGM, gsz = (nM - fm) < WGM ? (nM - fm) : WGM;
        u.pm = fm + ((wgid % nig) % gsz); u.pn = (wgid % nig) / gsz; return true;
    }
    __device__ __forceinline__ void a_ready(const Unit&) const {}
    __device__ __forceinline__ void done(const Unit&) const {}
};

__device__ __forceinline__ int pg8_opaque(int x) { asm volatile("" : "+v"(x)); return x; }
__device__ __forceinline__ unsigned cvt_pk_bf16(float lo, float hi) { unsigned r; asm volatile("v_cvt_pk_bf16_f32 %0, %1, %2" : "=v"(r) : "v"(lo), "v"(hi)); return r; }

struct EpiU {
    static constexpr bool PERM = true, AFTER_DRAIN = false; static constexpr int BMA_ROWS = 192, BMA = BMA_ROWS, HA = BMA / 2, MA = HA / 32, WRA = HA / 2;
    bf16_t* U; int ldu; float* gates; bf16_t* vto; bf16_t* kfo; bf16_t* vfm;
    __device__ __forceinline__ void operator()(const f32x4 (&acc)[2][2][4][2], const Unit& u, int wr, int wc, int fr, int fq) const {
        const int row0 = u.pm * BMA + wr * WRA + fr, col0 = u.pn * BM + wc * 32 + 8 * fq;
        const bool dog = gates != nullptr && u.pn == 13 && wc == 1 && fq < 2;
        const bool dov = vto != nullptr && (u.pn == 12 || u.pn == 13);
        const bool dok = kfo != nullptr && (u.pn == 10 || u.pn == 11);
        const bool dom = vfm != nullptr && u.pn >= 7 && u.pn <= 9;
#pragma unroll
        for (int ai = 0; ai < 2; ++ai)
#pragma unroll
            for (int m = 0; m < MA; ++m) {
                const int row = row0 + ai * HA + m * 16;
#pragma unroll
                for (int bj = 0; bj < 2; ++bj) {
                    const f32x4 v0 = acc[ai][bj][m][0], v1 = acc[ai][bj][m][1];
                    const int col = col0 + bj * HALF;
                    u32x4 w; w.x = cvt_pk_bf16(v0[0], v0[1]); w.y = cvt_pk_bf16(v0[2], v0[3]); w.z = cvt_pk_bf16(v1[0], v1[1]); w.w = cvt_pk_bf16(v1[2], v1[3]);
                    *(u32x4*)(U + (size_t)row * ldu + col) = w;
                    if (bj == 1 && dog) { float* g = gates + (size_t)row * 16 + 8 * fq; *(f32x4*)g = v0; *(f32x4*)(g + 4) = v1; }
                    if (dom && col >= 1920 && col < 2432) { const int cc = col - 1920, hd = cc >> 7, ev = cc & 127, t16 = row & 15;
                        bf16_t* vp = vfm + ((size_t)((row >> 5) * 4 + hd) * 8 + (ev >> 5) * 2 + ((row >> 4) & 1)) * 512 + (((t16 >> 2) & 1) * 32 + (ev & 31)) * 8 + 4 * (t16 >> 3) + (t16 & 3);
                        vp[0] = (bf16_t)(w.x & 0xffffu); vp[8] = (bf16_t)(w.x >> 16); vp[16] = (bf16_t)(w.y & 0xffffu); vp[24] = (bf16_t)(w.y >> 16);
                        vp[32] = (bf16_t)(w.z & 0xffffu); vp[40] = (bf16_t)(w.z >> 16); vp[48] = (bf16_t)(w.w & 0xffffu); vp[56] = (bf16_t)(w.w >> 16);
                    }
                    if (dok) { const int cc = col - 2560, hd = cc >> 6, d = cc & 63;
                        *(u32x4*)(kfo + ((size_t)((row >> 5) * 8 + hd) * 4 + (d >> 4)) * 512 + (((d >> 3) & 1) * 32 + (row & 31)) * 8) = w; }
                    if (dov) { const int cc = col - 3072, hd = cc >> 6, dv = cc & 63, t16 = row & 15;
                        bf16_t* vp = vto + ((size_t)((row >> 5) * 8 + hd) * 4 + (dv >> 5) * 2 + ((row >> 4) & 1)) * 512 + (((t16 >> 2) & 1) * 32 + (dv & 31)) * 8 + 4 * (t16 >> 3) + (t16 & 3);
                        vp[0] = (bf16_t)(w.x & 0xffffu); vp[8] = (bf16_t)(w.x >> 16); vp[16] = (bf16_t)(w.y & 0xffffu); vp[24] = (bf16_t)(w.y >> 16);
                        vp[32] = (bf16_t)(w.z & 0xffffu); vp[40] = (bf16_t)(w.z >> 16); vp[48] = (bf16_t)(w.w & 0xffffu); vp[56] = (bf16_t)(w.w >> 16);
                    }
                }
            }
    }
};

struct EpiY {
    static constexpr bool PERM = true, AFTER_DRAIN = false; static constexpr int BMA_ROWS = 128, BMA = BMA_ROWS, HA = BMA / 2, MA = HA / 32, WRA = HA / 2;
    float* Y; const float* ysp; const float* yss; const float* mod_l;
    __device__ __forceinline__ void operator()(const f32x4 (&acc)[2][2][4][2], const Unit& u, int wr, int wc, int fr, int fq) const {
        const int row0 = u.pm * BMA + wr * WRA + fr, col0 = u.pn * BM + wc * 32 + 8 * fq;
#pragma unroll
        for (int bj = 0; bj < 2; ++bj) {
            const int col = col0 + bj * HALF;
#pragma unroll
            for (int ai = 0; ai < 2; ++ai)
#pragma unroll
                for (int m = 0; m < MA; ++m) {
                    const int row = row0 + ai * HA + m * 16;
                    const float* gp = mod_l + (row < 4096 ? 0 : (row < 5120 ? 1 : 2)) * 3072 + 2048 + col;
                    const f32x4 g0 = *(const f32x4*)gp, g1 = *(const f32x4*)(gp + 4);
                    const float* src = (row < 4096 ? ysp + (size_t)row * 1024 : yss + (size_t)(row - 4096) * 1024) + col;
                    const f32x4 y0 = *(const f32x4*)src, y1 = *(const f32x4*)(src + 4);
                    float* dst = Y + (size_t)row * 1024 + col;
                    *(f32x4*)dst = y0 + g0 * acc[ai][bj][m][0];
                    *(f32x4*)(dst + 4) = y1 + g1 * acc[ai][bj][m][1];
                }
        }
    }
};


struct EpiYN {
    static constexpr bool PERM = true, AFTER_DRAIN = true; static constexpr int BMA_ROWS = 128, BMA = BMA_ROWS, HA = BMA / 2, MA = HA / 32, WRA = HA / 2;
    float* Y; const float* ysp; const float* yss; const float* mod_l;
    bf16_t* H; const float* nw; const float* mod_n;
    unsigned* xs; unsigned* cnt;
    __device__ __forceinline__ void operator()(const f32x4 (&)[2][2][4][2], const Unit&, int, int, int, int) const {}
    __device__ __forceinline__ void fused(f32x4 (&acc)[2][2][4][2], const Unit& u, int wr, int wc, int fr, int fq, PG8_LAS unsigned char* lds, int wid, int lane) const {
        const int tid = wid * 64 + lane;
        PG8_LAS float* part = (PG8_LAS float*)lds; PG8_LAS float* rstds = part + 512;
        const int row0 = u.pm * BMA + wr * WRA + fr, col0 = u.pn * BM + wc * 32 + 8 * fq;
        const int cond = u.pm < 32 ? 0 : (u.pm < 40 ? 1 : 2);
        float ss[2][2] = {{0.f, 0.f}, {0.f, 0.f}};
#pragma unroll
        for (int bj = 0; bj < 2; ++bj) {
            const int col = col0 + bj * HALF;
            const float* gp = mod_l + cond * 3072 + 2048 + col;
            const f32x4 g0 = *(const f32x4*)gp, g1 = *(const f32x4*)(gp + 4);
#pragma unroll
            for (int ai = 0; ai < 2; ++ai)
#pragma unroll
                for (int m = 0; m < MA; ++m) {
                    const int row = row0 + ai * HA + m * 16;
                    const float* src = (row < 4096 ? ysp + (size_t)row * 1024 : yss + (size_t)(row - 4096) * 1024) + col;
                    const f32x4 v0 = *(const f32x4*)src + g0 * acc[ai][bj][m][0], v1 = *(const f32x4*)(src + 4) + g1 * acc[ai][bj][m][1];
                    float* dst = Y + (size_t)row * 1024 + col;
                    *(f32x4*)dst = v0; *(f32x4*)(dst + 4) = v1;
                    acc[ai][bj][m][0] = v0; acc[ai][bj][m][1] = v1;
                    ss[ai][m] += (v0[0] * v0[0] + v0[1] * v0[1]) + (v0[2] * v0[2] + v0[3] * v0[3]) + (v1[0] * v1[0] + v1[1] * v1[1]) + (v1[2] * v1[2] + v1[3] * v1[3]);
                }
        }
#pragma unroll
        for (int ai = 0; ai < 2; ++ai)
#pragma unroll
            for (int m = 0; m < MA; ++m) { float s = ss[ai][m]; s += __shfl_xor(s, 16); s += __shfl_xor(s, 32);
                if (fq == 0) part[wc * 128 + ai * HA + wr * WRA + m * 16 + fr] = s; }
        __syncthreads();
        if (tid < 128) { const float t = part[tid] + part[128 + tid] + part[256 + tid] + part[384 + tid];
            __hip_atomic_store(xs + (size_t)(u.pm * 4 + u.pn) * 128 + tid, __builtin_bit_cast(unsigned, t), __ATOMIC_RELAXED, __HIP_MEMORY_SCOPE_AGENT); }
        asm volatile("s_waitcnt vmcnt(0)" ::: "memory");
        __syncthreads();
        if (tid == 0) { unsigned* c = cnt + 16 * u.pm;
            __hip_atomic_fetch_add(c, 1u, __ATOMIC_RELAXED, __HIP_MEMORY_SCOPE_AGENT);
            unsigned sp = 0; while (__hip_atomic_load(c, __ATOMIC_RELAXED, __HIP_MEMORY_SCOPE_AGENT) < 4u && ++sp < (1u << 20)) __builtin_amdgcn_s_sleep(1); }
        __syncthreads();
        if (tid < 128) { float t = 0.f;
#pragma unroll
            for (int p = 0; p < 4; ++p) t += __builtin_bit_cast(float, __hip_atomic_load(xs + (size_t)(u.pm * 4 + p) * 128 + tid, __ATOMIC_RELAXED, __HIP_MEMORY_SCOPE_AGENT));
            rstds[tid] = rsqrtf(t * (1.f / 1024.f) + 1e-6f); }
        __syncthreads();
#pragma unroll
        for (int bj = 0; bj < 2; ++bj) {
            const int col = col0 + bj * HALF;
            const float* mp = mod_n + cond * 3072 + col;
            const f32x4 n0 = *(const f32x4*)(nw + col), n1 = *(const f32x4*)(nw + col + 4), sh0 = *(const f32x4*)mp, sh1 = *(const f32x4*)(mp + 4), sc0 = *(const f32x4*)(mp + 1024), sc1 = *(const f32x4*)(mp + 1028);
            const f32x4 m0 = n0 * (sc0 + 1.f), m1 = n1 * (sc1 + 1.f);
#pragma unroll
            for (int ai = 0; ai < 2; ++ai)
#pragma unroll
                for (int m = 0; m < MA; ++m) {
                    const int rl = ai * HA + wr * WRA + m * 16 + fr; const float r = rstds[rl];
                    const f32x4 h0 = acc[ai][bj][m][0] * r * m0 + sh0, h1 = acc[ai][bj][m][1] * r * m1 + sh1;
                    u32x4 w; w.x = cvt_pk_bf16(h0[0], h0[1]); w.y = cvt_pk_bf16(h0[2], h0[3]); w.z = cvt_pk_bf16(h1[0], h1[1]); w.w = cvt_pk_bf16(h1[2], h1[3]);
                    *(u32x4*)(H + (size_t)(u.pm * BMA + rl) * 1024 + col) = w;
                }
        }
    }
};
template <class Epi, class Sched, bool ALIGN_EPI = false, bool SP2 = false>
__device__ __forceinline__ void gemm_phase(PG8_LAS unsigned char* lds, const Gemm g, const Sched& S, const Epi& E) {
    constexpr int BMA = Epi::BMA_ROWS, HA = BMA / 2, MA = HA / 32, WRA = HA / 2;
    const int tid = pg8_opaque((int)threadIdx.x), wid = __builtin_amdgcn_readfirstlane(tid >> 6), lane = tid & 63, wr = wid >> 2, wc = wid & 3, fr = lane & 15, fq = lane >> 4;
    const int K = g.K, nt = K / BK;
    unsigned voffA[2], voffB[2];
#pragma unroll
    for (int i = 0; i < 2; ++i) { int R, C; stage_rc(tid * 16 + i * 8192, R, C); const int Rb = Epi::PERM ? ((R & ~31) + perm32(R & 31)) : R;
        voffA[i] = (unsigned)(R * K + C) * 2u; voffB[i] = (unsigned)(Rb * K + C) * 2u; }
    const size_t kstep = (size_t)(BK * 2);
    const size_t hstep = (size_t)HALF * K * 2;
    const size_t tstep = 2 * hstep;
    const size_t hstepA = (size_t)HA * K * 2, tstepA = 2 * hstepA;
    const unsigned ldsw = (unsigned)wid * 1024u;
    const int aoff = lds_byte(wr * WRA + fr, fq * 8), boff = lds_byte(wc * 32 + fr, fq * 8);
#define PG8_SA(b, h) (((b) * 2 + (h)) * HTB)
#define PG8_SB(b, h) ((4 + (b) * 2 + (h)) * HTB)
#define PG8_STAGE(bufoff, gbase, voff) do { _Pragma("unroll") for (int _i = 0; _i < 2; ++_i) \
        __builtin_amdgcn_global_load_lds((const unsigned*)((const char*)(gbase) + (voff)[_i]), (PG8_LAS unsigned*)(lds + (bufoff) + ldsw + _i * 8192), 16, 0, 0); } while (0)
#define PG8_LDA(dst, b, h) do { _Pragma("unroll") for (int m = 0; m < MA; ++m) _Pragma("unroll") for (int k = 0; k < 2; ++k) dst[m][k] = *(const PG8_LAS bf16x8*)(lds + PG8_SA(b, h) + aoff + m * 2048 + k * 1024); } while (0)
#define PG8_LDB(dst, b, h) do { _Pragma("unroll") for (int n = 0; n < 2; ++n) _Pragma("unroll") for (int k = 0; k < 2; ++k) dst[n][k] = *(const PG8_LAS bf16x8*)(lds + PG8_SB(b, h) + boff + n * 2048 + k * 1024); } while (0)
#define PG8_MMA(ai, bj, At, Bt) do { __builtin_amdgcn_s_setprio(1); _Pragma("unroll") for (int m = 0; m < MA; ++m) _Pragma("unroll") for (int n = 0; n < 2; ++n) _Pragma("unroll") for (int k = 0; k < 2; ++k) \
        acc[ai][bj][m][n] = __builtin_amdgcn_mfma_f32_16x16x32_bf16(Bt[n][k], At[m][k], acc[ai][bj][m][n], 0, 0, 0); __builtin_amdgcn_s_setprio(0); } while (0)
#define PG8_WAIT_V(n) asm volatile("s_waitcnt vmcnt(" #n ")" ::: "memory")
#define PG8_WAIT_L(n) asm volatile("s_waitcnt lgkmcnt(" #n ")" ::: "memory")
#define PG8_BAR __builtin_amdgcn_s_barrier()
#define PG8_SCHED __builtin_amdgcn_sched_barrier(0)
    Unit cur, nxt; int ui = 0;
    if (!S.next(0, cur)) return;
    f32x4 acc[2][2][4][2];
#pragma unroll
    for (int a = 0; a < 2; ++a)
#pragma unroll
        for (int b = 0; b < 2; ++b)
#pragma unroll
            for (int m = 0; m < MA; ++m)
#pragma unroll
                for (int n = 0; n < 2; ++n) acc[a][b][m][n] = (f32x4){0.f, 0.f, 0.f, 0.f};
    bf16x8 At[4][2], B0[2][2], B1[2][2];
    const char* cA = (const char*)g.A + (size_t)cur.pm * tstepA; const char* cB = (const char*)g.Bt + (size_t)cur.pn * tstep;
    S.a_ready(cur);
    if constexpr (SP2) {
        PG8_STAGE(PG8_SB(0, 0), cB, voffB); PG8_STAGE(PG8_SB(0, 1), cB + hstep, voffB); PG8_STAGE(PG8_SA(0, 0), cA, voffA); PG8_STAGE(PG8_SA(0, 1), cA + hstepA, voffA);
        if (wr == 1) PG8_BAR;
        PG8_WAIT_V(2); PG8_BAR;
        PG8_STAGE(PG8_SB(1, 0), cB + kstep, voffB); PG8_STAGE(PG8_SA(1, 0), cA + kstep, voffA); PG8_STAGE(PG8_SB(1, 1), cB + hstep + kstep, voffB);
        PG8_WAIT_V(6); PG8_BAR;
    } else {
        PG8_STAGE(PG8_SB(0, 0), cB, voffB); PG8_STAGE(PG8_SA(0, 0), cA, voffA); PG8_STAGE(PG8_SB(0, 1), cB + hstep, voffB); PG8_STAGE(PG8_SA(0, 1), cA + hstepA, voffA);
        if (wr == 1) PG8_BAR;
        PG8_WAIT_V(4); PG8_BAR;
        PG8_STAGE(PG8_SB(1, 0), cB + kstep, voffB); PG8_STAGE(PG8_SA(1, 0), cA + kstep, voffA); PG8_STAGE(PG8_SB(1, 1), cB + hstep + kstep, voffB);
        PG8_WAIT_V(6); PG8_BAR;
    }
    for (;;) {
        const bool has_next = S.next(ui + 1, nxt);
        const char* nA = has_next ? (const char*)g.A + (size_t)nxt.pm * tstepA : cA; const char* nB = has_next ? (const char*)g.Bt + (size_t)nxt.pn * tstep : cB;
        for (int t = 0; t < nt; t += 2) {
            const bool last = (t == nt - 2);
            const char* a1 = cA + (size_t)(t + 1) * kstep;
            const char* a2 = last ? nA : cA + (size_t)(t + 2) * kstep; const char* b2 = last ? nB : cB + (size_t)(t + 2) * kstep;
            const char* a3 = a2 + kstep; const char* b3 = b2 + kstep;
            if (last && has_next) S.a_ready(nxt);
            if constexpr (SP2) {
            PG8_LDB(B0, 0, 0); PG8_LDB(B1, 0, 1); PG8_SCHED; PG8_LDA(At, 0, 0); PG8_STAGE(PG8_SA(1, 1), a1 + hstepA, voffA);
            PG8_WAIT_V(8); PG8_WAIT_L(0); PG8_BAR; PG8_MMA(0, 0, At, B0); PG8_MMA(0, 1, At, B1); PG8_BAR; PG8_SCHED;
            PG8_LDA(At, 0, 1); PG8_STAGE(PG8_SB(0, 0), b2, voffB); PG8_STAGE(PG8_SB(0, 1), b2 + hstep, voffB); PG8_STAGE(PG8_SA(0, 0), a2, voffA);
            PG8_WAIT_V(8); PG8_WAIT_L(0); PG8_BAR; PG8_MMA(1, 0, At, B0); PG8_MMA(1, 1, At, B1); PG8_BAR; PG8_SCHED;
            PG8_LDB(B0, 1, 0); PG8_LDB(B1, 1, 1); PG8_SCHED; PG8_LDA(At, 1, 0); PG8_STAGE(PG8_SA(0, 1), a2 + hstepA, voffA);
            PG8_WAIT_V(8); PG8_WAIT_L(0); PG8_BAR; PG8_MMA(0, 0, At, B0); PG8_MMA(0, 1, At, B1); PG8_BAR; PG8_SCHED;
            PG8_LDA(At, 1, 1); PG8_STAGE(PG8_SB(1, 0), b3, voffB); PG8_STAGE(PG8_SB(1, 1), b3 + hstep, voffB); PG8_STAGE(PG8_SA(1, 0), a3, voffA);
            PG8_WAIT_V(8); PG8_WAIT_L(0); PG8_BAR; PG8_MMA(1, 0, At, B0); PG8_MMA(1, 1, At, B1); PG8_BAR; PG8_SCHED;
            } else {
            PG8_LDB(B0, 0, 0); PG8_SCHED; PG8_LDA(At, 0, 0); PG8_STAGE(PG8_SA(1, 1), a1 + hstepA, voffA);
            PG8_WAIT_L(8); PG8_BAR; PG8_WAIT_L(0); PG8_MMA(0, 0, At, B0); PG8_BAR; PG8_SCHED;
            PG8_LDB(B1, 0, 1); PG8_STAGE(PG8_SB(0, 0), b2, voffB);
            PG8_BAR; PG8_WAIT_L(0); PG8_MMA(0, 1, At, B1); PG8_BAR;
            PG8_LDA(At, 0, 1); PG8_STAGE(PG8_SA(0, 0), a2, voffA);
            PG8_BAR; PG8_WAIT_L(0); PG8_MMA(1, 0, At, B0); PG8_BAR; PG8_SCHED;
            PG8_STAGE(PG8_SB(0, 1), b2 + hstep, voffB);
            PG8_WAIT_V(6); PG8_BAR; PG8_MMA(1, 1, At, B1); PG8_BAR;
            PG8_LDB(B0, 1, 0); PG8_SCHED; PG8_LDA(At, 1, 0); PG8_STAGE(PG8_SA(0, 1), a2 + hstepA, voffA);
            PG8_WAIT_L(8); PG8_BAR; PG8_WAIT_L(0); PG8_MMA(0, 0, At, B0); PG8_BAR; PG8_SCHED;
            PG8_LDB(B1, 1, 1); PG8_STAGE(PG8_SB(1, 0), b3, voffB);
            PG8_BAR; PG8_WAIT_L(0); PG8_MMA(0, 1, At, B1); PG8_BAR;
            PG8_LDA(At, 1, 1); PG8_STAGE(PG8_SA(1, 0), a3, voffA);
            PG8_BAR; PG8_WAIT_L(0); PG8_MMA(1, 0, At, B0); PG8_BAR; PG8_SCHED;
            PG8_STAGE(PG8_SB(1, 1), b3 + hstep, voffB);
            PG8_WAIT_V(6); PG8_BAR; PG8_MMA(1, 1, At, B1); PG8_BAR;
            }
        }
        if constexpr (ALIGN_EPI) { if (wr == 0) PG8_BAR; }
        if constexpr (!Epi::AFTER_DRAIN) { E(acc, cur, wr, wc, fr, fq); S.done(cur); }
        if (!has_next) break;
#pragma unroll
        for (int a = 0; a < 2; ++a)
#pragma unroll
            for (int b = 0; b < 2; ++b)
#pragma unroll
                for (int m = 0; m < MA; ++m)
#pragma unroll
                    for (int n = 0; n < 2; ++n) acc[a][b][m][n] = (f32x4){0.f, 0.f, 0.f, 0.f};
        cur = nxt; cA = nA; cB = nB; ++ui;
        if constexpr (ALIGN_EPI) { if (wr == 1) PG8_BAR; }
    }
    PG8_WAIT_V(0);
    if constexpr (!ALIGN_EPI) { if (wr == 0) PG8_BAR; }
    PG8_BAR;
    if constexpr (Epi::AFTER_DRAIN) { E.fused(acc, cur, wr, wc, fr, fq, lds, wid, lane); S.done(cur); }
#undef PG8_SA
#undef PG8_SB
#undef PG8_STAGE
#undef PG8_LDA
#undef PG8_LDB
#undef PG8_MMA
#undef PG8_WAIT_V
#undef PG8_WAIT_L
#undef PG8_BAR
#undef PG8_SCHED
}
}
#define XB_TMO      128
#define XB_XCNT(j)  (256  + 64 * (j))
#define XB_XSUB(j)  (1280 + 64 * (j))
#define XB_XGEN(j)  (2304 + 64 * (j))
#define XB_TOP      3328
#define XB_TOPGEN   3392
#define XCD_BAR_WORDS 3456
#define XB_SPIN_CAP (1u << 18)

__device__ __forceinline__ unsigned xb_ld(unsigned* p)              { return __hip_atomic_load(p, __ATOMIC_RELAXED, __HIP_MEMORY_SCOPE_AGENT); }
__device__ __forceinline__ unsigned xb_add(unsigned* p, unsigned v) { return __hip_atomic_fetch_add(p, v, __ATOMIC_RELAXED, __HIP_MEMORY_SCOPE_AGENT); }
__device__ __forceinline__ unsigned xb_xcc_id() { return (unsigned)__builtin_amdgcn_s_getreg((3 << 11) | 20) & 0xFu; }
#define XB_SPIN(cond, bar) do { unsigned _sp = 0; while (cond) { __builtin_amdgcn_s_sleep(1); \
    if ((++_sp & 255u) == 0u) { if (xb_ld(&(bar)[XB_TMO])) break; if (_sp > XB_SPIN_CAP) { atomicAdd(&(bar)[XB_TMO], 1u); break; } } } } while (0)

struct XcdBarrier {
    unsigned* bar; unsigned x;
    volatile LAS unsigned* st;
};

__device__ __forceinline__ XcdBarrier xcd_barrier_post(unsigned* bar, volatile LAS unsigned* st) {
    XcdBarrier b; b.bar = bar; b.x = xb_xcc_id(); b.st = st;
    if (threadIdx.x == 0) (void)xb_add(&bar[XB_XCNT(b.x)], 1u);
    return b;
}
__device__ __forceinline__ void xcd_barrier_complete(unsigned* bar, unsigned x, unsigned& nloc, unsigned& nx) {
    const unsigned G = gridDim.x * gridDim.y * gridDim.z;
    unsigned sum, cnt, mine, sp = 0u;
    for (;;) {
        sum = 0u; cnt = 0u; mine = 0u;
#pragma unroll
        for (unsigned j = 0; j < 16; ++j) { const unsigned c = xb_ld(&bar[XB_XCNT(j)]); sum += c; cnt += (c > 0u) ? 1u : 0u; mine = (j == x) ? c : mine; }
        if (sum == G) break;
        __builtin_amdgcn_s_sleep(1);
        if ((++sp & 255u) == 0u) { if (xb_ld(&bar[XB_TMO])) break; if (sp > XB_SPIN_CAP) { atomicAdd(&bar[XB_TMO], 1u); break; } }
    }
    nloc = mine > 0u ? mine : 1u; nx = cnt > 0u ? cnt : 1u;
}

__device__ __forceinline__ void xcd_barrier(const XcdBarrier& b) {
    asm volatile("s_waitcnt vmcnt(0)" ::: "memory");
    __syncthreads();
    if (threadIdx.x == 0) {
        unsigned* bar = b.bar;
        __builtin_amdgcn_s_waitcnt(0);
        unsigned nloc = b.st[0], nx = b.st[1];
        if (nloc == 0u) { xcd_barrier_complete(bar, b.x, nloc, nx); b.st[0] = nloc; b.st[1] = nx; }
        const unsigned old = xb_add(&bar[XB_XSUB(b.x)], 1u);
        const unsigned gen = old / nloc;
        if (old + 1u == (gen + 1u) * nloc) {
            __builtin_amdgcn_fence(__ATOMIC_RELEASE, "agent");
            asm volatile("s_waitcnt vmcnt(0)" ::: "memory");
            const unsigned og = xb_add(&bar[XB_TOP], 1u);
            const unsigned tg = og / nx;
            if (og + 1u == (tg + 1u) * nx) xb_add(&bar[XB_TOPGEN], 1u);
            else XB_SPIN(xb_ld(&bar[XB_TOPGEN]) == tg, bar);
            __builtin_amdgcn_fence(__ATOMIC_ACQUIRE, "agent");
            xb_add(&bar[XB_XGEN(b.x)], 1u);
            asm volatile("s_waitcnt vmcnt(0)" ::: "memory");
        } else {
            XB_SPIN(xb_ld(&bar[XB_XGEN(b.x)]) == gen, bar);
            __builtin_amdgcn_fence(__ATOMIC_ACQUIRE, "agent");
            asm volatile("s_waitcnt vmcnt(0)" ::: "memory");
        }
    }
    __syncthreads();
}

constexpr int NWAVES = 8, NTHR = 512;
constexpr int LDS_BYTES = 147456;
constexpr int MISC_OFF = 147456 - 256;
constexpr int CW_BAR = 4096;

struct Args {
    const float* in[32];
    float* out;
    unsigned char* ws;
    int ph_lo, ph_hi;
};

struct Ctx {
    LAS unsigned char* lds;
    unsigned char* ldsg;
    int tid, lane, wave, G, bid;
};


#ifndef PROF_ID
#define PROF_ID 0
#endif
#ifndef PROF_K
#define PROF_K 8
#endif
#define PROF_BEGIN(id) unsigned long long pt0_##id = 0; if (PROF_ID == (id)) pt0_##id = __builtin_amdgcn_s_memrealtime();
#define PROF_END(id) if (PROF_ID == (id) && threadIdx.x == 0) { const unsigned dt_ = (unsigned)(__builtin_amdgcn_s_memrealtime() - pt0_##id); ((volatile LAS unsigned*)(X.lds + MISC_OFF))[16] += dt_; }

__device__ __forceinline__ int opaque_v(int x) { asm volatile("" : "+v"(x)); return x; }
__device__ __forceinline__ int opaque_s(int x) { asm volatile("" : "+s"(x)); return x; }
__device__ __forceinline__ int map_even(int dg) {
    if (dg < 24) return dg;
    if (dg < 152) return dg + 2;
    if (dg < 216) return dg + 3;
    if (dg < 218) return dg - 192;
    if (dg == 218) return 154;
    return -1;
}
__device__ __forceinline__ void transpose_item(const float* W, int ldn, int K, bf16* WT, int k0, int n0, int ca, int cb, LAS float* scr, int lane, bool frag = false) {
    const int n = lane & 31; const int sc = (n < 16) ? ca : cb;
    float tv[32];
#pragma unroll
    for (int i = 0; i < 32; ++i) { const int kk = 2 * i + (lane >> 5); tv[i] = sc >= 0 ? W[(size_t)(k0 + kk) * ldn + sc + (n & 15)] : 0.f; }
    SB_PIN
#pragma unroll
    for (int i = 0; i < 32; ++i) { const int kk = 2 * i + (lane >> 5); scr[kk * 33 + n] = tv[i]; }
    LDS_WAIT(); asm volatile("" ::: "memory");
    const int c = lane & 7;
#pragma unroll
    for (int j = 0; j < 4; ++j) { const int nn = (lane >> 3) + 8 * j; const LAS float* s = scr + (8 * c) * 33 + nn;
        v4u o; o.x = pk2(s[0 * 33], s[1 * 33]); o.y = pk2(s[2 * 33], s[3 * 33]); o.z = pk2(s[4 * 33], s[5 * 33]); o.w = pk2(s[6 * 33], s[7 * 33]);
        bf16* dst = frag ? WT + ((size_t)((n0 + nn) >> 5) * (K >> 4) + ((k0 + 8 * c) >> 4)) * 512 + ((((k0 + 8 * c) >> 3) & 1) * 32 + ((n0 + nn) & 31)) * 8 : WT + (size_t)(n0 + nn) * K + k0 + 8 * c;
        *(v4u*)dst = o; }
    LDS_WAIT(); asm volatile("" ::: "memory");
}

__device__ __forceinline__ void phase_norm(const Args& a, const Ctx& X, int l) {
    const float* ysp = l == 0 ? a.in[0] : a.out; const float* yss = l == 0 ? a.in[1] : a.out + (size_t)NP * DM;
    const float* nw = a.in[11] + l * DM;
    const float* modl = (const float*)(a.ws + WS_MOD) + l * 3 * 3072;
    bf16* H = (bf16*)(a.ws + WS_H);
    const int lane = opaque_v(X.tid) & 63; const int gw = X.bid * NWAVES + opaque_s(X.wave), NGW = X.G * NWAVES;
    f32x4 v[3][4];
#pragma unroll
    for (int q = 0; q < 3; ++q) { const int r = gw + q * NGW; const float* y = r < NP ? ysp + (size_t)r * DM : yss + (size_t)(r - NP) * DM;
#pragma unroll
        for (int j = 0; j < 4; ++j) v[q][j] = r < NT ? *(const f32x4*)(y + 4 * lane + 256 * j) : (f32x4){0.f, 0.f, 0.f, 0.f}; }
    SB_PIN
#pragma unroll
    for (int q = 0; q < 3; ++q) { const int r = gw + q * NGW; if (r < NT) {
        const float* md = modl + cond_of_row(r) * 3072;
        float ss = 0.f;
#pragma unroll
        for (int j = 0; j < 4; ++j) ss += (v[q][j].x * v[q][j].x + v[q][j].y * v[q][j].y) + (v[q][j].z * v[q][j].z + v[q][j].w * v[q][j].w);
        const float rstd = rsqrtf(wave_sum(ss) * (1.f / DM) + EPS);
#pragma unroll
        for (int j = 0; j < 4; ++j) { const int k = 4 * lane + 256 * j;
            const f32x4 g = *(const f32x4*)(nw + k), sh = *(const f32x4*)(md + k), sc = *(const f32x4*)(md + 1024 + k);
            const f32x4 o = v[q][j] * rstd * g * (sc + 1.f) + sh;
            st4bf(H + (size_t)r * DM + k, o.x, o.y, o.z, o.w); }
    } }
}

__device__ __forceinline__ void mod_unit(const Args& a, const Ctx& X, int l, int chunk, int tid, int lane, int wave) {
    LAS float* scs = (LAS float*)X.lds;
    LAS float* part = scs + 3072;
    const float* c_ctx = a.in[10]; const float* c = a.in[2];
    for (int i = tid; i < 3072; i += NTHR) { const int r = i >> 10, k = i & 1023; const float v = r == 0 ? c_ctx[k] : c[(r - 1) * 1024 + k]; scs[i] = v / (1.f + expf(-v)); }
    __syncthreads();
    const int j0 = chunk * 64;
    const float* w = a.in[12] + (size_t)l * 1024 * 3072 + j0 + lane;
    float a0 = 0.f, a1 = 0.f, a2 = 0.f;
#pragma unroll 32
    for (int kk = 0; kk < 128; ++kk) { const int k = wave * 128 + kk; const float wv = w[(size_t)k * 3072]; a0 += scs[k] * wv; a1 += scs[1024 + k] * wv; a2 += scs[2048 + k] * wv; }
    part[(wave * 3 + 0) * 64 + lane] = a0; part[(wave * 3 + 1) * 64 + lane] = a1; part[(wave * 3 + 2) * 64 + lane] = a2;
    __syncthreads();
    if (tid < 192) { const int r = tid >> 6, cc = tid & 63; float s = 0.f;
#pragma unroll
        for (int w8 = 0; w8 < 8; ++w8) s += part[(w8 * 3 + r) * 64 + cc];
        __hip_atomic_store((unsigned*)(a.ws + WS_MOD) + (l * 3 + r) * 3072 + j0 + cc, __builtin_bit_cast(unsigned, s + a.in[13][l * 3072 + j0 + cc]), __ATOMIC_RELAXED, __HIP_MEMORY_SCOPE_AGENT); }
    asm volatile("s_waitcnt vmcnt(0)" ::: "memory");
    __syncthreads();
    if (l == 0 && tid == 0) __hip_atomic_fetch_add((unsigned*)(a.ws + WS_CTL + CTL_MODCNT), 1u, __ATOMIC_RELAXED, __HIP_MEMORY_SCOPE_AGENT);
}
__device__ __forceinline__ void prep_weights(const Args& a, const Ctx& X, int l, int gw, int NGW, int lane, int wave) {
    unsigned char* ws = a.ws;
    LAS float* scr = (LAS float*)(X.lds + 32768 + wave * 8448);
    const int j = l >> 1;
    if ((l & 1) == 0) {
        for (int it = gw; it < 2464; it += NGW) {
            if (it < 1792) { const int nb = it % 112, kb = it / 112;
                transpose_item(a.in[14] + (size_t)j * 1024 * 3504, 3504, 1024, (bf16*)(ws + WS_WTEV) + (size_t)j * 3584 * 1024, kb * 64, nb * 32,
                               map_even(2 * nb) < 0 ? -1 : map_even(2 * nb) * 16, map_even(2 * nb + 1) < 0 ? -1 : map_even(2 * nb + 1) * 16, scr, lane);
            } else if (it < 2304) { const int r = it - 1792, nb = r % 32, kb = r / 32;
                transpose_item(a.in[24] + (size_t)j * 1024 * 1024, 1024, 1024, (bf16*)(ws + WS_WTOUT) + (size_t)l * 1024 * 1024, kb * 64, nb * 32, nb * 32, nb * 32 + 16, scr, lane);
            } else if (it < 2400) { const int r = it - 2304, nb = r % 24, kb = r / 24;
                transpose_item(a.in[17] + (size_t)j * 256 * 768, 768, 256, (bf16*)(ws + WS_WTQB) + (size_t)j * 768 * 256, kb * 64, nb * 32, nb * 32, nb * 32 + 16, scr, lane, true);
            } else { const int r = it - 2400, nb = r % 32, kb = r / 32;
                transpose_item(a.in[18] + (size_t)j * 128 * 1024, 1024, 128, (bf16*)(ws + WS_WTKVB) + (size_t)j * 1024 * 128, kb * 64, nb * 32, nb * 32, nb * 32 + 16, scr, lane, true);
            }
        }
    } else {
        for (int it = gw; it < 2560; it += NGW) {
            if (it < 2048) { const int nb = it % 128, kb = it / 128;
                transpose_item(a.in[25] + (size_t)j * 1024 * 4096, 4096, 1024, (bf16*)(ws + WS_WTOD) + (size_t)j * 4096 * 1024, kb * 64, nb * 32, nb * 32, nb * 32 + 16, scr, lane);
            } else { const int r = it - 2048, nb = r % 32, kb = r / 32;
                transpose_item(a.in[31] + (size_t)j * 1024 * 1024, 1024, 1024, (bf16*)(ws + WS_WTOUT) + (size_t)l * 1024 * 1024, kb * 64, nb * 32, nb * 32, nb * 32 + 16, scr, lane);
            }
        }
    }
}
__device__ __forceinline__ void phase_p0a(const Args& a, const Ctx& X) {
    unsigned char* ws = a.ws;
    const int tid = opaque_v(X.tid), lane = tid & 63, wave = opaque_s(X.wave);
    if (X.bid < 192) mod_unit(a, X, X.bid / 48, X.bid % 48, tid, lane, wave);
    else if (X.bid == 192) {
        const int pos = tid >> 3, f = tid & 7;
        const float ang = (float)pos * powf(10000.f, -(float)f / 8.f);
        float* rt = (float*)(ws + WS_ROPE);
        rt[pos * 16 + f] = cosf(ang); rt[pos * 16 + 8 + f] = sinf(ang);
    } else {
        const int nb = X.G - 193, b0 = X.bid - 193;
        const float* ck = a.in[8]; const float* cv = a.in[9]; const float* c0 = a.in[5];
        bf16* nakc = (bf16*)(ws + WS_NAKC); bf16* navc = (bf16*)(ws + WS_NAVC); float* c0t = (float*)(ws + WS_C0T);
#pragma unroll 4
        for (int idx = b0 * NTHR + tid; idx < 524288; idx += nb * NTHR) {
            const int d = idx & 63, h = (idx >> 6) & 7, key = (idx >> 9) & 255, bj = idx >> 17;
            { const size_t blk = ((size_t)(bj * 8 + h) * 8 + (key >> 5)) * 4; const int kr = key & 31, t16 = key & 15;
              nakc[(blk + (d >> 4)) * 512 + (((d >> 3) & 1) * 32 + kr) * 8 + (d & 7)] = (bf16)(pk2(ck[idx] / a.in[29][(bj & 1) * 64 + d], 0.f) & 0xffffu);
              navc[(blk + (d >> 5) * 2 + (kr >> 4)) * 512 + (((t16 >> 2) & 1) * 32 + (d & 31)) * 8 + 4 * (t16 >> 3) + (t16 & 3)] = (bf16)(pk2(cv[idx], 0.f) & 0xffffu); }
            const int e = idx & 127, dd = (idx >> 7) & 127, mat = idx >> 14;
            c0t[(size_t)mat * 16384 + e * 128 + dd] = c0[idx];
        }
    }
    for (int l = 0; l < 4; ++l) prep_weights(a, X, l, X.bid * NWAVES + wave, X.G * NWAVES, lane, wave);
    if (tid == 0) { unsigned sp = 0; while (__hip_atomic_load((unsigned*)(ws + WS_CTL + CTL_MODCNT), __ATOMIC_RELAXED, __HIP_MEMORY_SCOPE_AGENT) < 48u && ++sp < (1u << 20)) __builtin_amdgcn_s_sleep(2);
        __builtin_amdgcn_fence(__ATOMIC_ACQUIRE, "agent"); asm volatile("s_waitcnt vmcnt(0)" ::: "memory"); }
    __syncthreads();
    phase_norm(a, X, 0);
}
__device__ __forceinline__ void gemm2_side(const Args& a, const Ctx& X, int l) {
    const int tid = opaque_v(X.tid), lane = tid & 63, wave = opaque_s(X.wave), idx = X.bid - 96;
    if (idx < 48) mod_unit(a, X, l + 1, idx, tid, lane, wave);
    prep_weights(a, X, l + 1, idx * NWAVES + wave, (X.G - 96) * NWAVES, lane, wave);
}

__device__ __forceinline__ void unit_mla_q(const Args& a, const Ctx& X, int j, int t) {
    const bf16* U = (const bf16*)(a.ws + WS_U); bf16* Q = (bf16*)(a.ws + WS_Q);
    const bf16* Wq = (const bf16*)(a.ws + WS_WTQB) + (size_t)j * 768 * 256;
    const float* rope = (const float*)(a.ws + WS_ROPE);
    const float* qan = a.in[15] + j * 256; const float* qn = a.in[19] + j * 96;
    bf16* Xn = (bf16*)X.ldsg;
    const int tid = opaque_v(X.tid), lane = tid & 63, w = opaque_s(X.wave), r = lane & 31, hh = lane >> 5, R0 = t * 64; (void)tid;
    PROF_BEGIN(20)
    { v2u raw8[8]; const f32x4 g = *(const f32x4*)(qan + 4 * lane);
#pragma unroll
      for (int i = 0; i < 8; ++i) raw8[i] = *(const v2u*)(U + (size_t)(R0 + 8 * w + i) * UE + CE_QA + 4 * lane);
      SB_PIN
#pragma unroll
      for (int i = 0; i < 8; ++i) { const int row = 8 * w + i; const v2u raw = raw8[i];
        const float x0 = bflo(raw.x), x1 = bfhi(raw.x), x2 = bflo(raw.y), x3 = bfhi(raw.y);
        const float rstd = rsqrtf(wave_sum(x0 * x0 + x1 * x1 + x2 * x2 + x3 * x3) * (1.f / 256.f) + EPS);
        st4bf(Xn + row * 264 + 4 * lane, x0 * rstd * g.x, x1 * rstd * g.y, x2 * rstd * g.z, x3 * rstd * g.w); } }
    __syncthreads();
    PROF_END(20)
    PROF_BEGIN(21)
    f32x16 acc[3][2];
#pragma unroll
    for (int fb = 0; fb < 3; ++fb)
#pragma unroll
        for (int tb = 0; tb < 2; ++tb)
#pragma unroll
            for (int i = 0; i < 16; ++i) acc[fb][tb][i] = 0.f;
    const bf16* wp = Wq + (size_t)(w * 3) * 16 * 512 + lane * 8;
    const bf16* xp = Xn + r * 264 + 8 * hh;
#pragma unroll
    for (int kh = 0; kh < 4; ++kh) {
        bh8 af[4][3];
#pragma unroll
        for (int k8 = 0; k8 < 4; ++k8)
#pragma unroll
            for (int fb = 0; fb < 3; ++fb) af[k8][fb] = ld16(wp + (size_t)(fb * 16 + kh * 4 + k8) * 512);
        SB_PIN
#pragma unroll
        for (int k8 = 0; k8 < 4; ++k8) { const int ks = kh * 4 + k8; bh8 bfr[2];
#pragma unroll
            for (int tb = 0; tb < 2; ++tb) bfr[tb] = ld16(xp + tb * 32 * 264 + 16 * ks);
#pragma unroll
            for (int fb = 0; fb < 3; ++fb)
#pragma unroll
                for (int tb = 0; tb < 2; ++tb) acc[fb][tb] = mfma32(af[k8][fb], bfr[tb], acc[fb][tb]); }
        SB_PIN
    }
    PROF_END(21)
    PROF_BEGIN(22)
#pragma unroll
    for (int tb = 0; tb < 2; ++tb) {
        float ss = 0.f;
#pragma unroll
        for (int fb = 0; fb < 3; ++fb)
#pragma unroll
            for (int i = 0; i < 16; ++i) ss += acc[fb][tb][i] * acc[fb][tb][i];
        ss += __shfl_xor(ss, 32);
        const float rstd = rsqrtf(ss * (1.f / 96.f) + EPS) * (0.10206207261596577f * 1.4426950408889634f);
        const int row = R0 + 32 * tb + r;
        const bool sample = row >= NP; const int tp = (row - NP) & 1023;
#pragma unroll
        for (int fb = 0; fb < 3; ++fb) {
            float v[16];
#pragma unroll
            for (int g = 0; g < 4; ++g) { const f32x4 gn = *(const f32x4*)(qn + 32 * fb + 8 * g + 4 * hh);
                v[4 * g + 0] = acc[fb][tb][4 * g + 0] * rstd * gn.x; v[4 * g + 1] = acc[fb][tb][4 * g + 1] * rstd * gn.y;
                v[4 * g + 2] = acc[fb][tb][4 * g + 2] * rstd * gn.z; v[4 * g + 3] = acc[fb][tb][4 * g + 3] * rstd * gn.w; }
            if (fb == 2 && sample) {
                const float* rr_ = rope + (tp >> 6) * 16 + 4 * hh; const float* rc_ = rope + (tp & 63) * 16 + 4 * hh;
#pragma unroll
                for (int e = 0; e < 4; ++e) {
                    float cs = rr_[e], sn = rr_[8 + e], x1 = v[e], x2 = v[4 + e];
                    v[e] = x1 * cs - x2 * sn; v[4 + e] = x1 * sn + x2 * cs;
                    cs = rc_[e]; sn = rc_[8 + e]; x1 = v[8 + e]; x2 = v[12 + e];
                    v[8 + e] = x1 * cs - x2 * sn; v[12 + e] = x1 * sn + x2 * cs;
                }
            }
#pragma unroll
            for (int g = 0; g < 4; ++g) st4bf(Q + (size_t)row * 768 + w * 96 + 32 * fb + 8 * g + 4 * hh, v[4 * g], v[4 * g + 1], v[4 * g + 2], v[4 * g + 3]);
        }
    }
    __syncthreads();    PROF_END(22)
}

__device__ __forceinline__ void unit_mla_kv(const Args& a, const Ctx& X, int j, int t) {
    const bf16* U = (const bf16*)(a.ws + WS_U); bf16* KM = (bf16*)(a.ws + WS_KM); bf16* VTM = (bf16*)(a.ws + WS_VTM);
    const bf16* Wkv = (const bf16*)(a.ws + WS_WTKVB) + (size_t)j * 1024 * 128;
    const float* rope = (const float*)(a.ws + WS_ROPE);
    const float* kvan = a.in[16] + j * 128; const float* kn = a.in[20] + j * 96;
    bf16* Xc = (bf16*)X.ldsg;
    float* kpes = (float*)(X.ldsg + 17408);
    const int tid = opaque_v(X.tid), lane = tid & 63, w = opaque_s(X.wave), r = lane & 31, hh = lane >> 5; (void)tid;
    const bool own = t >= 0;
    int R0 = 0, krow0, bs = 0;
    if (own) { R0 = t * 64; if (R0 < NP) krow0 = R0; else { bs = (R0 - NP) >> 10; krow0 = NP + bs * 1280 + 256 + ((R0 - NP) & 1023); } }
    else { const int ct = -1 - t; bs = ct >> 2; krow0 = NP + bs * 1280 + (ct & 3) * 64; }
    { unsigned raw8[8]; float kp8[8]; f32x2 c8[8];
      if (own) {
#pragma unroll
          for (int i = 0; i < 8; ++i) { raw8[i] = *(const unsigned*)(U + (size_t)(R0 + 8 * w + i) * UE + CE_KVA + 2 * lane);
              kp8[i] = lane < 32 ? bf2f(U[(size_t)(R0 + 8 * w + i) * UE + CE_KPE + lane]) : 0.f; }
      } else {
#pragma unroll
          for (int i = 0; i < 8; ++i) { const int s = ((-1 - t) & 3) * 64 + 8 * w + i; const size_t o = (size_t)(bs * 2 + j) * 256 + s;
              c8[i] = *(const f32x2*)(a.in[3] + o * 128 + 2 * lane); kp8[i] = lane < 32 ? a.in[4][o * 32 + lane] : 0.f; }
      }
      const f32x2 g = *(const f32x2*)(kvan + 2 * lane);
      SB_PIN
#pragma unroll
      for (int i = 0; i < 8; ++i) { const int row = 8 * w + i;
        if (own) {
            const float x0 = bflo(raw8[i]), x1 = bfhi(raw8[i]);
            const float rstd = rsqrtf(wave_sum(x0 * x0 + x1 * x1) * (1.f / 128.f) + EPS);
            const float c0 = x0 * rstd * g.x, c1 = x1 * rstd * g.y;
            *(unsigned*)(Xc + row * 136 + 2 * lane) = pk2(c0, c1);
            if (lane < 32) kpes[row * 32 + lane] = kp8[i];
            if (R0 < NP) { const int b = (R0 + row) >> 8, s = (R0 + row) & 255; const size_t o = (size_t)(b * 2 + j) * 256 + s;
                *(f32x2*)(a.out + O_CKV + o * 128 + 2 * lane) = (f32x2){c0, c1};
                if (lane < 32) a.out[O_KPE + o * 32 + lane] = kp8[i]; }
        } else {
            *(unsigned*)(Xc + row * 136 + 2 * lane) = pk2(c8[i].x, c8[i].y);
            if (lane < 32) kpes[row * 32 + lane] = kp8[i];
        } } }
    __syncthreads();
    f32x16 ak[2][2], av[2][2];
#pragma unroll
    for (int x = 0; x < 2; ++x)
#pragma unroll
        for (int y = 0; y < 2; ++y)
#pragma unroll
            for (int i = 0; i < 16; ++i) { ak[x][y][i] = 0.f; av[x][y][i] = 0.f; }
    const bf16* wp = Wkv + (size_t)(w * 4) * 8 * 512 + lane * 8;
    const bf16* xp = Xc + r * 136 + 8 * hh;
#pragma unroll
    for (int kh = 0; kh < 2; ++kh) { bh8 wk[4][2], wv[4][2];
#pragma unroll
      for (int k4 = 0; k4 < 4; ++k4)
#pragma unroll
          for (int fb = 0; fb < 2; ++fb) { wk[k4][fb] = ld16(wp + (size_t)(fb * 8 + kh * 4 + k4) * 512); wv[k4][fb] = ld16(wp + (size_t)((2 + fb) * 8 + kh * 4 + k4) * 512); }
      SB_PIN
#pragma unroll
      for (int k4 = 0; k4 < 4; ++k4) { const int ks = kh * 4 + k4; bh8 xf[2];
#pragma unroll
          for (int tb = 0; tb < 2; ++tb) xf[tb] = ld16(xp + tb * 32 * 136 + 16 * ks);
#pragma unroll
          for (int fb = 0; fb < 2; ++fb)
#pragma unroll
              for (int tb = 0; tb < 2; ++tb) { ak[fb][tb] = mfma32(wk[k4][fb], xf[tb], ak[fb][tb]); av[tb][fb] = mfma32(xf[tb], wv[k4][fb], av[tb][fb]); } }
      SB_PIN }
    const bool sample_own = own && R0 >= NP;
#pragma unroll
    for (int tb = 0; tb < 2; ++tb) {
        const int tok = 32 * tb + r;
        float kp[16]; float ss = 0.f;
#pragma unroll
        for (int g = 0; g < 4; ++g) { const f32x4 q4 = *(const f32x4*)(kpes + tok * 32 + 16 * hh + 4 * g); kp[4 * g] = q4.x; kp[4 * g + 1] = q4.y; kp[4 * g + 2] = q4.z; kp[4 * g + 3] = q4.w; }
#pragma unroll
        for (int i = 0; i < 16; ++i) ss += kp[i] * kp[i] + ak[0][tb][i] * ak[0][tb][i] + ak[1][tb][i] * ak[1][tb][i];
        ss += __shfl_xor(ss, 32);
        const float rstd = rsqrtf(ss * (1.f / 96.f) + EPS);
        bf16* kdst = KM + ((size_t)(((krow0 >> 5) + tb) * 8 + w) * 6) * 512 + r * 8;
#pragma unroll
        for (int fb = 0; fb < 2; ++fb)
#pragma unroll
            for (int g = 0; g < 4; ++g) { const int f0 = 32 * fb + 8 * g + 4 * hh; const f32x4 gn = *(const f32x4*)(kn + f0);
                st4bf(kdst + (2 * fb + (g >> 1)) * 512 + (g & 1) * 256 + 4 * hh, ak[fb][tb][4 * g] * rstd * gn.x, ak[fb][tb][4 * g + 1] * rstd * gn.y, ak[fb][tb][4 * g + 2] * rstd * gn.z, ak[fb][tb][4 * g + 3] * rstd * gn.w); }
#pragma unroll
        for (int g = 0; g < 4; ++g) { const f32x4 gn = *(const f32x4*)(kn + 64 + 16 * hh + 4 * g);
            kp[4 * g] *= rstd * gn.x; kp[4 * g + 1] *= rstd * gn.y; kp[4 * g + 2] *= rstd * gn.z; kp[4 * g + 3] *= rstd * gn.w; }
        if (sample_own) {
            const int tp = (R0 - NP + tok) & 1023; const int pos = hh == 0 ? (tp >> 6) : (tp & 63);
            const float* rp = rope + pos * 16;
#pragma unroll
            for (int i = 0; i < 8; ++i) { const float cs = rp[i], sn = rp[8 + i], x1 = kp[i], x2 = kp[8 + i]; kp[i] = x1 * cs - x2 * sn; kp[8 + i] = x1 * sn + x2 * cs; }
        }
#pragma unroll
        for (int g = 0; g < 4; ++g) st4bf(kdst + (4 + hh) * 512 + (g >> 1) * 256 + 4 * (g & 1), kp[4 * g], kp[4 * g + 1], kp[4 * g + 2], kp[4 * g + 3]);
#pragma unroll
        for (int fb = 0; fb < 2; ++fb) { bf16* vdst = VTM + ((size_t)(((krow0 >> 5) + tb) * 8 + w) * 4 + 2 * fb) * 512 + (hh * 32 + r) * 8;
#pragma unroll
            for (int g = 0; g < 4; ++g) st4bf(vdst + (g >> 1) * 512 + 4 * (g & 1), av[tb][fb][4 * g], av[tb][fb][4 * g + 1], av[tb][fb][4 * g + 2], av[tb][fb][4 * g + 3]); }
    }
    __syncthreads();
}

struct AttnState { f32x16 o0, o1; float m, l; };
__device__ __forceinline__ void attn_init(AttnState& st) {
#pragma unroll
    for (int i = 0; i < 16; ++i) { st.o0[i] = 0.f; st.o1[i] = 0.f; }
    st.m = -1e30f; st.l = 0.f;
}
template <int NKS> struct KVf { bh8 k[NKS]; bh8 v[4]; };
template <int NKS> __device__ __forceinline__ void load_kv(KVf<NKS>& f, const bf16* kp, const bf16* vp) {
#pragma unroll
    for (int ks = 0; ks < NKS; ++ks) f.k[ks] = ld16(kp + ks * 512);
#pragma unroll
    for (int q = 0; q < 4; ++q) f.v[q] = ld16(vp + q * 512);
}
template <int NKS, bool MASKED>
__device__ __forceinline__ void attn_compute(AttnState& st, const bh8* qf, const KVf<NKS>& f, const float* rk, int hh, bool na, int kc0, int dr, int cq, int c0, const float* rpbs) {
    f32x16 s;
#pragma unroll
    for (int i = 0; i < 16; ++i) s[i] = 0.f;
#pragma unroll
    for (int ks = 0; ks < NKS; ++ks) s = mfma32(f.k[ks], qf[ks], s);
    if (rk) {
#pragma unroll
        for (int g = 0; g < 4; ++g) { const f32x4 rv = *(const f32x4*)(rk + 8 * g + 4 * hh); s[4 * g] *= rv.x; s[4 * g + 1] *= rv.y; s[4 * g + 2] *= rv.z; s[4 * g + 3] *= rv.w; }
    }
    if (MASKED && na) {
#pragma unroll
        for (int i = 0; i < 16; ++i) { const int kc = kc0 + crow(i, hh); const bool ok = kc >= c0 && kc < c0 + 16;
            int dc = kc - cq; dc = dc < -15 ? -15 : (dc > 15 ? 15 : dc);
            s[i] = ok ? s[i] + rpbs[dr * 31 + dc + 15] : -1e30f; }
    }
    float mx = fmaxf(fmaxf(s[0], s[1]), s[2]);
#pragma unroll
    for (int i = 3; i < 15; i += 2) mx = fmaxf(fmaxf(mx, s[i]), s[i + 1]);
    mx = fmaxf(mx, s[15]);
    mx = fmaxf(mx, __shfl_xor(mx, 32));
    const float mn = fmaxf(st.m, mx);
    if (__builtin_amdgcn_ballot_w64(mn > st.m) != 0ull) {
        const float alpha = __builtin_amdgcn_exp2f(st.m - mn);
        st.l *= alpha;
#pragma unroll
        for (int i = 0; i < 16; ++i) { st.o0[i] *= alpha; st.o1[i] *= alpha; }
        st.m = mn;
    }
    float ps = 0.f;
#pragma unroll
    for (int i = 0; i < 16; ++i) { float p = __builtin_amdgcn_exp2f(s[i] - mn); if (MASKED) p = s[i] > -1e29f ? p : 0.f; s[i] = p; ps += p; }
    st.l += ps;
    const bh8 p0 = pfrag(s, 0), p1 = pfrag(s, 1);
    st.o0 = mfma32(f.v[0], p0, st.o0); st.o0 = mfma32(f.v[1], p1, st.o0);
    st.o1 = mfma32(f.v[2], p0, st.o1); st.o1 = mfma32(f.v[3], p1, st.o1);
}
template <int KS>
__device__ __forceinline__ void attn_merge_store(AttnState& st, float* part, int w, int lane, const v4u* gpre, bf16* zp) {
    const int r = lane & 31, hh = lane >> 5;
    float* mine = part + w * 2048; float* ml = part + 8 * 2048;
#pragma unroll
    for (int i = 0; i < 16; ++i) { mine[crow(i, hh) * 32 + r] = st.o0[i]; mine[(32 + crow(i, hh)) * 32 + r] = st.o1[i]; }
    const float lt = st.l + __shfl_xor(st.l, 32);
    if (hh == 0) { ml[(w * 2) * 32 + r] = st.m; ml[(w * 2 + 1) * 32 + r] = lt; }
    __syncthreads();
    const int qb = w / KS, kp = w % KS;
    float f[KS]; float ms = -1e30f, L = 0.f;
#pragma unroll
    for (int k = 0; k < KS; ++k) ms = fmaxf(ms, ml[((qb * KS + k) * 2) * 32 + r]);
#pragma unroll
    for (int k = 0; k < KS; ++k) { f[k] = __builtin_amdgcn_exp2f(ml[((qb * KS + k) * 2) * 32 + r] - ms); L += f[k] * ml[((qb * KS + k) * 2 + 1) * 32 + r]; }
    const float inv = 1.f / L;
    constexpr int ND = 32 / KS;
    const int dv0 = (64 / KS) * kp + ND * hh;
#pragma unroll
    for (int c = 0; c < ND / 8; ++c) {
        float o[8];
#pragma unroll
        for (int e = 0; e < 8; ++e) { float v = 0.f;
#pragma unroll
            for (int k = 0; k < KS; ++k) v += f[k] * part[(qb * KS + k) * 2048 + (dv0 + 8 * c + e) * 32 + r];
            o[e] = v * inv; }
        const v4u gr = gpre[c];
        v4u z; z.x = pk2(o[0] * silu_f(bflo(gr.x)), o[1] * silu_f(bfhi(gr.x))); z.y = pk2(o[2] * silu_f(bflo(gr.y)), o[3] * silu_f(bfhi(gr.y)));
        z.z = pk2(o[4] * silu_f(bflo(gr.z)), o[5] * silu_f(bfhi(gr.z))); z.w = pk2(o[6] * silu_f(bflo(gr.w)), o[7] * silu_f(bfhi(gr.w)));
        *(v4u*)(zp + dv0 + 8 * c) = z;
    }
    __syncthreads();
}

template <int KS> __device__ __forceinline__ void attn_gate_prefetch(v4u* gpre, const bf16* gp, int w, int lane) {
    constexpr int ND = 32 / KS; const int dv0 = (64 / KS) * (w % KS) + ND * (lane >> 5);
#pragma unroll
    for (int c = 0; c < ND / 8; ++c) gpre[c] = *(const v4u*)(gp + dv0 + 8 * c);
}

__device__ __forceinline__ void unit_mla_attn(const Args& a, const Ctx& X, int u) {
    const bf16* U = (const bf16*)(a.ws + WS_U); const bf16* Q = (const bf16*)(a.ws + WS_Q); const bf16* KM = (const bf16*)(a.ws + WS_KM); const bf16* VTM = (const bf16*)(a.ws + WS_VTM);
    bf16* Z = (bf16*)(a.ws + WS_Z);
    const int tid = opaque_v(X.tid), lane = tid & 63, w = opaque_s(X.wave), r = lane & 31, hh = lane >> 5;
    int h, q0, kb0, nkb; const bool samp = u < 256;
    if (samp) { const int bs = u >> 7, qg = u & 15; h = (u >> 4) & 7; q0 = NP + bs * 1024 + 64 * qg + 32 * (w >> 2); kb0 = NP + bs * 1280 + 320 * (w & 3); nkb = 10; }
    else { const int v = u - 256, b = v >> 4, qh = v & 1; h = (v >> 1) & 7; q0 = b * 256 + 128 * qh + 32 * (w >> 1); kb0 = b * 256 + 128 * (w & 1); nkb = 4; }
    PROF_BEGIN(30)
    bh8 qf[6];
#pragma unroll
    for (int ks = 0; ks < 6; ++ks) qf[ks] = ld16(Q + (size_t)(q0 + r) * 768 + h * 96 + 16 * ks + 8 * hh);
    AttnState st; attn_init(st);
    v4u gpre[2];
    { const bf16* gp = U + (size_t)(q0 + r) * UE + CE_GA + h * 64; if (samp) attn_gate_prefetch<4>(gpre, gp, w, lane); else attn_gate_prefetch<2>(gpre, gp, w, lane); }
    const bf16* kp = KM + ((size_t)((kb0 >> 5) * 8 + h) * 6) * 512 + lane * 8;
    const bf16* vp = VTM + ((size_t)((kb0 >> 5) * 8 + h) * 4) * 512 + lane * 8;
    KVf<6> fa, fb;
    load_kv<6>(fa, kp, vp);
    PROF_END(30)
    PROF_BEGIN(31)
    for (int kb = 0; kb < nkb; kb += 2) {
        load_kv<6>(fb, kp + (size_t)(kb + 1) * 8 * 6 * 512, vp + (size_t)(kb + 1) * 8 * 4 * 512);
        SB_PIN
        attn_compute<6, false>(st, qf, fa, nullptr, hh, false, 0, 0, 0, 0, nullptr);
        if (kb + 2 < nkb) load_kv<6>(fa, kp + (size_t)(kb + 2) * 8 * 6 * 512, vp + (size_t)(kb + 2) * 8 * 4 * 512);
        SB_PIN
        attn_compute<6, false>(st, qf, fb, nullptr, hh, false, 0, 0, 0, 0, nullptr);
    }
    PROF_END(31)
    PROF_BEGIN(32)
    const int row = q0 + r;
    if (samp) attn_merge_store<4>(st, (float*)X.ldsg, w, lane, gpre, Z + (size_t)row * DM + h * 64);
    else attn_merge_store<2>(st, (float*)X.ldsg, w, lane, gpre, Z + (size_t)row * DM + h * 64);
    PROF_END(32)
}

__device__ __forceinline__ void load_q64(const bf16* qrow  , const float* qnorm, const float* knorm, int hh, bh8* qa) {
    float x[4][8]; float ss = 0.f;
#pragma unroll
    for (int ks = 0; ks < 4; ++ks) { const v4u raw = *(const v4u*)(qrow + 16 * ks + 8 * hh);
        x[ks][0] = bflo(raw.x); x[ks][1] = bfhi(raw.x); x[ks][2] = bflo(raw.y); x[ks][3] = bfhi(raw.y); x[ks][4] = bflo(raw.z); x[ks][5] = bfhi(raw.z); x[ks][6] = bflo(raw.w); x[ks][7] = bfhi(raw.w);
#pragma unroll
        for (int e = 0; e < 8; ++e) ss += x[ks][e] * x[ks][e]; }
    ss += __shfl_xor(ss, 32);
    const float rstd = rsqrtf(ss * (1.f / 64.f) + EPS) * (0.125f * 1.4426950408889634f);
#pragma unroll
    for (int ks = 0; ks < 4; ++ks) { float ya[8];
#pragma unroll
        for (int e = 0; e < 8; ++e) { const int d = 16 * ks + 8 * hh + e; ya[e] = x[ks][e] * rstd * qnorm[d] * knorm[d]; }
        v4u va; va.x = pk2(ya[0], ya[1]); va.y = pk2(ya[2], ya[3]); va.z = pk2(ya[4], ya[5]); va.w = pk2(ya[6], ya[7]);
        qa[ks] = __builtin_bit_cast(bh8, va); }
}

__device__ __forceinline__ void unit_odd_attn(const Args& a, const Ctx& X, int j, int u) {
    const bf16* U = (const bf16*)(a.ws + WS_U); const bf16* VTO = (const bf16*)(a.ws + WS_VTO); bf16* Z = (bf16*)(a.ws + WS_Z);
    const float* qnorm = a.in[28] + j * 64; const float* knorm = a.in[29] + j * 64;
    float* part = (float*)X.ldsg; float* rk = part + 8 * 2048 + 512;
    const int b = u >> 4, h = (u >> 1) & 7, qh = u & 1, tid = opaque_v(X.tid), lane = tid & 63, w = opaque_s(X.wave), r = lane & 31, hh = lane >> 5, R0 = b * 256;
    PROF_BEGIN(26)
    { const int key = tid >> 1, half = tid & 1;
      const bf16* kp = U + (size_t)(R0 + key) * UO + CO_KD + h * 64 + 32 * half;
      float kx[32]; float ss = 0.f;
#pragma unroll
      for (int q = 0; q < 4; ++q) { const v4u kr = *(const v4u*)(kp + 8 * q);
          kx[8 * q] = bflo(kr.x); kx[8 * q + 1] = bfhi(kr.x); kx[8 * q + 2] = bflo(kr.y); kx[8 * q + 3] = bfhi(kr.y); kx[8 * q + 4] = bflo(kr.z); kx[8 * q + 5] = bfhi(kr.z); kx[8 * q + 6] = bflo(kr.w); kx[8 * q + 7] = bfhi(kr.w); }
#pragma unroll
      for (int e = 0; e < 32; ++e) ss += kx[e] * kx[e];
      ss += __shfl_xor(ss, 1);
      const float rstd = rsqrtf(ss * (1.f / 64.f) + EPS);
      if (half == 0) rk[key] = rstd;
      if (qh == 0) {
          const bf16* vp = U + (size_t)(R0 + key) * UO + CO_VD + h * 64 + 32 * half;
          float* ok = a.out + O_NK + ((size_t)(b * 2 + j) * 256 + key) * 512 + h * 64 + 32 * half; float* ov = a.out + O_NV + ((size_t)(b * 2 + j) * 256 + key) * 512 + h * 64 + 32 * half;
#pragma unroll
          for (int q = 0; q < 8; ++q) { const f32x4 g = *(const f32x4*)(knorm + 32 * half + 4 * q);
              *(f32x4*)(ok + 4 * q) = (f32x4){kx[4 * q] * rstd * g.x, kx[4 * q + 1] * rstd * g.y, kx[4 * q + 2] * rstd * g.z, kx[4 * q + 3] * rstd * g.w}; }
#pragma unroll
          for (int q = 0; q < 4; ++q) { const v4u vr = *(const v4u*)(vp + 8 * q);
              *(f32x4*)(ov + 8 * q) = (f32x4){bflo(vr.x), bfhi(vr.x), bflo(vr.y), bfhi(vr.y)}; *(f32x4*)(ov + 8 * q + 4) = (f32x4){bflo(vr.z), bfhi(vr.z), bflo(vr.w), bfhi(vr.w)}; }
      } }
    __syncthreads();
    PROF_END(26)
    PROF_BEGIN(27)
    const int row = R0 + 128 * qh + 32 * (w >> 1) + r, kb0 = R0 + 128 * (w & 1);
    bh8 qa[4];
    load_q64(U + (size_t)row * UO + CO_QD + h * 64, qnorm, knorm, hh, qa);
    AttnState st; attn_init(st);
    v4u gpre[2]; attn_gate_prefetch<2>(gpre, U + (size_t)row * UO + CO_GD + h * 64, w, lane);
    const bf16* kp = (const bf16*)(a.ws + WS_KFO) + ((size_t)((kb0 >> 5) * 8 + h) * 4) * 512 + lane * 8;
    const bf16* vp = VTO + ((size_t)((kb0 >> 5) * 8 + h) * 4) * 512 + lane * 8;
    const float* rkp = rk + 128 * (w & 1);
    KVf<4> fa, fb;
    load_kv<4>(fa, kp, vp);
#pragma unroll
    for (int kb = 0; kb < 4; kb += 2) {
        load_kv<4>(fb, kp + (size_t)(kb + 1) * 8 * 4 * 512, vp + (size_t)(kb + 1) * 8 * 4 * 512);
        SB_PIN
        attn_compute<4, false>(st, qa, fa, rkp + 32 * kb, hh, false, 0, 0, 0, 0, nullptr);
        if (kb + 2 < 4) load_kv<4>(fa, kp + (size_t)(kb + 2) * 8 * 4 * 512, vp + (size_t)(kb + 2) * 8 * 4 * 512);
        SB_PIN
        attn_compute<4, false>(st, qa, fb, rkp + 32 * (kb + 1), hh, false, 0, 0, 0, 0, nullptr);
    }
    PROF_END(27)
    PROF_BEGIN(28)
    attn_merge_store<2>(st, part, w, lane, gpre, Z + (size_t)row * DM + 512 + h * 64);
    PROF_END(28)
}

__device__ __forceinline__ void na_block_ptrs(int g, int rb, int R0s, int h, int lane, const bf16* KFO, const bf16* VFO, const bf16* kc, const bf16* vc,
                                              const bf16*& kp, const bf16*& vp, int& rki, bool& win, int& kc0, int& bi) {
    if (g < 8) { kp = kc + (size_t)g * 4 * 512 + lane * 8; vp = vc + (size_t)g * 4 * 512 + lane * 8; rki = 512 + 32 * g; win = false; kc0 = 0; bi = 0; }
    else { const int i = (g - 8) >> 1, xk = g & 1; const int tok0 = (rb + i) * 64 + 32 * xk; const size_t blk = ((size_t)(((R0s + tok0) >> 5) * 8 + h) * 4) * 512 + lane * 8;
        kp = KFO + blk; vp = VFO + blk; rki = i * 64 + 32 * xk; win = true; kc0 = 32 * xk; bi = i; }
}
__device__ __forceinline__ void unit_na(const Args& a, const Ctx& X, int j, int u) {
    const bf16* U = (const bf16*)(a.ws + WS_U); const bf16* VTO = (const bf16*)(a.ws + WS_VTO); bf16* Z = (bf16*)(a.ws + WS_Z);
    const float* qnorm = a.in[28] + j * 64; const float* knorm = a.in[29] + j * 64;
    float* part = (float*)X.ldsg; float* rk = part + 8 * 2048 + 512;
    float* rpbs = rk + 768;
    const int bs = u >> 7, h = (u >> 4) & 7, rr = u & 15, tid = opaque_v(X.tid), lane = tid & 63, w = opaque_s(X.wave), r = lane & 31, hh = lane >> 5, R0s = NP + bs * 1024;
    const int rb = rr - 4 < 0 ? 0 : (rr - 4 > 8 ? 8 : rr - 4);
    { const bf16* kp = U + (size_t)(R0s + rb * 64 + tid) * UO + CO_KD + h * 64; float ss = 0.f;
#pragma unroll
      for (int q = 0; q < 8; ++q) { const v4u kr = *(const v4u*)(kp + 8 * q);
          const float k0 = bflo(kr.x), k1 = bfhi(kr.x), k2 = bflo(kr.y), k3 = bfhi(kr.y), k4 = bflo(kr.z), k5 = bfhi(kr.z), k6 = bflo(kr.w), k7 = bfhi(kr.w);
          ss += (k0 * k0 + k1 * k1) + (k2 * k2 + k3 * k3) + (k4 * k4 + k5 * k5) + (k6 * k6 + k7 * k7); }
      rk[tid] = rsqrtf(ss * (1.f / 64.f) + EPS);
      if (tid < 256) rk[512 + tid] = 1.f;
      if (tid < 465) rpbs[tid] = a.in[30][(size_t)(j * 8 + h) * 465 + tid] * 1.4426950408889634f; }
    __syncthreads();
    const int xq = w >> 2, kpart = w & 3, tok = rr * 64 + 32 * xq + r, cq = 32 * xq + r;
    const int c0 = cq - 8 < 0 ? 0 : (cq - 8 > 48 ? 48 : cq - 8);
    const int row = R0s + tok;
    bh8 qa[4];
    load_q64(U + (size_t)row * UO + CO_QD + h * 64, qnorm, knorm, hh, qa);
    AttnState st; attn_init(st);
    v4u gpre[1]; attn_gate_prefetch<4>(gpre, U + (size_t)row * UO + CO_GD + h * 64, w, lane);
    const bf16* kc = (const bf16*)(a.ws + WS_NAKC) + (size_t)((bs * 2 + j) * 8 + h) * 8 * 4 * 512;
    const bf16* vc = (const bf16*)(a.ws + WS_NAVC) + (size_t)((bs * 2 + j) * 8 + h) * 8 * 4 * 512;
    const bf16* KFO = (const bf16*)(a.ws + WS_KFO);
    const int g0 = 6 * kpart;
    KVf<4> fa, fb;
    const bf16 *kpa, *vpa, *kpb, *vpb; int rka, rkb, kca, kcb, bia, bib; bool wa, wb;
    na_block_ptrs(g0, rb, R0s, h, lane, KFO, VTO, kc, vc, kpa, vpa, rka, wa, kca, bia);
    load_kv<4>(fa, kpa, vpa);
#pragma unroll 1
    for (int g = 0; g < 6; g += 2) {
        na_block_ptrs(g0 + g + 1, rb, R0s, h, lane, KFO, VTO, kc, vc, kpb, vpb, rkb, wb, kcb, bib);
        load_kv<4>(fb, kpb, vpb);
        SB_PIN
        attn_compute<4, true>(st, qa, fa, rk + rka, hh, wa, kca, rb + bia - rr + 7, cq, c0, rpbs);
        if (g + 2 < 6) { na_block_ptrs(g0 + g + 2, rb, R0s, h, lane, KFO, VTO, kc, vc, kpa, vpa, rka, wa, kca, bia); load_kv<4>(fa, kpa, vpa); }
        SB_PIN
        attn_compute<4, true>(st, qa, fb, rk + rkb, hh, wb, kcb, rb + bib - rr + 7, cq, c0, rpbs);
    }
    attn_merge_store<4>(st, part, w, lane, gpre, Z + (size_t)row * DM + 512 + h * 64);
}
#ifndef RU_OUT_A
#define RU_OUT_A 1
#endif
#ifndef RU_OUT_B
#define RU_OUT_B 1
#endif
#ifndef RU_OUT_C
#define RU_OUT_C 1
#endif
__device__ __forceinline__ float scan_incl_sum(float v, int lane) {
#pragma unroll
    for (int o = 1; o < 64; o <<= 1) { const float t = __shfl_up(v, o); if (lane >= o) v += t; }
    return v;
}
__device__ __forceinline__ float scan_incl_max(float v, int lane) {
#pragma unroll
    for (int o = 1; o < 64; o <<= 1) { const float t = __shfl_up(v, o); if (lane >= o) v = fmaxf(v, t); }
    return v;
}
__device__ __forceinline__ float scan_incl_max_rev(float v, int lane) {
#pragma unroll
    for (int o = 1; o < 64; o <<= 1) { const float t = __shfl_down(v, o); if (lane + o < 64) v = fmaxf(v, t); }
    return v;
}
constexpr float KSC = 0.08838834764831845f;

__device__ __forceinline__ void stage_T(const bf16* src  , int pitch, bf16* d0, const float* w0, bf16* d1, const float* w1, int wave, int lane) {
#pragma unroll
    for (int i = 0; i < 2; ++i) { const int c = wave * 2 + i;
        const v4u raw = *(const v4u*)(src + (size_t)lane * pitch + 8 * c);
        float x[8] = {bflo(raw.x), bfhi(raw.x), bflo(raw.y), bfhi(raw.y), bflo(raw.z), bfhi(raw.z), bflo(raw.w), bfhi(raw.w)};
        if (w0) { const float s0 = w0[lane] * KSC, s1 = w1[lane] * KSC;
#pragma unroll
            for (int e = 0; e < 8; ++e) { d0[(8 * c + e) * 72 + lane] = (bf16)(pk2(x[e] * s0, 0.f) & 0xffffu); d1[(8 * c + e) * 72 + lane] = (bf16)(pk2(x[e] * s1, 0.f) & 0xffffu); }
        } else {
            const unsigned rr[4] = {raw.x, raw.y, raw.z, raw.w};
#pragma unroll
            for (int e = 0; e < 8; ++e) d0[(8 * c + e) * 72 + lane] = (bf16)((rr[e >> 1] >> (16 * (e & 1))) & 0xffffu);
        }
    }
}

__device__ __forceinline__ void unit_mlstm_L(const Args& a, const Ctx& X, int j, int h, int gc) {
    const bf16* U = (const bf16*)(a.ws + WS_U); const float* GT = (const float*)(a.ws + WS_GATES); const bf16* VFM = (const bf16*)(a.ws + WS_VFM);
    float* AG = (float*)(a.ws + WS_AG); float* LT = (float*)(a.ws + WS_LT); float* NL = (float*)(a.ws + WS_NL); float* GQ = (float*)(a.ws + WS_GQ);
    float* wgt = (float*)X.ldsg;
    bf16* KwT = (bf16*)(X.ldsg + 1024);
    const int tid = opaque_v(X.tid), lane = tid & 63, w = opaque_s(X.wave), r = lane & 31, hh = lane >> 5, R0 = gc * 64;
    v4u kraw[2];
#pragma unroll
    for (int i = 0; i < 2; ++i) kraw[i] = *(const v4u*)(U + (size_t)(R0 + lane) * UE + CE_KM + h * 128 + 8 * (w * 2 + i));
    bh8 vf[4][4];
#pragma unroll
    for (int eb = 0; eb < 4; ++eb)
#pragma unroll
        for (int q = 0; q < 4; ++q) vf[eb][q] = ld16(VFM + ((size_t)(((2 * gc + (q >> 1)) * 4 + h) * 8 + eb * 2 + (q & 1))) * 512 + lane * 8);
    SB_PIN
    if (w < 2) { const int dir = w; const int row = R0 + lane;
        const float lf = logsigmoid_f(GT[(size_t)row * 16 + 8 + dir * 4 + h] + a.in[22][j * 8 + dir * 4 + h]);
        const float ii = GT[(size_t)row * 16 + dir * 4 + h] + a.in[21][j * 8 + dir * 4 + h];
        const float P = scan_incl_sum(lf, lane); const float T = __shfl(P, 63);
        const float dec = (dir == 0 ? (T - P) : (P - lf)) + ii;
        const float am = wave_max(dec);
        wgt[dir * 64 + lane] = expf(dec - am) * KSC;
        if (lane == 0) { AG[((dir * 4 + h) * 96 + gc) * 2] = am; AG[((dir * 4 + h) * 96 + gc) * 2 + 1] = T; }
        const float cum = dir == 0 ? P : (T - P + lf), bv = ii - cum;
        const float pm = dir == 0 ? scan_incl_max(bv, lane) : scan_incl_max_rev(bv, lane);
        *(f32x4*)(GQ + ((size_t)(dir * 4 + h) * NT + row) * 4) = (f32x4){cum, bv, pm, 0.f};
    }
    __syncthreads();
#pragma unroll
    for (int i = 0; i < 2; ++i) { const int c = w * 2 + i; const unsigned rr[4] = {kraw[i].x, kraw[i].y, kraw[i].z, kraw[i].w};
        const float s0 = wgt[lane], s1 = wgt[64 + lane];
#pragma unroll
        for (int e = 0; e < 8; ++e) { const float x = (e & 1) ? bfhi(rr[e >> 1]) : bflo(rr[e >> 1]);
            KwT[(8 * c + e) * 72 + lane] = (bf16)(pk2(x * s0, 0.f) & 0xffffu); KwT[128 * 72 + (8 * c + e) * 72 + lane] = (bf16)(pk2(x * s1, 0.f) & 0xffffu); } }
    __syncthreads();
    { const int dir = w >> 2, db = w & 3; const size_t ub = (size_t)((dir * 4 + h) * 96 + gc);
      bh8 bfr[4];
#pragma unroll
      for (int q = 0; q < 4; ++q) { const bf16* kp = KwT + dir * 128 * 72 + (32 * db + r) * 72 + 16 * q + 4 * hh; bfr[q] = ld2x8(kp, kp + 8); }
#pragma unroll
      for (int eb = 0; eb < 4; ++eb) { f32x16 acc;
#pragma unroll
          for (int i = 0; i < 16; ++i) acc[i] = 0.f;
#pragma unroll
          for (int q = 0; q < 4; ++q) acc = mfma32(vf[eb][q], bfr[q], acc);
          float* dst = LT + ub * 16384 + 32 * db + r;
#pragma unroll
          for (int i = 0; i < 16; ++i) dst[(32 * eb + crow(i, hh)) * 128] = acc[i]; }
      if (tid < 256) { const int dr = tid >> 7, d = tid & 127; const bf16* p = KwT + dr * 128 * 72 + d * 72; float s = 0.f;
#pragma unroll
          for (int q = 0; q < 8; ++q) { const v4u x = *(const v4u*)(p + 8 * q); s += (bflo(x.x) + bfhi(x.x)) + (bflo(x.y) + bfhi(x.y)) + (bflo(x.z) + bfhi(x.z)) + (bflo(x.w) + bfhi(x.w)); }
          NL[(size_t)((dr * 4 + h) * 96 + gc) * 128 + d] = s; } }
    __syncthreads();
}

template <int NC, int NV>
__device__ __forceinline__ void scan_body(const Args& a, int j, int tid, int dir, int h, int gc0, int sl, int initmat  , long outsb  ) {
    const float* AG = (const float*)(a.ws + WS_AG); const float* LT = (const float*)(a.ws + WS_LT); const float* NL = (const float*)(a.ws + WS_NL);
    bf16* CTB = (bf16*)(a.ws + WS_CTB); float* NPV = (float*)(a.ws + WS_NPV); float* MPV = (float*)(a.ws + WS_MPV);
    const size_t ub0 = (size_t)((dir * 4 + h) * 96 + gc0);
    const int e0 = sl * (NV * 2048) + tid * 4;
    f32x4 Lv[NC][NV]; float nl[NC];
    const bool don = tid < 128 && sl == 0;
#pragma unroll
    for (int c = 0; c < NC; ++c) {
#pragma unroll
        for (int i = 0; i < NV; ++i) Lv[c][i] = *(const f32x4*)(LT + (ub0 + c) * 16384 + e0 + 2048 * i);
        nl[c] = don ? NL[(ub0 + c) * 128 + tid] : 0.f; }
    SB_PIN
    f32x4 Cs[NV]; float ns = 0.f, m = 0.f;
#pragma unroll
    for (int i = 0; i < NV; ++i) Cs[i] = (f32x4){0.f, 0.f, 0.f, 0.f};
    if (initmat >= 0) { const float* c0 = (const float*)(a.ws + WS_C0T) + (size_t)initmat * 16384;
#pragma unroll
        for (int i = 0; i < NV; ++i) Cs[i] = *(const f32x4*)(c0 + e0 + 2048 * i);
        if (don) ns = a.in[6][(size_t)initmat * 128 + tid];
        m = a.in[7][initmat]; }
#pragma unroll
    for (int p = 0; p < NC; ++p) {
        const int c = dir ? NC - 1 - p : p;
        const float ac = AG[(ub0 + c) * 2], Gc = AG[(ub0 + c) * 2 + 1];
#pragma unroll
        for (int i = 0; i < NV; ++i) { const int idx = e0 + 2048 * i; st4bf(CTB + (ub0 + c) * 16384 + idx, Cs[i].x, Cs[i].y, Cs[i].z, Cs[i].w); }
        if (don) NPV[(ub0 + c) * 128 + tid] = ns;
        if (tid == 0 && sl == 0) MPV[ub0 + c] = m;
        const float mn = fmaxf(Gc + m, ac), ws = expf(Gc + m - mn), wl = expf(ac - mn);
#pragma unroll
        for (int i = 0; i < NV; ++i) Cs[i] = Cs[i] * ws + Lv[c][i] * wl;
        ns = ns * ws + nl[c] * wl; m = mn;
    }
    if (outsb >= 0) {
#pragma unroll
        for (int i = 0; i < NV; ++i) { const int idx = e0 + 2048 * i, e = idx >> 7, d = idx & 127; float* o = a.out + O_C + (size_t)outsb * 16384 + e;
            o[(d + 0) * 128] = Cs[i].x; o[(d + 1) * 128] = Cs[i].y; o[(d + 2) * 128] = Cs[i].z; o[(d + 3) * 128] = Cs[i].w; }
        if (don) a.out[O_N + (size_t)outsb * 128 + tid] = ns;
        if (tid == 0 && sl == 0) a.out[O_M + outsb] = m;
    }
}
__device__ __forceinline__ void unit_mlstm_scan(const Args& a, const Ctx& X, int j, int s) {
    const int tid = opaque_v(X.tid);
    if (s < 256) { const int sl = s & 1, q = s >> 1, b = q >> 3, h = (q >> 1) & 3, dir = q & 1;
        scan_body<4, 4>(a, j, tid, dir, h, 4 * b, sl, -1, (long)((b * 2 + j) * 2 + dir) * 4 + h); }
    else { const int v = s - 256, sl = v & 7, q = v >> 3, bs = q >> 3, h = (q >> 1) & 3, dir = q & 1;
        scan_body<16, 1>(a, j, tid, dir, h, 64 + 16 * bs, sl, ((bs * 2 + j) * 2 + dir) * 4 + h, -1); }
}

__device__ __forceinline__ void unit_mlstm_out(const Args& a, const Ctx& X, int j, int h, int gc) {
    const bf16* U = (const bf16*)(a.ws + WS_U);
    const bf16* CTB = (const bf16*)(a.ws + WS_CTB); const float* NPV = (const float*)(a.ws + WS_NPV); const float* MPV = (const float*)(a.ws + WS_MPV);
    bf16* Z = (bf16*)(a.ws + WS_Z);
    unsigned char* L = X.ldsg;
    bf16* Qs = (bf16*)L; bf16* Ks = (bf16*)(L + 17408); bf16* CT = (bf16*)(L + 34816);
    float* ctm = (float*)(L + 137216); float* bb = ctm + 128; float* wint = bb + 128; float* emt = wint + 128;
    float* nprev = emt + 128;
    float* ssq = nprev + 256;
    const int tid = opaque_v(X.tid), lane = tid & 63, w = opaque_s(X.wave), r = lane & 31, hh = lane >> 5, R0 = gc * 64;
    const int tb = w & 1, eb = w >> 1, tau = 32 * tb + r;
    PROF_BEGIN(23)
    v4u qraw[2], kraw[2], craw[4];
#pragma unroll
    for (int i = 0; i < 2; ++i) { const int q = tid + 512 * i, row = q >> 4, cc = q & 15;
        qraw[i] = *(const v4u*)(U + (size_t)(R0 + row) * UE + CE_QM + h * 128 + 8 * cc);
        kraw[i] = *(const v4u*)(U + (size_t)(R0 + row) * UE + CE_KM + h * 128 + 8 * cc); }
#pragma unroll
    for (int i = 0; i < 4; ++i) { const int q = tid + 512 * i, e = q >> 4, cc = q & 15; craw[i] = *(const v4u*)(CTB + (size_t)((0 * 4 + h) * 96 + gc) * 16384 + e * 128 + 8 * cc); }
    const float npr = tid < 256 ? NPV[(size_t)(((tid >> 7) * 4 + h) * 96 + gc) * 128 + (tid & 127)] : 0.f;
    bh8 vf[4];
#pragma unroll
    for (int q = 0; q < 4; ++q) vf[q] = ld16((const bf16*)(a.ws + WS_VFM) + ((size_t)(((2 * gc + (q >> 1)) * 4 + h) * 8 + eb * 2 + (q & 1))) * 512 + lane * 8);
    f32x4 gq = (f32x4){0.f, 0.f, 0.f, 0.f}; float mp = 0.f;
    if (w < 2) { gq = *(const f32x4*)((const float*)(a.ws + WS_GQ) + ((size_t)(w * 4 + h) * NT + R0 + lane) * 4); mp = MPV[(size_t)((w * 4 + h) * 96 + gc)]; }
    { const int row = R0 + tau; v2u* og = (v2u*)(L + 104448) + tid * 8;
#pragma unroll
      for (int g = 0; g < 4; ++g) { const int e0 = 32 * eb + 8 * g + 4 * hh;
          og[g] = *(const v2u*)(U + (size_t)row * UE + CE_OM + h * 128 + e0); og[4 + g] = *(const v2u*)(U + (size_t)row * UE + CE_GM + h * 128 + e0); } }
    SB_PIN
#pragma unroll
    for (int i = 0; i < 2; ++i) { const int q = tid + 512 * i, row = q >> 4, cc = q & 15;
        *(v4u*)(Qs + row * 136 + 8 * cc) = qraw[i]; *(v4u*)(Ks + row * 136 + 8 * cc) = kraw[i]; }
#pragma unroll
    for (int i = 0; i < 4; ++i) { const int q = tid + 512 * i, e = q >> 4, cc = q & 15; *(v4u*)(CT + e * 136 + 8 * cc) = craw[i];
        craw[i] = *(const v4u*)(CTB + (size_t)((1 * 4 + h) * 96 + gc) * 16384 + e * 128 + 8 * cc); }
#pragma unroll
    for (int i = 0; i < 4; ++i) { const int q = tid + 512 * i, e = q >> 4, cc = q & 15; *(v4u*)(CT + 128 * 136 + e * 136 + 8 * cc) = craw[i]; }
    if (tid < 256) nprev[tid] = npr;
    if (w < 2) { const int dir = w; const float cum = gq.x, bv = gq.y, pm = gq.z;
        const float mt = cum + fmaxf(mp, pm);
        ctm[dir * 64 + lane] = cum - mt; bb[dir * 64 + lane] = bv; wint[dir * 64 + lane] = expf(cum + mp - mt); emt[dir * 64 + lane] = expf(-mt); }
    __syncthreads();
    PROF_END(23)
    PROF_BEGIN(24)
    const bf16* qp = Qs + (32 * tb + r) * 136 + 8 * hh;
    bh8 qf[8];
#pragma unroll
    for (int ks = 0; ks < 8; ++ks) qf[ks] = ld16(qp + 16 * ks);
    f32x16 hsum;
    for (int rpb_ = 0; rpb_ < RU_OUT_B; ++rpb_) {
#pragma unroll
    for (int i = 0; i < 16; ++i) hsum[i] = 0.f;
#pragma unroll 1
    for (int dir = 0; dir < 2; ++dir) {
        const int sgn = 1 - 2 * dir;
        const bf16* CTd = CT + dir * 128 * 136; const float* npv = nprev + dir * 128;
        const float ct = ctm[dir * 64 + tau], wi = wint[dir * 64 + tau];
        float rs = 0.f, qd = 0.f;
        f32x16 accv;
#pragma unroll
        for (int i = 0; i < 16; ++i) accv[i] = 0.f;
#pragma unroll
        for (int sb = 0; sb < 2; ++sb) {
            bh8 kf[8]; f32x16 ps;
#pragma unroll
            for (int ks = 0; ks < 8; ++ks) kf[ks] = ld16(Ks + (32 * sb + r) * 136 + 16 * ks + 8 * hh);
#pragma unroll
            for (int i = 0; i < 16; ++i) ps[i] = 0.f;
#pragma unroll
            for (int ks = 0; ks < 8; ++ks) ps = mfma32(kf[ks], qf[ks], ps);
#pragma unroll
            for (int g = 0; g < 4; ++g) { const f32x4 b4 = *(const f32x4*)(bb + dir * 64 + 32 * sb + 8 * g + 4 * hh);
#pragma unroll
                for (int e = 0; e < 4; ++e) { const int dd = (32 * sb + 8 * g + 4 * hh + e - tau) * sgn; const bool ok = dd <= 0;
                    const float v = ok ? ps[4 * g + e] * KSC * __expf(ct + b4[e]) : 0.f; ps[4 * g + e] = v; rs += v; } }
            accv = mfma32(vf[2 * sb], pfrag(ps, 0), accv);
            accv = mfma32(vf[2 * sb + 1], pfrag(ps, 1), accv);
            __builtin_amdgcn_sched_barrier(0);
        }
        rs += __shfl_xor(rs, 32);
#pragma unroll
        for (int ks = 0; ks < 8; ++ks) { const v4u qq = __builtin_bit_cast(v4u, qf[ks]); const f32x4 n0 = *(const f32x4*)(npv + 16 * ks + 8 * hh), n1 = *(const f32x4*)(npv + 16 * ks + 8 * hh + 4);
            qd += bflo(qq.x) * n0.x + bfhi(qq.x) * n0.y + bflo(qq.y) * n0.z + bfhi(qq.y) * n0.w + bflo(qq.z) * n1.x + bfhi(qq.z) * n1.y + bflo(qq.w) * n1.z + bfhi(qq.w) * n1.w;
            if ((ks & 1) == 1) __builtin_amdgcn_sched_barrier(0); }
        qd += __shfl_xor(qd, 32);
        __builtin_amdgcn_sched_barrier(0);
        bh8 cf[8];
#pragma unroll
        for (int ks = 0; ks < 8; ++ks) cf[ks] = ld16(CTd + (32 * eb + r) * 136 + 16 * ks + 8 * hh);
        const float qn = wi * qd + rs;
        f32x16 acc;
#pragma unroll
        for (int i = 0; i < 16; ++i) acc[i] = 0.f;
#pragma unroll
        for (int ks = 0; ks < 8; ++ks) acc = mfma32(cf[ks], qf[ks], acc);
#pragma unroll
        for (int i = 0; i < 16; ++i) acc[i] = acc[i] * wi + accv[i];
        const float inv = 1.f / fmaxf(fabsf(qn), emt[dir * 64 + tau]);
#pragma unroll
        for (int i = 0; i < 16; ++i) hsum[i] += acc[i] * inv;
        __builtin_amdgcn_sched_barrier(0);
    }
    }
    PROF_END(24)
    PROF_BEGIN(25)
    { float ss = 0.f;
#pragma unroll
      for (int i = 0; i < 16; ++i) ss += hsum[i] * hsum[i];
      ss += __shfl_xor(ss, 32);
      if (hh == 0) ssq[(tb * 4 + eb) * 32 + r] = ss; }
    __syncthreads();
    { const int tid2 = opaque_v(tid), lane2 = tid2 & 63, w2 = opaque_s(w), r2 = lane2 & 31, hh2 = lane2 >> 5, tb2 = w2 & 1, eb2 = w2 >> 1, tau2 = 32 * tb2 + r2;
    { const float tot = ssq[(tb2 * 4 + 0) * 32 + r2] + ssq[(tb2 * 4 + 1) * 32 + r2] + ssq[(tb2 * 4 + 2) * 32 + r2] + ssq[(tb2 * 4 + 3) * 32 + r2];
      const float rstd = rsqrtf(tot * (1.f / 128.f) + EPS);
      const int row = R0 + tau2; const float* hn = a.in[23] + j * 512 + h * 128;
#pragma unroll
      for (int g = 0; g < 4; ++g) { const int e0 = 32 * eb2 + 8 * g + 4 * hh2; const f32x4 gn = *(const f32x4*)(hn + e0); const v2u om = ((const v2u*)(L + 104448))[tid2 * 8 + g], gm = ((const v2u*)(L + 104448))[tid2 * 8 + 4 + g];
          st4bf(Z + (size_t)row * DM + 512 + h * 128 + e0,
                hsum[4 * g] * rstd * gn.x * sigmoid_f(bflo(om.x)) * silu_f(bflo(gm.x)), hsum[4 * g + 1] * rstd * gn.y * sigmoid_f(bfhi(om.x)) * silu_f(bfhi(gm.x)),
                hsum[4 * g + 2] * rstd * gn.z * sigmoid_f(bflo(om.y)) * silu_f(bflo(gm.y)), hsum[4 * g + 3] * rstd * gn.w * sigmoid_f(bfhi(om.y)) * silu_f(bfhi(gm.y))); } }
    }
    __syncthreads();
    PROF_END(25)
}
__device__ __forceinline__ void unit_conv(const Args& a, const Ctx& X, int j, int t) {
    const bf16* U = (const bf16*)(a.ws + WS_U); bf16* Z = (bf16*)(a.ws + WS_Z);
    const int tid = opaque_v(X.tid), cg = (tid & 63) * 8, r0 = t * 32 + (tid >> 6) * 4;
    const int S = r0 < NP ? 256 : 1024; const int s0 = r0 < NP ? (r0 & 255) : ((r0 - NP) & 1023);
    v4u xc[6], cc[6], bc[4], gc[4];
#pragma unroll
    for (int i = 0; i < 6; ++i) { const int s = s0 - 1 + i; const bool ok = s >= 0 && s < S; const bf16* u = U + (size_t)(r0 - 1 + i) * UO;
        xc[i] = ok ? *(const v4u*)(u + CO_XC + cg) : (v4u){0u, 0u, 0u, 0u}; cc[i] = ok ? *(const v4u*)(u + CO_CC + cg) : (v4u){0u, 0u, 0u, 0u}; }
#pragma unroll
    for (int i = 0; i < 4; ++i) { const bf16* u = U + (size_t)(r0 + i) * UO; bc[i] = *(const v4u*)(u + CO_BC + cg); gc[i] = *(const v4u*)(u + CO_GC + cg); }
    SB_PIN
    float w0[8], w1[8], w2[8], cb[8];
#pragma unroll
    for (int q = 0; q < 2; ++q) { const f32x4 a0 = *(const f32x4*)(a.in[26] + j * 1536 + cg + 4 * q), a1 = *(const f32x4*)(a.in[26] + j * 1536 + 512 + cg + 4 * q),
                                              a2 = *(const f32x4*)(a.in[26] + j * 1536 + 1024 + cg + 4 * q), a3 = *(const f32x4*)(a.in[27] + j * 512 + cg + 4 * q);
#pragma unroll
        for (int e = 0; e < 4; ++e) { w0[4 * q + e] = a0[e]; w1[4 * q + e] = a1[e]; w2[4 * q + e] = a2[e]; cb[4 * q + e] = a3[e]; } }
    float x[6][8];
#pragma unroll
    for (int i = 0; i < 6; ++i) { const unsigned xr[4] = {xc[i].x, xc[i].y, xc[i].z, xc[i].w}, cr[4] = {cc[i].x, cc[i].y, cc[i].z, cc[i].w};
#pragma unroll
        for (int q = 0; q < 4; ++q) { x[i][2 * q] = bflo(xr[q]) * bflo(cr[q]); x[i][2 * q + 1] = bfhi(xr[q]) * bfhi(cr[q]); } }
#pragma unroll
    for (int i = 0; i < 4; ++i) { const unsigned br[4] = {bc[i].x, bc[i].y, bc[i].z, bc[i].w}, gr[4] = {gc[i].x, gc[i].y, gc[i].z, gc[i].w};
        float o[8];
#pragma unroll
        for (int e = 0; e < 8; ++e) { const float bv = (e & 1) ? bfhi(br[e >> 1]) : bflo(br[e >> 1]), gv = (e & 1) ? bfhi(gr[e >> 1]) : bflo(gr[e >> 1]);
            const float cv = x[i][e] * w0[e] + x[i + 1][e] * w1[e] + x[i + 2][e] * w2[e] + cb[e];
            o[e] = bv * cv * silu_f(gv); }
        v4u z; z.x = pk2(o[0], o[1]); z.y = pk2(o[2], o[3]); z.z = pk2(o[4], o[5]); z.w = pk2(o[6], o[7]);
        *(v4u*)(Z + (size_t)(r0 + i) * DM + cg) = z; }
}

constexpr int NPHASES = 17;


#ifndef G1_ALIGN
#define G1_ALIGN true
#endif
#ifndef G1_SP2
#define G1_SP2 true
#endif
#ifndef G2_ALIGN
#define G2_ALIGN true
#endif
#ifndef G2_SP2
#define G2_SP2 true
#endif
#ifndef RU_Q
#define RU_Q 1
#endif
#ifndef RU_KV
#define RU_KV 1
#endif
#ifndef RU_L
#define RU_L 1
#endif
#ifndef RU_ATTS
#define RU_ATTS 1
#endif
#ifndef RU_SCAN
#define RU_SCAN 1
#endif
#ifndef RU_OUT
#define RU_OUT 1
#endif
#ifndef RU_ATTP
#define RU_ATTP 1
#endif
#ifndef RU_NA
#define RU_NA 1
#endif
#ifndef RU_OATT
#define RU_OATT 1
#endif
#ifndef RU_CONV
#define RU_CONV 1
#endif
#ifndef RU_SIDE
#define RU_SIDE 1
#endif
#define REPU(n, call) for (int rp_ = 0; rp_ < (n); ++rp_) { call; }
#define PU(id, stmt) { PROF_BEGIN(id) stmt PROF_END(id) }
__device__ __forceinline__ void phase_gemm1(const Args& a, const Ctx& X, int l) {
    const int j = l >> 1; const bool even = (l & 1) == 0;
    pg8::Gemm g{(const bf16*)(a.ws + WS_H), even ? (const bf16*)(a.ws + WS_WTEV) + (size_t)j * 3584 * 1024 : (const bf16*)(a.ws + WS_WTOD) + (size_t)j * 4096 * 1024, NT, even ? UE : UO, DM};
    pg8::StaticOrder S; S.init(NT, even ? UE : UO, X.G, X.bid, pg8::EpiU::BMA_ROWS);
    pg8::EpiU E{(bf16*)(a.ws + WS_U), even ? UE : UO, even ? (float*)(a.ws + WS_GATES) : nullptr, even ? nullptr : (bf16*)(a.ws + WS_VTO), even ? nullptr : (bf16*)(a.ws + WS_KFO), even ? (bf16*)(a.ws + WS_VFM) : nullptr};
    pg8::gemm_phase<pg8::EpiU, pg8::StaticOrder, G1_ALIGN, G1_SP2>(X.lds, g, S, E);
}
__device__ __forceinline__ void phase_gemm2(const Args& a, const Ctx& X, int l) {
    pg8::Gemm g{(const bf16*)(a.ws + WS_Z), (const bf16*)(a.ws + WS_WTOUT) + (size_t)l * 1024 * 1024, NT, DM, DM};
    pg8::StaticOrder S; S.init(NT, DM, X.G, X.bid, pg8::EpiY::BMA_ROWS);
    const float* ysp = l == 0 ? a.in[0] : a.out; const float* yss = l == 0 ? a.in[1] : a.out + (size_t)NP * DM;
    const float* modl = (const float*)(a.ws + WS_MOD) + l * 3 * 3072;
    if (l < 3) {
        pg8::EpiYN E{a.out, ysp, yss, modl, (bf16*)(a.ws + WS_H), a.in[11] + (l + 1) * DM, modl + 3 * 3072,
                     (unsigned*)(a.ws + WS_XS) + (size_t)l * 48 * 4 * 128, (unsigned*)(a.ws + WS_CTL + CTL_NCNT) + l * 48 * 16};
        pg8::gemm_phase<pg8::EpiYN, pg8::StaticOrder, false, G2_SP2>(X.lds, g, S, E);
    } else {
        pg8::EpiY E{a.out, ysp, yss, modl};
        pg8::gemm_phase<pg8::EpiY, pg8::StaticOrder, G2_ALIGN, G2_SP2>(X.lds, g, S, E);
    }
}
__device__ __forceinline__ void phase_e2(const Args& a, const Ctx& X, int j) {
    const int b = X.bid;
    for (int s = 0; s < 4; ++s) {
        int u;
        if (b < 200) { if (s == 0) u = b; else if (s == 1) u = 200 + b; else break; }
        else { u = 400 + (b - 200) + 56 * s; if (u >= 584) break; }
        if (u < 96) PU(10, REPU(RU_Q, unit_mla_q(a, X, j, u)))
        else if (u < 200) PU(11, REPU(RU_KV, unit_mla_kv(a, X, j, u < 192 ? u - 96 : -1 - (u - 192))))
        else { const int v = u - 200; PU(12, REPU(RU_L, unit_mlstm_L(a, X, j, v / 96, v % 96))) }
    }
}
__device__ __forceinline__ void phase_e2b(const Args& a, const Ctx& X, int j) {
    for (int u = X.bid; u < 640; u += X.G) {
        if (u < 256) PU(13, REPU(RU_ATTS, unit_mla_attn(a, X, u)))
        else PU(14, REPU(RU_SCAN, unit_mlstm_scan(a, X, j, u - 256)))
    }
}
__device__ __forceinline__ void phase_e3(const Args& a, const Ctx& X, int j) {
    const int b = X.bid;
    for (int s = 0; s < 3; ++s) {
        int u;
        if (s == 0) u = b; else if (b < 128) { if (s == 1) u = 256 + b; else break; } else u = 384 + (b - 128) + 128 * (s - 1);
        if (u < 384) PU(15, REPU(RU_OUT, unit_mlstm_out(a, X, j, u / 96, u % 96)))
        else PU(16, REPU(RU_ATTP, unit_mla_attn(a, X, u - 384 + 256)))
    }
}
__device__ __forceinline__ void phase_o2(const Args& a, const Ctx& X, int j) {
    for (int u = X.bid; u < 704; u += X.G) {
        if (u < 256) PU(17, REPU(RU_NA, unit_na(a, X, j, u)))
        else if (u < 512) PU(18, REPU(RU_OATT, unit_odd_attn(a, X, j, u - 256)))
        else PU(19, REPU(RU_CONV, unit_conv(a, X, j, u - 512)))
    }
}


#ifndef REP_P0A
#define REP_P0A 1
#endif
#ifndef REP_NORM
#define REP_NORM 1
#endif
#ifndef REP_G1
#define REP_G1 1
#endif
#ifndef REP_E2
#define REP_E2 1
#endif
#ifndef REP_G2L0
#define REP_G2L0 1
#endif
#ifndef REP_E2B
#define REP_E2B 1
#endif
#ifndef REP_E3
#define REP_E3 1
#endif
#ifndef REP_O2
#define REP_O2 1
#endif
#ifndef PHMASK
#define PHMASK 0x7f
#endif
#define PH_NOP(...) ((void)0)
#if PHMASK & 1
#define PH_P0A phase_p0a
#else
#define PH_P0A PH_NOP
#endif
#if PHMASK & 2
#define PH_NORM phase_norm
#else
#define PH_NORM PH_NOP
#endif
#if PHMASK & 4
#define PH_G1 phase_gemm1
#else
#define PH_G1 PH_NOP
#endif
#if PHMASK & 8
#define PH_E2 phase_e2
#else
#define PH_E2 PH_NOP
#endif
#if PHMASK & 16
#define PH_E3 phase_e3
#define PH_E2B phase_e2b
#else
#define PH_E3 PH_NOP
#define PH_E2B PH_NOP
#endif
#if PHMASK & 32
#define PH_O2 phase_o2
#else
#define PH_O2 PH_NOP
#endif
#if PHMASK & 64
#define PH_G2 phase_gemm2
#else
#define PH_G2 PH_NOP
#endif
__global__ void __launch_bounds__(NTHR, 2) mega_fwd(Args args) {
    extern __shared__ __attribute__((aligned(16))) unsigned char lds[];
    Ctx X; X.lds = (LAS unsigned char*)lds; X.ldsg = lds;
    X.tid = threadIdx.x; X.lane = X.tid & 63; X.wave = __builtin_amdgcn_readfirstlane(X.tid >> 6); X.G = gridDim.x; X.bid = blockIdx.x;
    volatile LAS unsigned* MISC = (volatile LAS unsigned*)(X.lds + MISC_OFF);
    if (X.tid < 32) MISC[X.tid] = 0u;
    __syncthreads();
    const int lo = args.ph_lo, hi = args.ph_hi;
    XcdBarrier bar; bar.bar = (unsigned*)(args.ws + WS_CTL) + CW_BAR; bar.x = 0; bar.st = MISC + 8;
    if (hi - lo > 1) bar = xcd_barrier_post((unsigned*)(args.ws + WS_CTL) + CW_BAR, MISC + 8);
    int ph = 0;
#define RUN(pid, n, body) do { if (ph >= lo && ph < hi) { for (int rp = 0; rp < (n); ++rp) { { PROF_BEGIN(pid) body; PROF_END(pid) } if (ph + 1 < hi || rp + 1 < (n)) { PROF_BEGIN(9) xcd_barrier(bar); PROF_END(9) } } } ++ph; } while (0)
    RUN(1, REP_P0A, PH_P0A(args, X));
    for (int l = 0; l < 4; ++l) {
        const int j = l >> 1;
        RUN(3, REP_G1, PH_G1(args, X, l));
        if ((l & 1) == 0) { RUN(4, REP_E2, PH_E2(args, X, j)); RUN(5, REP_E2B, PH_E2B(args, X, j)); RUN(6, REP_E3, PH_E3(args, X, j)); }
        else { RUN(7, REP_O2, PH_O2(args, X, j)); }
        RUN(8, l == 0 ? REP_G2L0 : 1, PH_G2(args, X, l));
    }
#undef RUN
    if (PROF_ID != 0 && threadIdx.x == 0) { const unsigned long long t0 = __builtin_amdgcn_s_memrealtime(); const unsigned long long w = (unsigned long long)PROF_K * ((volatile LAS unsigned*)(X.lds + MISC_OFF))[16];
        while (__builtin_amdgcn_s_memrealtime() - t0 < w) __builtin_amdgcn_s_sleep(8); }
}

#ifndef MK_SPLIT
#define MK_SPLIT 0
#endif

extern "C" void kernel_launch(void* const* d_in, const int* in_sizes, int n_in, void* d_out, int out_size, void* d_ws, size_t ws_size, hipStream_t stream) {
    static int ready = 0;
    if (!ready) {
        if (hipFuncSetAttribute((const void*)mega_fwd, hipFuncAttributeMaxDynamicSharedMemorySize, LDS_BYTES) != hipSuccess) fprintf(stderr, "kernel_launch: hipFuncSetAttribute failed\n");
        int per_cu = 0;
        if (hipOccupancyMaxActiveBlocksPerMultiprocessor(&per_cu, (const void*)mega_fwd, NTHR, LDS_BYTES) != hipSuccess || per_cu < 1) fprintf(stderr, "kernel_launch: occupancy query says %d blocks per CU\n", per_cu);
        (void)hipGetLastError();
        ready = 1;
    }
    (void)hipMemsetAsync((char*)d_ws + WS_CTL, 0, CTL_ZERO_BYTES, stream);
    Args a{};
    for (int i = 0; i < 32; ++i) a.in[i] = (const float*)d_in[i];
    a.out = (float*)d_out; a.ws = (unsigned char*)d_ws;
#if MK_SPLIT
    for (int p = 0; p < NPHASES; ++p) { a.ph_lo = p; a.ph_hi = p + 1; hipLaunchKernelGGL(mega_fwd, dim3(256), dim3(NTHR), LDS_BYTES, stream, a); }
#else
    a.ph_lo = 0; a.ph_hi = NPHASES;
    hipLaunchKernelGGL(mega_fwd, dim3(256), dim3(NTHR), LDS_BYTES, stream, a);
#endif
}
```

```cpp
#include <hip/hip_runtime.h>
#include <cstdio>
#include <cstdint>
#include <math.h>

#define GAS __attribute__((address_space(1)))
#define LAS __attribute__((address_space(3)))
typedef unsigned short bf16;
typedef unsigned v4u __attribute__((ext_vector_type(4)));
typedef unsigned v2u __attribute__((ext_vector_type(2)));
typedef float f32x4 __attribute__((ext_vector_type(4)));
typedef float f32x2 __attribute__((ext_vector_type(2)));
typedef float f32x16 __attribute__((ext_vector_type(16)));
typedef short bf16x8 __attribute__((ext_vector_type(8)));
typedef __bf16 bh8 __attribute__((ext_vector_type(8)));
typedef __bf16 bh2 __attribute__((ext_vector_type(2)));
typedef GAS unsigned gu32;
#define RLX_AGENT __ATOMIC_RELAXED, __HIP_MEMORY_SCOPE_AGENT
#define LDS_WAIT() asm volatile("s_waitcnt lgkmcnt(0)" ::: "memory")
#define LDS_BARRIER() asm volatile("s_waitcnt lgkmcnt(0)\n\ts_barrier" ::: "memory")
#define SB_PIN __builtin_amdgcn_sched_barrier(0);
#define VM_WAIT() asm volatile("s_waitcnt vmcnt(0)" ::: "memory")

constexpr int DM = 1024, NP = 4096, NS = 2048, NT = 6144;
constexpr int UE = 3584, UO = 4096;
constexpr float EPS = 1e-6f;
constexpr int CE_QA = 0, CE_KVA = 256, CE_GA = 384, CE_QM = 896, CE_KM = 1408, CE_VM = 1920, CE_OM = 2432, CE_GM = 2944, CE_KPE = 3456;
constexpr int CO_XC = 0, CO_BC = 512, CO_CC = 1024, CO_GC = 1536, CO_QD = 2048, CO_KD = 2560, CO_VD = 3072, CO_GD = 3584;
constexpr size_t O_Y = 0, O_CKV = 6291456, O_KPE = 7340032, O_C = 7602176, O_N = 11796480, O_M = 11829248, O_NK = 11829504, O_NV = 16023808;
constexpr size_t MiB = 1u << 20;
constexpr size_t WS_CTL = 0, CTL_ZERO_BYTES = 65536;
constexpr size_t WS_ROPE = 65536;
constexpr size_t WS_MOD = 131072;
constexpr size_t WS_AG = 327680;
constexpr size_t WS_WTEV = 1 * MiB;
constexpr size_t WS_WTOD = 17 * MiB;
constexpr size_t WS_WTOUT = 33 * MiB;
constexpr size_t WS_WTQB = 41 * MiB;
constexpr size_t WS_WTKVB = 42 * MiB;
constexpr size_t WS_NAKC = 43 * MiB;
constexpr size_t WS_NAVC = 44 * MiB;
constexpr size_t WS_C0T = 45 * MiB;
constexpr size_t WS_H = 47 * MiB;
constexpr size_t WS_U = 59 * MiB;
constexpr size_t WS_Z = 107 * MiB;
constexpr size_t WS_GATES = 119 * MiB;
constexpr size_t WS_Q = 120 * MiB;
constexpr size_t WS_KM = 129 * MiB;
constexpr size_t WS_VTM = 139 * MiB;
constexpr size_t WS_VTO = 146 * MiB;
constexpr size_t WS_LT = 152 * MiB;
constexpr size_t WS_NL = 200 * MiB;
constexpr size_t WS_CTB = 201 * MiB;
constexpr size_t WS_NPV = 225 * MiB;
constexpr size_t WS_MPV = 226 * MiB;
constexpr size_t WS_KFO = 227 * MiB;
constexpr size_t WS_VFM = 234 * MiB;
constexpr size_t WS_GQ = 241 * MiB;
constexpr size_t WS_XS = 242 * MiB;
constexpr size_t WS_YB = 243 * MiB;
constexpr size_t CTL_NCNT = 32768;
constexpr size_t CTL_MODCNT = 49152;
constexpr size_t CTL_SCANCNT = 50176;
constexpr int KROWS = 6656;

__device__ __forceinline__ unsigned pk2(float lo, float hi) { f32x2 v = {lo, hi}; bh2 b = __builtin_convertvector(v, bh2); return __builtin_bit_cast(unsigned, b); }
__device__ __forceinline__ float bf2f(unsigned u16) { return __builtin_bit_cast(float, u16 << 16); }
__device__ __forceinline__ float bflo(unsigned u) { return __builtin_bit_cast(float, u << 16); }
__device__ __forceinline__ float bfhi(unsigned u) { return __builtin_bit_cast(float, u & 0xffff0000u); }
__device__ __forceinline__ float silu_f(float x) { return x / (1.f + __expf(-x)); }
__device__ __forceinline__ float sigmoid_f(float x) { return 1.f / (1.f + __expf(-x)); }
__device__ __forceinline__ float logsigmoid_f(float x) { return fminf(x, 0.f) - log1pf(expf(-fabsf(x))); }
__device__ __forceinline__ int cond_of_row(int r) { return r < NP ? 0 : 1 + ((r - NP) >> 10); }
__device__ __forceinline__ float wave_sum(float v) {
#pragma unroll
    for (int o = 1; o < 64; o <<= 1) v += __shfl_xor(v, o);
    return v;
}
__device__ __forceinline__ float wave_max(float v) {
#pragma unroll
    for (int o = 1; o < 64; o <<= 1) v = fmaxf(v, __shfl_xor(v, o));
    return v;
}
__device__ __forceinline__ f32x16 mfma32(bh8 a, bh8 b, f32x16 c) { return __builtin_amdgcn_mfma_f32_32x32x16_bf16(a, b, c, 0, 0, 0); }
__device__ __forceinline__ bh8 ld16(const bf16* p) { return *(const bh8*)p; }
__device__ __forceinline__ bh8 ld2x8(const bf16* p0, const bf16* p1) { v2u a = *(const v2u*)p0, b = *(const v2u*)p1; v4u v = {a.x, a.y, b.x, b.y}; return __builtin_bit_cast(bh8, v); }
__device__ __forceinline__ bh8 pfrag(const f32x16& p, int s) {
    v4u v; v.x = pk2(p[8 * s + 0], p[8 * s + 1]); v.y = pk2(p[8 * s + 2], p[8 * s + 3]); v.z = pk2(p[8 * s + 4], p[8 * s + 5]); v.w = pk2(p[8 * s + 6], p[8 * s + 7]);
    return __builtin_bit_cast(bh8, v);
}
__device__ __forceinline__ int crow(int i, int hh) { return (i & 3) + 8 * (i >> 2) + 4 * hh; }
__device__ __forceinline__ void st4bf(bf16* p, float a, float b, float c, float d) { v2u v; v.x = pk2(a, b); v.y = pk2(c, d); *(v2u*)p = v; }

namespace pg8 {
#define PG8_LAS __attribute__((address_space(3)))
typedef unsigned short bf16_t;
typedef short bf16x8 __attribute__((ext_vector_type(8)));
typedef float f32x4 __attribute__((ext_vector_type(4)));
typedef unsigned u32x4 __attribute__((ext_vector_type(4)));
#ifndef PG8_WGM
#define PG8_WGM 8
#endif
constexpr int BM = 256, BK = 64, HALF = 128, HTB = HALF * BK * 2  , STAGE_BYTES = 8 * HTB, NXCD = 8, WGM = PG8_WGM;

__host__ __device__ __forceinline__ int lds_byte(int r, int c) { const int st = (r >> 4) * 2 + (c >> 5), rr = r & 15, cc = c & 31, ob = rr * 64 + cc * 2; return st * 1024 + (ob ^ (((ob >> 9) & 1) << 5)); }
__host__ __device__ __forceinline__ void stage_rc(int b, int& R, int& C) { const int st = b / 1024, sb = b % 1024, swz = sb ^ (((sb >> 9) & 1) << 5); R = (st >> 1) * 16 + swz / 64; C = (st & 1) * 32 + (swz % 64) / 2; }
__host__ __device__ __forceinline__ int perm32(int rho) { const int n = rho >> 4, i = rho & 15; return 8 * (i >> 2) + 4 * n + (i & 3); }

struct Unit { int pm, pn; };
struct Gemm { const bf16_t* A; const bf16_t* Bt; int M, N, K; };

struct StaticOrder {
    int nM, nN, nwg, G, c;
    __host__ __device__ void init(int M, int N, int G_, int c_, int bma) { nM = M / bma; nN = N / BM; nwg = nM * nN; G = G_; c = c_; }
    __host__ __device__ bool next(int i, Unit& u) const {
        const long L = (long)i * G + c; if (L >= nwg) return false;
        int wgid = (int)L; { const int q = nwg / NXCD, r = nwg % NXCD, xcd = wgid % NXCD, off = wgid / NXCD; wgid = (xcd < r ? xcd * (q + 1) : r * (q + 1) + (xcd - r) * q) + off; }
        const int nig = WGM * nN, gid = wgid / nig, fm = gid * WGM, gsz = (nM - fm) < WGM ? (nM - fm) : WGM;
        u.pm = fm + ((wgid % nig) % gsz); u.pn = (wgid % nig) / gsz; return true;
    }
    __device__ __forceinline__ void a_ready(const Unit&) const {}
    __device__ __forceinline__ void done(const Unit&) const {}
};

__device__ __forceinline__ int pg8_opaque(int x) { asm volatile("" : "+v"(x)); return x; }
__device__ __forceinline__ unsigned cvt_pk_bf16(float lo, float hi) { unsigned r; asm volatile("v_cvt_pk_bf16_f32 %0, %1, %2" : "=v"(r) : "v"(lo), "v"(hi)); return r; }

#ifndef WT_STORES
#define WT_STORES 0
#endif
__device__ __forceinline__ void st16_wt(void* p, u32x4 v) {
#if WT_STORES
    asm volatile("global_store_dwordx4 %0, %1, off sc1\n\ts_nop 1" :: "v"(p), "v"(v) : "memory");
#else
    *(u32x4*)p = v;
#endif
}
__device__ __forceinline__ void quad_transpose(u32x4& w, int lane) {
    const bool o1 = lane & 1, o2 = lane & 2;
    { const unsigned t0 = o1 ? w.x : w.y, t1 = o1 ? w.z : w.w;
      const unsigned r0 = (unsigned)__shfl_xor((int)t0, 1), r1 = (unsigned)__shfl_xor((int)t1, 1);
      if (o1) { w.x = r0; w.z = r1; } else { w.y = r0; w.w = r1; } }
    { const unsigned t0 = o2 ? w.x : w.z, t1 = o2 ? w.y : w.w;
      const unsigned r0 = (unsigned)__shfl_xor((int)t0, 2), r1 = (unsigned)__shfl_xor((int)t1, 2);
      if (o2) { w.x = r0; w.y = r1; } else { w.z = r0; w.w = r1; } }
}
struct EpiU {
    static constexpr bool PERM = true, AFTER_DRAIN = false; static constexpr int BMA_ROWS = 192, BMA = BMA_ROWS, HA = BMA / 2, MA = HA / 32, WRA = HA / 2;
    bf16_t* U; int ldu; float* gates; bf16_t* vto; bf16_t* kfo; bf16_t* vfm;
    __device__ __forceinline__ void operator()(const f32x4 (&acc)[2][2][4][2], const Unit& u, int wr, int wc, int fr, int fq) const {
        const int row0 = u.pm * BMA + wr * WRA + fr, col0 = u.pn * BM + wc * 32 + 8 * fq;
        const bool dog = gates != nullptr && u.pn == 13 && wc == 1 && fq < 2;
        const bool dov = vto != nullptr && (u.pn == 12 || u.pn == 13);
        const bool dok = kfo != nullptr && (u.pn == 10 || u.pn == 11);
        const bool dom = vfm != nullptr && u.pn >= 7 && u.pn <= 9;
#pragma unroll
        for (int ai = 0; ai < 2; ++ai)
#pragma unroll
            for (int m = 0; m < MA; ++m) {
                const int row = row0 + ai * HA + m * 16;
#pragma unroll
                for (int bj = 0; bj < 2; ++bj) {
                    const f32x4 v0 = acc[ai][bj][m][0], v1 = acc[ai][bj][m][1];
                    const int col = col0 + bj * HALF;
                    u32x4 w; w.x = cvt_pk_bf16(v0[0], v0[1]); w.y = cvt_pk_bf16(v0[2], v0[3]); w.z = cvt_pk_bf16(v1[0], v1[1]); w.w = cvt_pk_bf16(v1[2], v1[3]);
                    st16_wt(U + (size_t)row * ldu + col, w);
                    if (bj == 1 && dog) { float* g = gates + (size_t)row * 16 + 8 * fq; *(f32x4*)g = v0; *(f32x4*)(g + 4) = v1; }
                    if (dom) {
                        const bool in = col >= 1920 && col < 2432; const int cc = in ? col - 1920 : 0, hd = cc >> 7, ev = cc & 127;
                        u32x4 wq = w;
                        quad_transpose(wq, fq * 16 + fr);
                        if (in) { const int q = fr & 3, t16 = row & 15, k = t16 >> 2, dv = ev + 2 * q;
                            bf16_t* p = vfm + ((size_t)((row >> 5) * 4 + hd) * 8 + (dv >> 5) * 2 + ((row >> 4) & 1)) * 512 + ((k & 1) * 32 + (dv & 31)) * 8 + 4 * (k >> 1);
                            typedef unsigned u32x2_ __attribute__((ext_vector_type(2)));
                            *(u32x2_*)p = (u32x2_){(wq.x & 0xffffu) | (wq.y << 16), (wq.z & 0xffffu) | (wq.w << 16)};
                            *(u32x2_*)(p + 8) = (u32x2_){(wq.x >> 16) | (wq.y & 0xffff0000u), (wq.z >> 16) | (wq.w & 0xffff0000u)}; }
                    }
                    if (dok) { const int cc = col - 2560, hd = cc >> 6, d = cc & 63;
                        *(u32x4*)(kfo + ((size_t)((row >> 5) * 8 + hd) * 4 + (d >> 4)) * 512 + (((d >> 3) & 1) * 32 + (row & 31)) * 8) = w; }
                    if (dov) { const int cc = col - 3072, hd = cc >> 6, dv0 = cc & 63;
                        u32x4 wq = w;
                        quad_transpose(wq, fq * 16 + fr);
                        const int q = fr & 3, t16 = row & 15, k = t16 >> 2, dv = dv0 + 2 * q;
                        bf16_t* p = vto + ((size_t)((row >> 5) * 8 + hd) * 4 + (dv >> 5) * 2 + ((row >> 4) & 1)) * 512 + ((k & 1) * 32 + (dv & 31)) * 8 + 4 * (k >> 1);
                        typedef unsigned u32x2_ __attribute__((ext_vector_type(2)));
                        *(u32x2_*)p = (u32x2_){(wq.x & 0xffffu) | (wq.y << 16), (wq.z & 0xffffu) | (wq.w << 16)};
                        *(u32x2_*)(p + 8) = (u32x2_){(wq.x >> 16) | (wq.y & 0xffff0000u), (wq.z >> 16) | (wq.w & 0xffff0000u)};
                    }
                }
            }
    }
};

struct EpiY {
    static constexpr bool PERM = true, AFTER_DRAIN = false; static constexpr int BMA_ROWS = 128, BMA = BMA_ROWS, HA = BMA / 2, MA = HA / 32, WRA = HA / 2;
    float* Y; const bf16_t* YB; const float* mod_l;
    __device__ __forceinline__ void operator()(const f32x4 (&acc)[2][2][4][2], const Unit& u, int wr, int wc, int fr, int fq) const {
        const int row0 = u.pm * BMA + wr * WRA + fr, col0 = u.pn * BM + wc * 32 + 8 * fq;
        const int cond = u.pm < 32 ? 0 : (u.pm < 40 ? 1 : 2);
        f32x4 gv[2][2]; u32x4 yr[2][2][MA];
#pragma unroll
        for (int bj = 0; bj < 2; ++bj) { const float* gp = mod_l + cond * 3072 + 2048 + col0 + bj * HALF; gv[bj][0] = *(const f32x4*)gp; gv[bj][1] = *(const f32x4*)(gp + 4);
#pragma unroll
            for (int ai = 0; ai < 2; ++ai)
#pragma unroll
                for (int m = 0; m < MA; ++m) yr[bj][ai][m] = *(const u32x4*)(YB + (size_t)(row0 + ai * HA + m * 16) * 1024 + col0 + bj * HALF); }
        __builtin_amdgcn_sched_barrier(0);
#pragma unroll
        for (int bj = 0; bj < 2; ++bj) {
            const int col = col0 + bj * HALF;
#pragma unroll
            for (int ai = 0; ai < 2; ++ai)
#pragma unroll
                for (int m = 0; m < MA; ++m) {
                    const int row = row0 + ai * HA + m * 16;
                    const u32x4 y = yr[bj][ai][m];
                    const f32x4 y0 = {bflo(y.x), bfhi(y.x), bflo(y.y), bfhi(y.y)}, y1 = {bflo(y.z), bfhi(y.z), bflo(y.w), bfhi(y.w)};
                    float* dst = Y + (size_t)row * 1024 + col;
                    *(f32x4*)dst = y0 + gv[bj][0] * acc[ai][bj][m][0];
                    *(f32x4*)(dst + 4) = y1 + gv[bj][1] * acc[ai][bj][m][1];
                }
        }
    }
};


template <bool SRC16>
struct EpiYN {
    static constexpr bool PERM = true, AFTER_DRAIN = true; static constexpr int BMA_ROWS = 128, BMA = BMA_ROWS, HA = BMA / 2, MA = HA / 32, WRA = HA / 2;
    bf16_t* YB; const float* ysp; const float* yss; const float* mod_l;
    bf16_t* H; const float* nw; const float* mod_n;
    unsigned* xs; unsigned* cnt;
    __device__ __forceinline__ void operator()(const f32x4 (&)[2][2][4][2], const Unit&, int, int, int, int) const {}
    __device__ __forceinline__ void prefetch(f32x4 (&pre)[2][2][4][2], const Unit& u, int wr, int wc, int fr, int fq) const {
        const int row0 = u.pm * BMA + wr * WRA + fr, col0 = u.pn * BM + wc * 32 + 8 * fq;
#pragma unroll
        for (int bj = 0; bj < 2; ++bj)
#pragma unroll
            for (int ai = 0; ai < 2; ++ai)
#pragma unroll
                for (int m = 0; m < MA; ++m) { const int row = row0 + ai * HA + m * 16, col = col0 + bj * HALF;
                    if constexpr (!SRC16) { const float* src = (row < 4096 ? ysp + (size_t)row * 1024 : yss + (size_t)(row - 4096) * 1024) + col;
                        pre[ai][bj][m][0] = *(const f32x4*)src; pre[ai][bj][m][1] = *(const f32x4*)(src + 4); }
                    else pre[ai][bj][m][0] = __builtin_bit_cast(f32x4, *(const u32x4*)(YB + (size_t)row * 1024 + col)); }
    }
    __device__ __forceinline__ void fused(f32x4 (&acc)[2][2][4][2], const f32x4 (&pre)[2][2][4][2], const Unit& u, int wr, int wc, int fr, int fq, PG8_LAS unsigned char* lds, int wid, int lane) const {
        const int tid = wid * 64 + lane;
        PG8_LAS float* part = (PG8_LAS float*)lds; PG8_LAS float* rstds = part + 512;
        const int row0 = u.pm * BMA + wr * WRA + fr, col0 = u.pn * BM + wc * 32 + 8 * fq;
        const int cond = u.pm < 32 ? 0 : (u.pm < 40 ? 1 : 2);
        float ss[2][2] = {{0.f, 0.f}, {0.f, 0.f}};
        f32x4 gv[2][2], nv[2][6];
#pragma unroll
        for (int bj = 0; bj < 2; ++bj) { const int col = col0 + bj * HALF; const float* gp = mod_l + cond * 3072 + 2048 + col; const float* mp = mod_n + cond * 3072 + col;
            gv[bj][0] = *(const f32x4*)gp; gv[bj][1] = *(const f32x4*)(gp + 4);
            nv[bj][0] = *(const f32x4*)(nw + col); nv[bj][1] = *(const f32x4*)(nw + col + 4); nv[bj][2] = *(const f32x4*)mp; nv[bj][3] = *(const f32x4*)(mp + 4); nv[bj][4] = *(const f32x4*)(mp + 1024); nv[bj][5] = *(const f32x4*)(mp + 1028); }
        __builtin_amdgcn_sched_barrier(0);
#pragma unroll
        for (int bj = 0; bj < 2; ++bj) {
            const f32x4 g0 = gv[bj][0], g1 = gv[bj][1];
#pragma unroll
            for (int ai = 0; ai < 2; ++ai)
#pragma unroll
                for (int m = 0; m < MA; ++m) {
                    const int row = row0 + ai * HA + m * 16;
                    f32x4 p0 = pre[ai][bj][m][0], p1 = pre[ai][bj][m][1];
                    if constexpr (SRC16) { const u32x4 x = __builtin_bit_cast(u32x4, pre[ai][bj][m][0]); p0 = (f32x4){bflo(x.x), bfhi(x.x), bflo(x.y), bfhi(x.y)}; p1 = (f32x4){bflo(x.z), bfhi(x.z), bflo(x.w), bfhi(x.w)}; }
                    const f32x4 v0 = p0 + g0 * acc[ai][bj][m][0], v1 = p1 + g1 * acc[ai][bj][m][1];
                    acc[ai][bj][m][0] = v0; acc[ai][bj][m][1] = v1;
                    ss[ai][m] += (v0[0] * v0[0] + v0[1] * v0[1]) + (v0[2] * v0[2] + v0[3] * v0[3]) + (v1[0] * v1[0] + v1[1] * v1[1]) + (v1[2] * v1[2] + v1[3] * v1[3]);
                }
        }
#pragma unroll
        for (int ai = 0; ai < 2; ++ai)
#pragma unroll
            for (int m = 0; m < MA; ++m) { float s = ss[ai][m]; s += __shfl_xor(s, 16); s += __shfl_xor(s, 32);
                if (fq == 0) part[wc * 128 + ai * HA + wr * WRA + m * 16 + fr] = s; }
        __syncthreads();
        if (tid < 128) { const float t = part[tid] + part[128 + tid] + part[256 + tid] + part[384 + tid];
            __hip_atomic_store(xs + (size_t)(u.pm * 4 + u.pn) * 128 + tid, __builtin_bit_cast(unsigned, t), __ATOMIC_RELAXED, __HIP_MEMORY_SCOPE_AGENT); }
        asm volatile("s_waitcnt vmcnt(0)" ::: "memory");
        __syncthreads();
        if (tid == 0) { unsigned* c = cnt + 16 * u.pm;
            __hip_atomic_fetch_add(c, 1u, __ATOMIC_RELAXED, __HIP_MEMORY_SCOPE_AGENT);
            unsigned sp = 0; while (__hip_atomic_load(c, __ATOMIC_RELAXED, __HIP_MEMORY_SCOPE_AGENT) < 4u && ++sp < (1u << 20)) __builtin_amdgcn_s_sleep(1); }
        __syncthreads();
        if (tid < 128) { float t = 0.f;
#pragma unroll
            for (int p = 0; p < 4; ++p) t += __builtin_bit_cast(float, __hip_atomic_load(xs + (size_t)(u.pm * 4 + p) * 128 + tid, __ATOMIC_RELAXED, __HIP_MEMORY_SCOPE_AGENT));
            rstds[tid] = rsqrtf(t * (1.f / 1024.f) + 1e-6f); }
        __syncthreads();
#pragma unroll
        for (int bj = 0; bj < 2; ++bj) {
            const int col = col0 + bj * HALF;
            const f32x4 n0 = nv[bj][0], n1 = nv[bj][1], sh0 = nv[bj][2], sh1 = nv[bj][3], sc0 = nv[bj][4], sc1 = nv[bj][5];
            const f32x4 m0 = n0 * (sc0 + 1.f), m1 = n1 * (sc1 + 1.f);
#pragma unroll
            for (int ai = 0; ai < 2; ++ai)
#pragma unroll
                for (int m = 0; m < MA; ++m) {
                    const int rl = ai * HA + wr * WRA + m * 16 + fr; const float r = rstds[rl];
                    const f32x4 h0 = acc[ai][bj][m][0] * r * m0 + sh0, h1 = acc[ai][bj][m][1] * r * m1 + sh1;
                    { const f32x4 a0 = acc[ai][bj][m][0], a1 = acc[ai][bj][m][1]; u32x4 yw; yw.x = cvt_pk_bf16(a0[0], a0[1]); yw.y = cvt_pk_bf16(a0[2], a0[3]); yw.z = cvt_pk_bf16(a1[0], a1[1]); yw.w = cvt_pk_bf16(a1[2], a1[3]);
                      *(u32x4*)(YB + (size_t)(u.pm * BMA + rl) * 1024 + col) = yw; }
                    u32x4 w; w.x = cvt_pk_bf16(h0[0], h0[1]); w.y = cvt_pk_bf16(h0[2], h0[3]); w.z = cvt_pk_bf16(h1[0], h1[1]); w.w = cvt_pk_bf16(h1[2], h1[3]);
                    st16_wt(H + (size_t)(u.pm * BMA + rl) * 1024 + col, w);
                }
        }
    }
};
template <class Epi, class Sched, bool ALIGN_EPI = false, bool SP2 = false>
__device__ __forceinline__ void gemm_phase(PG8_LAS unsigned char* lds, const Gemm g, const Sched& S, const Epi& E) {
    constexpr int BMA = Epi::BMA_ROWS, HA = BMA / 2, MA = HA / 32, WRA = HA / 2;
    const int tid = pg8_opaque((int)threadIdx.x), wid = __builtin_amdgcn_readfirstlane(tid >> 6), lane = tid & 63, wr = wid >> 2, wc = wid & 3, fr = lane & 15, fq = lane >> 4;
    const int K = g.K, nt = K / BK;
    unsigned voffA[2], voffB[2];
#pragma unroll
    for (int i = 0; i < 2; ++i) { int R, C; stage_rc(tid * 16 + i * 8192, R, C); const int Rb = Epi::PERM ? ((R & ~31) + perm32(R & 31)) : R;
        voffA[i] = (unsigned)(R * K + C) * 2u; voffB[i] = (unsigned)(Rb * K + C) * 2u; }
    const size_t kstep = (size_t)(BK * 2);
    const size_t hstep = (size_t)HALF * K * 2;
    const size_t tstep = 2 * hstep;
    const size_t hstepA = (size_t)HA * K * 2, tstepA = 2 * hstepA;
    const unsigned ldsw = (unsigned)wid * 1024u;
    const int aoff = lds_byte(wr * WRA + fr, fq * 8), boff = lds_byte(wc * 32 + fr, fq * 8);
#define PG8_SA(b, h) (((b) * 2 + (h)) * HTB)
#define PG8_SB(b, h) ((4 + (b) * 2 + (h)) * HTB)
#define PG8_STAGE(bufoff, gbase, voff) do { _Pragma("unroll") for (int _i = 0; _i < 2; ++_i) \
        __builtin_amdgcn_global_load_lds((const unsigned*)((const char*)(gbase) + (voff)[_i]), (PG8_LAS unsigned*)(lds + (bufoff) + ldsw + _i * 8192), 16, 0, 0); } while (0)
#define PG8_LDA(dst, b, h) do { _Pragma("unroll") for (int m = 0; m < MA; ++m) _Pragma("unroll") for (int k = 0; k < 2; ++k) dst[m][k] = *(const PG8_LAS bf16x8*)(lds + PG8_SA(b, h) + aoff + m * 2048 + k * 1024); } while (0)
#define PG8_LDB(dst, b, h) do { _Pragma("unroll") for (int n = 0; n < 2; ++n) _Pragma("unroll") for (int k = 0; k < 2; ++k) dst[n][k] = *(const PG8_LAS bf16x8*)(lds + PG8_SB(b, h) + boff + n * 2048 + k * 1024); } while (0)
#define PG8_MMA(ai, bj, At, Bt) do { __builtin_amdgcn_s_setprio(1); _Pragma("unroll") for (int m = 0; m < MA; ++m) _Pragma("unroll") for (int n = 0; n < 2; ++n) _Pragma("unroll") for (int k = 0; k < 2; ++k) \
        acc[ai][bj][m][n] = __builtin_amdgcn_mfma_f32_16x16x32_bf16(Bt[n][k], At[m][k], acc[ai][bj][m][n], 0, 0, 0); __builtin_amdgcn_s_setprio(0); } while (0)
#define PG8_WAIT_V(n) asm volatile("s_waitcnt vmcnt(" #n ")" ::: "memory")
#define PG8_WAIT_L(n) asm volatile("s_waitcnt lgkmcnt(" #n ")" ::: "memory")
#define PG8_BAR __builtin_amdgcn_s_barrier()
#define PG8_SCHED __builtin_amdgcn_sched_barrier(0)
    Unit cur, nxt; int ui = 0;
    if (!S.next(0, cur)) return;
    f32x4 acc[2][2][4][2];
#pragma unroll
    for (int a = 0; a < 2; ++a)
#pragma unroll
        for (int b = 0; b < 2; ++b)
#pragma unroll
            for (int m = 0; m < MA; ++m)
#pragma unroll
                for (int n = 0; n < 2; ++n) acc[a][b][m][n] = (f32x4){0.f, 0.f, 0.f, 0.f};
    bf16x8 At[4][2], B0[2][2], B1[2][2];
    const char* cA = (const char*)g.A + (size_t)cur.pm * tstepA; const char* cB = (const char*)g.Bt + (size_t)cur.pn * tstep;
    S.a_ready(cur);
    f32x4 pre[2][2][4][2];
    if constexpr (Epi::AFTER_DRAIN) E.prefetch(pre, cur, wr, wc, fr, fq);
    if constexpr (SP2) {
        PG8_STAGE(PG8_SB(0, 0), cB, voffB); PG8_STAGE(PG8_SB(0, 1), cB + hstep, voffB); PG8_STAGE(PG8_SA(0, 0), cA, voffA); PG8_STAGE(PG8_SA(0, 1), cA + hstepA, voffA);
        if (wr == 1) PG8_BAR;
        PG8_WAIT_V(2); PG8_BAR;
        PG8_STAGE(PG8_SB(1, 0), cB + kstep, voffB); PG8_STAGE(PG8_SA(1, 0), cA + kstep, voffA); PG8_STAGE(PG8_SB(1, 1), cB + hstep + kstep, voffB);
        PG8_WAIT_V(6); PG8_BAR;
    } else {
        PG8_STAGE(PG8_SB(0, 0), cB, voffB); PG8_STAGE(PG8_SA(0, 0), cA, voffA); PG8_STAGE(PG8_SB(0, 1), cB + hstep, voffB); PG8_STAGE(PG8_SA(0, 1), cA + hstepA, voffA);
        if (wr == 1) PG8_BAR;
        PG8_WAIT_V(4); PG8_BAR;
        PG8_STAGE(PG8_SB(1, 0), cB + kstep, voffB); PG8_STAGE(PG8_SA(1, 0), cA + kstep, voffA); PG8_STAGE(PG8_SB(1, 1), cB + hstep + kstep, voffB);
        PG8_WAIT_V(6); PG8_BAR;
    }
    for (;;) {
        const bool has_next = S.next(ui + 1, nxt);
        const char* nA = has_next ? (const char*)g.A + (size_t)nxt.pm * tstepA : cA; const char* nB = has_next ? (const char*)g.Bt + (size_t)nxt.pn * tstep : cB;
        for (int t = 0; t < nt; t += 2) {
            const bool last = (t == nt - 2);
            const char* a1 = cA + (size_t)(t + 1) * kstep;
            const char* a2 = last ? nA : cA + (size_t)(t + 2) * kstep; const char* b2 = last ? nB : cB + (size_t)(t + 2) * kstep;
            const char* a3 = a2 + kstep; const char* b3 = b2 + kstep;
            if (last && has_next) S.a_ready(nxt);
            if constexpr (SP2) {
            PG8_LDB(B0, 0, 0); PG8_LDB(B1, 0, 1); PG8_SCHED; PG8_LDA(At, 0, 0); PG8_STAGE(PG8_SA(1, 1), a1 + hstepA, voffA);
            PG8_WAIT_V(8); PG8_WAIT_L(0); PG8_BAR; PG8_MMA(0, 0, At, B0); PG8_MMA(0, 1, At, B1); PG8_BAR; PG8_SCHED;
            PG8_LDA(At, 0, 1); PG8_STAGE(PG8_SB(0, 0), b2, voffB); PG8_STAGE(PG8_SB(0, 1), b2 + hstep, voffB); PG8_STAGE(PG8_SA(0, 0), a2, voffA);
            PG8_WAIT_V(8); PG8_WAIT_L(0); PG8_BAR; PG8_MMA(1, 0, At, B0); PG8_MMA(1, 1, At, B1); PG8_BAR; PG8_SCHED;
            PG8_LDB(B0, 1, 0); PG8_LDB(B1, 1, 1); PG8_SCHED; PG8_LDA(At, 1, 0); PG8_STAGE(PG8_SA(0, 1), a2 + hstepA, voffA);
            PG8_WAIT_V(8); PG8_WAIT_L(0); PG8_BAR; PG8_MMA(0, 0, At, B0); PG8_MMA(0, 1, At, B1); PG8_BAR; PG8_SCHED;
            PG8_LDA(At, 1, 1); PG8_STAGE(PG8_SB(1, 0), b3, voffB); PG8_STAGE(PG8_SB(1, 1), b3 + hstep, voffB); PG8_STAGE(PG8_SA(1, 0), a3, voffA);
            PG8_WAIT_V(8); PG8_WAIT_L(0); PG8_BAR; PG8_MMA(1, 0, At, B0); PG8_MMA(1, 1, At, B1); PG8_BAR; PG8_SCHED;
            } else {
            PG8_LDB(B0, 0, 0); PG8_SCHED; PG8_LDA(At, 0, 0); PG8_STAGE(PG8_SA(1, 1), a1 + hstepA, voffA);
            PG8_WAIT_L(8); PG8_BAR; PG8_WAIT_L(0); PG8_MMA(0, 0, At, B0); PG8_BAR; PG8_SCHED;
            PG8_LDB(B1, 0, 1); PG8_STAGE(PG8_SB(0, 0), b2, voffB);
            PG8_BAR; PG8_WAIT_L(0); PG8_MMA(0, 1, At, B1); PG8_BAR;
            PG8_LDA(At, 0, 1); PG8_STAGE(PG8_SA(0, 0), a2, voffA);
            PG8_BAR; PG8_WAIT_L(0); PG8_MMA(1, 0, At, B0); PG8_BAR; PG8_SCHED;
            PG8_STAGE(PG8_SB(0, 1), b2 + hstep, voffB);
            PG8_WAIT_V(6); PG8_BAR; PG8_MMA(1, 1, At, B1); PG8_BAR;
            PG8_LDB(B0, 1, 0); PG8_SCHED; PG8_LDA(At, 1, 0); PG8_STAGE(PG8_SA(0, 1), a2 + hstepA, voffA);
            PG8_WAIT_L(8); PG8_BAR; PG8_WAIT_L(0); PG8_MMA(0, 0, At, B0); PG8_BAR; PG8_SCHED;
            PG8_LDB(B1, 1, 1); PG8_STAGE(PG8_SB(1, 0), b3, voffB);
            PG8_BAR; PG8_WAIT_L(0); PG8_MMA(0, 1, At, B1); PG8_BAR;
            PG8_LDA(At, 1, 1); PG8_STAGE(PG8_SA(1, 0), a3, voffA);
            PG8_BAR; PG8_WAIT_L(0); PG8_MMA(1, 0, At, B0); PG8_BAR; PG8_SCHED;
            PG8_STAGE(PG8_SB(1, 1), b3 + hstep, voffB);
            PG8_WAIT_V(6); PG8_BAR; PG8_MMA(1, 1, At, B1); PG8_BAR;
            }
        }
        if constexpr (ALIGN_EPI) { if (wr == 0) PG8_BAR; }
        if constexpr (!Epi::AFTER_DRAIN) { E(acc, cur, wr, wc, fr, fq); S.done(cur); }
        if (!has_next) break;
#pragma unroll
        for (int a = 0; a < 2; ++a)
#pragma unroll
            for (int b = 0; b < 2; ++b)
#pragma unroll
                for (int m = 0; m < MA; ++m)
#pragma unroll
                    for (int n = 0; n < 2; ++n) acc[a][b][m][n] = (f32x4){0.f, 0.f, 0.f, 0.f};
        cur = nxt; cA = nA; cB = nB; ++ui;
        if constexpr (ALIGN_EPI) { if (wr == 1) PG8_BAR; }
    }
    PG8_WAIT_V(0);
    if constexpr (!ALIGN_EPI) { if (wr == 0) PG8_BAR; }
    PG8_BAR;
    if constexpr (Epi::AFTER_DRAIN) { E.fused(acc, pre, cur, wr, wc, fr, fq, lds, wid, lane); S.done(cur); }
#undef PG8_SA
#undef PG8_SB
#undef PG8_STAGE
#undef PG8_LDA
#undef PG8_LDB
#undef PG8_MMA
#undef PG8_WAIT_V
#undef PG8_WAIT_L
#undef PG8_BAR
#undef PG8_SCHED
}
}
#ifndef XB_DIRECT
#define XB_DIRECT 0
#endif
#ifndef XB_EARLY_FLUSH
#define XB_EARLY_FLUSH 0
#endif
#define XB_TMO      128
#define XB_XCNT(j)  (256  + 64 * (j))
#define XB_XSUB(j)  (1280 + 64 * (j))
#define XB_XGEN(j)  (2304 + 64 * (j))
#define XB_TOP      3328
#define XB_TOPGEN   3392
#define XCD_BAR_WORDS 3456
#define XB_SPIN_CAP (1u << 18)

__device__ __forceinline__ unsigned xb_ld(unsigned* p)              { return __hip_atomic_load(p, __ATOMIC_RELAXED, __HIP_MEMORY_SCOPE_AGENT); }
__device__ __forceinline__ unsigned xb_add(unsigned* p, unsigned v) { return __hip_atomic_fetch_add(p, v, __ATOMIC_RELAXED, __HIP_MEMORY_SCOPE_AGENT); }
__device__ __forceinline__ unsigned xb_xcc_id() { return (unsigned)__builtin_amdgcn_s_getreg((3 << 11) | 20) & 0xFu; }
#define XB_SPIN(cond, bar) do { unsigned _sp = 0; while (cond) { __builtin_amdgcn_s_sleep(1); \
    if ((++_sp & 255u) == 0u) { if (xb_ld(&(bar)[XB_TMO])) break; if (_sp > XB_SPIN_CAP) { atomicAdd(&(bar)[XB_TMO], 1u); break; } } } } while (0)

struct XcdBarrier {
    unsigned* bar; unsigned x;
    volatile LAS unsigned* st;
};

__device__ __forceinline__ XcdBarrier xcd_barrier_post(unsigned* bar, volatile LAS unsigned* st) {
    XcdBarrier b; b.bar = bar; b.x = xb_xcc_id(); b.st = st;
    if (threadIdx.x == 0) (void)xb_add(&bar[XB_XCNT(b.x)], 1u);
    return b;
}
__device__ __forceinline__ void xcd_barrier_complete(unsigned* bar, unsigned x, unsigned& nloc, unsigned& nx) {
    const unsigned G = gridDim.x * gridDim.y * gridDim.z;
    unsigned sum, cnt, mine, sp = 0u;
    for (;;) {
        sum = 0u; cnt = 0u; mine = 0u;
#pragma unroll
        for (unsigned j = 0; j < 16; ++j) { const unsigned c = xb_ld(&bar[XB_XCNT(j)]); sum += c; cnt += (c > 0u) ? 1u : 0u; mine = (j == x) ? c : mine; }
        if (sum == G) break;
        __builtin_amdgcn_s_sleep(1);
        if ((++sp & 255u) == 0u) { if (xb_ld(&bar[XB_TMO])) break; if (sp > XB_SPIN_CAP) { atomicAdd(&bar[XB_TMO], 1u); break; } }
    }
    nloc = mine > 0u ? mine : 1u; nx = cnt > 0u ? cnt : 1u;
}

__device__ __forceinline__ void xcd_barrier(const XcdBarrier& b) {
    asm volatile("s_waitcnt vmcnt(0)" ::: "memory");
    __syncthreads();
    if (threadIdx.x == 0) {
        unsigned* bar = b.bar;
        __builtin_amdgcn_s_waitcnt(0);
        unsigned nloc = b.st[0], nx = b.st[1];
        if (nloc == 0u) { xcd_barrier_complete(bar, b.x, nloc, nx); b.st[0] = nloc; b.st[1] = nx; }
#if XB_EARLY_FLUSH
        __builtin_amdgcn_fence(__ATOMIC_RELEASE, "agent");
        asm volatile("s_waitcnt vmcnt(0)" ::: "memory");
#endif
        const unsigned old = xb_add(&bar[XB_XSUB(b.x)], 1u);
        const unsigned gen = old / nloc;
#if XB_DIRECT
        if (old + 1u == (gen + 1u) * nloc) {
            __builtin_amdgcn_fence(__ATOMIC_RELEASE, "agent");
            asm volatile("s_waitcnt vmcnt(0)" ::: "memory");
            (void)xb_add(&bar[XB_TOP], 1u);
        }
        { const unsigned target = (gen + 1u) * nx; XB_SPIN(xb_ld(&bar[XB_TOP]) < target, bar); }
        __builtin_amdgcn_fence(__ATOMIC_ACQUIRE, "agent");
        asm volatile("s_waitcnt vmcnt(0)" ::: "memory");
#else
        if (old + 1u == (gen + 1u) * nloc) {
            __builtin_amdgcn_fence(__ATOMIC_RELEASE, "agent");
            asm volatile("s_waitcnt vmcnt(0)" ::: "memory");
            const unsigned og = xb_add(&bar[XB_TOP], 1u);
            const unsigned tg = og / nx;
            if (og + 1u == (tg + 1u) * nx) xb_add(&bar[XB_TOPGEN], 1u);
            else XB_SPIN(xb_ld(&bar[XB_TOPGEN]) == tg, bar);
            __builtin_amdgcn_fence(__ATOMIC_ACQUIRE, "agent");
            xb_add(&bar[XB_XGEN(b.x)], 1u);
            asm volatile("s_waitcnt vmcnt(0)" ::: "memory");
        } else {
            XB_SPIN(xb_ld(&bar[XB_XGEN(b.x)]) == gen, bar);
            __builtin_amdgcn_fence(__ATOMIC_ACQUIRE, "agent");
            asm volatile("s_waitcnt vmcnt(0)" ::: "memory");
        }
#endif
    }
    __syncthreads();
}

constexpr int NWAVES = 8, NTHR = 512;
constexpr int LDS_BYTES = 147456;
constexpr int MISC_OFF = 147456 - 256;
constexpr int CW_BAR = 4096;

struct Args {
    const float* in[32];
    float* out;
    unsigned char* ws;
    int ph_lo, ph_hi;
};

struct Ctx {
    LAS unsigned char* lds;
    unsigned char* ldsg;
    int tid, lane, wave, G, bid;
};


#ifndef PROF_ID
#define PROF_ID 0
#endif
#ifndef PROF_K
#define PROF_K 8
#endif
#define PROF_BEGIN(id) unsigned long long pt0_##id = 0; if (PROF_ID == (id)) pt0_##id = __builtin_amdgcn_s_memrealtime();
#define PROF_END(id) if (PROF_ID == (id) && threadIdx.x == 0) { const unsigned dt_ = (unsigned)(__builtin_amdgcn_s_memrealtime() - pt0_##id); ((volatile LAS unsigned*)(X.lds + MISC_OFF))[16] += dt_; }

__device__ __forceinline__ int opaque_v(int x) { asm volatile("" : "+v"(x)); return x; }
__device__ __forceinline__ int opaque_s(int x) { asm volatile("" : "+s"(x)); return x; }
__device__ __forceinline__ int map_even(int dg) {
    if (dg < 24) return dg;
    if (dg < 152) return dg + 2;
    if (dg < 216) return dg + 3;
    if (dg < 218) return dg - 192;
    if (dg == 218) return 154;
    return -1;
}
__device__ __forceinline__ void transpose_item(const float* W, int ldn, int K, bf16* WT, int k0, int n0, int ca, int cb, LAS float* scr, int lane, bool frag = false) {
    const int kq = lane >> 3, nq = lane & 7; const int sc = (nq < 4) ? ca : cb;
    f32x4 tv[8];
#pragma unroll
    for (int i = 0; i < 8; ++i) tv[i] = sc >= 0 ? *(const f32x4*)(W + (size_t)(k0 + 8 * i + kq) * ldn + sc + 4 * (nq & 3)) : (f32x4){0.f, 0.f, 0.f, 0.f};
    SB_PIN
#pragma unroll
    for (int i = 0; i < 8; ++i) { LAS float* d = scr + (8 * i + kq) * 33 + 4 * nq; d[0] = tv[i].x; d[1] = tv[i].y; d[2] = tv[i].z; d[3] = tv[i].w; }
    LDS_WAIT(); asm volatile("" ::: "memory");
    const int c = lane & 7;
#pragma unroll
    for (int j = 0; j < 4; ++j) { const int nn = (lane >> 3) + 8 * j; const LAS float* s = scr + (8 * c) * 33 + nn;
        v4u o; o.x = pk2(s[0 * 33], s[1 * 33]); o.y = pk2(s[2 * 33], s[3 * 33]); o.z = pk2(s[4 * 33], s[5 * 33]); o.w = pk2(s[6 * 33], s[7 * 33]);
        bf16* dst = frag ? WT + ((size_t)((n0 + nn) >> 5) * (K >> 4) + ((k0 + 8 * c) >> 4)) * 512 + ((((k0 + 8 * c) >> 3) & 1) * 32 + ((n0 + nn) & 31)) * 8 : WT + (size_t)(n0 + nn) * K + k0 + 8 * c;
        *(v4u*)dst = o; }
    LDS_WAIT(); asm volatile("" ::: "memory");
}

__device__ __forceinline__ void norm_load(const Args& a, const Ctx& X, int l, f32x4 (&v)[3][4]) {
    const float* ysp = l == 0 ? a.in[0] : a.out; const float* yss = l == 0 ? a.in[1] : a.out + (size_t)NP * DM;
    const int lane = opaque_v(X.tid) & 63; const int gw = X.bid * NWAVES + opaque_s(X.wave), NGW = X.G * NWAVES;
#pragma unroll
    for (int q = 0; q < 3; ++q) { const int r = gw + q * NGW; const float* y = r < NP ? ysp + (size_t)r * DM : yss + (size_t)(r - NP) * DM;
#pragma unroll
        for (int j = 0; j < 4; ++j) v[q][j] = r < NT ? *(const f32x4*)(y + 4 * lane + 256 * j) : (f32x4){0.f, 0.f, 0.f, 0.f}; }
    SB_PIN
}
__device__ __forceinline__ void norm_finish(const Args& a, const Ctx& X, int l, f32x4 (&v)[3][4]) {
    const float* nw = a.in[11] + l * DM;
    const float* modl = (const float*)(a.ws + WS_MOD) + l * 3 * 3072;
    bf16* H = (bf16*)(a.ws + WS_H);
    const int lane = opaque_v(X.tid) & 63; const int gw = X.bid * NWAVES + opaque_s(X.wave), NGW = X.G * NWAVES;
#pragma unroll
    for (int q = 0; q < 3; ++q) { const int r = gw + q * NGW; if (r < NT) {
        const float* md = modl + cond_of_row(r) * 3072;
        float ss = 0.f;
#pragma unroll
        for (int j = 0; j < 4; ++j) ss += (v[q][j].x * v[q][j].x + v[q][j].y * v[q][j].y) + (v[q][j].z * v[q][j].z + v[q][j].w * v[q][j].w);
        const float rstd = rsqrtf(wave_sum(ss) * (1.f / DM) + EPS);
#pragma unroll
        for (int j = 0; j < 4; ++j) { const int k = 4 * lane + 256 * j;
            const f32x4 g = *(const f32x4*)(nw + k), sh = *(const f32x4*)(md + k), sc = *(const f32x4*)(md + 1024 + k);
            const f32x4 o = v[q][j] * rstd * g * (sc + 1.f) + sh;
            st4bf(H + (size_t)r * DM + k, o.x, o.y, o.z, o.w); }
    } }
}

__device__ __forceinline__ void mod_unit(const Args& a, const Ctx& X, int l, int chunk, int tid, int lane, int wave) {
    LAS float* scs = (LAS float*)X.lds;
    LAS float* part = scs + 3072;
    const float* c_ctx = a.in[10]; const float* c = a.in[2];
    for (int i = tid; i < 3072; i += NTHR) { const int r = i >> 10, k = i & 1023; const float v = r == 0 ? c_ctx[k] : c[(r - 1) * 1024 + k]; scs[i] = v / (1.f + expf(-v)); }
    __syncthreads();
    const int j0 = chunk * 64;
    const float* w = a.in[12] + (size_t)l * 1024 * 3072 + j0 + lane;
    float a0 = 0.f, a1 = 0.f, a2 = 0.f;
#pragma unroll
    for (int hk = 0; hk < 2; ++hk) { float wv[64];
#pragma unroll
        for (int kk = 0; kk < 64; ++kk) wv[kk] = w[(size_t)(wave * 128 + hk * 64 + kk) * 3072];
        SB_PIN
#pragma unroll
        for (int kk = 0; kk < 64; ++kk) { const int k = wave * 128 + hk * 64 + kk; a0 += scs[k] * wv[kk]; a1 += scs[1024 + k] * wv[kk]; a2 += scs[2048 + k] * wv[kk]; } }
    part[(wave * 3 + 0) * 64 + lane] = a0; part[(wave * 3 + 1) * 64 + lane] = a1; part[(wave * 3 + 2) * 64 + lane] = a2;
    __syncthreads();
    if (tid < 192) { const int r = tid >> 6, cc = tid & 63; float s = 0.f;
#pragma unroll
        for (int w8 = 0; w8 < 8; ++w8) s += part[(w8 * 3 + r) * 64 + cc];
        __hip_atomic_store((unsigned*)(a.ws + WS_MOD) + (l * 3 + r) * 3072 + j0 + cc, __builtin_bit_cast(unsigned, s + a.in[13][l * 3072 + j0 + cc]), __ATOMIC_RELAXED, __HIP_MEMORY_SCOPE_AGENT); }
    asm volatile("s_waitcnt vmcnt(0)" ::: "memory");
    __syncthreads();
}
__device__ __forceinline__ void mod_unit32(const Args& a, const Ctx& X, int chunk, int tid, int lane, int wave) {
    LAS float* scs = (LAS float*)X.lds;
    LAS float* part = scs + 3072;
    const float* c_ctx = a.in[10]; const float* c = a.in[2];
    const int j0 = chunk * 32, col = lane & 31, kp = lane >> 5;
    const float* w = a.in[12] + j0 + col;
    float wv[64];
#pragma unroll
    for (int kk = 0; kk < 64; ++kk) wv[kk] = w[(size_t)(wave * 128 + 2 * kk + kp) * 3072];
    SB_PIN
    for (int i = tid; i < 3072; i += NTHR) { const int r = i >> 10, k = i & 1023; const float v = r == 0 ? c_ctx[k] : c[(r - 1) * 1024 + k]; scs[i] = v / (1.f + expf(-v)); }
    __syncthreads();
    float a0 = 0.f, a1 = 0.f, a2 = 0.f;
#pragma unroll
    for (int kk = 0; kk < 64; ++kk) { const int k = wave * 128 + 2 * kk + kp; a0 += scs[k] * wv[kk]; a1 += scs[1024 + k] * wv[kk]; a2 += scs[2048 + k] * wv[kk]; }
    a0 += __shfl_xor(a0, 32); a1 += __shfl_xor(a1, 32); a2 += __shfl_xor(a2, 32);
    if (kp == 0) { part[(wave * 3 + 0) * 32 + col] = a0; part[(wave * 3 + 1) * 32 + col] = a1; part[(wave * 3 + 2) * 32 + col] = a2; }
    __syncthreads();
    if (tid < 96) { const int r = tid >> 5, cc = tid & 31; float s = 0.f;
#pragma unroll
        for (int w8 = 0; w8 < 8; ++w8) s += part[(w8 * 3 + r) * 32 + cc];
        __hip_atomic_store((unsigned*)(a.ws + WS_MOD) + r * 3072 + j0 + cc, __builtin_bit_cast(unsigned, s + a.in[13][j0 + cc]), __ATOMIC_RELAXED, __HIP_MEMORY_SCOPE_AGENT); }
    asm volatile("s_waitcnt vmcnt(0)" ::: "memory");
    __syncthreads();
    if (tid == 0) __hip_atomic_fetch_add((unsigned*)(a.ws + WS_CTL + CTL_MODCNT), 1u, __ATOMIC_RELAXED, __HIP_MEMORY_SCOPE_AGENT);
}
__device__ __forceinline__ void prep_weights(const Args& a, const Ctx& X, int l, int gw, int NGW, int lane, int wave, int it_lo = 0, int it_hi = 1 << 30) {
    unsigned char* ws = a.ws;
    LAS float* scr = (LAS float*)(X.lds + 32768 + wave * 8448);
    const int j = l >> 1;
    if ((l & 1) == 0) {
        for (int it = it_lo + gw; it < (it_hi < 2464 ? it_hi : 2464); it += NGW) {
            if (it < 1792) { const int nb = it % 112, kb = it / 112;
                transpose_item(a.in[14] + (size_t)j * 1024 * 3504, 3504, 1024, (bf16*)(ws + WS_WTEV) + (size_t)j * 3584 * 1024, kb * 64, nb * 32,
                               map_even(2 * nb) < 0 ? -1 : map_even(2 * nb) * 16, map_even(2 * nb + 1) < 0 ? -1 : map_even(2 * nb + 1) * 16, scr, lane);
            } else if (it < 2304) { const int r = it - 1792, nb = r % 32, kb = r / 32;
                transpose_item(a.in[24] + (size_t)j * 1024 * 1024, 1024, 1024, (bf16*)(ws + WS_WTOUT) + (size_t)l * 1024 * 1024, kb * 64, nb * 32, nb * 32, nb * 32 + 16, scr, lane);
            } else if (it < 2400) { const int r = it - 2304, nb = r % 24, kb = r / 24;
                transpose_item(a.in[17] + (size_t)j * 256 * 768, 768, 256, (bf16*)(ws + WS_WTQB) + (size_t)j * 768 * 256, kb * 64, nb * 32, nb * 32, nb * 32 + 16, scr, lane, true);
            } else { const int r = it - 2400, nb = r % 32, kb = r / 32;
                transpose_item(a.in[18] + (size_t)j * 128 * 1024, 1024, 128, (bf16*)(ws + WS_WTKVB) + (size_t)j * 1024 * 128, kb * 64, nb * 32, nb * 32, nb * 32 + 16, scr, lane, true);
            }
        }
    } else {
        for (int it = it_lo + gw; it < (it_hi < 2560 ? it_hi : 2560); it += NGW) {
            if (it < 2048) { const int nb = it % 128, kb = it / 128;
                transpose_item(a.in[25] + (size_t)j * 1024 * 4096, 4096, 1024, (bf16*)(ws + WS_WTOD) + (size_t)j * 4096 * 1024, kb * 64, nb * 32, nb * 32, nb * 32 + 16, scr, lane);
            } else { const int r = it - 2048, nb = r % 32, kb = r / 32;
                transpose_item(a.in[31] + (size_t)j * 1024 * 1024, 1024, 1024, (bf16*)(ws + WS_WTOUT) + (size_t)l * 1024 * 1024, kb * 64, nb * 32, nb * 32, nb * 32 + 16, scr, lane);
            }
        }
    }
}
__device__ __forceinline__ void phase_p0a(const Args& a, const Ctx& X) {
    unsigned char* ws = a.ws;
    const int tid = opaque_v(X.tid), lane = tid & 63, wave = opaque_s(X.wave);
    f32x4 nv[3][4];
    norm_load(a, X, 0, nv);
    PROF_BEGIN(30)
    if (X.bid < 96) { PROF_BEGIN(36) mod_unit32(a, X, X.bid, tid, lane, wave); PROF_END(36) }
    else {
        if (X.bid == 192) {
            const int pos = tid >> 3, f = tid & 7;
            const float ang = (float)pos * powf(10000.f, -(float)f / 8.f);
            float* rt = (float*)(ws + WS_ROPE);
            rt[pos * 16 + f] = cosf(ang); rt[pos * 16 + 8 + f] = sinf(ang);
        }
        const int nthr = 160 * NTHR, base = (X.bid - 96) * NTHR + tid;
        const float* ck = a.in[8]; const float* cv = a.in[9]; const float* c0 = a.in[5];
        bf16* nakc = (bf16*)(ws + WS_NAKC); bf16* navc = (bf16*)(ws + WS_NAVC); float* c0t = (float*)(ws + WS_C0T);
        float vk[7], vv[7], vc[7];
#pragma unroll
        for (int i = 0; i < 7; ++i) { const int idx = base + i * nthr; const bool ok = idx < 524288; vk[i] = ok ? ck[idx] : 0.f; vv[i] = ok ? cv[idx] : 0.f; vc[i] = ok ? c0[idx] : 0.f; }
        SB_PIN
#pragma unroll
        for (int i = 0; i < 7; ++i) { const int idx = base + i * nthr; if (idx < 524288) {
            const int d = idx & 63, h = (idx >> 6) & 7, key = (idx >> 9) & 255, bj = idx >> 17;
            { const size_t blk = ((size_t)(bj * 8 + h) * 8 + (key >> 5)) * 4; const int kr = key & 31, t16 = key & 15;
              nakc[(blk + (d >> 4)) * 512 + (((d >> 3) & 1) * 32 + kr) * 8 + (d & 7)] = (bf16)(pk2(vk[i] / a.in[29][(bj & 1) * 64 + d], 0.f) & 0xffffu);
              navc[(blk + (d >> 5) * 2 + (kr >> 4)) * 512 + (((t16 >> 2) & 1) * 32 + (d & 31)) * 8 + 4 * (t16 >> 3) + (t16 & 3)] = (bf16)(pk2(vv[i], 0.f) & 0xffffu); }
            const int e = idx & 127, dd = (idx >> 7) & 127, mat = idx >> 14;
            c0t[(size_t)mat * 16384 + e * 128 + dd] = vc[i];
        } }
    }
    PROF_END(30)
    PROF_BEGIN(31)
    if (X.bid >= 96) prep_weights(a, X, 0, (X.bid - 96) * NWAVES + wave, 160 * NWAVES, lane, wave, 0, 1792);
    PROF_END(31)
    PROF_BEGIN(32)
    if (tid == 0) { unsigned sp = 0; while (__hip_atomic_load((unsigned*)(ws + WS_CTL + CTL_MODCNT), __ATOMIC_RELAXED, __HIP_MEMORY_SCOPE_AGENT) < 96u && ++sp < (1u << 20)) __builtin_amdgcn_s_sleep(2);
        __builtin_amdgcn_fence(__ATOMIC_ACQUIRE, "agent"); asm volatile("s_waitcnt vmcnt(0)" ::: "memory"); }
    __syncthreads();
    PROF_END(32)
    PROF_BEGIN(33)
    norm_finish(a, X, 0, nv);
    PROF_END(33)
}
__device__ __forceinline__ void prep_side(const Args& a, const Ctx& X, int slot) {
    const int tid = opaque_v(X.tid), lane = tid & 63, wave = opaque_s(X.wave);
    const bool modslot = slot == 0 || slot == 1 || slot == 3;
    __syncthreads();
    int gw = (X.bid - 192) * NWAVES + wave, NGW = 64 * NWAVES, reps = 1;
    if (modslot) { NGW = 768; if (X.bid < 240) mod_unit(a, X, slot == 0 ? 1 : slot == 1 ? 2 : 3, X.bid - 192, tid, lane, wave); else { gw = 384 + (X.bid - 240) * NWAVES + wave; reps = 3; } }
#pragma unroll 1
    for (int rep = 0; rep < reps; ++rep, gw += 128) {
        if (slot == 0) { prep_weights(a, X, 0, gw, NGW, lane, wave, 1792, 2464); prep_weights(a, X, 1, gw, NGW, lane, wave, 0, 512); }
        else if (slot == 1) prep_weights(a, X, 1, gw, NGW, lane, wave, 512, 2560);
        else if (slot == 2) prep_weights(a, X, 2, gw, NGW, lane, wave, 0, 2464);
        else if (slot == 3) prep_weights(a, X, 3, gw, NGW, lane, wave, 0, 768);
        else prep_weights(a, X, 3, gw, NGW, lane, wave, 768, 2560);
    }
}

__device__ __forceinline__ void unit_mla_q(const Args& a, const Ctx& X, int j, int t) {
    const bf16* U = (const bf16*)(a.ws + WS_U); bf16* Q = (bf16*)(a.ws + WS_Q);
    const bf16* Wq = (const bf16*)(a.ws + WS_WTQB) + (size_t)j * 768 * 256;
    const float* rope = (const float*)(a.ws + WS_ROPE);
    const float* qan = a.in[15] + j * 256; const float* qn = a.in[19] + j * 96;
    bf16* Xn = (bf16*)X.ldsg;
    const int tid = opaque_v(X.tid), lane = tid & 63, w = opaque_s(X.wave), r = lane & 31, hh = lane >> 5, R0 = t * 64; (void)tid;
    PROF_BEGIN(20)
    { v2u raw8[8]; const f32x4 g = *(const f32x4*)(qan + 4 * lane);
#pragma unroll
      for (int i = 0; i < 8; ++i) raw8[i] = *(const v2u*)(U + (size_t)(R0 + 8 * w + i) * UE + CE_QA + 4 * lane);
      SB_PIN
#pragma unroll
      for (int i = 0; i < 8; ++i) { const int row = 8 * w + i; const v2u raw = raw8[i];
        const float x0 = bflo(raw.x), x1 = bfhi(raw.x), x2 = bflo(raw.y), x3 = bfhi(raw.y);
        const float rstd = rsqrtf(wave_sum(x0 * x0 + x1 * x1 + x2 * x2 + x3 * x3) * (1.f / 256.f) + EPS);
        st4bf(Xn + row * 264 + 4 * lane, x0 * rstd * g.x, x1 * rstd * g.y, x2 * rstd * g.z, x3 * rstd * g.w); } }
    __syncthreads();
    PROF_END(20)
    PROF_BEGIN(21)
    f32x16 acc[3][2];
#pragma unroll
    for (int fb = 0; fb < 3; ++fb)
#pragma unroll
        for (int tb = 0; tb < 2; ++tb)
#pragma unroll
            for (int i = 0; i < 16; ++i) acc[fb][tb][i] = 0.f;
    const bf16* wp = Wq + (size_t)(w * 3) * 16 * 512 + lane * 8;
    const bf16* xp = Xn + r * 264 + 8 * hh;
#pragma unroll
    for (int kh = 0; kh < 4; ++kh) {
        bh8 af[4][3];
#pragma unroll
        for (int k8 = 0; k8 < 4; ++k8)
#pragma unroll
            for (int fb = 0; fb < 3; ++fb) af[k8][fb] = ld16(wp + (size_t)(fb * 16 + kh * 4 + k8) * 512);
        SB_PIN
#pragma unroll
        for (int k8 = 0; k8 < 4; ++k8) { const int ks = kh * 4 + k8; bh8 bfr[2];
#pragma unroll
            for (int tb = 0; tb < 2; ++tb) bfr[tb] = ld16(xp + tb * 32 * 264 + 16 * ks);
#pragma unroll
            for (int fb = 0; fb < 3; ++fb)
#pragma unroll
                for (int tb = 0; tb < 2; ++tb) acc[fb][tb] = mfma32(af[k8][fb], bfr[tb], acc[fb][tb]); }
        SB_PIN
    }
    PROF_END(21)
    PROF_BEGIN(22)
    f32x4 gnv[3][4]; f32x4 rpv[2][4];
#pragma unroll
    for (int fb = 0; fb < 3; ++fb)
#pragma unroll
        for (int g = 0; g < 4; ++g) gnv[fb][g] = *(const f32x4*)(qn + 32 * fb + 8 * g + 4 * hh);
#pragma unroll
    for (int tb = 0; tb < 2; ++tb) { const int row = R0 + 32 * tb + r; const int tp = (row - NP) & 1023;
        const float* rr_ = rope + (tp >> 6) * 16 + 4 * hh; const float* rc_ = rope + (tp & 63) * 16 + 4 * hh;
        if (R0 >= NP) { rpv[tb][0] = *(const f32x4*)rr_; rpv[tb][1] = *(const f32x4*)(rr_ + 8); rpv[tb][2] = *(const f32x4*)rc_; rpv[tb][3] = *(const f32x4*)(rc_ + 8); }
        else { rpv[tb][0] = rpv[tb][1] = rpv[tb][2] = rpv[tb][3] = (f32x4){0.f, 0.f, 0.f, 0.f}; } }
    SB_PIN
#pragma unroll
    for (int tb = 0; tb < 2; ++tb) {
        float ss = 0.f;
#pragma unroll
        for (int fb = 0; fb < 3; ++fb)
#pragma unroll
            for (int i = 0; i < 16; ++i) ss += acc[fb][tb][i] * acc[fb][tb][i];
        ss += __shfl_xor(ss, 32);
        const float rstd = rsqrtf(ss * (1.f / 96.f) + EPS) * (0.10206207261596577f * 1.4426950408889634f);
        const int row = R0 + 32 * tb + r;
        const bool sample = row >= NP; const int tp = (row - NP) & 1023;
#pragma unroll
        for (int fb = 0; fb < 3; ++fb) {
            float v[16];
#pragma unroll
            for (int g = 0; g < 4; ++g) { const f32x4 gn = gnv[fb][g];
                v[4 * g + 0] = acc[fb][tb][4 * g + 0] * rstd * gn.x; v[4 * g + 1] = acc[fb][tb][4 * g + 1] * rstd * gn.y;
                v[4 * g + 2] = acc[fb][tb][4 * g + 2] * rstd * gn.z; v[4 * g + 3] = acc[fb][tb][4 * g + 3] * rstd * gn.w; }
            if (fb == 2 && sample) {
#pragma unroll
                for (int e = 0; e < 4; ++e) {
                    float cs = rpv[tb][0][e], sn = rpv[tb][1][e], x1 = v[e], x2 = v[4 + e];
                    v[e] = x1 * cs - x2 * sn; v[4 + e] = x1 * sn + x2 * cs;
                    cs = rpv[tb][2][e]; sn = rpv[tb][3][e]; x1 = v[8 + e]; x2 = v[12 + e];
                    v[8 + e] = x1 * cs - x2 * sn; v[12 + e] = x1 * sn + x2 * cs;
                }
            }
#pragma unroll
            for (int g = 0; g < 4; ++g)
                st4bf(Q + ((size_t)((row >> 5) * 8 + w) * 6 + (2 * fb + (g >> 1))) * 512 + ((g & 1) * 32 + (row & 31)) * 8 + 4 * hh, v[4 * g], v[4 * g + 1], v[4 * g + 2], v[4 * g + 3]);
        }
    }
    LDS_BARRIER();
    PROF_END(22)
}

__device__ __forceinline__ void unit_mla_kv(const Args& a, const Ctx& X, int j, int t) {
    const bf16* U = (const bf16*)(a.ws + WS_U); bf16* KM = (bf16*)(a.ws + WS_KM); bf16* VTM = (bf16*)(a.ws + WS_VTM);
    const bf16* Wkv = (const bf16*)(a.ws + WS_WTKVB) + (size_t)j * 1024 * 128;
    const float* rope = (const float*)(a.ws + WS_ROPE);
    const float* kvan = a.in[16] + j * 128; const float* kn = a.in[20] + j * 96;
    bf16* Xc = (bf16*)X.ldsg;
    float* kpes = (float*)(X.ldsg + 17408);
    const int tid = opaque_v(X.tid), lane = tid & 63, w = opaque_s(X.wave), r = lane & 31, hh = lane >> 5; (void)tid;
    const bool own = t >= 0;
    int R0 = 0, krow0, bs = 0;
    if (own) { R0 = t * 64; if (R0 < NP) krow0 = R0; else { bs = (R0 - NP) >> 10; krow0 = NP + bs * 1280 + 256 + ((R0 - NP) & 1023); } }
    else { const int ct = -1 - t; bs = ct >> 2; krow0 = NP + bs * 1280 + (ct & 3) * 64; }
    { unsigned raw8[8]; float kp8[8]; f32x2 c8[8];
      if (own) {
#pragma unroll
          for (int i = 0; i < 8; ++i) { raw8[i] = *(const unsigned*)(U + (size_t)(R0 + 8 * w + i) * UE + CE_KVA + 2 * lane);
              kp8[i] = lane < 32 ? bf2f(U[(size_t)(R0 + 8 * w + i) * UE + CE_KPE + lane]) : 0.f; }
      } else {
#pragma unroll
          for (int i = 0; i < 8; ++i) { const int s = ((-1 - t) & 3) * 64 + 8 * w + i; const size_t o = (size_t)(bs * 2 + j) * 256 + s;
              c8[i] = *(const f32x2*)(a.in[3] + o * 128 + 2 * lane); kp8[i] = lane < 32 ? a.in[4][o * 32 + lane] : 0.f; }
      }
      const f32x2 g = *(const f32x2*)(kvan + 2 * lane);
      SB_PIN
#pragma unroll
      for (int i = 0; i < 8; ++i) { const int row = 8 * w + i;
        if (own) {
            const float x0 = bflo(raw8[i]), x1 = bfhi(raw8[i]);
            const float rstd = rsqrtf(wave_sum(x0 * x0 + x1 * x1) * (1.f / 128.f) + EPS);
            const float c0 = x0 * rstd * g.x, c1 = x1 * rstd * g.y;
            *(unsigned*)(Xc + row * 136 + 2 * lane) = pk2(c0, c1);
            if (lane < 32) kpes[row * 32 + lane] = kp8[i];
            if (R0 < NP) { const int b = (R0 + row) >> 8, s = (R0 + row) & 255; const size_t o = (size_t)(b * 2 + j) * 256 + s;
                *(f32x2*)(a.out + O_CKV + o * 128 + 2 * lane) = (f32x2){c0, c1};
                if (lane < 32) a.out[O_KPE + o * 32 + lane] = kp8[i]; }
        } else {
            *(unsigned*)(Xc + row * 136 + 2 * lane) = pk2(c8[i].x, c8[i].y);
            if (lane < 32) kpes[row * 32 + lane] = kp8[i];
        } } }
    __syncthreads();
    f32x16 ak[2][2], av[2][2];
#pragma unroll
    for (int x = 0; x < 2; ++x)
#pragma unroll
        for (int y = 0; y < 2; ++y)
#pragma unroll
            for (int i = 0; i < 16; ++i) { ak[x][y][i] = 0.f; av[x][y][i] = 0.f; }
    const bf16* wp = Wkv + (size_t)(w * 4) * 8 * 512 + lane * 8;
    const bf16* xp = Xc + r * 136 + 8 * hh;
#pragma unroll
    for (int kh = 0; kh < 2; ++kh) { bh8 wk[4][2], wv[4][2];
#pragma unroll
      for (int k4 = 0; k4 < 4; ++k4)
#pragma unroll
          for (int fb = 0; fb < 2; ++fb) { wk[k4][fb] = ld16(wp + (size_t)(fb * 8 + kh * 4 + k4) * 512); wv[k4][fb] = ld16(wp + (size_t)((2 + fb) * 8 + kh * 4 + k4) * 512); }
      SB_PIN
#pragma unroll
      for (int k4 = 0; k4 < 4; ++k4) { const int ks = kh * 4 + k4; bh8 xf[2];
#pragma unroll
          for (int tb = 0; tb < 2; ++tb) xf[tb] = ld16(xp + tb * 32 * 136 + 16 * ks);
#pragma unroll
          for (int fb = 0; fb < 2; ++fb)
#pragma unroll
              for (int tb = 0; tb < 2; ++tb) { ak[fb][tb] = mfma32(wk[k4][fb], xf[tb], ak[fb][tb]); av[tb][fb] = mfma32(xf[tb], wv[k4][fb], av[tb][fb]); } }
      SB_PIN }
    const bool sample_own = own && R0 >= NP;
    f32x4 gkv[2][4], gpv[4];
#pragma unroll
    for (int fb = 0; fb < 2; ++fb)
#pragma unroll
        for (int g = 0; g < 4; ++g) gkv[fb][g] = *(const f32x4*)(kn + 32 * fb + 8 * g + 4 * hh);
#pragma unroll
    for (int g = 0; g < 4; ++g) gpv[g] = *(const f32x4*)(kn + 64 + 16 * hh + 4 * g);
    SB_PIN
#pragma unroll
    for (int tb = 0; tb < 2; ++tb) {
        const int tok = 32 * tb + r;
        float kp[16]; float ss = 0.f;
#pragma unroll
        for (int g = 0; g < 4; ++g) { const f32x4 q4 = *(const f32x4*)(kpes + tok * 32 + 16 * hh + 4 * g); kp[4 * g] = q4.x; kp[4 * g + 1] = q4.y; kp[4 * g + 2] = q4.z; kp[4 * g + 3] = q4.w; }
#pragma unroll
        for (int i = 0; i < 16; ++i) ss += kp[i] * kp[i] + ak[0][tb][i] * ak[0][tb][i] + ak[1][tb][i] * ak[1][tb][i];
        ss += __shfl_xor(ss, 32);
        const float rstd = rsqrtf(ss * (1.f / 96.f) + EPS);
        bf16* kdst = KM + ((size_t)(((krow0 >> 5) + tb) * 8 + w) * 6) * 512 + r * 8;
#pragma unroll
        for (int fb = 0; fb < 2; ++fb)
#pragma unroll
            for (int g = 0; g < 4; ++g) { const f32x4 gn = gkv[fb][g];
                st4bf(kdst + (2 * fb + (g >> 1)) * 512 + (g & 1) * 256 + 4 * hh, ak[fb][tb][4 * g] * rstd * gn.x, ak[fb][tb][4 * g + 1] * rstd * gn.y, ak[fb][tb][4 * g + 2] * rstd * gn.z, ak[fb][tb][4 * g + 3] * rstd * gn.w); }
#pragma unroll
        for (int g = 0; g < 4; ++g) { const f32x4 gn = gpv[g];
            kp[4 * g] *= rstd * gn.x; kp[4 * g + 1] *= rstd * gn.y; kp[4 * g + 2] *= rstd * gn.z; kp[4 * g + 3] *= rstd * gn.w; }
        if (sample_own) {
            const int tp = (R0 - NP + tok) & 1023; const int pos = hh == 0 ? (tp >> 6) : (tp & 63);
            const float* rp = rope + pos * 16;
#pragma unroll
            for (int i = 0; i < 8; ++i) { const float cs = rp[i], sn = rp[8 + i], x1 = kp[i], x2 = kp[8 + i]; kp[i] = x1 * cs - x2 * sn; kp[8 + i] = x1 * sn + x2 * cs; }
        }
#pragma unroll
        for (int g = 0; g < 4; ++g) st4bf(kdst + (4 + hh) * 512 + (g >> 1) * 256 + 4 * (g & 1), kp[4 * g], kp[4 * g + 1], kp[4 * g + 2], kp[4 * g + 3]);
#pragma unroll
        for (int fb = 0; fb < 2; ++fb) { bf16* vdst = VTM + ((size_t)(((krow0 >> 5) + tb) * 8 + w) * 4 + 2 * fb) * 512 + (hh * 32 + r) * 8;
#pragma unroll
            for (int g = 0; g < 4; ++g) st4bf(vdst + (g >> 1) * 512 + 4 * (g & 1), av[tb][fb][4 * g], av[tb][fb][4 * g + 1], av[tb][fb][4 * g + 2], av[tb][fb][4 * g + 3]); }
    }
    LDS_BARRIER();
}

struct AttnState { f32x16 o0, o1; float m, l; };
__device__ __forceinline__ void attn_init(AttnState& st) {
#pragma unroll
    for (int i = 0; i < 16; ++i) { st.o0[i] = 0.f; st.o1[i] = 0.f; }
    st.m = -1e30f; st.l = 0.f;
}
template <int NKS> struct KVf { bh8 k[NKS]; bh8 v[4]; };
template <int NKS> __device__ __forceinline__ void load_kv(KVf<NKS>& f, const bf16* kp, const bf16* vp) {
#pragma unroll
    for (int ks = 0; ks < NKS; ++ks) f.k[ks] = ld16(kp + ks * 512);
#pragma unroll
    for (int q = 0; q < 4; ++q) f.v[q] = ld16(vp + q * 512);
}
template <int NKS, bool MASKED>
__device__ __forceinline__ void attn_compute(AttnState& st, const bh8* qf, const KVf<NKS>& f, const float* rk, int hh, bool na, int kc0, int dr, int cq, int c0, const float* rpbs) {
    f32x16 s;
#pragma unroll
    for (int i = 0; i < 16; ++i) s[i] = 0.f;
#pragma unroll
    for (int ks = 0; ks < NKS; ++ks) s = mfma32(f.k[ks], qf[ks], s);
    if (rk) {
#pragma unroll
        for (int g = 0; g < 4; ++g) { const f32x4 rv = *(const f32x4*)(rk + 8 * g + 4 * hh); s[4 * g] *= rv.x; s[4 * g + 1] *= rv.y; s[4 * g + 2] *= rv.z; s[4 * g + 3] *= rv.w; }
    }
    if (MASKED && na) {
#pragma unroll
        for (int i = 0; i < 16; ++i) { const int kc = kc0 + crow(i, hh); const bool ok = kc >= c0 && kc < c0 + 16;
            int dc = kc - cq; dc = dc < -15 ? -15 : (dc > 15 ? 15 : dc);
            s[i] = ok ? s[i] + rpbs[dr * 31 + dc + 15] : -1e30f; }
    }
    float mx = fmaxf(fmaxf(s[0], s[1]), s[2]);
#pragma unroll
    for (int i = 3; i < 15; i += 2) mx = fmaxf(fmaxf(mx, s[i]), s[i + 1]);
    mx = fmaxf(mx, s[15]);
    mx = fmaxf(mx, __shfl_xor(mx, 32));
    const float mn = fmaxf(st.m, mx);
    if (__builtin_amdgcn_ballot_w64(mn > st.m) != 0ull) {
        const float alpha = __builtin_amdgcn_exp2f(st.m - mn);
        st.l *= alpha;
#pragma unroll
        for (int i = 0; i < 16; ++i) { st.o0[i] *= alpha; st.o1[i] *= alpha; }
        st.m = mn;
    }
    float ps = 0.f;
#pragma unroll
    for (int i = 0; i < 16; ++i) { float p = __builtin_amdgcn_exp2f(s[i] - mn); if (MASKED) p = s[i] > -1e29f ? p : 0.f; s[i] = p; ps += p; }
    st.l += ps;
    const bh8 p0 = pfrag(s, 0), p1 = pfrag(s, 1);
    st.o0 = mfma32(f.v[0], p0, st.o0); st.o0 = mfma32(f.v[1], p1, st.o0);
    st.o1 = mfma32(f.v[2], p0, st.o1); st.o1 = mfma32(f.v[3], p1, st.o1);
}
template <int KS>
__device__ __forceinline__ void attn_merge_store(AttnState& st, float* part, int w, int lane, const v4u* gpre, bf16* zp, bool active = true) {
    const int r = lane & 31, hh = lane >> 5;
    float* mine = part + w * 2048; float* ml = part + 8 * 2048;
    if (active) {
#pragma unroll
    for (int i = 0; i < 16; ++i) { mine[crow(i, hh) * 32 + r] = st.o0[i]; mine[(32 + crow(i, hh)) * 32 + r] = st.o1[i]; }
    const float lt = st.l + __shfl_xor(st.l, 32);
    if (hh == 0) { ml[(w * 2) * 32 + r] = st.m; ml[(w * 2 + 1) * 32 + r] = lt; }
    }
    __syncthreads();
    if (active) {
    const int qb = w / KS, kp = w % KS;
    float f[KS]; float ms = -1e30f, L = 0.f;
#pragma unroll
    for (int k = 0; k < KS; ++k) ms = fmaxf(ms, ml[((qb * KS + k) * 2) * 32 + r]);
#pragma unroll
    for (int k = 0; k < KS; ++k) { f[k] = __builtin_amdgcn_exp2f(ml[((qb * KS + k) * 2) * 32 + r] - ms); L += f[k] * ml[((qb * KS + k) * 2 + 1) * 32 + r]; }
    const float inv = 1.f / L;
    constexpr int ND = 32 / KS;
    const int dv0 = (64 / KS) * kp + ND * hh;
#pragma unroll
    for (int c = 0; c < ND / 8; ++c) {
        float o[8];
#pragma unroll
        for (int e = 0; e < 8; ++e) { float v = 0.f;
#pragma unroll
            for (int k = 0; k < KS; ++k) v += f[k] * part[(qb * KS + k) * 2048 + (dv0 + 8 * c + e) * 32 + r];
            o[e] = v * inv; }
        const v4u gr = gpre[c];
        v4u z; z.x = pk2(o[0] * silu_f(bflo(gr.x)), o[1] * silu_f(bfhi(gr.x))); z.y = pk2(o[2] * silu_f(bflo(gr.y)), o[3] * silu_f(bfhi(gr.y)));
        z.z = pk2(o[4] * silu_f(bflo(gr.z)), o[5] * silu_f(bfhi(gr.z))); z.w = pk2(o[6] * silu_f(bflo(gr.w)), o[7] * silu_f(bfhi(gr.w)));
        *(v4u*)(zp + dv0 + 8 * c) = z;
    }
    }
    __syncthreads();
}

template <int KS> __device__ __forceinline__ void attn_gate_prefetch(v4u* gpre, const bf16* gp, int w, int lane) {
    constexpr int ND = 32 / KS; const int dv0 = (64 / KS) * (w % KS) + ND * (lane >> 5);
#pragma unroll
    for (int c = 0; c < ND / 8; ++c) gpre[c] = *(const v4u*)(gp + dv0 + 8 * c);
}

__device__ __forceinline__ void unit_mla_attn(const Args& a, const Ctx& X, int u) {
    const bf16* U = (const bf16*)(a.ws + WS_U); const bf16* Q = (const bf16*)(a.ws + WS_Q); const bf16* KM = (const bf16*)(a.ws + WS_KM); const bf16* VTM = (const bf16*)(a.ws + WS_VTM);
    bf16* Z = (bf16*)(a.ws + WS_Z);
    const int tid = opaque_v(X.tid), lane = tid & 63, w = opaque_s(X.wave), r = lane & 31, hh = lane >> 5;
    int h, q0, kb0, nkb; const bool samp = u < 256;
    if (samp) { const int bs = u >> 7, qg = u & 15; h = (u >> 4) & 7; q0 = NP + bs * 1024 + 64 * qg + 32 * (w >> 2); kb0 = NP + bs * 1280 + 320 * (w & 3); nkb = 10; }
    else { const int v = u - 256, b = v >> 4, qh = v & 1; h = (v >> 1) & 7; q0 = b * 256 + 128 * qh + 32 * (w >> 1); kb0 = b * 256 + 128 * (w & 1); nkb = 4; }
    PROF_BEGIN(30)
    bh8 qf[6];
#pragma unroll
    for (int ks = 0; ks < 6; ++ks) qf[ks] = ld16(Q + ((size_t)((q0 >> 5) * 8 + h) * 6 + ks) * 512 + lane * 8);
    AttnState st; attn_init(st);
    v4u gpre[2];
    { const bf16* gp = U + (size_t)(q0 + r) * UE + CE_GA + h * 64; if (samp) attn_gate_prefetch<4>(gpre, gp, w, lane); else attn_gate_prefetch<2>(gpre, gp, w, lane); }
    const bf16* kp = KM + ((size_t)((kb0 >> 5) * 8 + h) * 6) * 512 + lane * 8;
    const bf16* vp = VTM + ((size_t)((kb0 >> 5) * 8 + h) * 4) * 512 + lane * 8;
    KVf<6> fa, fb;
    load_kv<6>(fa, kp, vp);
    PROF_END(30)
    PROF_BEGIN(31)
    for (int kb = 0; kb < nkb; kb += 2) {
        load_kv<6>(fb, kp + (size_t)(kb + 1) * 8 * 6 * 512, vp + (size_t)(kb + 1) * 8 * 4 * 512);
        SB_PIN
        attn_compute<6, false>(st, qf, fa, nullptr, hh, false, 0, 0, 0, 0, nullptr);
        if (kb + 2 < nkb) load_kv<6>(fa, kp + (size_t)(kb + 2) * 8 * 6 * 512, vp + (size_t)(kb + 2) * 8 * 4 * 512);
        SB_PIN
        attn_compute<6, false>(st, qf, fb, nullptr, hh, false, 0, 0, 0, 0, nullptr);
    }
    PROF_END(31)
    PROF_BEGIN(32)
    const int row = q0 + r;
    if (samp) attn_merge_store<4>(st, (float*)X.ldsg, w, lane, gpre, Z + (size_t)row * DM + h * 64);
    else attn_merge_store<2>(st, (float*)X.ldsg, w, lane, gpre, Z + (size_t)row * DM + h * 64);
    PROF_END(32)
}

__device__ __forceinline__ void load_q64(const bf16* qrow  , const float* qnorm, const float* knorm, int hh, bh8* qa) {
    float x[4][8]; float ss = 0.f;
#pragma unroll
    for (int ks = 0; ks < 4; ++ks) { const v4u raw = *(const v4u*)(qrow + 16 * ks + 8 * hh);
        x[ks][0] = bflo(raw.x); x[ks][1] = bfhi(raw.x); x[ks][2] = bflo(raw.y); x[ks][3] = bfhi(raw.y); x[ks][4] = bflo(raw.z); x[ks][5] = bfhi(raw.z); x[ks][6] = bflo(raw.w); x[ks][7] = bfhi(raw.w);
#pragma unroll
        for (int e = 0; e < 8; ++e) ss += x[ks][e] * x[ks][e]; }
    ss += __shfl_xor(ss, 32);
    const float rstd = rsqrtf(ss * (1.f / 64.f) + EPS) * (0.125f * 1.4426950408889634f);
#pragma unroll
    for (int ks = 0; ks < 4; ++ks) { float ya[8];
#pragma unroll
        for (int e = 0; e < 8; ++e) { const int d = 16 * ks + 8 * hh + e; ya[e] = x[ks][e] * rstd * qnorm[d] * knorm[d]; }
        v4u va; va.x = pk2(ya[0], ya[1]); va.y = pk2(ya[2], ya[3]); va.z = pk2(ya[4], ya[5]); va.w = pk2(ya[6], ya[7]);
        qa[ks] = __builtin_bit_cast(bh8, va); }
}

__device__ __forceinline__ void na_block_ptrs(int g, int rb, int R0s, int h, int lane, const bf16* KFO, const bf16* VFO, const bf16* kc, const bf16* vc,
                                              const bf16*& kp, const bf16*& vp, int& rki, bool& win, int& kc0, int& bi) {
    if (g < 8) { kp = kc + (size_t)g * 4 * 512 + lane * 8; vp = vc + (size_t)g * 4 * 512 + lane * 8; rki = 512 + 32 * g; win = false; kc0 = 0; bi = 0; }
    else { const int i = (g - 8) >> 1, xk = g & 1; const int tok0 = (rb + i) * 64 + 32 * xk; const size_t blk = ((size_t)(((R0s + tok0) >> 5) * 8 + h) * 4) * 512 + lane * 8;
        kp = KFO + blk; vp = VFO + blk; rki = i * 64 + 32 * xk; win = true; kc0 = 32 * xk; bi = i; }
}

template <int NR> __device__ __forceinline__ void convN_wave(const Args& a, int j, int r0, int lane) {
    const bf16* U = (const bf16*)(a.ws + WS_U); bf16* Z = (bf16*)(a.ws + WS_Z);
    const int cg = lane * 8;
    v4u xc[NR + 2], cc[NR + 2], bc[NR], gc[NR];
#pragma unroll
    for (int i = 0; i < NR + 2; ++i) { int rr = r0 - 1 + i; rr = rr < 0 ? 0 : (rr > NT - 1 ? NT - 1 : rr); const bf16* u = U + (size_t)rr * UO;
        xc[i] = *(const v4u*)(u + CO_XC + cg); cc[i] = *(const v4u*)(u + CO_CC + cg); }
#pragma unroll
    for (int i = 0; i < NR; ++i) { const bf16* u = U + (size_t)(r0 + i) * UO; bc[i] = *(const v4u*)(u + CO_BC + cg); gc[i] = *(const v4u*)(u + CO_GC + cg); }
    float w0[8], w1[8], w2[8], cb[8];
#pragma unroll
    for (int q = 0; q < 2; ++q) { const f32x4 a0 = *(const f32x4*)(a.in[26] + j * 1536 + cg + 4 * q), a1 = *(const f32x4*)(a.in[26] + j * 1536 + 512 + cg + 4 * q),
                                              a2 = *(const f32x4*)(a.in[26] + j * 1536 + 1024 + cg + 4 * q), a3 = *(const f32x4*)(a.in[27] + j * 512 + cg + 4 * q);
#pragma unroll
        for (int e = 0; e < 4; ++e) { w0[4 * q + e] = a0[e]; w1[4 * q + e] = a1[e]; w2[4 * q + e] = a2[e]; cb[4 * q + e] = a3[e]; } }
    SB_PIN
    float x[NR + 2][8];
#pragma unroll
    for (int i = 0; i < NR + 2; ++i) { const unsigned xr[4] = {xc[i].x, xc[i].y, xc[i].z, xc[i].w}, cr[4] = {cc[i].x, cc[i].y, cc[i].z, cc[i].w};
#pragma unroll
        for (int q = 0; q < 4; ++q) { x[i][2 * q] = bflo(xr[q]) * bflo(cr[q]); x[i][2 * q + 1] = bfhi(xr[q]) * bfhi(cr[q]); } }
#pragma unroll
    for (int i = 0; i < NR; ++i) { const int t = r0 + i; const int S = t < NP ? 256 : 1024, s = t < NP ? (t & 255) : ((t - NP) & 1023);
        const float mp = s > 0 ? 1.f : 0.f, mn = s < S - 1 ? 1.f : 0.f;
        const unsigned br[4] = {bc[i].x, bc[i].y, bc[i].z, bc[i].w}, gr[4] = {gc[i].x, gc[i].y, gc[i].z, gc[i].w};
        float o[8];
#pragma unroll
        for (int e = 0; e < 8; ++e) { const float bv = (e & 1) ? bfhi(br[e >> 1]) : bflo(br[e >> 1]), gv = (e & 1) ? bfhi(gr[e >> 1]) : bflo(gr[e >> 1]);
            o[e] = bv * (mp * x[i][e] * w0[e] + x[i + 1][e] * w1[e] + mn * x[i + 2][e] * w2[e] + cb[e]) * silu_f(gv); }
        v4u z; z.x = pk2(o[0], o[1]); z.y = pk2(o[2], o[3]); z.z = pk2(o[4], o[5]); z.w = pk2(o[6], o[7]);
        *(v4u*)(Z + (size_t)(r0 + i) * DM + cg) = z; }
}

__device__ __forceinline__ void unit_o2_combo(const Args& a, const Ctx& X, int j, int u) {
    const bf16* U = (const bf16*)(a.ws + WS_U); const bf16* VTO = (const bf16*)(a.ws + WS_VTO); bf16* Z = (bf16*)(a.ws + WS_Z);
    const bf16* KFO = (const bf16*)(a.ws + WS_KFO);
    const float* qnorm = a.in[28] + j * 64; const float* knorm = a.in[29] + j * 64;
    float* part = (float*)X.ldsg; float* rk = part + 8 * 2048 + 512;
    float* rpbs = rk + 768;
    float* rko = rpbs + 512;
    const int tid = opaque_v(X.tid), lane = tid & 63, w = opaque_s(X.wave), r = lane & 31, hh = lane >> 5;
    const int bs = u >> 7, hn = (u >> 4) & 7, rr = u & 15, R0s = NP + bs * 1024;
    const int b = u >> 4, ho = (u >> 1) & 7, qh = u & 1, R0 = b * 256;
    const int rb = rr - 4 < 0 ? 0 : (rr - 4 > 8 ? 8 : rr - 4);
    {
        const int sub = lane & 7, rgrp = lane >> 3;
        v4u kn[8], ko[4];
#pragma unroll
        for (int q = 0; q < 8; ++q) kn[q] = *(const v4u*)(U + (size_t)(R0s + rb * 64 + (w * 8 + q) * 8 + rgrp) * UO + CO_KD + hn * 64 + 8 * sub);
#pragma unroll
        for (int q = 0; q < 4; ++q) ko[q] = *(const v4u*)(U + (size_t)(R0 + (w * 4 + q) * 8 + rgrp) * UO + CO_KD + ho * 64 + 8 * sub);
        const float rpv = tid < 465 ? a.in[30][(size_t)(j * 8 + hn) * 465 + tid] * 1.4426950408889634f : 0.f;
        SB_PIN
#pragma unroll
        for (int q = 0; q < 12; ++q) { const v4u x = q < 8 ? kn[q < 8 ? q : 0] : ko[q < 8 ? 0 : q - 8];
            const float k0 = bflo(x.x), k1 = bfhi(x.x), k2 = bflo(x.y), k3 = bfhi(x.y), k4 = bflo(x.z), k5 = bfhi(x.z), k6 = bflo(x.w), k7 = bfhi(x.w);
            float ss = (k0 * k0 + k1 * k1) + (k2 * k2 + k3 * k3) + (k4 * k4 + k5 * k5) + (k6 * k6 + k7 * k7);
            ss += __shfl_xor(ss, 1); ss += __shfl_xor(ss, 2); ss += __shfl_xor(ss, 4);
            const float rs = rsqrtf(ss * (1.f / 64.f) + EPS);
            if (sub == 0) { if (q < 8) rk[(w * 8 + q) * 8 + rgrp] = rs; else rko[(w * 4 + (q - 8)) * 8 + rgrp] = rs; } }
        if (tid < 256) rk[512 + tid] = 1.f;
        rpbs[tid] = rpv;
    }
    __syncthreads();
    AttnState st; attn_init(st);
    v4u gpre[2]; gpre[0] = (v4u){0u, 0u, 0u, 0u}; gpre[1] = gpre[0];
    int zrow = 0, zh = 0;
    if (w < 4) {
        const int xq = w >> 1, kpart = w & 1, tok = rr * 64 + 32 * xq + r, cq = 32 * xq + r;
        const int c0 = cq - 8 < 0 ? 0 : (cq - 8 > 48 ? 48 : cq - 8);
        const int row = R0s + tok; zrow = row; zh = hn;
        bh8 qa[4];
        load_q64(U + (size_t)row * UO + CO_QD + hn * 64, qnorm, knorm, hh, qa);
        attn_gate_prefetch<2>(gpre, U + (size_t)row * UO + CO_GD + hn * 64, w, lane);
        const bf16* kc = (const bf16*)(a.ws + WS_NAKC) + (size_t)((bs * 2 + j) * 8 + hn) * 8 * 4 * 512;
        const bf16* vc = (const bf16*)(a.ws + WS_NAVC) + (size_t)((bs * 2 + j) * 8 + hn) * 8 * 4 * 512;
        const int g0 = 12 * kpart;
        KVf<4> fa, fb;
        const bf16 *kpa, *vpa, *kpb, *vpb; int rka, rkb, kca, kcb, bia, bib; bool wa, wb;
        na_block_ptrs(g0, rb, R0s, hn, lane, KFO, VTO, kc, vc, kpa, vpa, rka, wa, kca, bia);
        load_kv<4>(fa, kpa, vpa);
#pragma unroll 1
        for (int g = 0; g < 12; g += 2) {
            na_block_ptrs(g0 + g + 1, rb, R0s, hn, lane, KFO, VTO, kc, vc, kpb, vpb, rkb, wb, kcb, bib);
            load_kv<4>(fb, kpb, vpb);
            SB_PIN
            attn_compute<4, true>(st, qa, fa, rk + rka, hh, wa, kca, rb + bia - rr + 7, cq, c0, rpbs);
            if (g + 2 < 12) { na_block_ptrs(g0 + g + 2, rb, R0s, hn, lane, KFO, VTO, kc, vc, kpa, vpa, rka, wa, kca, bia); load_kv<4>(fa, kpa, vpa); }
            SB_PIN
            attn_compute<4, true>(st, qa, fb, rk + rkb, hh, wb, kcb, rb + bib - rr + 7, cq, c0, rpbs);
        }
    } else {
        const int row = R0 + 128 * qh + 32 * (w - 4) + r;
        bh8 qa[4];
        load_q64(U + (size_t)row * UO + CO_QD + ho * 64, qnorm, knorm, hh, qa);
        v2u gg[8];
        { const bf16* gp = U + (size_t)row * UO + CO_GD + ho * 64;
#pragma unroll
          for (int g = 0; g < 4; ++g) { gg[g] = *(const v2u*)(gp + 8 * g + 4 * hh); gg[4 + g] = *(const v2u*)(gp + 32 + 8 * g + 4 * hh); } }
        const bf16* kp = KFO + ((size_t)((R0 >> 5) * 8 + ho) * 4) * 512 + lane * 8;
        const bf16* vp = VTO + ((size_t)((R0 >> 5) * 8 + ho) * 4) * 512 + lane * 8;
        KVf<4> fa, fb;
        load_kv<4>(fa, kp, vp);
#pragma unroll 1
        for (int kb = 0; kb < 8; kb += 2) {
            load_kv<4>(fb, kp + (size_t)(kb + 1) * 8 * 4 * 512, vp + (size_t)(kb + 1) * 8 * 4 * 512);
            SB_PIN
            attn_compute<4, false>(st, qa, fa, rko + 32 * kb, hh, false, 0, 0, 0, 0, nullptr);
            if (kb + 2 < 8) load_kv<4>(fa, kp + (size_t)(kb + 2) * 8 * 4 * 512, vp + (size_t)(kb + 2) * 8 * 4 * 512);
            SB_PIN
            attn_compute<4, false>(st, qa, fb, rko + 32 * (kb + 1), hh, false, 0, 0, 0, 0, nullptr);
        }
        const float inv = 1.f / (st.l + __shfl_xor(st.l, 32));
        bf16* zp = Z + (size_t)row * DM + 512 + ho * 64;
#pragma unroll
        for (int g = 0; g < 4; ++g) { const int dv = 8 * g + 4 * hh;
            st4bf(zp + dv, st.o0[4 * g] * inv * silu_f(bflo(gg[g].x)), st.o0[4 * g + 1] * inv * silu_f(bfhi(gg[g].x)), st.o0[4 * g + 2] * inv * silu_f(bflo(gg[g].y)), st.o0[4 * g + 3] * inv * silu_f(bfhi(gg[g].y)));
            st4bf(zp + 32 + dv, st.o1[4 * g] * inv * silu_f(bflo(gg[4 + g].x)), st.o1[4 * g + 1] * inv * silu_f(bfhi(gg[4 + g].x)), st.o1[4 * g + 2] * inv * silu_f(bflo(gg[4 + g].y)), st.o1[4 * g + 3] * inv * silu_f(bfhi(gg[4 + g].y))); }
        attn_init(st);
        SB_PIN
        convN_wave<3>(a, j, 24 * u + 6 * (w - 4), lane);
        convN_wave<3>(a, j, 24 * u + 6 * (w - 4) + 3, lane);
        SB_PIN
        if (qh == 0) {
            const int half = lane >> 5, d2 = 2 * (lane & 31);
            const f32x2 kg = *(const f32x2*)(knorm + d2);
            const bf16* kb = U + (size_t)R0 * UO + CO_KD + ho * 64 + d2; const bf16* vb = U + (size_t)R0 * UO + CO_VD + ho * 64 + d2;
            float* okb = a.out + O_NK + (size_t)(b * 2 + j) * 256 * 512 + ho * 64 + d2; float* ovb = a.out + O_NV + (size_t)(b * 2 + j) * 256 * 512 + ho * 64 + d2;
#pragma unroll 1
            for (int it0 = 0; it0 < 32; it0 += 8) { unsigned kr[8], vr[8];
#pragma unroll
                for (int i = 0; i < 8; ++i) { const int key = 64 * (w - 4) + 2 * (it0 + i) + half; kr[i] = *(const unsigned*)(kb + (size_t)key * UO); vr[i] = *(const unsigned*)(vb + (size_t)key * UO); }
                SB_PIN
#pragma unroll
                for (int i = 0; i < 8; ++i) { const int key = 64 * (w - 4) + 2 * (it0 + i) + half; const float rstd = rko[key];
                    *(f32x2*)(okb + (size_t)key * 512) = (f32x2){bflo(kr[i]) * rstd * kg.x, bfhi(kr[i]) * rstd * kg.y};
                    *(f32x2*)(ovb + (size_t)key * 512) = (f32x2){bflo(vr[i]), bfhi(vr[i])}; } }
        }
    }
    attn_merge_store<2>(st, part, w & 3, lane, gpre, Z + (size_t)zrow * DM + 512 + zh * 64, w < 4);
}
#ifndef RU_OUT_A
#define RU_OUT_A 1
#endif
#ifndef RU_OUT_B
#define RU_OUT_B 1
#endif
#ifndef RU_OUT_C
#define RU_OUT_C 1
#endif
__device__ __forceinline__ float scan_incl_sum(float v, int lane) {
#pragma unroll
    for (int o = 1; o < 64; o <<= 1) { const float t = __shfl_up(v, o); if (lane >= o) v += t; }
    return v;
}
__device__ __forceinline__ float scan_incl_max(float v, int lane) {
#pragma unroll
    for (int o = 1; o < 64; o <<= 1) { const float t = __shfl_up(v, o); if (lane >= o) v = fmaxf(v, t); }
    return v;
}
__device__ __forceinline__ float scan_incl_max_rev(float v, int lane) {
#pragma unroll
    for (int o = 1; o < 64; o <<= 1) { const float t = __shfl_down(v, o); if (lane + o < 64) v = fmaxf(v, t); }
    return v;
}
constexpr float KSC = 0.08838834764831845f;

__device__ __forceinline__ void stage_T(const bf16* src  , int pitch, bf16* d0, const float* w0, bf16* d1, const float* w1, int wave, int lane) {
#pragma unroll
    for (int i = 0; i < 2; ++i) { const int c = wave * 2 + i;
        const v4u raw = *(const v4u*)(src + (size_t)lane * pitch + 8 * c);
        float x[8] = {bflo(raw.x), bfhi(raw.x), bflo(raw.y), bfhi(raw.y), bflo(raw.z), bfhi(raw.z), bflo(raw.w), bfhi(raw.w)};
        if (w0) { const float s0 = w0[lane] * KSC, s1 = w1[lane] * KSC;
#pragma unroll
            for (int e = 0; e < 8; ++e) { d0[(8 * c + e) * 72 + lane] = (bf16)(pk2(x[e] * s0, 0.f) & 0xffffu); d1[(8 * c + e) * 72 + lane] = (bf16)(pk2(x[e] * s1, 0.f) & 0xffffu); }
        } else {
            const unsigned rr[4] = {raw.x, raw.y, raw.z, raw.w};
#pragma unroll
            for (int e = 0; e < 8; ++e) d0[(8 * c + e) * 72 + lane] = (bf16)((rr[e >> 1] >> (16 * (e & 1))) & 0xffffu);
        }
    }
}

__device__ __forceinline__ void unit_mlstm_L(const Args& a, const Ctx& X, int j, int h, int gc) {
    const bf16* U = (const bf16*)(a.ws + WS_U); const float* GT = (const float*)(a.ws + WS_GATES); const bf16* VFM = (const bf16*)(a.ws + WS_VFM);
    float* AG = (float*)(a.ws + WS_AG); unsigned* LT = (unsigned*)(a.ws + WS_LT); float* NL = (float*)(a.ws + WS_NL); float* GQ = (float*)(a.ws + WS_GQ);
    float* wgt = (float*)X.ldsg;
    bf16* KwT = (bf16*)(X.ldsg + 1024);
    const int tid = opaque_v(X.tid), lane = tid & 63, w = opaque_s(X.wave), r = lane & 31, hh = lane >> 5, R0 = gc * 64;
    v4u kraw[2];
#pragma unroll
    for (int i = 0; i < 2; ++i) kraw[i] = *(const v4u*)(U + (size_t)(R0 + lane) * UE + CE_KM + h * 128 + 8 * (w * 2 + i));
    bh8 vf[4][4];
#pragma unroll
    for (int eb = 0; eb < 4; ++eb)
#pragma unroll
        for (int q = 0; q < 4; ++q) vf[eb][q] = ld16(VFM + ((size_t)(((2 * gc + (q >> 1)) * 4 + h) * 8 + eb * 2 + (q & 1))) * 512 + lane * 8);
    SB_PIN
    if (w < 2) { const int dir = w; const int row = R0 + lane;
        const float lf = logsigmoid_f(GT[(size_t)row * 16 + 8 + dir * 4 + h] + a.in[22][j * 8 + dir * 4 + h]);
        const float ii = GT[(size_t)row * 16 + dir * 4 + h] + a.in[21][j * 8 + dir * 4 + h];
        const float P = scan_incl_sum(lf, lane); const float T = __shfl(P, 63);
        const float dec = (dir == 0 ? (T - P) : (P - lf)) + ii;
        const float am = wave_max(dec);
        wgt[dir * 64 + lane] = expf(dec - am) * KSC;
        if (lane == 0) { AG[((dir * 4 + h) * 96 + gc) * 2] = am; AG[((dir * 4 + h) * 96 + gc) * 2 + 1] = T; }
        const float cum = dir == 0 ? P : (T - P + lf), bv = ii - cum;
        const float pm = dir == 0 ? scan_incl_max(bv, lane) : scan_incl_max_rev(bv, lane);
        *(f32x4*)(GQ + ((size_t)(dir * 4 + h) * NT + row) * 4) = (f32x4){cum, bv, pm, 0.f};
    }
    __syncthreads();
#pragma unroll
    for (int i = 0; i < 2; ++i) { const int c = w * 2 + i; const unsigned rr[4] = {kraw[i].x, kraw[i].y, kraw[i].z, kraw[i].w};
        const float s0 = wgt[lane], s1 = wgt[64 + lane];
#pragma unroll
        for (int e = 0; e < 8; ++e) { const float x = (e & 1) ? bfhi(rr[e >> 1]) : bflo(rr[e >> 1]);
            KwT[(8 * c + e) * 72 + lane] = (bf16)(pk2(x * s0, 0.f) & 0xffffu); KwT[128 * 72 + (8 * c + e) * 72 + lane] = (bf16)(pk2(x * s1, 0.f) & 0xffffu); } }
    __syncthreads();
    { const int dir = w >> 2, db = w & 3; const size_t ub = (size_t)((dir * 4 + h) * 96 + gc);
      bh8 bfr[4];
#pragma unroll
      for (int q = 0; q < 4; ++q) { const bf16* kp = KwT + dir * 128 * 72 + (32 * db + r) * 72 + 16 * q + 4 * hh; bfr[q] = ld2x8(kp, kp + 8); }
#pragma unroll
      for (int eb = 0; eb < 4; ++eb) { f32x16 acc;
#pragma unroll
          for (int i = 0; i < 16; ++i) acc[i] = 0.f;
#pragma unroll
          for (int q = 0; q < 4; ++q) acc = mfma32(vf[eb][q], bfr[q], acc);
          unsigned* dst = LT + ub * 8192 + 32 * db + r;
#pragma unroll
          for (int i = 0; i < 16; i += 2) dst[(16 * eb + (crow(i, hh) >> 1)) * 128] = pk2(acc[i], acc[i + 1]); }
      if (tid < 256) { const int dr = tid >> 7, d = tid & 127; const bf16* p = KwT + dr * 128 * 72 + d * 72; float s = 0.f;
#pragma unroll
          for (int q = 0; q < 8; ++q) { const v4u x = *(const v4u*)(p + 8 * q); s += (bflo(x.x) + bfhi(x.x)) + (bflo(x.y) + bfhi(x.y)) + (bflo(x.z) + bfhi(x.z)) + (bflo(x.w) + bfhi(x.w)); }
          NL[(size_t)((dr * 4 + h) * 96 + gc) * 128 + d] = s; } }
    __syncthreads();
}

template <int NC, int NV, bool WT>
__device__ __forceinline__ void scan_body(const Args& a, int j, int tid, int dir, int h, int gc0, int sl, int initmat  , long outsb  ) {
    static_assert(NV == 1, "one 4-element group per thread");
    const float* AG = (const float*)(a.ws + WS_AG); const unsigned* LT = (const unsigned*)(a.ws + WS_LT); const float* NL = (const float*)(a.ws + WS_NL);
    bf16* CTB = (bf16*)(a.ws + WS_CTB); float* NPV = (float*)(a.ws + WS_NPV); float* MPV = (float*)(a.ws + WS_MPV);
    const size_t ub0 = (size_t)((dir * 4 + h) * 96 + gc0);
    const int ch4 = sl * 512 + tid, p = ch4 >> 6, d0 = 2 * (ch4 & 63);
    v2u Lr[NC]; float nl[NC];
    const bool don = tid < 128 && sl == 0;
#pragma unroll
    for (int c = 0; c < NC; ++c) {
        Lr[c] = *(const v2u*)(LT + (ub0 + c) * 8192 + p * 128 + d0);
        nl[c] = don ? NL[(ub0 + c) * 128 + tid] : 0.f; }
    float agA[NC], agG[NC];
#pragma unroll
    for (int c = 0; c < NC; ++c) { agA[c] = AG[(ub0 + c) * 2]; agG[c] = AG[(ub0 + c) * 2 + 1]; }
    SB_PIN
    f32x4 Cs = {0.f, 0.f, 0.f, 0.f}; float ns = 0.f, m = 0.f;
    if (initmat >= 0) { const float* c0 = (const float*)(a.ws + WS_C0T) + (size_t)initmat * 16384;
        const f32x2 ce = *(const f32x2*)(c0 + (2 * p) * 128 + d0), co = *(const f32x2*)(c0 + (2 * p + 1) * 128 + d0);
        Cs = (f32x4){ce.x, co.x, ce.y, co.y};
        if (don) ns = a.in[6][(size_t)initmat * 128 + tid];
        m = a.in[7][initmat]; }
#pragma unroll
    for (int q = 0; q < NC; ++q) {
        const int c = dir ? NC - 1 - q : q;
        const float ac = agA[c], Gc = agG[c];
        { bf16* ce = CTB + (ub0 + c) * 16384 + (2 * p) * 128 + d0;
          if (WT) { __hip_atomic_store((unsigned*)ce, pk2(Cs.x, Cs.z), __ATOMIC_RELAXED, __HIP_MEMORY_SCOPE_AGENT);
                    __hip_atomic_store((unsigned*)(ce + 128), pk2(Cs.y, Cs.w), __ATOMIC_RELAXED, __HIP_MEMORY_SCOPE_AGENT); }
          else { *(unsigned*)ce = pk2(Cs.x, Cs.z); *(unsigned*)(ce + 128) = pk2(Cs.y, Cs.w); } }
        if (don) { if (WT) __hip_atomic_store((unsigned*)(NPV + (ub0 + c) * 128 + tid), __builtin_bit_cast(unsigned, ns), __ATOMIC_RELAXED, __HIP_MEMORY_SCOPE_AGENT); else NPV[(ub0 + c) * 128 + tid] = ns; }
        if (tid == 0 && sl == 0) { if (WT) __hip_atomic_store((unsigned*)(MPV + ub0 + c), __builtin_bit_cast(unsigned, m), __ATOMIC_RELAXED, __HIP_MEMORY_SCOPE_AGENT); else MPV[ub0 + c] = m; }
        const float mn = fmaxf(Gc + m, ac), ws = expf(Gc + m - mn), wl = expf(ac - mn);
        const f32x4 Lv = {bflo(Lr[c].x), bfhi(Lr[c].x), bflo(Lr[c].y), bfhi(Lr[c].y)};
        Cs = Cs * ws + Lv * wl;
        ns = ns * ws + nl[c] * wl; m = mn;
    }
    (void)outsb; (void)j;
}
__device__ __forceinline__ void unit_mlstm_scan(const Args& a, const Ctx& X, int j, int v) {
    const int tid = opaque_v(X.tid);
    const int sl = v & 7, q = v >> 3, bs = q >> 3, h = (q >> 1) & 3, dir = q & 1;
    scan_body<16, 1, true>(a, j, tid, dir, h, 64 + 16 * bs, sl, ((bs * 2 + j) * 2 + dir) * 4 + h, -1);
    asm volatile("s_waitcnt vmcnt(0)" ::: "memory");
    __syncthreads();
    if (tid == 0) {
        __hip_atomic_fetch_add((unsigned*)(a.ws + WS_CTL + CTL_SCANCNT) + (size_t)(j * 16 + (bs * 4 + h) * 2 + dir) * 16, 1u, __ATOMIC_RELAXED, __HIP_MEMORY_SCOPE_AGENT); }
}

__device__ __forceinline__ void unit_mlstm_fin(const Args& a, const Ctx& X, int j, int u) {
    const float* AG = (const float*)(a.ws + WS_AG); const unsigned* LT = (const unsigned*)(a.ws + WS_LT); const float* NL = (const float*)(a.ws + WS_NL);
    const int b = u >> 3, h = (u >> 1) & 3, dir = u & 1, tid = opaque_v(X.tid), gc0 = 4 * b;
    float* T = (float*)X.ldsg;
    float* coef = T + 128 * 129;
    if (tid == 0) { const float* ag = AG + (size_t)((dir * 4 + h) * 96 + gc0) * 2; float m = 0.f, sfx = 0.f;
        if (dir == 0) { for (int i = 0; i < 4; ++i) m = fmaxf(ag[2 * i + 1] + m, ag[2 * i]); for (int q = 3; q >= 0; --q) { coef[q] = expf(ag[2 * q] + sfx - m); sfx += ag[2 * q + 1]; } }
        else { for (int i = 3; i >= 0; --i) m = fmaxf(ag[2 * i + 1] + m, ag[2 * i]); for (int q = 0; q < 4; ++q) { coef[q] = expf(ag[2 * q] + sfx - m); sfx += ag[2 * q + 1]; } }
        coef[4] = m; }
    __syncthreads();
    f32x4 acc[4][2];
#pragma unroll
    for (int i = 0; i < 4; ++i) { acc[i][0] = (f32x4){0.f, 0.f, 0.f, 0.f}; acc[i][1] = (f32x4){0.f, 0.f, 0.f, 0.f}; }
    float nacc = 0.f;
    { v4u raw[4][4];
#pragma unroll
      for (int q = 0; q < 4; ++q)
#pragma unroll
          for (int i = 0; i < 4; ++i) raw[q][i] = *(const v4u*)(LT + (size_t)((dir * 4 + h) * 96 + gc0 + q) * 8192 + 4 * (tid + 512 * i));
      SB_PIN
#pragma unroll
      for (int q = 0; q < 4; ++q) { const float cf = coef[q];
#pragma unroll
          for (int i = 0; i < 4; ++i) { const v4u x = raw[q][i];
              acc[i][0] += cf * (f32x4){bflo(x.x), bflo(x.y), bflo(x.z), bflo(x.w)}; acc[i][1] += cf * (f32x4){bfhi(x.x), bfhi(x.y), bfhi(x.z), bfhi(x.w)}; }
          if (tid < 128) nacc += cf * NL[(size_t)((dir * 4 + h) * 96 + gc0 + q) * 128 + tid]; } }
#pragma unroll
    for (int i = 0; i < 4; ++i) { const int ch = tid + 512 * i, pp = ch >> 5, d = 4 * (ch & 31);
#pragma unroll
        for (int par = 0; par < 2; ++par) { float* tp = T + (2 * pp + par) * 129 + d; tp[0] = acc[i][par].x; tp[1] = acc[i][par].y; tp[2] = acc[i][par].z; tp[3] = acc[i][par].w; } }
    __syncthreads();
    const size_t sb = (size_t)((b * 2 + j) * 2 + dir) * 4 + h;
#pragma unroll 8
    for (int i = 0; i < 32; ++i) { const int idx = tid + 512 * i, d = idx >> 7, e = idx & 127; a.out[O_C + sb * 16384 + idx] = T[e * 129 + d]; }
    if (tid < 128) a.out[O_N + sb * 128 + tid] = nacc;
    if (tid == 0) a.out[O_M + sb] = coef[4];
    LDS_BARRIER();
}

template <bool PROMPT>
__device__ __forceinline__ void unit_mlstm_out(const Args& a, const Ctx& X, int j, int h, int gc) {
    const bf16* U = (const bf16*)(a.ws + WS_U);
    const bf16* CTB = (const bf16*)(a.ws + WS_CTB); const float* NPV = (const float*)(a.ws + WS_NPV); const float* MPV = (const float*)(a.ws + WS_MPV);
    bf16* Z = (bf16*)(a.ws + WS_Z);
    unsigned char* L = X.ldsg;
    bf16* Qs = (bf16*)L; bf16* Ks = (bf16*)(L + 17408); bf16* CT = (bf16*)(L + 34816);
    float* ctm = (float*)(L + 137216); float* bb = ctm + 128; float* wint = bb + 128; float* emt = wint + 128;
    float* nprev = emt + 128;
    float* ssq = nprev + 256;
    const int tid = opaque_v(X.tid), lane = tid & 63, w = opaque_s(X.wave), r = lane & 31, hh = lane >> 5, R0 = gc * 64;
    const int tb = w & 1, eb = w >> 1, tau = 32 * tb + r;
    PROF_BEGIN(23)
    float* coefs = ssq + 256;
    if (!PROMPT) {
        if (tid == 0) { const int bs = (gc - 64) >> 4; const unsigned* c0 = (const unsigned*)(a.ws + WS_CTL + CTL_SCANCNT) + (size_t)(j * 16 + (bs * 4 + h) * 2) * 16;
            unsigned sp = 0; while ((__hip_atomic_load(c0, __ATOMIC_RELAXED, __HIP_MEMORY_SCOPE_AGENT) < 8u || __hip_atomic_load(c0 + 16, __ATOMIC_RELAXED, __HIP_MEMORY_SCOPE_AGENT) < 8u) && ++sp < (1u << 20)) __builtin_amdgcn_s_sleep(2);
            __builtin_amdgcn_fence(__ATOMIC_ACQUIRE, "agent"); asm volatile("s_waitcnt vmcnt(0)" ::: "memory"); }
        __syncthreads();
    } else if (tid == 0 || tid == 64) {
        const int dir = tid >> 6, c = gc & 3; const float* ag = (const float*)(a.ws + WS_AG) + (size_t)((dir * 4 + h) * 96 + (gc - c)) * 2;
        float mm = 0.f, sfx = 0.f;
#pragma unroll
        for (int q = 0; q < 4; ++q) coefs[dir * 4 + q] = 0.f;
        if (dir == 0) { for (int i = 0; i < c; ++i) mm = fmaxf(ag[2 * i + 1] + mm, ag[2 * i]);
            for (int q = c - 1; q >= 0; --q) { coefs[q] = expf(ag[2 * q] + sfx - mm); sfx += ag[2 * q + 1]; } }
        else { for (int i = 3; i > c; --i) mm = fmaxf(ag[2 * i + 1] + mm, ag[2 * i]);
            for (int q = c + 1; q < 4; ++q) { coefs[4 + q] = expf(ag[2 * q] + sfx - mm); sfx += ag[2 * q + 1]; } }
        coefs[8 + dir] = mm; }
    v4u qraw[2], kraw[2], craw[4];
#pragma unroll
    for (int i = 0; i < 2; ++i) { const int q = tid + 512 * i, row = q >> 4, cc = q & 15;
        qraw[i] = *(const v4u*)(U + (size_t)(R0 + row) * UE + CE_QM + h * 128 + 8 * cc);
        kraw[i] = *(const v4u*)(U + (size_t)(R0 + row) * UE + CE_KM + h * 128 + 8 * cc); }
    float npr = 0.f;
    if (!PROMPT) {
#pragma unroll
        for (int i = 0; i < 4; ++i) { const int q = tid + 512 * i, e = q >> 4, cc = q & 15; craw[i] = *(const v4u*)(CTB + (size_t)((0 * 4 + h) * 96 + gc) * 16384 + e * 128 + 8 * cc); }
        npr = tid < 256 ? NPV[(size_t)(((tid >> 7) * 4 + h) * 96 + gc) * 128 + (tid & 127)] : 0.f;
    }
    bh8 vf[4];
#pragma unroll
    for (int q = 0; q < 4; ++q) vf[q] = ld16((const bf16*)(a.ws + WS_VFM) + ((size_t)(((2 * gc + (q >> 1)) * 4 + h) * 8 + eb * 2 + (q & 1))) * 512 + lane * 8);
    f32x4 gq = (f32x4){0.f, 0.f, 0.f, 0.f}; float mp = 0.f;
    if (w < 2) { gq = *(const f32x4*)((const float*)(a.ws + WS_GQ) + ((size_t)(w * 4 + h) * NT + R0 + lane) * 4); if (!PROMPT) mp = MPV[(size_t)((w * 4 + h) * 96 + gc)]; }
    v4u oraw[2], graw[2];
#pragma unroll
    for (int i = 0; i < 2; ++i) { const int q = tid + 512 * i, row = q >> 4, cc = q & 15;
        oraw[i] = *(const v4u*)(U + (size_t)(R0 + row) * UE + CE_OM + h * 128 + 8 * cc); graw[i] = *(const v4u*)(U + (size_t)(R0 + row) * UE + CE_GM + h * 128 + 8 * cc); }
    SB_PIN
#pragma unroll
    for (int i = 0; i < 2; ++i) { const int q = tid + 512 * i, row = q >> 4, cc = q & 15; unsigned char* pp = L + 104448 + row * 256 + ((cc ^ (row & 15)) << 4);
        *(v4u*)pp = oraw[i]; *(v4u*)(pp + 16384) = graw[i]; }
#pragma unroll
    for (int i = 0; i < 2; ++i) { const int q = tid + 512 * i, row = q >> 4, cc = q & 15;
        *(v4u*)(Qs + row * 136 + 8 * cc) = qraw[i]; *(v4u*)(Ks + row * 136 + 8 * cc) = kraw[i]; }
    if (!PROMPT) {
#pragma unroll
        for (int i = 0; i < 4; ++i) { const int q = tid + 512 * i, e = q >> 4, cc = q & 15; *(v4u*)(CT + e * 136 + 8 * cc) = craw[i];
            craw[i] = *(const v4u*)(CTB + (size_t)((1 * 4 + h) * 96 + gc) * 16384 + e * 128 + 8 * cc); }
#pragma unroll
        for (int i = 0; i < 4; ++i) { const int q = tid + 512 * i, e = q >> 4, cc = q & 15; *(v4u*)(CT + 128 * 136 + e * 136 + 8 * cc) = craw[i]; }
        if (tid < 256) nprev[tid] = npr;
    } else {
        __syncthreads();
        const unsigned* LT = (const unsigned*)(a.ws + WS_LT); const float* NL = (const float*)(a.ws + WS_NL); const int c = gc & 3, gc0 = gc - c;
#pragma unroll 1
        for (int dir = 0; dir < 2; ++dir) {
            f32x4 acc[4][2];
#pragma unroll
            for (int i = 0; i < 4; ++i) { acc[i][0] = (f32x4){0.f, 0.f, 0.f, 0.f}; acc[i][1] = (f32x4){0.f, 0.f, 0.f, 0.f}; }
            float nacc = 0.f;
#pragma unroll
            for (int qq = 0; qq < 3; ++qq) { const int q = dir == 0 ? qq : 3 - qq;
                const bool use = dir == 0 ? (q < c) : (q > c);
                if (use) { const float cf = coefs[dir * 4 + q]; const unsigned* src = LT + (size_t)((dir * 4 + h) * 96 + gc0 + q) * 8192 + 4 * tid;
                    v4u raw[4];
#pragma unroll
                    for (int i = 0; i < 4; ++i) raw[i] = *(const v4u*)(src + 2048 * i);
#pragma unroll
                    for (int i = 0; i < 4; ++i) { const v4u x = raw[i];
                        acc[i][0] += cf * (f32x4){bflo(x.x), bflo(x.y), bflo(x.z), bflo(x.w)}; acc[i][1] += cf * (f32x4){bfhi(x.x), bfhi(x.y), bfhi(x.z), bfhi(x.w)}; }
                    if (tid < 128) nacc += cf * NL[(size_t)((dir * 4 + h) * 96 + gc0 + q) * 128 + tid]; } }
#pragma unroll
            for (int i = 0; i < 4; ++i) { const int ch = tid + 512 * i, pp = ch >> 5, d = 4 * (ch & 31);
                st4bf(CT + dir * 128 * 136 + (2 * pp) * 136 + d, acc[i][0].x, acc[i][0].y, acc[i][0].z, acc[i][0].w);
                st4bf(CT + dir * 128 * 136 + (2 * pp + 1) * 136 + d, acc[i][1].x, acc[i][1].y, acc[i][1].z, acc[i][1].w); }
            if (tid < 128) nprev[dir * 128 + tid] = nacc;
        }
        if (w < 2) mp = coefs[8 + w];
    }
    if (w < 2) { const int dir = w; const float cum = gq.x, bv = gq.y, pm = gq.z;
        const float mt = cum + fmaxf(mp, pm);
        ctm[dir * 64 + lane] = cum - mt; bb[dir * 64 + lane] = bv; wint[dir * 64 + lane] = expf(cum + mp - mt); emt[dir * 64 + lane] = expf(-mt); }
    __syncthreads();
    PROF_END(23)
    PROF_BEGIN(24)
    const bf16* qp = Qs + (32 * tb + r) * 136 + 8 * hh;
    bh8 qf[8];
#pragma unroll
    for (int ks = 0; ks < 8; ++ks) qf[ks] = ld16(qp + 16 * ks);
    f32x16 hsum;
    for (int rpb_ = 0; rpb_ < RU_OUT_B; ++rpb_) {
#pragma unroll
    for (int i = 0; i < 16; ++i) hsum[i] = 0.f;
#pragma unroll 1
    for (int dir = 0; dir < 2; ++dir) {
        const int sgn = 1 - 2 * dir;
        const bf16* CTd = CT + dir * 128 * 136; const float* npv = nprev + dir * 128;
        const float ct = ctm[dir * 64 + tau], wi = wint[dir * 64 + tau];
        float rs = 0.f, qd = 0.f;
        f32x16 accv;
#pragma unroll
        for (int i = 0; i < 16; ++i) accv[i] = 0.f;
#pragma unroll
        for (int sb = 0; sb < 2; ++sb) {
            bh8 kf[8]; f32x16 ps;
#pragma unroll
            for (int ks = 0; ks < 8; ++ks) kf[ks] = ld16(Ks + (32 * sb + r) * 136 + 16 * ks + 8 * hh);
#pragma unroll
            for (int i = 0; i < 16; ++i) ps[i] = 0.f;
#pragma unroll
            for (int ks = 0; ks < 8; ++ks) ps = mfma32(kf[ks], qf[ks], ps);
#pragma unroll
            for (int g = 0; g < 4; ++g) { const f32x4 b4 = *(const f32x4*)(bb + dir * 64 + 32 * sb + 8 * g + 4 * hh);
#pragma unroll
                for (int e = 0; e < 4; ++e) { const int dd = (32 * sb + 8 * g + 4 * hh + e - tau) * sgn; const bool ok = dd <= 0;
                    const float v = ok ? ps[4 * g + e] * KSC * __expf(ct + b4[e]) : 0.f; ps[4 * g + e] = v; rs += v; } }
            accv = mfma32(vf[2 * sb], pfrag(ps, 0), accv);
            accv = mfma32(vf[2 * sb + 1], pfrag(ps, 1), accv);
            __builtin_amdgcn_sched_barrier(0);
        }
        rs += __shfl_xor(rs, 32);
#pragma unroll
        for (int ks = 0; ks < 8; ++ks) { const v4u qq = __builtin_bit_cast(v4u, qf[ks]); const f32x4 n0 = *(const f32x4*)(npv + 16 * ks + 8 * hh), n1 = *(const f32x4*)(npv + 16 * ks + 8 * hh + 4);
            qd += bflo(qq.x) * n0.x + bfhi(qq.x) * n0.y + bflo(qq.y) * n0.z + bfhi(qq.y) * n0.w + bflo(qq.z) * n1.x + bfhi(qq.z) * n1.y + bflo(qq.w) * n1.z + bfhi(qq.w) * n1.w;
            if ((ks & 1) == 1) __builtin_amdgcn_sched_barrier(0); }
        qd += __shfl_xor(qd, 32);
        __builtin_amdgcn_sched_barrier(0);
        bh8 cf[8];
#pragma unroll
        for (int ks = 0; ks < 8; ++ks) cf[ks] = ld16(CTd + (32 * eb + r) * 136 + 16 * ks + 8 * hh);
        const float qn = wi * qd + rs;
        f32x16 acc;
#pragma unroll
        for (int i = 0; i < 16; ++i) acc[i] = 0.f;
#pragma unroll
        for (int ks = 0; ks < 8; ++ks) acc = mfma32(cf[ks], qf[ks], acc);
#pragma unroll
        for (int i = 0; i < 16; ++i) acc[i] = acc[i] * wi + accv[i];
        const float inv = 1.f / fmaxf(fabsf(qn), emt[dir * 64 + tau]);
#pragma unroll
        for (int i = 0; i < 16; ++i) hsum[i] += acc[i] * inv;
        __builtin_amdgcn_sched_barrier(0);
    }
    }
    PROF_END(24)
    PROF_BEGIN(25)
    { float ss = 0.f;
#pragma unroll
      for (int i = 0; i < 16; ++i) ss += hsum[i] * hsum[i];
      ss += __shfl_xor(ss, 32);
      if (hh == 0) ssq[(tb * 4 + eb) * 32 + r] = ss; }
    __syncthreads();
    { const int tid2 = opaque_v(tid), lane2 = tid2 & 63, w2 = opaque_s(w), r2 = lane2 & 31, hh2 = lane2 >> 5, tb2 = w2 & 1, eb2 = w2 >> 1, tau2 = 32 * tb2 + r2;
    { const float tot = ssq[(tb2 * 4 + 0) * 32 + r2] + ssq[(tb2 * 4 + 1) * 32 + r2] + ssq[(tb2 * 4 + 2) * 32 + r2] + ssq[(tb2 * 4 + 3) * 32 + r2];
      const float rstd = rsqrtf(tot * (1.f / 128.f) + EPS);
      const int row = R0 + tau2; const float* hn = a.in[23] + j * 512 + h * 128;
      f32x4 gnv[4];
#pragma unroll
      for (int g = 0; g < 4; ++g) gnv[g] = *(const f32x4*)(hn + 32 * eb2 + 8 * g + 4 * hh2);
      SB_PIN
#pragma unroll
      for (int g = 0; g < 4; ++g) { const int e0 = 32 * eb2 + 8 * g + 4 * hh2; const f32x4 gn = gnv[g]; const unsigned char* pp = L + 104448 + tau2 * 256 + (((4 * eb2 + g) ^ (tau2 & 15)) << 4) + 8 * hh2; const v2u om = *(const v2u*)pp, gm = *(const v2u*)(pp + 16384);
          st4bf((bf16*)L + tau2 * 136 + e0,
                hsum[4 * g] * rstd * gn.x * sigmoid_f(bflo(om.x)) * silu_f(bflo(gm.x)), hsum[4 * g + 1] * rstd * gn.y * sigmoid_f(bfhi(om.x)) * silu_f(bfhi(gm.x)),
                hsum[4 * g + 2] * rstd * gn.z * sigmoid_f(bflo(om.y)) * silu_f(bflo(gm.y)), hsum[4 * g + 3] * rstd * gn.w * sigmoid_f(bfhi(om.y)) * silu_f(bfhi(gm.y))); } }
    }
    __syncthreads();
#pragma unroll
    for (int i = 0; i < 2; ++i) { const int q = opaque_v(X.tid) + 512 * i, row = q >> 4, cc = q & 15; *(v4u*)(Z + (size_t)(gc * 64 + row) * DM + 512 + h * 128 + 8 * cc) = *(const v4u*)((const bf16*)X.ldsg + row * 136 + 8 * cc); }
    LDS_BARRIER();
    PROF_END(25)
}

constexpr int NPHASES = 15;


#ifndef G1_ALIGN
#define G1_ALIGN true
#endif
#ifndef G1_SP2
#define G1_SP2 true
#endif
#ifndef G2_ALIGN
#define G2_ALIGN true
#endif
#ifndef G2_SP2
#define G2_SP2 true
#endif
#ifndef RU_Q
#define RU_Q 1
#endif
#ifndef RU_KV
#define RU_KV 1
#endif
#ifndef RU_L
#define RU_L 1
#endif
#ifndef RU_ATTS
#define RU_ATTS 1
#endif
#ifndef RU_SCAN
#define RU_SCAN 1
#endif
#ifndef RU_OUT
#define RU_OUT 1
#endif
#ifndef RU_ATTP
#define RU_ATTP 1
#endif
#ifndef RU_NA
#define RU_NA 1
#endif
#ifndef RU_OATT
#define RU_OATT 1
#endif
#ifndef RU_CONV
#define RU_CONV 1
#endif
#ifndef RU_SIDE
#define RU_SIDE 1
#endif
#define REPU(n, call) for (int rp_ = 0; rp_ < (n); ++rp_) { call; }
#define PU(id, stmt) { PROF_BEGIN(id) stmt PROF_END(id) }
__device__ __forceinline__ void phase_gemm1(const Args& a, const Ctx& X, int l) {
    const int j = l >> 1; const bool even = (l & 1) == 0;
    pg8::Gemm g{(const bf16*)(a.ws + WS_H), even ? (const bf16*)(a.ws + WS_WTEV) + (size_t)j * 3584 * 1024 : (const bf16*)(a.ws + WS_WTOD) + (size_t)j * 4096 * 1024, NT, even ? UE : UO, DM};
    pg8::StaticOrder S; S.init(NT, even ? UE : UO, X.G, X.bid, pg8::EpiU::BMA_ROWS);
    pg8::EpiU E{(bf16*)(a.ws + WS_U), even ? UE : UO, even ? (float*)(a.ws + WS_GATES) : nullptr, even ? nullptr : (bf16*)(a.ws + WS_VTO), even ? nullptr : (bf16*)(a.ws + WS_KFO), even ? (bf16*)(a.ws + WS_VFM) : nullptr};
    pg8::gemm_phase<pg8::EpiU, pg8::StaticOrder, G1_ALIGN, G1_SP2>(X.lds, g, S, E);
    if ((l == 0 || l == 2) && X.bid >= 192) { PROF_BEGIN(35) prep_side(a, X, l == 0 ? 0 : 3); PROF_END(35) }
}
__device__ __forceinline__ void phase_gemm2(const Args& a, const Ctx& X, int l) {
    pg8::Gemm g{(const bf16*)(a.ws + WS_Z), (const bf16*)(a.ws + WS_WTOUT) + (size_t)l * 1024 * 1024, NT, DM, DM};
    pg8::StaticOrder S; S.init(NT, DM, X.G, X.bid, pg8::EpiY::BMA_ROWS);
    const float* ysp = l == 0 ? a.in[0] : a.out; const float* yss = l == 0 ? a.in[1] : a.out + (size_t)NP * DM;
    const float* modl = (const float*)(a.ws + WS_MOD) + l * 3 * 3072;
    if (X.bid >= 192) { if (l < 3) { PROF_BEGIN(35) prep_side(a, X, l == 0 ? 1 : l == 1 ? 2 : 4); PROF_END(35) } return; }
    if (l < 3) {
        unsigned* xs = (unsigned*)(a.ws + WS_XS) + (size_t)l * 48 * 4 * 128; unsigned* cnt = (unsigned*)(a.ws + WS_CTL + CTL_NCNT) + l * 48 * 16;
        if (l == 0) { pg8::EpiYN<false> E{(bf16*)(a.ws + WS_YB), ysp, yss, modl, (bf16*)(a.ws + WS_H), a.in[11] + (l + 1) * DM, modl + 3 * 3072, xs, cnt};
            pg8::gemm_phase<pg8::EpiYN<false>, pg8::StaticOrder, false, G2_SP2>(X.lds, g, S, E); }
        else { pg8::EpiYN<true> E{(bf16*)(a.ws + WS_YB), nullptr, nullptr, modl, (bf16*)(a.ws + WS_H), a.in[11] + (l + 1) * DM, modl + 3 * 3072, xs, cnt};
            pg8::gemm_phase<pg8::EpiYN<true>, pg8::StaticOrder, false, G2_SP2>(X.lds, g, S, E); }
    } else {
        pg8::EpiY E{a.out, (const bf16*)(a.ws + WS_YB), modl};
        pg8::gemm_phase<pg8::EpiY, pg8::StaticOrder, G2_ALIGN, G2_SP2>(X.lds, g, S, E);
    }
}
__device__ __forceinline__ void phase_e2(const Args& a, const Ctx& X, int j) {
    const int b = X.bid;
    for (int s = 0; s < 4; ++s) {
        int u;
        if (b < 200) { if (s == 0) u = b; else if (s == 1) u = 200 + b; else break; }
        else { u = 400 + (b - 200) + 56 * s; if (u >= 584) break; }
        if (u < 96) PU(10, REPU(RU_Q, unit_mla_q(a, X, j, u)))
        else if (u < 200) PU(11, REPU(RU_KV, unit_mla_kv(a, X, j, u < 192 ? u - 96 : -1 - (u - 192))))
        else { const int v = u - 200; PU(12, REPU(RU_L, unit_mlstm_L(a, X, j, v / 96, v % 96))) }
    }
}
__device__ __forceinline__ int xmap16(int b) { return ((b & 7) * 2 + (b >> 7)) * 16 + ((b >> 3) & 15); }
__device__ __forceinline__ int xmap_op(int b) { const int slot = b >> 3, grp = (b & 7) * 8 + (slot >> 2); return (grp >> 4) * 64 + (grp & 15) * 4 + (slot & 3); }
__device__ __forceinline__ int xmap_fin(int b) { const int s2 = (b >> 3) - 16, grp = (b & 7) * 8 + (s2 >> 1); return (grp & 15) * 8 + (grp >> 4) * 2 + (s2 & 1); }
__device__ __forceinline__ int xmap_p(int b) { const int s2 = (b >> 3) - 16; return ((b & 7) * 8 + (s2 >> 1)) * 2 + (s2 & 1); }
__device__ __forceinline__ void phase_e3(const Args& a, const Ctx& X, int j) {
    const int b = X.bid;
    for (int s = 0; s < 5; ++s) {
        int kind, idx;
        if (b < 128) { if (s == 0) { kind = 0; idx = b; } else if (s == 1) { kind = 1; idx = xmap16(b); } else if (s == 2) { kind = 3; idx = xmap_op(b); } else if (s == 3) { kind = 4; idx = b; } else break; }
        else { if (s == 0) { kind = 1; idx = xmap16(b); } else if (s == 1) { kind = 3; idx = xmap_op(b); } else if (s == 2) { kind = 2; idx = xmap_p(b); } else if (s == 3) { kind = 2; idx = 128 + xmap_p(b); } else { kind = 5; idx = xmap_fin(b); } }
        if (kind == 0) PU(14, REPU(RU_SCAN, unit_mlstm_scan(a, X, j, idx)))
        else if (kind == 1) PU(13, REPU(RU_ATTS, unit_mla_attn(a, X, idx)))
        else if (kind == 2) PU(16, REPU(RU_ATTP, unit_mla_attn(a, X, 256 + idx)))
        else if (kind == 3) PU(15, REPU(RU_OUT, unit_mlstm_out<true>(a, X, j, idx >> 6, idx & 63)))
        else if (kind == 4) PU(15, REPU(RU_OUT, unit_mlstm_out<false>(a, X, j, idx >> 5, 64 + (idx & 31))))
        else PU(18, REPU(RU_OATT, unit_mlstm_fin(a, X, j, idx)))
    }
}
__device__ __forceinline__ void phase_o2(const Args& a, const Ctx& X, int j) {
    PU(17, REPU(RU_NA, unit_o2_combo(a, X, j, xmap16(X.bid))))
}


#ifndef REP_P0A
#define REP_P0A 1
#endif
#ifndef REP_NORM
#define REP_NORM 1
#endif
#ifndef REP_G1
#define REP_G1 1
#endif
#ifndef REP_E2
#define REP_E2 1
#endif
#ifndef REP_G2L0
#define REP_G2L0 1
#endif
#ifndef REP_E2B
#define REP_E2B 1
#endif
#ifndef REP_E3
#define REP_E3 1
#endif
#ifndef REP_O2
#define REP_O2 1
#endif
#ifndef PHMASK
#define PHMASK 0x7f
#endif
#define PH_NOP(...) ((void)0)
#if PHMASK & 1
#define PH_P0A phase_p0a
#else
#define PH_P0A PH_NOP
#endif
#if PHMASK & 2
#define PH_NORM phase_norm
#else
#define PH_NORM PH_NOP
#endif
#if PHMASK & 4
#define PH_G1 phase_gemm1
#else
#define PH_G1 PH_NOP
#endif
#if PHMASK & 8
#define PH_E2 phase_e2
#else
#define PH_E2 PH_NOP
#endif
#if PHMASK & 16
#define PH_E3 phase_e3
#else
#define PH_E3 PH_NOP
#define PH_E2B PH_NOP
#endif
#if PHMASK & 32
#define PH_O2 phase_o2
#else
#define PH_O2 PH_NOP
#endif
#if PHMASK & 64
#define PH_G2 phase_gemm2
#else
#define PH_G2 PH_NOP
#endif
__global__ void __launch_bounds__(NTHR, 2) mega_fwd(Args args) {
    extern __shared__ __attribute__((aligned(16))) unsigned char lds[];
    Ctx X; X.lds = (LAS unsigned char*)lds; X.ldsg = lds;
    X.tid = threadIdx.x; X.lane = X.tid & 63; X.wave = __builtin_amdgcn_readfirstlane(X.tid >> 6); X.G = gridDim.x; X.bid = blockIdx.x;
    volatile LAS unsigned* MISC = (volatile LAS unsigned*)(X.lds + MISC_OFF);
    if (X.tid < 32) MISC[X.tid] = 0u;
    __syncthreads();
    const int lo = args.ph_lo, hi = args.ph_hi;
    XcdBarrier bar; bar.bar = (unsigned*)(args.ws + WS_CTL) + CW_BAR; bar.x = 0; bar.st = MISC + 8;
    if (hi - lo > 1) bar = xcd_barrier_post((unsigned*)(args.ws + WS_CTL) + CW_BAR, MISC + 8);
    int ph = 0;
#define RUN(pid, n, body) do { if (ph >= lo && ph < hi) { for (int rp = 0; rp < (n); ++rp) { { PROF_BEGIN(pid) body; PROF_END(pid) } if (ph + 1 < hi || rp + 1 < (n)) { PROF_BEGIN(9) xcd_barrier(bar); PROF_END(9) } } } ++ph; } while (0)
    RUN(1, REP_P0A, PH_P0A(args, X));
    for (int l = 0; l < 4; ++l) {
        const int j = l >> 1;
        RUN(3, REP_G1, PH_G1(args, X, l));
        if ((l & 1) == 0) { RUN(4, REP_E2, PH_E2(args, X, j)); RUN(6, REP_E3, PH_E3(args, X, j)); }
        else { RUN(7, REP_O2, PH_O2(args, X, j)); }
        RUN(8, l == 0 ? REP_G2L0 : 1, PH_G2(args, X, l));
    }
#undef RUN
    if (PROF_ID != 0 && threadIdx.x == 0) { const unsigned long long t0 = __builtin_amdgcn_s_memrealtime(); const unsigned long long w = (unsigned long long)PROF_K * ((volatile LAS unsigned*)(X.lds + MISC_OFF))[16];
        while (__builtin_amdgcn_s_memrealtime() - t0 < w) __builtin_amdgcn_s_sleep(8); }
}

#ifndef MK_SPLIT
#define MK_SPLIT 0
#endif

extern "C" void kernel_launch(void* const* d_in, const int* in_sizes, int n_in, void* d_out, int out_size, void* d_ws, size_t ws_size, hipStream_t stream) {
    static int ready = 0;
    if (!ready) {
        if (hipFuncSetAttribute((const void*)mega_fwd, hipFuncAttributeMaxDynamicSharedMemorySize, LDS_BYTES) != hipSuccess) fprintf(stderr, "kernel_launch: hipFuncSetAttribute failed\n");
        int per_cu = 0;
        if (hipOccupancyMaxActiveBlocksPerMultiprocessor(&per_cu, (const void*)mega_fwd, NTHR, LDS_BYTES) != hipSuccess || per_cu < 1) fprintf(stderr, "kernel_launch: occupancy query says %d blocks per CU\n", per_cu);
        (void)hipGetLastError();
        ready = 1;
    }
    (void)hipMemsetAsync((char*)d_ws + WS_CTL, 0, CTL_ZERO_BYTES, stream);
    Args a{};
    for (int i = 0; i < 32; ++i) a.in[i] = (const float*)d_in[i];
    a.out = (float*)d_out; a.ws = (unsigned char*)d_ws;
#if MK_SPLIT
    for (int p = 0; p < NPHASES; ++p) { a.ph_lo = p; a.ph_hi = p + 1; hipLaunchKernelGGL(mega_fwd, dim3(256), dim3(NTHR), LDS_BYTES, stream, a); }
#else
    a.ph_lo = 0; a.ph_hi = NPHASES;
    hipLaunchKernelGGL(mega_fwd, dim3(256), dim3(NTHR), LDS_BYTES, stream, a);
#endif
}
```
